# Optimizing an MI355X kernel written in HIP

```python
import jax, jax.numpy as jnp
from jax import lax
import numpy as np

D_MODEL = 1024
BATCH = 2
SEQ = 8192
DEPTH = 1

N_MEM = 256
EPS = 1e-6
MLSTM_HEADS = 4
MLSTM_HEAD_DIM = D_MODEL // MLSTM_HEADS
MLSTM_DIM = MLSTM_HEADS * MLSTM_HEAD_DIM
MLSTM_CHUNK = 128
CONV_WIDTH = 4
SGU_GROUPS = 8
SGU_GROUP_DIM = D_MODEL // SGU_GROUPS
SGU_DIM = SGU_GROUPS * SGU_GROUP_DIM
SGU_CHUNK = 128
N_BRANCH = 2
IN_WIDTHS = (2 * MLSTM_DIM, MLSTM_DIM, MLSTM_DIM, MLSTM_HEADS, MLSTM_HEADS, SGU_DIM, SGU_DIM, N_BRANCH * D_MODEL)
IN_DIM = sum(IN_WIDTHS)
SPLIT_POINTS = tuple(int(s) for s in np.cumsum(IN_WIDTHS)[:-1])
XATTN_HEADS = 4
XATTN_HEAD_DIM = D_MODEL // XATTN_HEADS
XATTN_DIM = XATTN_HEADS * XATTN_HEAD_DIM
MOE_GROUPS = 4
EXPERTS_PER_GROUP = 8
N_EXPERTS = MOE_GROUPS * EXPERTS_PER_GROUP
MOE_TOPK = 2
EXPERT_FF = D_MODEL // 2
MOE_BLOCK = 128

kernel_name = 'hybrid_mlstm_sgu_xattn_hmoe'


def rmsnorm(x, g):
    x32 = x.astype(jnp.float32)
    y = x32 * lax.rsqrt(jnp.mean(x32 * x32, axis=-1, keepdims=True) + EPS)
    return (y * g.astype(jnp.float32)).astype(x.dtype)


def causal_depthwise_conv(x, w, b):
    c = x.shape[-1]
    y = lax.conv_general_dilated(x, w[:, None, :].astype(x.dtype), window_strides=(1,),
                                 padding=[(CONV_WIDTH - 1, 0)],
                                 dimension_numbers=('NWC', 'WIO', 'NWC'),
                                 feature_group_count=c)
    return y + b.astype(x.dtype)


def mlstm_chunkwise(q, k, v, i_pre, f_pre):
    B, S, H, dh = q.shape
    L = MLSTM_CHUNK
    nc = S // L
    f32 = jnp.float32

    def to_chunks(a):
        return a.astype(f32).reshape(B, nc, L, H, dh).transpose(1, 0, 3, 2, 4)

    qc = to_chunks(q)
    kc = to_chunks(k) * (dh ** -0.5)
    vc = to_chunks(v)
    logf = jax.nn.log_sigmoid(f_pre.astype(f32)).reshape(B, nc, L, H).transpose(1, 0, 3, 2)
    ig = i_pre.astype(f32).reshape(B, nc, L, H).transpose(1, 0, 3, 2)
    causal = jnp.tril(jnp.ones((L, L), dtype=bool))

    def step(carry, inp):
        C, n, m = carry
        q_, k_, v_, lf, ic = inp
        b = jnp.cumsum(lf, axis=-1)
        dmat = jnp.where(causal, b[..., :, None] - b[..., None, :] + ic[..., None, :], -jnp.inf)
        inter = b + m[..., None]
        m_t = jnp.maximum(inter, jnp.max(dmat, axis=-1))
        dexp = jnp.exp(dmat - m_t[..., None])
        inter_w = jnp.exp(inter - m_t)
        s = jnp.einsum('bhtd,bhsd->bhts', q_, k_) * dexp
        num = jnp.einsum('bhts,bhsd->bhtd', s, v_) + inter_w[..., None] * jnp.einsum('bhtd,bhde->bhte', q_, C)
        den = jnp.sum(s, axis=-1) + inter_w * jnp.einsum('bhtd,bhd->bht', q_, n)
        h = num / jnp.maximum(jnp.abs(den), jnp.exp(-m_t))[..., None]
        b_last = b[..., -1]
        w_log = b_last[..., None] - b + ic
        m_new = jnp.maximum(b_last + m, jnp.max(w_log, axis=-1))
        decay = jnp.exp(b_last + m - m_new)
        ws = jnp.exp(w_log - m_new[..., None])
        C_new = decay[..., None, None] * C + jnp.einsum('bhs,bhsd,bhse->bhde', ws, k_, v_)
        n_new = decay[..., None] * n + jnp.einsum('bhs,bhsd->bhd', ws, k_)
        return (C_new, n_new, m_new), h

    init = (jnp.zeros((B, H, dh, dh), f32), jnp.zeros((B, H, dh), f32), jnp.zeros((B, H), f32))
    _, hs = lax.scan(step, init, (qc, kc, vc, logf, ig))
    return hs.transpose(1, 0, 3, 2, 4).reshape(B, S, H, dh).astype(q.dtype)


def spatial_gating(u, v, sgu_norm_g, w_s, b_s):
    B, S, _ = u.shape
    nc = S // SGU_CHUNK
    u = jax.nn.gelu(u)
    v = rmsnorm(jax.nn.gelu(v), sgu_norm_g)
    vb = v.reshape(B, nc, SGU_CHUNK, SGU_GROUPS, SGU_GROUP_DIM)
    w_causal = jnp.tril(w_s).astype(v.dtype)
    mixed = jnp.einsum('gts,bcsgd->bctgd', w_causal, vb) + b_s.T.astype(v.dtype)[:, :, None]
    return u * mixed.reshape(B, S, SGU_DIM)


def hybrid_mixer(xn, w_in, b_gate, b_if, conv_w, conv_b, mh_norm_g, sgu_norm_g, w_s, b_s, w_out):
    B, S, _ = xn.shape
    proj = xn @ w_in
    qk, v, o, i_pre, f_pre, u, sv, gates = jnp.split(proj, SPLIT_POINTS, axis=-1)
    qk = jax.nn.silu(causal_depthwise_conv(qk, conv_w, conv_b))
    q, k = jnp.split(qk, 2, axis=-1)
    b_i, b_f = jnp.split(b_if, 2)
    hd = (B, S, MLSTM_HEADS, MLSTM_HEAD_DIM)
    h = mlstm_chunkwise(q.reshape(hd), k.reshape(hd), v.reshape(hd), i_pre + b_i, f_pre + b_f)
    y_a = rmsnorm(h, mh_norm_g.reshape(MLSTM_HEADS, MLSTM_HEAD_DIM)).reshape(B, S, MLSTM_DIM) * jax.nn.sigmoid(o)
    y_b = spatial_gating(u, sv, sgu_norm_g, w_s, b_s)
    g_a, g_b = jnp.split(jax.nn.sigmoid(gates + b_gate), 2, axis=-1)
    return (g_a * y_a + g_b * y_b) @ w_out


def memory_cross_attention(xn, mn, w_xq, w_xkv, w_xo):
    B, S, _ = xn.shape
    M = mn.shape[1]
    q = (xn @ w_xq).reshape(B, S, XATTN_HEADS, XATTN_HEAD_DIM)
    k, v = jnp.split(mn @ w_xkv, 2, axis=-1)
    k = k.reshape(B, M, XATTN_HEADS, XATTN_HEAD_DIM)
    v = v.reshape(B, M, XATTN_HEADS, XATTN_HEAD_DIM)
    scores = jnp.einsum('bshd,bmhd->bhsm', q, k).astype(jnp.float32) * (XATTN_HEAD_DIM ** -0.5)
    p = jax.nn.softmax(scores, axis=-1).astype(v.dtype)
    out = jnp.einsum('bhsm,bmhd->bshd', p, v).reshape(B, S, XATTN_DIM)
    return out @ w_xo


def hierarchical_moe(xn, w_rg, b_rg, w_re, b_re, w1, w3, w2):
    B, S, D = xn.shape
    N = B * S
    xt = xn.reshape(N, D)
    g_logits = (xt @ w_rg + b_rg).astype(jnp.float32)
    g_idx = jnp.argmax(g_logits, axis=-1)
    p_g = jnp.take_along_axis(jax.nn.softmax(g_logits, axis=-1), g_idx[:, None], axis=1)
    e_logits = (xt @ w_re + b_re).astype(jnp.float32).reshape(N, MOE_GROUPS, EXPERTS_PER_GROUP)
    e_in_group = jnp.take_along_axis(e_logits, g_idx[:, None, None], axis=1)[:, 0]
    top_v, top_i = lax.top_k(e_in_group, MOE_TOPK)
    gate = p_g * jax.nn.softmax(top_v, axis=-1)
    expert = g_idx[:, None].astype(jnp.int32) * EXPERTS_PER_GROUP + top_i.astype(jnp.int32)

    A = N * MOE_TOPK
    e_flat = expert.reshape(A)
    tok_flat = jnp.repeat(jnp.arange(N, dtype=jnp.int32), MOE_TOPK)
    order = jnp.argsort(e_flat)
    e_sorted = e_flat[order]
    counts = jnp.bincount(e_flat, length=N_EXPERTS)
    starts = jnp.cumsum(counts) - counts
    padded = (counts + MOE_BLOCK - 1) // MOE_BLOCK * MOE_BLOCK
    pends = jnp.cumsum(padded)
    pstarts = pends - padded
    dest_sorted = (pstarts[e_sorted] + jnp.arange(A, dtype=jnp.int32) - starts[e_sorted]).astype(jnp.int32)
    n_blocks = -(-A // MOE_BLOCK) + N_EXPERTS
    P = n_blocks * MOE_BLOCK
    buf_tok = jnp.zeros((P,), jnp.int32).at[dest_sorted].set(tok_flat[order])
    block_expert = jnp.minimum(
        jnp.searchsorted(pends, jnp.arange(n_blocks, dtype=jnp.int32) * MOE_BLOCK, side='right'),
        N_EXPERTS - 1).astype(jnp.int32)

    def block_ffn(args):
        tok, e = args
        xb = xt[tok]
        hb = jax.nn.silu(xb @ w1[e]) * (xb @ w3[e])
        return hb @ w2[e]

    out_buf = lax.map(block_ffn, (buf_tok.reshape(n_blocks, MOE_BLOCK), block_expert)).reshape(P, D)
    dest = jnp.zeros((A,), jnp.int32).at[order].set(dest_sorted)
    y_assign = out_buf[dest].reshape(N, MOE_TOPK, D)
    y = jnp.einsum('nk,nkd->nd', gate.astype(xt.dtype), y_assign)
    return y.reshape(B, S, D)


def setup_inputs(seed: int = 0) -> dict:
    key = jax.random.key(seed)
    ks = jax.random.split(key, 32)
    D, L = D_MODEL, DEPTH

    def nrm(k, shape, scale):
        return jax.random.normal(k, shape, jnp.float32) * scale

    def gain(k, shape):
        return 1.0 + 0.02 * jax.random.normal(k, shape, jnp.float32)

    b_i = nrm(ks[4], (L, MLSTM_HEADS), 0.1)
    b_f = jnp.linspace(3.0, 6.0, MLSTM_HEADS, dtype=jnp.float32)[None, :] + nrm(ks[5], (L, MLSTM_HEADS), 0.1)
    return {
        'x': nrm(ks[0], (BATCH, SEQ, D), 1.0),
        'mem': nrm(ks[1], (BATCH, N_MEM, D), 1.0),
        'norm_mix_g': gain(ks[2], (L, D)),
        'w_in': nrm(ks[3], (L, D, IN_DIM), D ** -0.5),
        'b_gate': nrm(ks[6], (L, N_BRANCH * D), 0.02),
        'b_if': jnp.concatenate([b_i, b_f], axis=-1),
        'conv_w': nrm(ks[7], (L, CONV_WIDTH, 2 * MLSTM_DIM), CONV_WIDTH ** -0.5),
        'conv_b': nrm(ks[8], (L, 2 * MLSTM_DIM), 0.02),
        'mh_norm_g': gain(ks[9], (L, MLSTM_DIM)),
        'sgu_norm_g': gain(ks[10], (L, SGU_DIM)),
        'w_s': nrm(ks[11], (L, SGU_GROUPS, SGU_CHUNK, SGU_CHUNK), SGU_CHUNK ** -0.5),
        'b_s': gain(ks[12], (L, SGU_GROUPS, SGU_CHUNK)),
        'w_out': nrm(ks[13], (L, D, D), D ** -0.5),
        'norm_x_g': gain(ks[14], (L, D)),
        'norm_mem_g': gain(ks[15], (L, D)),
        'w_xq': nrm(ks[16], (L, D, XATTN_DIM), D ** -0.5),
        'w_xkv': nrm(ks[17], (L, D, 2 * XATTN_DIM), D ** -0.5),
        'w_xo': nrm(ks[18], (L, XATTN_DIM, D), XATTN_DIM ** -0.5),
        'norm_moe_g': gain(ks[19], (L, D)),
        'w_rg': nrm(ks[20], (L, D, MOE_GROUPS), D ** -0.5),
        'b_rg': nrm(ks[21], (L, MOE_GROUPS), 0.01),
        'w_re': nrm(ks[22], (L, D, N_EXPERTS), D ** -0.5),
        'b_re': nrm(ks[23], (L, N_EXPERTS), 0.01),
        'w1': nrm(ks[24], (L, N_EXPERTS, D, EXPERT_FF), D ** -0.5),
        'w3': nrm(ks[25], (L, N_EXPERTS, D, EXPERT_FF), D ** -0.5),
        'w2': nrm(ks[26], (L, N_EXPERTS, EXPERT_FF, D), EXPERT_FF ** -0.5),
        'norm_f_g': gain(ks[27], (D,)),
    }


def reference(x, mem, norm_mix_g, w_in, b_gate, b_if, conv_w, conv_b, mh_norm_g, sgu_norm_g, w_s, b_s, w_out,
              norm_x_g, norm_mem_g, w_xq, w_xkv, w_xo, norm_moe_g, w_rg, b_rg, w_re, b_re, w1, w3, w2, norm_f_g):
    for l in range(DEPTH):
        x = x + hybrid_mixer(rmsnorm(x, norm_mix_g[l]), w_in[l], b_gate[l], b_if[l], conv_w[l], conv_b[l],
                             mh_norm_g[l], sgu_norm_g[l], w_s[l], b_s[l], w_out[l])
        x = x + memory_cross_attention(rmsnorm(x, norm_x_g[l]), rmsnorm(mem, norm_mem_g[l]),
                                       w_xq[l], w_xkv[l], w_xo[l])
        x = x + hierarchical_moe(rmsnorm(x, norm_moe_g[l]), w_rg[l], b_rg[l], w_re[l], b_re[l],
                                 w1[l], w3[l], w2[l])
    return rmsnorm(x, norm_f_g)
```

```cpp
#include <hip/hip_runtime.h>
#include <cstdio>
#include <cstdint>
#include <cmath>

typedef _Float16 h16;
typedef unsigned short u16;

constexpr int DM = 1024, NB = 2, SEQ = 8192, NTOK = NB * SEQ;
constexpr int NMEM = 256, NHEAD = 4, DH = 256, CHUNK = 128, NCHUNK = SEQ / CHUNK;
constexpr int IN_DIM = 8200;
constexpr int C_QK = 0, C_V = 2048, C_O = 3072, C_I = 4096, C_F = 4100, C_U = 4104, C_SV = 5128, C_G = 6152;
constexpr int NEXP = 32, NGRP = 4, EPG = 8, FF = 512, NSLOT = NTOK * 2;
constexpr float EPS = 1e-6f;

constexpr size_t MiB = 1u << 20;
constexpr size_t WS_CTL = 0;
constexpr size_t CTL_BYTES = 1 * MiB;
constexpr size_t WS_SMALL = 1 * MiB;
constexpr size_t OFF_RSTD0 = WS_SMALL;
constexpr size_t OFF_SSSV  = OFF_RSTD0 + 65536;
constexpr size_t OFF_SS1   = OFF_SSSV + 65536;
constexpr size_t OFF_SS2   = OFF_SS1 + 65536;
constexpr size_t OFF_IG    = OFF_SS2 + 65536;
constexpr size_t OFF_LF    = OFF_IG + 262144;
constexpr size_t OFF_MST   = OFF_LF + 262144;
constexpr size_t OFF_RSTDM = OFF_MST + 4096;
constexpr size_t OFF_AL    = 4 * MiB + 1048576;
constexpr size_t OFF_BE    = OFF_AL + 262144;
constexpr size_t OFF_NM    = OFF_BE + 262144;
constexpr size_t OFF_WU    = OFF_NM + 262144;
constexpr size_t OFF_DEC   = OFF_WU + 262144;
constexpr size_t OFF_WRT   = 7 * MiB;
constexpr size_t OFF_GATE  = 2 * MiB;
constexpr size_t OFF_SLOTE = OFF_GATE + 131072;
constexpr size_t OFF_SLOTP = OFF_SLOTE + 131072;
constexpr size_t OFF_LIST  = 3 * MiB;
constexpr size_t OFF_NAIVE_C = 262 * MiB;
constexpr size_t OFF_NAIVE_N = 6 * MiB + 8192;
constexpr size_t OFF_NAIVE_S = 6 * MiB + 65536;
constexpr size_t WS_WSM  = 8 * MiB;
constexpr size_t WS_KM   = 18 * MiB;
constexpr size_t WS_VTM  = 19 * MiB;
constexpr size_t WS_WIN  = 20 * MiB;
constexpr size_t WS_XH   = 36 * MiB;
constexpr size_t WS_V    = 68 * MiB;
constexpr size_t WS_OG   = 100 * MiB;
constexpr size_t WS_UG   = 132 * MiB;
constexpr size_t WS_SV   = 164 * MiB;
constexpr size_t WS_CST  = 196 * MiB;
constexpr size_t WS_H    = 228 * MiB;
constexpr size_t WS_NST  = 260 * MiB;
constexpr size_t WS_MEMH = 261 * MiB;
constexpr size_t WS_END  = 268 * MiB;
constexpr size_t WS_Y    = WS_XH;
constexpr size_t WS_QC   = WS_UG;
constexpr size_t WS_KC   = WS_SV;
static_assert(OFF_RSTDM + 4096 <= 2 * MiB && OFF_SLOTP + 131072 <= OFF_LIST && OFF_LIST + 2 * MiB <= OFF_AL && OFF_DEC + 4096 <= OFF_NAIVE_N && OFF_NAIVE_N + 8192 <= OFF_NAIVE_S && OFF_NAIVE_S + 524288 <= WS_WSM && OFF_NAIVE_C + 2 * MiB <= WS_END, "small map");
constexpr int CW_CNT = 64;

struct Ptrs {
    const float *x, *mem, *norm_mix_g, *w_in, *b_gate, *b_if, *conv_w, *conv_b, *mh_norm_g, *sgu_norm_g, *w_s, *b_s, *w_out,
                *norm_x_g, *norm_mem_g, *w_xq, *w_xkv, *w_xo, *norm_moe_g, *w_rg, *b_rg, *w_re, *b_re, *w1, *w3, *w2, *norm_f_g;
    float* out; unsigned char* ws;
};

__device__ __forceinline__ float sigmoidf_(float v) { return 1.f / (1.f + __expf(-v)); }
__device__ __forceinline__ float siluf_(float v) { return v / (1.f + __expf(-v)); }
__device__ __forceinline__ float gelu_tanh(float v) { const float u = 0.7978845608028654f * (v + 0.044715f * v * v * v); return v / (1.f + __expf(-2.f * u)); }
__device__ __forceinline__ float logsigmoidf_(float v) { return fminf(v, 0.f) - log1pf(__expf(-fabsf(v))); }
__device__ __forceinline__ float wave_sum(float v) {
#pragma unroll
    for (int o = 1; o < 64; o <<= 1) v += __shfl_xor(v, o);
    return v;
}
__device__ __forceinline__ float wave_max(float v) {
#pragma unroll
    for (int o = 1; o < 64; o <<= 1) v = fmaxf(v, __shfl_xor(v, o));
    return v;
}
__host__ __device__ __forceinline__ int vt_slot(int key) { const int g = key & ~15, r = key & 15;   const int hh = (r >> 2) & 1, j = ((r >> 3) << 2) | (r & 3); return g + 8 * hh + j; }

__global__ void nk_zero(Ptrs p) {
    float* a = (float*)(p.ws + OFF_SSSV);
    const int i = blockIdx.x * blockDim.x + threadIdx.x;
    if (i < 3 * NTOK) a[i] = 0.f;
}
__global__ void nk_rows0(Ptrs p) {
    const int row = blockIdx.x * 4 + (threadIdx.x >> 6), lane = threadIdx.x & 63;
    const float* xr = p.x + (size_t)row * DM;
    float ss = 0.f; float acc[8];
#pragma unroll
    for (int j = 0; j < 8; ++j) acc[j] = 0.f;
    h16* xh = (h16*)(p.ws + WS_XH) + (size_t)row * DM;
    for (int k = lane; k < DM; k += 64) {
        const float v = xr[k]; ss += v * v; xh[k] = (h16)v;
        const float vg = v * p.norm_mix_g[k];
#pragma unroll
        for (int j = 0; j < 8; ++j) acc[j] += vg * p.w_in[(size_t)k * IN_DIM + C_I + j];
    }
    ss = wave_sum(ss);
    const float rstd = rsqrtf(ss / DM + EPS);
#pragma unroll
    for (int j = 0; j < 8; ++j) acc[j] = wave_sum(acc[j]);
    if (lane == 0) {
        ((float*)(p.ws + OFF_RSTD0))[row] = rstd;
        float* ig = (float*)(p.ws + OFF_IG) + row * 4; float* lf = (float*)(p.ws + OFF_LF) + row * 4;
#pragma unroll
        for (int h = 0; h < 4; ++h) { ig[h] = acc[h] * rstd + p.b_if[h]; lf[h] = logsigmoidf_(acc[4 + h] * rstd + p.b_if[4 + h]); }
    }
}
__global__ void nk_mem(Ptrs p) {
    const int row = blockIdx.x * 4 + (threadIdx.x >> 6), lane = threadIdx.x & 63;
    const float* xr = p.mem + (size_t)row * DM; h16* o = (h16*)(p.ws + WS_MEMH) + (size_t)row * DM;
    float ss = 0.f;
    for (int k = lane; k < DM; k += 64) { const float v = xr[k]; ss += v * v; o[k] = (h16)v; }
    ss = wave_sum(ss);
    if (lane == 0) ((float*)(p.ws + OFF_RSTDM))[row] = rsqrtf(ss / DM + EPS);
}
__global__ void nk_mstate(Ptrs p) {
    const int bh = blockIdx.x, b = bh >> 2, h = bh & 3, lane = threadIdx.x;
    const float* ig = (const float*)(p.ws + OFF_IG); const float* lf = (const float*)(p.ws + OFF_LF);
    float B = 0.f, mx = -INFINITY;
    for (int s = 0; s < CHUNK; ++s) { const int t = b * SEQ + lane * CHUNK + s; B += lf[t * 4 + h]; mx = fmaxf(mx, ig[t * 4 + h] - B); }
    const float blast = B, maxw = B + mx;
    __shared__ float sb[64], sm[64];
    sb[lane] = blast; sm[lane] = maxw; __syncthreads();
    if (lane == 0) { float m = 0.f; float* mst = (float*)(p.ws + OFF_MST) + bh * 64;
        for (int c = 0; c < NCHUNK; ++c) { mst[c] = m; m = fmaxf(sb[c] + m, sm[c]); } }
}
__global__ void nk_proj(Ptrs p) {
    const int l = blockIdx.x * 256 + threadIdx.x;
    const int r0 = blockIdx.y * 8;
    int c0, c1 = -1, kind;
    if (l < 2048) { c0 = C_QK + l; kind = 0; }
    else if (l < 3072) { c0 = C_V + (l - 2048); kind = 1; }
    else if (l < 4096) { c0 = C_O + (l - 3072); c1 = C_G + (l - 3072); kind = 2; }
    else if (l < 5120) { c0 = C_U + (l - 4096); c1 = C_G + 1024 + (l - 4096); kind = 3; }
    else if (l < 6144) { c0 = C_SV + (l - 5120); kind = 4; }
    else return;
    float a0[8], a1[8];
#pragma unroll
    for (int r = 0; r < 8; ++r) { a0[r] = 0.f; a1[r] = 0.f; }
    for (int k = 0; k < DM; ++k) {
        const float g = p.norm_mix_g[k];
        const float w0 = p.w_in[(size_t)k * IN_DIM + c0] * g;
        const float w1 = (c1 >= 0) ? p.w_in[(size_t)k * IN_DIM + c1] * g : 0.f;
#pragma unroll
        for (int r = 0; r < 8; ++r) { const float xv = p.x[(size_t)(r0 + r) * DM + k]; a0[r] += xv * w0; a1[r] += xv * w1; }
    }
    const float* rstd0 = (const float*)(p.ws + OFF_RSTD0);
#pragma unroll
    for (int r = 0; r < 8; ++r) {
        const int t = r0 + r; const float rs = rstd0[t]; const float v0 = a0[r] * rs, v1 = a1[r] * rs;
        if (kind == 0) ((h16*)p.out)[(size_t)t * 2048 + l] = (h16)v0;
        else if (kind == 1) ((h16*)(p.ws + WS_V))[(size_t)t * DM + (l - 2048)] = (h16)v0;
        else if (kind == 2) { const int c = l - 3072; ((h16*)(p.ws + WS_OG))[(size_t)t * DM + c] = (h16)(sigmoidf_(v0) * sigmoidf_(v1 + p.b_gate[c])); }
        else if (kind == 3) { const int c = l - 4096; ((h16*)(p.ws + WS_UG))[(size_t)t * DM + c] = (h16)(gelu_tanh(v0) * sigmoidf_(v1 + p.b_gate[1024 + c])); }
        else { const int c = l - 5120; const float gv = gelu_tanh(v0); ((h16*)(p.ws + WS_SV))[(size_t)t * DM + c] = (h16)gv; atomicAdd((float*)(p.ws + OFF_SSSV) + t, gv * gv); }
    }
}
__global__ void nk_conv(Ptrs p) {
    const size_t i = (size_t)blockIdx.x * 256 + threadIdx.x; const int t = (int)(i >> 11), c = (int)(i & 2047), tl = t & (SEQ - 1);
    const h16* qk = (const h16*)p.out;
    float a = p.conv_b[c];
#pragma unroll
    for (int j = 0; j < 4; ++j) { const int dt = j - 3; if (tl + dt >= 0) a += p.conv_w[j * 2048 + c] * (float)qk[(size_t)(t + dt) * 2048 + c]; }
    a = siluf_(a);
    if (c < 1024) ((h16*)(p.ws + WS_QC))[(size_t)t * DM + c] = (h16)a; else ((h16*)(p.ws + WS_KC))[(size_t)t * DM + (c - 1024)] = (h16)(a * 0.0625f);
}
__global__ void __launch_bounds__(1024) nk_mlstm(Ptrs p) {
    const int bh = blockIdx.x, b = bh >> 2, hd = bh & 3, tid = threadIdx.x;
    const h16* Qc = (const h16*)(p.ws + WS_QC); const h16* Kc = (const h16*)(p.ws + WS_KC); const h16* V = (const h16*)(p.ws + WS_V);
    float* C = (float*)(p.ws + OFF_NAIVE_C) + (size_t)bh * 65536; float* nvec = (float*)(p.ws + OFF_NAIVE_N) + bh * 256; float* Sp = (float*)(p.ws + OFF_NAIVE_S) + (size_t)bh * 16384;
    const float* ig = (const float*)(p.ws + OFF_IG); const float* lf = (const float*)(p.ws + OFF_LF);
    float* Hout = p.out;
    __shared__ float s_b[128], s_ic[128], s_mt[128], s_iw[128], s_ws[128], s_misc[4];
    for (int i = tid; i < 65536; i += 1024) C[i] = 0.f;
    if (tid < 256) nvec[tid] = 0.f;
    float m = 0.f;
    __syncthreads();
    for (int c = 0; c < NCHUNK; ++c) {
        const int t0 = b * SEQ + c * CHUNK;
        if (tid == 0) { float B = 0.f; for (int s = 0; s < CHUNK; ++s) { B += lf[(t0 + s) * 4 + hd]; s_b[s] = B; s_ic[s] = ig[(t0 + s) * 4 + hd]; } }
        __syncthreads();
        if (tid < 128) { const int t = tid; float mx = s_b[t] + m; for (int s = 0; s <= t; ++s) mx = fmaxf(mx, s_b[t] - s_b[s] + s_ic[s]); s_mt[t] = mx; s_iw[t] = __expf(s_b[t] + m - mx); }
        if (tid == 128) { const float bl = s_b[127]; float mx = bl + m; for (int s = 0; s < CHUNK; ++s) mx = fmaxf(mx, bl - s_b[s] + s_ic[s]); s_misc[0] = mx; s_misc[1] = __expf(bl + m - mx); }
        __syncthreads();
        if (tid < 128) s_ws[tid] = __expf(s_b[127] - s_b[tid] + s_ic[tid] - s_misc[0]);
        for (int i = tid; i < 16384; i += 1024) { const int t = i >> 7, s = i & 127; float v = 0.f;
            if (s <= t) { float d = 0.f; const h16* q = Qc + (size_t)(t0 + t) * DM + hd * DH; const h16* k = Kc + (size_t)(t0 + s) * DM + hd * DH;
                for (int e = 0; e < DH; ++e) d += (float)q[e] * (float)k[e];
                v = d * __expf(s_b[t] - s_b[s] + s_ic[s] - s_mt[t]); }
            Sp[i] = v; }
        __threadfence_block(); __syncthreads();
        for (int i = tid; i < 32768; i += 1024) { const int t = i >> 8, e = i & 255; float num = 0.f, den = 0.f;
            for (int s = 0; s <= t; ++s) { const float sv = Sp[t * 128 + s]; num += sv * (float)V[(size_t)(t0 + s) * DM + hd * DH + e]; den += sv; }
            float qc = 0.f, qn = 0.f; const h16* q = Qc + (size_t)(t0 + t) * DM + hd * DH;
            for (int d = 0; d < DH; ++d) { const float qv = (float)q[d]; qc += qv * C[d * 256 + e]; qn += qv * nvec[d]; }
            num += s_iw[t] * qc; den += s_iw[t] * qn;
            Hout[(size_t)(t0 + t) * DM + hd * DH + e] = num / fmaxf(fabsf(den), __expf(-s_mt[t])); }
        __syncthreads();
        const float decay = s_misc[1];
        for (int i = tid; i < 65536; i += 1024) { const int d = i >> 8, e = i & 255; float a = 0.f;
            for (int s = 0; s < CHUNK; ++s) a += s_ws[s] * (float)Kc[(size_t)(t0 + s) * DM + hd * DH + d] * (float)V[(size_t)(t0 + s) * DM + hd * DH + e];
            C[i] = decay * C[i] + a; }
        if (tid < 256) { float a = 0.f; for (int s = 0; s < CHUNK; ++s) a += s_ws[s] * (float)Kc[(size_t)(t0 + s) * DM + hd * DH + tid]; nvec[tid] = decay * nvec[tid] + a; }
        m = s_misc[0];
        __threadfence_block(); __syncthreads();
    }
}

__global__ void __launch_bounds__(1024) nk_mout(Ptrs p) {
    const int bh = blockIdx.x >> 6, c = blockIdx.x & 63, b = bh >> 2, hd = bh & 3, tid = threadIdx.x, t0 = b * SEQ + c * CHUNK;
    const h16* Qc = (const h16*)(p.ws + WS_QC); const h16* Kc = (const h16*)(p.ws + WS_KC); const h16* V = (const h16*)(p.ws + WS_V);
    const h16* Ct = (const h16*)(p.ws + WS_CST) + ((size_t)(bh * 64 + c)) * 65536; const float* nst = (const float*)(p.ws + WS_NST) + (size_t)(bh * 64 + c) * 256;
    const float* AL = (const float*)(p.ws + OFF_AL); const float* BE = (const float*)(p.ws + OFF_BE); const float* NM = (const float*)(p.ws + OFF_NM);
    const float mc = ((const float*)(p.ws + OFF_MST))[bh * 64 + c];
    __shared__ h16 Sp[128 * 128];
    for (int i = tid; i < 16384; i += 1024) { const int t = i >> 7, s = i & 127; float v = 0.f;
        if (s <= t) { float d = 0.f; const h16* q = Qc + (size_t)(t0 + t) * DM + hd * DH; const h16* k = Kc + (size_t)(t0 + s) * DM + hd * DH;
            for (int e = 0; e < DH; ++e) d += (float)q[e] * (float)k[e];
            v = d * __expf(AL[(t0 + t) * 4 + hd] + BE[(t0 + s) * 4 + hd]); }
        Sp[i] = (h16)v; }
    __syncthreads();
    for (int i = tid; i < 32768; i += 1024) { const int t = i >> 8, e = i & 255; float num = 0.f, den = 0.f;
        for (int s = 0; s <= t; ++s) { const float sv = (float)Sp[t * 128 + s]; num += sv * (float)V[(size_t)(t0 + s) * DM + hd * DH + e]; den += sv; }
        float qc = 0.f, qn = 0.f; const h16* q = Qc + (size_t)(t0 + t) * DM + hd * DH;
        for (int d = 0; d < DH; ++d) { const float qv = (float)q[d]; qc += qv * (float)Ct[e * 256 + d]; qn += qv * nst[d]; }
        const float iw = __expf(AL[(t0 + t) * 4 + hd] + mc);
        num += iw * qc; den += iw * qn;
        p.out[(size_t)(t0 + t) * DM + hd * DH + e] = num / fmaxf(fabsf(den), __expf(NM[(t0 + t) * 4 + hd])); }
}
__global__ void nk_sgu(Ptrs p) {
    const size_t i = (size_t)blockIdx.x * 256 + threadIdx.x; const int t = (int)(i >> 10), ch = (int)(i & 1023), g = ch >> 7, tl = t & 127, t0 = t - tl;
    const h16* SV = (const h16*)(p.ws + WS_SV); const float* ss = (const float*)(p.ws + OFF_SSSV);
    float a = 0.f;
    for (int s = 0; s <= tl; ++s) a += p.w_s[(g * 128 + tl) * 128 + s] * (float)SV[(size_t)(t0 + s) * DM + ch] * rsqrtf(ss[t0 + s] / DM + EPS);
    a = a * p.sgu_norm_g[ch] + p.b_s[g * 128 + tl];
    ((h16*)(p.ws + WS_XH))[i] = (h16)((float)((const h16*)(p.ws + WS_UG))[i] * a);
}
__global__ void nk_ya(Ptrs p) {
    const int w = blockIdx.x * 4 + (threadIdx.x >> 6), lane = threadIdx.x & 63, t = w >> 2, hd = w & 3;
    const float* hrow = p.out + (size_t)t * DM + hd * DH; float v[4]; float ss = 0.f;
#pragma unroll
    for (int j = 0; j < 4; ++j) { v[j] = hrow[lane + 64 * j]; ss += v[j] * v[j]; }
    ss = wave_sum(ss); const float rs = rsqrtf(ss / DH + EPS);
    h16* Z = (h16*)(p.ws + WS_XH) + (size_t)t * DM + hd * DH; const h16* OG = (const h16*)(p.ws + WS_OG) + (size_t)t * DM + hd * DH;
#pragma unroll
    for (int j = 0; j < 4; ++j) { const int e = lane + 64 * j; Z[e] = (h16)((float)Z[e] + v[j] * rs * p.mh_norm_g[hd * DH + e] * (float)OG[e]); }
}
__global__ void nk_wout(Ptrs p) {
    const int c = blockIdx.x * 256 + threadIdx.x, r0 = blockIdx.y * 8;
    const h16* Z = (const h16*)(p.ws + WS_XH);
    float a[8];
#pragma unroll
    for (int r = 0; r < 8; ++r) a[r] = 0.f;
    for (int k = 0; k < DM; ++k) { const float w = p.w_out[(size_t)k * DM + c];
#pragma unroll
        for (int r = 0; r < 8; ++r) a[r] += (float)Z[(size_t)(r0 + r) * DM + k] * w; }
#pragma unroll
    for (int r = 0; r < 8; ++r) { const int t = r0 + r; const float v = p.x[(size_t)t * DM + c] + a[r]; p.out[(size_t)t * DM + c] = v; ((h16*)(p.ws + WS_V))[(size_t)t * DM + c] = (h16)v;
        atomicAdd((float*)(p.ws + OFF_SS1) + t, v * v); }
}
__global__ void nk_q(Ptrs p) {
    const int c = blockIdx.x * 256 + threadIdx.x, r0 = blockIdx.y * 8;
    float a[8];
#pragma unroll
    for (int r = 0; r < 8; ++r) a[r] = 0.f;
    for (int k = 0; k < DM; ++k) { const float w = p.w_xq[(size_t)k * DM + c] * p.norm_x_g[k];
#pragma unroll
        for (int r = 0; r < 8; ++r) a[r] += p.out[(size_t)(r0 + r) * DM + k] * w; }
    const float* ss1 = (const float*)(p.ws + OFF_SS1);
#pragma unroll
    for (int r = 0; r < 8; ++r) { const int t = r0 + r; ((h16*)(p.ws + WS_XH))[(size_t)t * DM + c] = (h16)(a[r] * rsqrtf(ss1[t] / DM + EPS) * 0.0625f); }
}
__global__ void nk_kv(Ptrs p) {
    const int c = blockIdx.x * 256 + threadIdx.x, r0 = blockIdx.y * 8;
    float a[8];
#pragma unroll
    for (int r = 0; r < 8; ++r) a[r] = 0.f;
    for (int k = 0; k < DM; ++k) { const float w = p.w_xkv[(size_t)k * 2048 + c] * p.norm_mem_g[k];
#pragma unroll
        for (int r = 0; r < 8; ++r) a[r] += p.mem[(size_t)(r0 + r) * DM + k] * w; }
    const float* rm = (const float*)(p.ws + OFF_RSTDM);
#pragma unroll
    for (int r = 0; r < 8; ++r) { const int m = r0 + r; const float v = a[r] * rm[m];
        if (c < 1024) ((h16*)(p.ws + WS_KM))[(size_t)m * DM + c] = (h16)v;
        else ((h16*)(p.ws + WS_VTM))[(size_t)m * DM + (c - 1024)] = (h16)v; }
}
__global__ void nk_attn(Ptrs p) {
    const int t = blockIdx.x >> 2, hd = blockIdx.x & 3, b = t / SEQ, j = threadIdx.x;
    const h16* q = (const h16*)(p.ws + WS_XH) + (size_t)t * DM + hd * DH;
    const h16* K = (const h16*)(p.ws + WS_KM) + (size_t)(b * 256 + j) * DM + hd * DH;
    __shared__ float sp[256], red[8];
    float s = 0.f;
    for (int d = 0; d < DH; ++d) s += (float)q[d] * (float)K[d];
    float mx = wave_max(s); if ((j & 63) == 0) red[j >> 6] = mx; __syncthreads();
    mx = fmaxf(fmaxf(red[0], red[1]), fmaxf(red[2], red[3]));
    const float e = __expf(s - mx); sp[j] = e;
    float sm = wave_sum(e); if ((j & 63) == 0) red[4 + (j >> 6)] = sm; __syncthreads();
    sm = red[4] + red[5] + red[6] + red[7];
    const h16* VT = (const h16*)(p.ws + WS_VTM) + (size_t)(b * 256) * DM + hd * DH + j;
    float o = 0.f;
    for (int key = 0; key < 256; ++key) o += sp[key] * (float)VT[(size_t)key * DM];
    ((h16*)(p.ws + WS_OG))[(size_t)t * DM + hd * DH + j] = (h16)(o / sm);
}
__global__ void nk_wxo(Ptrs p) {
    const int c = blockIdx.x * 256 + threadIdx.x, r0 = blockIdx.y * 8;
    const h16* A = (const h16*)(p.ws + WS_OG);
    float a[8];
#pragma unroll
    for (int r = 0; r < 8; ++r) a[r] = 0.f;
    for (int k = 0; k < DM; ++k) { const float w = p.w_xo[(size_t)k * DM + c];
#pragma unroll
        for (int r = 0; r < 8; ++r) a[r] += (float)A[(size_t)(r0 + r) * DM + k] * w; }
#pragma unroll
    for (int r = 0; r < 8; ++r) { const int t = r0 + r; const float v = p.out[(size_t)t * DM + c] + a[r]; p.out[(size_t)t * DM + c] = v; ((h16*)(p.ws + WS_V))[(size_t)t * DM + c] = (h16)v;
        atomicAdd((float*)(p.ws + OFF_SS2) + t, v * v); }
}
__global__ void nk_router(Ptrs p) {
    const int t = blockIdx.x * 4 + (threadIdx.x >> 6), lane = threadIdx.x & 63;
    const float* xr = p.out + (size_t)t * DM; const float rs = rsqrtf(((const float*)(p.ws + OFF_SS2))[t] / DM + EPS);
    float acc[36];
#pragma unroll
    for (int j = 0; j < 36; ++j) acc[j] = 0.f;
    for (int k = lane; k < DM; k += 64) { const float v = xr[k] * rs * p.norm_moe_g[k];
#pragma unroll
        for (int j = 0; j < 4; ++j) acc[j] += v * p.w_rg[k * 4 + j];
#pragma unroll
        for (int j = 0; j < 32; ++j) acc[4 + j] += v * p.w_re[k * 32 + j]; }
#pragma unroll
    for (int j = 0; j < 36; ++j) acc[j] = wave_sum(acc[j]);
    if (lane == 0) {
        float gl[4]; int gi = 0;
#pragma unroll
        for (int j = 0; j < 4; ++j) gl[j] = acc[j] + p.b_rg[j];
        float gm = gl[0];
#pragma unroll
        for (int j = 1; j < 4; ++j) if (gl[j] > gm) { gm = gl[j]; gi = j; }
        float gs = 0.f;
#pragma unroll
        for (int j = 0; j < 4; ++j) gs += __expf(gl[j] - gm);
        float ev[8];
#pragma unroll
        for (int j = 0; j < 8; ++j) { float v = acc[4 + j] + p.b_re[j];
#pragma unroll
            for (int g = 1; g < 4; ++g) v = (gi == g) ? acc[4 + g * 8 + j] + p.b_re[g * 8 + j] : v;
            ev[j] = v; }
        float pg = 0.f;
#pragma unroll
        for (int j = 0; j < 4; ++j) pg = (gi == j) ? __expf(gl[j] - gm) / gs : pg;
        int i1 = 0; float v1 = ev[0];
#pragma unroll
        for (int j = 1; j < 8; ++j) if (ev[j] > v1) { v1 = ev[j]; i1 = j; }
        int i2 = -1; float v2 = -INFINITY;
#pragma unroll
        for (int j = 0; j < 8; ++j) if (j != i1 && ev[j] > v2) { v2 = ev[j]; i2 = j; }
        const float e2 = __expf(v2 - v1), g1 = pg / (1.f + e2), g2 = pg * e2 / (1.f + e2);
        unsigned* cnt = (unsigned*)(p.ws + WS_CTL) + CW_CNT;
        int* list = (int*)(p.ws + OFF_LIST); float* gate = (float*)(p.ws + OFF_GATE); int* se = (int*)(p.ws + OFF_SLOTE); int* sp = (int*)(p.ws + OFF_SLOTP);
        const int e1x = gi * 8 + i1, e2x = gi * 8 + i2;
        const unsigned p1 = atomicAdd(cnt + e1x, 1u); list[e1x * NTOK + p1] = t * 2; gate[t * 2] = g1; se[t * 2] = e1x; sp[t * 2] = (int)p1;
        const unsigned p2 = atomicAdd(cnt + e2x, 1u); list[e2x * NTOK + p2] = t * 2 + 1; gate[t * 2 + 1] = g2; se[t * 2 + 1] = e2x; sp[t * 2 + 1] = (int)p2;
    }
}
__device__ __forceinline__ int moe_pstart(const unsigned* cnt, int e) { int s = 0; for (int i = 0; i < e; ++i) s += (int)((cnt[i] + 255u) & ~255u); return s; }
__global__ void nk_ffn1(Ptrs p) {
    const int f = blockIdx.x * 256 + threadIdx.x, s0 = blockIdx.y * 8;
    const unsigned* cnt = (const unsigned*)(p.ws + WS_CTL) + CW_CNT; const int* se = (const int*)(p.ws + OFF_SLOTE); const int* sp = (const int*)(p.ws + OFF_SLOTP);
    const float* ss2 = (const float*)(p.ws + OFF_SS2);
    for (int r = 0; r < 8; ++r) { const int slot = s0 + r, tok = slot >> 1, e = se[slot];
        const float* xr = p.out + (size_t)tok * DM; float a1 = 0.f, a3 = 0.f;
        const float* W1 = p.w1 + (size_t)e * DM * FF; const float* W3 = p.w3 + (size_t)e * DM * FF;
        for (int k = 0; k < DM; ++k) { const float v = xr[k] * p.norm_moe_g[k]; a1 += v * W1[(size_t)k * FF + f]; a3 += v * W3[(size_t)k * FF + f]; }
        const float rs = rsqrtf(ss2[tok] / DM + EPS); a1 *= rs; a3 *= rs;
        const int prow = moe_pstart(cnt, e) + sp[slot];
        ((h16*)(p.ws + WS_H))[(size_t)prow * FF + f] = (h16)(siluf_(a1) * a3); }
}
__global__ void nk_ffn2(Ptrs p) {
    const int c = blockIdx.x * 256 + threadIdx.x, s0 = blockIdx.y * 8;
    const unsigned* cnt = (const unsigned*)(p.ws + WS_CTL) + CW_CNT; const int* se = (const int*)(p.ws + OFF_SLOTE); const int* sp = (const int*)(p.ws + OFF_SLOTP);
    const float* gate = (const float*)(p.ws + OFF_GATE);
    for (int r = 0; r < 8; ++r) { const int slot = s0 + r, e = se[slot]; const int prow = moe_pstart(cnt, e) + sp[slot];
        const h16* hr = (const h16*)(p.ws + WS_H) + (size_t)prow * FF; const float* W2 = p.w2 + (size_t)e * FF * DM; float a = 0.f;
        for (int k = 0; k < FF; ++k) a += (float)hr[k] * W2[(size_t)k * DM + c];
        ((h16*)(p.ws + WS_Y))[(size_t)slot * DM + c] = (h16)(a * gate[slot]); }
}
__global__ void nk_final(Ptrs p) {
    const int t = blockIdx.x * 4 + (threadIdx.x >> 6), lane = threadIdx.x & 63;
    float* xr = p.out + (size_t)t * DM; const h16* y0 = (const h16*)(p.ws + WS_Y) + (size_t)(2 * t) * DM; const h16* y1 = y0 + DM;
    float v[16]; float ss = 0.f;
#pragma unroll
    for (int j = 0; j < 16; ++j) { const int k = lane + 64 * j; v[j] = xr[k] + (float)y0[k] + (float)y1[k]; ss += v[j] * v[j]; }
    ss = wave_sum(ss); const float rs = rsqrtf(ss / DM + EPS);
#pragma unroll
    for (int j = 0; j < 16; ++j) { const int k = lane + 64 * j; xr[k] = v[j] * rs * p.norm_f_g[k]; }
}

#define LAS __attribute__((address_space(3)))
#define GAS __attribute__((address_space(1)))
typedef _Float16 h16x8 __attribute__((ext_vector_type(8)));
typedef _Float16 h16x4 __attribute__((ext_vector_type(4)));
typedef _Float16 h16x2 __attribute__((ext_vector_type(2)));
typedef float f32x4 __attribute__((ext_vector_type(4)));
typedef float f32x2 __attribute__((ext_vector_type(2)));
typedef unsigned u32x4 __attribute__((ext_vector_type(4)));
typedef unsigned u32x2 __attribute__((ext_vector_type(2)));
typedef GAS unsigned gu32;
#define RLX_AGENT __ATOMIC_RELAXED, __HIP_MEMORY_SCOPE_AGENT
#define LDS_WAIT() asm volatile("s_waitcnt lgkmcnt(0)" ::: "memory")
#define VM_WAIT() asm volatile("s_waitcnt vmcnt(0)" ::: "memory")
__device__ __forceinline__ unsigned pk_h2(float lo, float hi) { f32x2 v = {lo, hi}; return __builtin_bit_cast(unsigned, __builtin_convertvector(v, h16x2)); }
__device__ __forceinline__ u32x4 pk_h8(f32x4 a, f32x4 b) { u32x4 w; w.x = pk_h2(a[0], a[1]); w.y = pk_h2(a[2], a[3]); w.z = pk_h2(b[0], b[1]); w.w = pk_h2(b[2], b[3]); return w; }
__device__ __forceinline__ float fsigmoid(float v) { return __builtin_amdgcn_rcpf(1.f + __expf(-v)); }
__device__ __forceinline__ float fgelu(float v) { const float u = 1.5957691216057308f * (v + 0.044715f * v * v * v); return v * __builtin_amdgcn_rcpf(1.f + __expf(-u)); }
__device__ __forceinline__ float fsilu(float v) { return v * __builtin_amdgcn_rcpf(1.f + __expf(-v)); }

constexpr int NWAVES = 8, NTHREADS = 512;
constexpr int RING_BYTES = 143360, LDSCTL_OFF = RING_BYTES, MISC_OFF = LDSCTL_OFF + 320, LDS_BYTES = 147456;
constexpr int CW_TMO = 0, CW_BAR = 4096;

#define XB_TMO      128
#define XB_XCNT(j)  (256  + 64 * (j))
#define XB_XSUB(j)  (1280 + 64 * (j))
#define XB_XGEN(j)  (2304 + 64 * (j))
#define XB_TOP      3328
#define XB_TOPGEN   3392
#define XCD_BAR_WORDS 3456
#define XB_SPIN_CAP (1u << 20)
__device__ __forceinline__ unsigned xb_ld(unsigned* p)              { return __hip_atomic_load(p, __ATOMIC_RELAXED, __HIP_MEMORY_SCOPE_AGENT); }
__device__ __forceinline__ unsigned xb_add(unsigned* p, unsigned v) { return __hip_atomic_fetch_add(p, v, __ATOMIC_RELAXED, __HIP_MEMORY_SCOPE_AGENT); }
__device__ __forceinline__ unsigned xb_xcc_id() { return (unsigned)__builtin_amdgcn_s_getreg((3 << 11) | 20) & 0xFu; }
#define XB_SPIN(cond, bar) do { unsigned _sp = 0; while (cond) { __builtin_amdgcn_s_sleep(1); \
    if ((++_sp & 255u) == 0u) { if (xb_ld(&(bar)[XB_TMO])) break; if (_sp > XB_SPIN_CAP) { atomicAdd(&(bar)[XB_TMO], 1u); break; } } } } while (0)
struct XcdBarrier { unsigned* bar; unsigned x; volatile LAS unsigned* st; };
__device__ __forceinline__ XcdBarrier xcd_barrier_post(unsigned* bar, volatile LAS unsigned* st) {
    XcdBarrier b; b.bar = bar; b.x = xb_xcc_id(); b.st = st;
    if (threadIdx.x == 0) (void)xb_add(&bar[XB_XCNT(b.x)], 1u);
    return b;
}
__device__ __forceinline__ void xcd_barrier_complete(unsigned* bar, unsigned x, unsigned& nloc, unsigned& nx) {
    const unsigned G = gridDim.x * gridDim.y * gridDim.z;
    unsigned sum, cnt, mine, sp = 0u;
    for (;;) {
        sum = 0u; cnt = 0u; mine = 0u;
#pragma unroll
        for (unsigned j = 0; j < 16; ++j) { const unsigned c = xb_ld(&bar[XB_XCNT(j)]); sum += c; cnt += (c > 0u) ? 1u : 0u; mine = (j == x) ? c : mine; }
        if (sum == G) break;
        __builtin_amdgcn_s_sleep(1);
        if ((++sp & 255u) == 0u) { if (xb_ld(&bar[XB_TMO])) break; if (sp > XB_SPIN_CAP) { atomicAdd(&bar[XB_TMO], 1u); break; } }
    }
    nloc = mine > 0u ? mine : 1u; nx = cnt > 0u ? cnt : 1u;
}
__device__ __forceinline__ void xcd_barrier(const XcdBarrier& b) {
    asm volatile("s_waitcnt vmcnt(0)" ::: "memory");
    __syncthreads();
    if (threadIdx.x == 0) {
        unsigned* bar = b.bar;
        __builtin_amdgcn_s_waitcnt(0);
        unsigned nloc = b.st[0], nx = b.st[1];
        if (nloc == 0u) { xcd_barrier_complete(bar, b.x, nloc, nx); b.st[0] = nloc; b.st[1] = nx; }
        const unsigned old = xb_add(&bar[XB_XSUB(b.x)], 1u);
        const unsigned gen = old / nloc;
        if (old + 1u == (gen + 1u) * nloc) {
            __builtin_amdgcn_fence(__ATOMIC_RELEASE, "agent");
            asm volatile("s_waitcnt vmcnt(0)" ::: "memory");
            const unsigned og = xb_add(&bar[XB_TOP], 1u);
            const unsigned tg = og / nx;
            if (og + 1u == (tg + 1u) * nx) xb_add(&bar[XB_TOPGEN], 1u);
            else XB_SPIN(xb_ld(&bar[XB_TOPGEN]) == tg, bar);
            __builtin_amdgcn_fence(__ATOMIC_ACQUIRE, "agent");
            xb_add(&bar[XB_XGEN(b.x)], 1u);
            asm volatile("s_waitcnt vmcnt(0)" ::: "memory");
        } else {
            XB_SPIN(xb_ld(&bar[XB_XGEN(b.x)]) == gen, bar);
            __builtin_amdgcn_fence(__ATOMIC_ACQUIRE, "agent");
            asm volatile("s_waitcnt vmcnt(0)" ::: "memory");
        }
    }
    __syncthreads();
}

namespace pg8 {
constexpr int BM = 256, BK = 64, HALF = 128, HTB = HALF * BK * 2, STAGE_BYTES = 8 * HTB, NXCD = 8, WGM = 8;
__host__ __device__ __forceinline__ int lds_byte(int r, int c) { const int st = (r >> 4) * 2 + (c >> 5), rr = r & 15, cc = c & 31, ob = rr * 64 + cc * 2; return st * 1024 + (ob ^ (((ob >> 9) & 1) << 5)); }
__host__ __device__ __forceinline__ void stage_rc(int b, int& R, int& C) { const int st = b / 1024, sb = b % 1024, swz = sb ^ (((sb >> 9) & 1) << 5); R = (st >> 1) * 16 + swz / 64; C = (st & 1) * 32 + (swz % 64) / 2; }
__host__ __device__ __forceinline__ int perm32(int rho) { const int n = rho >> 4, i = rho & 15; return 8 * (i >> 2) + 4 * n + (i & 3); }
struct Unit { int pm, pn, e, nv, rb; };
struct StaticOrder {
    const char* A; const char* Bt; int K; int nM, nN, nwg, G, c;
    __device__ __forceinline__ void init(const void* A_, const void* Bt_, int M, int N, int K_, int G_, int c_) { A = (const char*)A_; Bt = (const char*)Bt_; K = K_; nM = M / BM; nN = N / BM; nwg = nM * nN; G = G_; c = c_; }
    __device__ __forceinline__ bool next(int i, Unit& u) const {
        const long L = (long)i * G + c; if (L >= nwg) return false;
        int wgid = (int)L; { const int q = nwg / NXCD, r = nwg % NXCD, xcd = wgid % NXCD, off = wgid / NXCD; wgid = (xcd < r ? xcd * (q + 1) : r * (q + 1) + (xcd - r) * q) + off; }
        const int nig = WGM * nN, gid = wgid / nig, fm = gid * WGM, gsz = (nM - fm) < WGM ? (nM - fm) : WGM;
        u.pm = fm + ((wgid % nig) % gsz); u.pn = (wgid % nig) / gsz; u.e = 0; u.nv = 256; u.rb = 0; return true;
    }
    __device__ __forceinline__ const char* a_base(const Unit& u) const { return A + (size_t)u.pm * (size_t)(BM * 2) * K; }
    __device__ __forceinline__ const char* b_base(const Unit& u) const { return Bt + (size_t)u.pn * (size_t)(BM * 2) * K; }
    __device__ __forceinline__ const char* g_base() const { return A; }
    __device__ __forceinline__ unsigned a_off(const Unit& u, int h, int R) const { return 0u; }
};

template <class Epi, class Sched, bool GATHER, bool ALIGN_EPI>
__device__ __forceinline__ void gemm_phase(LAS unsigned char* lds, const int K, const Sched& S, const Epi& E) {
    int tid = threadIdx.x; asm volatile("" : "+v"(tid));
    const int wid = __builtin_amdgcn_readfirstlane(tid >> 6), lane = tid & 63, wr = wid >> 2, wc = wid & 3, fr = lane & 15, fq = lane >> 4;
    const int nt = K / BK;
    unsigned voffA[2], voffB[2]; int Rst[2], Cst2[2];
#pragma unroll
    for (int i = 0; i < 2; ++i) { int R, C; stage_rc(tid * 16 + i * 8192, R, C); const int Rb = Epi::PERM ? ((R & ~31) + perm32(R & 31)) : R;
        voffA[i] = (unsigned)(R * K + C) * 2u; voffB[i] = (unsigned)(Rb * K + C) * 2u; Rst[i] = R; Cst2[i] = C * 2; }
    const size_t kstep = (size_t)(BK * 2);
    const size_t hstep = (size_t)HALF * K * 2;
    const unsigned ldsw = (unsigned)wid * 1024u;
    const int aoff = lds_byte(wr * 64 + fr, fq * 8), boff = lds_byte(wc * 32 + fr, fq * 8);
    const char* const gA = S.g_base();
#define PG8_SA(b, h) (((b) * 2 + (h)) * HTB)
#define PG8_SB(b, h) ((4 + (b) * 2 + (h)) * HTB)
#define PG8_GLDS(src, bufoff, i_) __builtin_amdgcn_global_load_lds((const unsigned*)(src), (LAS unsigned*)(lds + (bufoff) + ldsw + (i_) * 8192), 16, 0, 0)
#define PG8_STAGE_B(bufoff, gbase) do { _Pragma("unroll") for (int _i = 0; _i < 2; ++_i) PG8_GLDS((const char*)(gbase) + voffB[_i], bufoff, _i); } while (0)
#define PG8_STAGE_A(bufoff, pa, offs, h_, kb) do { _Pragma("unroll") for (int _i = 0; _i < 2; ++_i) { \
        if constexpr (GATHER) PG8_GLDS(gA + (size_t)((offs)[h_][_i] + (unsigned)(kb)), bufoff, _i); else PG8_GLDS((const char*)(pa) + (h_) * hstep + voffA[_i], bufoff, _i); } } while (0)
#define PG8_LDA(dst, b, h) do { _Pragma("unroll") for (int m = 0; m < 4; ++m) _Pragma("unroll") for (int k = 0; k < 2; ++k) dst[m][k] = *(const LAS h16x8*)(lds + PG8_SA(b, h) + aoff + m * 2048 + k * 1024); } while (0)
#define PG8_LDB(dst, b, h) do { _Pragma("unroll") for (int n = 0; n < 2; ++n) _Pragma("unroll") for (int k = 0; k < 2; ++k) dst[n][k] = *(const LAS h16x8*)(lds + PG8_SB(b, h) + boff + n * 2048 + k * 1024); } while (0)
#define PG8_MMA(ai, bj, At, Bt) do { __builtin_amdgcn_s_setprio(1); _Pragma("unroll") for (int m = 0; m < 4; ++m) _Pragma("unroll") for (int n = 0; n < 2; ++n) _Pragma("unroll") for (int k = 0; k < 2; ++k) \
        acc[ai][bj][m][n] = __builtin_amdgcn_mfma_f32_16x16x32_f16(Bt[n][k], At[m][k], acc[ai][bj][m][n], 0, 0, 0); __builtin_amdgcn_s_setprio(0); } while (0)
#define PG8_WAIT_V(n) asm volatile("s_waitcnt vmcnt(" #n ")" ::: "memory")
#define PG8_WAIT_L(n) asm volatile("s_waitcnt lgkmcnt(" #n ")" ::: "memory")
#define PG8_BAR __builtin_amdgcn_s_barrier()
#define PG8_SCHED __builtin_amdgcn_sched_barrier(0)
    Unit cur, nxt; int ui = 0;
    if (!S.next(0, cur)) return;
    f32x4 acc[2][2][4][2];
#pragma unroll
    for (int a = 0; a < 2; ++a)
#pragma unroll
        for (int b = 0; b < 2; ++b)
#pragma unroll
            for (int m = 0; m < 4; ++m)
#pragma unroll
                for (int n = 0; n < 2; ++n) acc[a][b][m][n] = (f32x4){0.f, 0.f, 0.f, 0.f};
    h16x8 At[4][2], B0[2][2], B1[2][2];
    const char* cA = S.a_base(cur); const char* cB = S.b_base(cur);
    unsigned aoc[2][2], aon[2][2], ao2[2][2];
    if constexpr (GATHER) {
#pragma unroll
        for (int h = 0; h < 2; ++h)
#pragma unroll
            for (int i = 0; i < 2; ++i) { aoc[h][i] = S.a_off(cur, h, Rst[i]) + (unsigned)Cst2[i]; aon[h][i] = aoc[h][i]; ao2[h][i] = aoc[h][i]; }
    }
    PG8_STAGE_B(PG8_SB(0, 0), cB); PG8_STAGE_B(PG8_SB(0, 1), cB + hstep); PG8_STAGE_A(PG8_SA(0, 0), cA, aoc, 0, 0); PG8_STAGE_A(PG8_SA(0, 1), cA, aoc, 1, 0);
    if (wr == 1) PG8_BAR;
    PG8_WAIT_V(2); PG8_BAR;
    PG8_STAGE_B(PG8_SB(1, 0), cB + kstep); PG8_STAGE_A(PG8_SA(1, 0), cA + kstep, aoc, 0, kstep); PG8_STAGE_B(PG8_SB(1, 1), cB + hstep + kstep);
    PG8_WAIT_V(6); PG8_BAR;
    for (;;) {
        const bool has_next = S.next(ui + 1, nxt);
        const char* nA = has_next ? S.a_base(nxt) : cA; const char* nB = has_next ? S.b_base(nxt) : cB;
        if constexpr (GATHER) {
#pragma unroll
            for (int h = 0; h < 2; ++h)
#pragma unroll
                for (int i = 0; i < 2; ++i) aon[h][i] = has_next ? S.a_off(nxt, h, Rst[i]) + (unsigned)Cst2[i] : aoc[h][i];
        }
        for (int t = 0; t < nt; t += 2) {
            const bool last = (t == nt - 2);
            const char* a1 = cA + (size_t)(t + 1) * kstep;
            const char* a2 = last ? nA : cA + (size_t)(t + 2) * kstep; const char* b2 = last ? nB : cB + (size_t)(t + 2) * kstep;
            const char* a3 = a2 + kstep; const char* b3 = b2 + kstep;
            if constexpr (GATHER) {
#pragma unroll
                for (int h = 0; h < 2; ++h)
#pragma unroll
                    for (int i = 0; i < 2; ++i) ao2[h][i] = last ? aon[h][i] : aoc[h][i] + (unsigned)((t + 2) * (int)kstep);
            }
            PG8_LDB(B0, 0, 0); PG8_LDB(B1, 0, 1); PG8_SCHED; PG8_LDA(At, 0, 0); PG8_STAGE_A(PG8_SA(1, 1), a1, aoc, 1, (t + 1) * (int)kstep);
            PG8_WAIT_V(8); PG8_WAIT_L(0); PG8_BAR; PG8_MMA(0, 0, At, B0); PG8_MMA(0, 1, At, B1); PG8_BAR; PG8_SCHED;
            PG8_LDA(At, 0, 1); PG8_STAGE_B(PG8_SB(0, 0), b2); PG8_STAGE_B(PG8_SB(0, 1), b2 + hstep); PG8_STAGE_A(PG8_SA(0, 0), a2, ao2, 0, 0);
            PG8_WAIT_V(8); PG8_WAIT_L(0); PG8_BAR; PG8_MMA(1, 0, At, B0); PG8_MMA(1, 1, At, B1); PG8_BAR; PG8_SCHED;
            PG8_LDB(B0, 1, 0); PG8_LDB(B1, 1, 1); PG8_SCHED; PG8_LDA(At, 1, 0); PG8_STAGE_A(PG8_SA(0, 1), a2, ao2, 1, 0);
            PG8_WAIT_V(8); PG8_WAIT_L(0); PG8_BAR; PG8_MMA(0, 0, At, B0); PG8_MMA(0, 1, At, B1); PG8_BAR; PG8_SCHED;
            PG8_LDA(At, 1, 1); PG8_STAGE_B(PG8_SB(1, 0), b3); PG8_STAGE_B(PG8_SB(1, 1), b3 + hstep); PG8_STAGE_A(PG8_SA(1, 0), a3, ao2, 0, kstep);
            PG8_WAIT_V(8); PG8_WAIT_L(0); PG8_BAR; PG8_MMA(1, 0, At, B0); PG8_MMA(1, 1, At, B1); PG8_BAR; PG8_SCHED;
        }
        if constexpr (ALIGN_EPI) { if (wr == 0) PG8_BAR; }
        E(acc, cur, wr, wc, fr, fq);
        if (!has_next) break;
#pragma unroll
        for (int a = 0; a < 2; ++a)
#pragma unroll
            for (int b = 0; b < 2; ++b)
#pragma unroll
                for (int m = 0; m < 4; ++m)
#pragma unroll
                    for (int n = 0; n < 2; ++n) acc[a][b][m][n] = (f32x4){0.f, 0.f, 0.f, 0.f};
        cur = nxt; cA = nA; cB = nB; ++ui;
        if constexpr (GATHER) {
#pragma unroll
            for (int h = 0; h < 2; ++h)
#pragma unroll
                for (int i = 0; i < 2; ++i) aoc[h][i] = aon[h][i];
        }
        if constexpr (ALIGN_EPI) { if (wr == 1) PG8_BAR; }
    }
    PG8_WAIT_V(0);
    if constexpr (!ALIGN_EPI) { if (wr == 0) PG8_BAR; }
    PG8_BAR;
#undef PG8_SA
#undef PG8_SB
#undef PG8_GLDS
#undef PG8_STAGE_A
#undef PG8_STAGE_B
#undef PG8_LDA
#undef PG8_LDB
#undef PG8_MMA
#undef PG8_WAIT_V
#undef PG8_WAIT_L
#undef PG8_BAR
#undef PG8_SCHED
}
}
using pg8::Unit;
struct EpiProj {
    static constexpr bool PERM = true;
    const float* rstd0; const float* b_gate; h16* QK; h16* V; h16* OG; h16* UG; h16* SV; float* sssv; bool doat;
    __device__ __forceinline__ void operator()(const f32x4 (&acc)[2][2][4][2], const Unit& u, int wr, int wc, int fr, int fq) const {
        const int row0 = u.pm * 256 + wr * 64 + fr, cw = wc * 32 + 8 * fq, pn = u.pn;
        if (pn < 12) {
            h16* base; int ld, col;
            if (pn < 8) { base = QK; ld = 2048; col = pn * 256; } else { base = V; ld = 1024; col = (pn - 8) * 256; }
#pragma unroll
            for (int ai = 0; ai < 2; ++ai)
#pragma unroll
                for (int m = 0; m < 4; ++m) { const int row = row0 + ai * 128 + m * 16; const float rs = rstd0[row]; h16* rp = base + (size_t)row * ld + col + cw;
#pragma unroll
                    for (int bj = 0; bj < 2; ++bj) *(u32x4*)(rp + bj * 128) = pk_h8(acc[ai][bj][m][0] * rs, acc[ai][bj][m][1] * rs); }
        } else if (pn < 28) {
            const bool isO = pn < 20; h16* base = isO ? OG : UG; const int c0 = (isO ? pn - 12 : pn - 20) * 128 + cw; const float* bg = b_gate + (isO ? 0 : 1024) + c0;
            const f32x4 b0 = *(const f32x4*)bg, b1 = *(const f32x4*)(bg + 4);
#pragma unroll
            for (int ai = 0; ai < 2; ++ai)
#pragma unroll
                for (int m = 0; m < 4; ++m) { const int row = row0 + ai * 128 + m * 16; const float rs = rstd0[row];
                    f32x4 a0 = acc[ai][0][m][0] * rs, a1 = acc[ai][0][m][1] * rs; const f32x4 g0 = acc[ai][1][m][0] * rs + b0, g1 = acc[ai][1][m][1] * rs + b1;
                    if (isO) {
#pragma unroll
                        for (int j = 0; j < 4; ++j) { a0[j] = fsigmoid(a0[j]) * fsigmoid(g0[j]); a1[j] = fsigmoid(a1[j]) * fsigmoid(g1[j]); }
                    } else {
#pragma unroll
                        for (int j = 0; j < 4; ++j) { a0[j] = fgelu(a0[j]) * fsigmoid(g0[j]); a1[j] = fgelu(a1[j]) * fsigmoid(g1[j]); }
                    }
                    *(u32x4*)(base + (size_t)row * 1024 + c0) = pk_h8(a0, a1); }
        } else {
            const int col = (pn - 28) * 256 + cw;
#pragma unroll
            for (int ai = 0; ai < 2; ++ai)
#pragma unroll
                for (int m = 0; m < 4; ++m) { const int row = row0 + ai * 128 + m * 16; const float rs = rstd0[row]; float sum = 0.f;
#pragma unroll
                    for (int bj = 0; bj < 2; ++bj) { f32x4 a0 = acc[ai][bj][m][0] * rs, a1 = acc[ai][bj][m][1] * rs;
#pragma unroll
                        for (int j = 0; j < 4; ++j) { a0[j] = fgelu(a0[j]); a1[j] = fgelu(a1[j]); sum += a0[j] * a0[j] + a1[j] * a1[j]; }
                        *(u32x4*)(SV + (size_t)row * 1024 + col + bj * 128) = pk_h8(a0, a1); }
                    sum += __shfl_xor(sum, 16); sum += __shfl_xor(sum, 32);
                    if (fq == 0 && doat) atomicAdd(sssv + row, sum); }
        }
    }
};
struct EpiKV {
    static constexpr bool PERM = true;
    const float* rstdm; h16* KM; h16* VM;
    __device__ __forceinline__ void operator()(const f32x4 (&acc)[2][2][4][2], const Unit& u, int wr, int wc, int fr, int fq) const {
        const int row0 = u.pm * 256 + wr * 64 + fr, cw = wc * 32 + 8 * fq, pn = u.pn; h16* base = (pn < 4) ? KM + pn * 256 : VM + (pn - 4) * 256;
#pragma unroll
        for (int ai = 0; ai < 2; ++ai)
#pragma unroll
            for (int m = 0; m < 4; ++m) { const int row = row0 + ai * 128 + m * 16; const float rs = rstdm[row];
#pragma unroll
                for (int bj = 0; bj < 2; ++bj) *(u32x4*)(base + (size_t)row * 1024 + bj * 128 + cw) = pk_h8(acc[ai][bj][m][0] * rs, acc[ai][bj][m][1] * rs); }
    }
};
struct EpiResid {
    static constexpr bool PERM = false;
    const float* resid; float* out; h16* outh; float* ss; bool doat;
    __device__ __forceinline__ void operator()(const f32x4 (&acc)[2][2][4][2], const Unit& u, int wr, int wc, int fr, int fq) const {
        const int row0 = u.pm * 256 + wr * 64 + fr, col0 = u.pn * 256 + wc * 32 + 4 * fq;
#pragma unroll
        for (int ai = 0; ai < 2; ++ai)
#pragma unroll
            for (int m = 0; m < 4; ++m) { const int row = row0 + ai * 128 + m * 16; const size_t off = (size_t)row * DM + col0; float sum = 0.f;
#pragma unroll
                for (int bj = 0; bj < 2; ++bj)
#pragma unroll
                    for (int n = 0; n < 2; ++n) { const size_t o = off + bj * 128 + n * 16; const f32x4 v = *(const f32x4*)(resid + o) + acc[ai][bj][m][n];
                        *(f32x4*)(out + o) = v; u32x2 w; w.x = pk_h2(v[0], v[1]); w.y = pk_h2(v[2], v[3]); *(u32x2*)(outh + o) = w;
                        sum += (v[0] * v[0] + v[1] * v[1]) + (v[2] * v[2] + v[3] * v[3]); }
                sum += __shfl_xor(sum, 16); sum += __shfl_xor(sum, 32);
                if (fq == 0 && doat) atomicAdd(ss + row, sum); }
    }
};
struct EpiQ {
    static constexpr bool PERM = true;
    const float* ss1; h16* Q;
    __device__ __forceinline__ void operator()(const f32x4 (&acc)[2][2][4][2], const Unit& u, int wr, int wc, int fr, int fq) const {
        const int row0 = u.pm * 256 + wr * 64 + fr, col0 = u.pn * 256 + wc * 32 + 8 * fq;
#pragma unroll
        for (int ai = 0; ai < 2; ++ai)
#pragma unroll
            for (int m = 0; m < 4; ++m) { const int row = row0 + ai * 128 + m * 16; const float rs = rsqrtf(ss1[row] * (1.f / DM) + EPS) * 0.0625f;
#pragma unroll
                for (int bj = 0; bj < 2; ++bj) *(u32x4*)(Q + (size_t)row * DM + col0 + bj * 128) = pk_h8(acc[ai][bj][m][0] * rs, acc[ai][bj][m][1] * rs); }
    }
};
struct MoeOrder {
    const char* A; const char* Bt; int K; size_t bexp; const int* list; const unsigned* cnt; const LAS int* tab; int G, c;
    __device__ __forceinline__ bool next(int i, Unit& u) const {
        const int L = i * G + c; const int total = tab[32] * 4; if (L >= total) return false;
        const int rbg = L >> 2; int e = 0;
#pragma unroll 1
        for (int j = 1; j < 32; ++j) e = (tab[j] <= rbg) ? j : e;
        u.pm = rbg; u.pn = L & 3; u.e = e; const int rb = rbg - tab[e]; u.rb = rb; const int left = (int)__hip_atomic_load(cnt + e, __ATOMIC_RELAXED, __HIP_MEMORY_SCOPE_AGENT) - rb * 256; u.nv = left < 256 ? left : 256; return true;
    }
    __device__ __forceinline__ const char* a_base(const Unit& u) const { return A + (size_t)u.pm * (size_t)(256 * 2) * K; }
    __device__ __forceinline__ const char* b_base(const Unit& u) const { return Bt + (size_t)u.e * bexp + (size_t)u.pn * (size_t)(256 * 2) * K; }
    __device__ __forceinline__ const char* g_base() const { return A; }
    __device__ __forceinline__ unsigned a_off(const Unit& u, int h, int R) const { const int r = h * 128 + R; const int tok = (r < u.nv) ? (list[u.e * NTOK + u.rb * 256 + r] >> 1) : 0; return (unsigned)tok * (unsigned)(K * 2); }
};
struct EpiFfn1 {
    static constexpr bool PERM = true;
    const int* list; const float* ss2; h16* H;
    __device__ __forceinline__ void operator()(const f32x4 (&acc)[2][2][4][2], const Unit& u, int wr, int wc, int fr, int fq) const {
        const int r0 = wr * 64 + fr, cw = wc * 32 + 8 * fq;
#pragma unroll
        for (int ai = 0; ai < 2; ++ai)
#pragma unroll
            for (int m = 0; m < 4; ++m) { const int r = r0 + ai * 128 + m * 16; const int tok = (r < u.nv) ? (list[u.e * NTOK + u.rb * 256 + r] >> 1) : 0;
                const float rs = rsqrtf(ss2[tok] * (1.f / DM) + EPS);
                f32x4 a0 = acc[ai][0][m][0] * rs, a1 = acc[ai][0][m][1] * rs; const f32x4 b0 = acc[ai][1][m][0] * rs, b1 = acc[ai][1][m][1] * rs;
#pragma unroll
                for (int j = 0; j < 4; ++j) { a0[j] = fsilu(a0[j]) * b0[j]; a1[j] = fsilu(a1[j]) * b1[j]; }
                *(u32x4*)(H + ((size_t)u.pm * 256 + r) * FF + u.pn * 128 + cw) = pk_h8(a0, a1); }
    }
};
struct EpiFfn2 {
    static constexpr bool PERM = true;
    const int* list; const float* gate; h16* Y;
    __device__ __forceinline__ void operator()(const f32x4 (&acc)[2][2][4][2], const Unit& u, int wr, int wc, int fr, int fq) const {
        const int r0 = wr * 64 + fr, cw = u.pn * 256 + wc * 32 + 8 * fq;
#pragma unroll
        for (int ai = 0; ai < 2; ++ai)
#pragma unroll
            for (int m = 0; m < 4; ++m) { const int r = r0 + ai * 128 + m * 16;
                if (r < u.nv) { const int slot = list[u.e * NTOK + u.rb * 256 + r]; const float g = gate[slot];
#pragma unroll
                    for (int bj = 0; bj < 2; ++bj) *(u32x4*)(Y + (size_t)slot * DM + cw + bj * 128) = pk_h8(acc[ai][bj][m][0] * g, acc[ai][bj][m][1] * g); } }
    }
};


typedef short s16x4 __attribute__((ext_vector_type(4)));
__device__ __forceinline__ h16x4 tr_read4(const LAS unsigned char* p) { return __builtin_bit_cast(h16x4, __builtin_amdgcn_ds_read_tr16_b64_v4i16((LAS s16x4*)p)); }
__device__ __forceinline__ h16x8 cat8(h16x4 a, h16x4 b) { return __builtin_shufflevector(a, b, 0, 1, 2, 3, 4, 5, 6, 7); }
__device__ __forceinline__ h16x4 cvt4(f32x4 v) { return __builtin_convertvector(v, h16x4); }
__device__ __forceinline__ void glds16_asm(const void* gsrc, unsigned lds_dst) { unsigned keep;
    asm volatile("s_mov_b32 %0, m0\n\ts_mov_b32 m0, %2\n\ts_nop 0\n\tglobal_load_lds_dwordx4 %1, off\n\ts_mov_b32 m0, %0" : "=&s"(keep) : "v"(gsrc), "s"(lds_dst) : "memory"); }
#define GLDS16(src, dst) glds16_asm((const void*)(src), __builtin_amdgcn_readfirstlane((unsigned)(size_t)(dst)))
constexpr int ATT_UNITS = 512, ATT_CH = 32768;
__device__ __forceinline__ void attn_issue(LAS unsigned char* lds, const h16* KM, const h16* VM, int c, int G, int bx, int wid, int lane) {
    const int i = c >> 3, n = c & 7, L = i * G + bx, hd = L & 3, tile = L >> 2, b = tile >> 6;
    LAS unsigned char* buf = lds + (unsigned)(c % 3) * ATT_CH;
    if (n < 4) { const char* Kb = (const char*)(KM + (size_t)(b * 256) * 1024 + hd * 256) + n * 128;
#pragma unroll
        for (int q = 0; q < 4; ++q) { const int I = wid * 4 + q, row = I * 8 + (lane >> 3), slot = (lane & 7) ^ ((row >> 1) & 7); GLDS16(Kb + (size_t)row * 2048 + slot * 16, buf + I * 1024); }
    } else { const char* Vb = (const char*)(VM + (size_t)(b * 256 + 64 * (n - 4)) * 1024 + hd * 256);
#pragma unroll
        for (int q = 0; q < 4; ++q) { const int I = wid * 4 + q, row = I * 2 + (lane >> 5), ch = (lane & 31) ^ ((row & 7) << 1); GLDS16(Vb + (size_t)row * 2048 + ch * 16, buf + I * 1024); }
    }
}
__device__ __forceinline__ void attn_phase(LAS unsigned char* lds, const h16* Q, const h16* KM, const h16* VM, h16* ATT, int G, int bx) {
    int tid = threadIdx.x; asm volatile("" : "+v"(tid));
    const int wid = __builtin_amdgcn_readfirstlane(tid >> 6), lane = tid & 63, fr = lane & 15, fq = lane >> 4;
    if (bx >= ATT_UNITS) return;
    const int nun = (ATT_UNITS - bx + G - 1) / G, total = nun * 8;
    attn_issue(lds, KM, VM, 0, G, bx, wid, lane); attn_issue(lds, KM, VM, 1, G, bx, wid, lane);
    const int tq = (lane & 15) >> 2, tp = lane & 3;
    for (int i = 0; i < nun; ++i) {
        const int L = i * G + bx, hd = L & 3, tile = L >> 2; const int trow = tile * 128 + wid * 16 + fr;
        f32x4 S[16]; h16x8 qf[8], pf[8]; f32x4 O[16]; float linv = 0.f;
#pragma unroll
        for (int kt = 0; kt < 16; ++kt) S[kt] = (f32x4){0.f, 0.f, 0.f, 0.f};
#pragma unroll
        for (int n = 0; n < 8; ++n) {
            const int c = i * 8 + n;
            asm volatile("s_waitcnt vmcnt(0)" ::: "memory"); __builtin_amdgcn_s_barrier(); asm volatile("" ::: "memory");
            if (n == 0) {
#pragma unroll
                for (int st = 0; st < 8; ++st) qf[st] = *(const h16x8*)(Q + (size_t)trow * 1024 + hd * 256 + 32 * st + 8 * fq);
            }
            if (c + 2 < total) attn_issue(lds, KM, VM, c + 2, G, bx, wid, lane);
            const LAS unsigned char* buf = lds + (unsigned)(c % 3) * ATT_CH;
            if (n < 4) {
#pragma unroll
                for (int kt = 0; kt < 16; ++kt)
#pragma unroll
                    for (int ks = 0; ks < 2; ++ks) { const int key = kt * 16 + fr, slot = 4 * ks + fq;
                        const h16x8 bf = *(const LAS h16x8*)(buf + key * 128 + ((slot ^ ((key >> 1) & 7)) * 16));
                        S[kt] = __builtin_amdgcn_mfma_f32_16x16x32_f16(bf, qf[2 * n + ks], S[kt], 0, 0, 0);
                        if (ks == 1 && (kt & 3) == 3) __builtin_amdgcn_sched_barrier(0); }
                if (n == 3) {
                    float mx = -INFINITY;
#pragma unroll
                    for (int kt = 0; kt < 16; ++kt)
#pragma unroll
                        for (int j = 0; j < 4; ++j) mx = fmaxf(mx, S[kt][j]);
                    mx = fmaxf(mx, __shfl_xor(mx, 16)); mx = fmaxf(mx, __shfl_xor(mx, 32));
                    float l = 0.f;
#pragma unroll
                    for (int kt = 0; kt < 16; ++kt)
#pragma unroll
                        for (int j = 0; j < 4; ++j) { const float e = __expf(S[kt][j] - mx); S[kt][j] = e; l += e; }
                    l += __shfl_xor(l, 16); l += __shfl_xor(l, 32); linv = 1.f / l;
#pragma unroll
                    for (int st = 0; st < 8; ++st) pf[st] = cat8(cvt4(S[2 * st]), cvt4(S[2 * st + 1]));
                }
            } else {
                if (n == 4) {
#pragma unroll
                    for (int dt = 0; dt < 16; ++dt) O[dt] = (f32x4){0.f, 0.f, 0.f, 0.f};
                }
#pragma unroll
                for (int ks = 0; ks < 2; ++ks) { const int r0 = 32 * ks + 4 * fq + tq, r1 = r0 + 16;
#pragma unroll
                    for (int dt = 0; dt < 16; ++dt) {
                        const h16x4 lo = tr_read4(buf + r0 * 512 + (((2 * dt + (tp >> 1)) ^ ((r0 & 7) << 1)) * 16) + (tp & 1) * 8);
                        const h16x4 hi = tr_read4(buf + r1 * 512 + (((2 * dt + (tp >> 1)) ^ ((r1 & 7) << 1)) * 16) + (tp & 1) * 8);
                        O[dt] = __builtin_amdgcn_mfma_f32_16x16x32_f16(cat8(lo, hi), pf[2 * (n - 4) + ks], O[dt], 0, 0, 0);
                        if ((dt & 3) == 3) __builtin_amdgcn_sched_barrier(0); } }
                if (n == 7) {
#pragma unroll
                    for (int dt = 0; dt < 16; ++dt) { const f32x4 o = O[dt] * linv; u32x2 w; w.x = pk_h2(o[0], o[1]); w.y = pk_h2(o[2], o[3]);
                        *(u32x2*)(ATT + (size_t)trow * 1024 + hd * 256 + 16 * dt + 4 * fq) = w; }
                }
            }
        }
    }
    asm volatile("s_waitcnt vmcnt(0)" ::: "memory"); __builtin_amdgcn_s_barrier();
}


__device__ __forceinline__ void mstate_ext(unsigned char* ws, int bh, int wave, int lane) {
    const float* ig = (const float*)(ws + OFF_IG); const float* lf = (const float*)(ws + OFF_LF);
    const int b = bh >> 2, h = bh & 3; float B = 0.f, mx = -INFINITY;
    for (int s = 0; s < CHUNK; ++s) { const int t = b * SEQ + lane * CHUNK + s; B += lf[t * 4 + h]; mx = fmaxf(mx, ig[t * 4 + h] - B); }
    const float blast = B, maxw = B + mx; float m = 0.f, mc = 0.f, mn = 0.f;
    for (int c = 0; c < NCHUNK; ++c) { const float bl = __shfl(blast, c), mw = __shfl(maxw, c); const float m2 = fmaxf(bl + m, mw); if (lane == c) { mc = m; mn = m2; } m = m2; }
    if (wave == 0) { ((float*)(ws + OFF_MST))[bh * 64 + lane] = mc; ((float*)(ws + OFF_DEC))[bh * 64 + lane] = __expf(blast + mc - mn); }
    float* AL = (float*)(ws + OFF_AL); float* BE = (float*)(ws + OFF_BE); float* NM = (float*)(ws + OFF_NM); float* WU = (float*)(ws + OFF_WU);
    B = 0.f; float rm = -INFINITY;
    for (int s = 0; s < CHUNK; ++s) { const int t = b * SEQ + lane * CHUNK + s; const float li = lf[t * 4 + h], ii = ig[t * 4 + h]; B += li; rm = fmaxf(rm, ii - B);
        if ((s >> 4) == wave) { const float mt = B + fmaxf(mc, rm); AL[t * 4 + h] = B - mt; BE[t * 4 + h] = ii - B; NM[t * 4 + h] = -mt; WU[t * 4 + h] = __expf(ii - B + blast - mn); } }
}

__device__ __forceinline__ int swz128(int row) { return (((row >> 1) & 1) | (((row >> 3) & 1) << 1)) << 1; }
__device__ __forceinline__ void scan_task(LAS unsigned char* lds, const Ptrs& p, unsigned char* ws, int task) {
    int tid = threadIdx.x; asm volatile("" : "+v"(tid));
    const int wid = __builtin_amdgcn_readfirstlane(tid >> 6), lane = tid & 63, fr = lane & 15, fq = lane >> 4;
    const int bh = task >> 4, et = (task >> 2) & 3, dtb = task & 3, b = bh >> 2, hd = bh & 3, e0 = et * 64, d0 = dtb * 64;
    const int cg = tid & 7, rp = tid >> 3, kcol = 1024 + hd * 256 + d0 + 8 * cg;
    f32x4 cw[4][2], cb[2];
#pragma unroll
    for (int j = 0; j < 4; ++j) { cw[j][0] = *(const f32x4*)(p.conv_w + j * 2048 + kcol); cw[j][1] = *(const f32x4*)(p.conv_w + j * 2048 + kcol + 4); }
    cb[0] = *(const f32x4*)(p.conv_b + kcol); cb[1] = *(const f32x4*)(p.conv_b + kcol + 4);
    const h16* QK = (const h16*)p.out; const float* WU = (const float*)(ws + OFF_WU); const float* DEC = (const float*)(ws + OFF_DEC) + bh * 64;
    const h16* Vg = (const h16*)(ws + WS_V);
    h16* CST = (h16*)(ws + WS_CST) + (size_t)bh * 64 * 65536; float* NST = (float*)(ws + WS_NST) + (size_t)bh * 64 * 256;
    const int dti = wid & 3, ep = wid >> 2; const bool doN = (et == 0) && (ep == 0);
    const int tq = (lane & 15) >> 2, tp = lane & 3;
    u32x4 raw[3][5]; float wu[3][2]; float dcv[3];
    f32x4 acc[2] = {(f32x4){0.f, 0.f, 0.f, 0.f}, (f32x4){0.f, 0.f, 0.f, 0.f}}; f32x4 nacc = (f32x4){0.f, 0.f, 0.f, 0.f};
    const h16x8 ones = {(h16)1.f, (h16)1.f, (h16)1.f, (h16)1.f, (h16)1.f, (h16)1.f, (h16)1.f, (h16)1.f};
#define SCAN_LOAD(c_, set_) do { const int t0_ = b * SEQ + (c_) * CHUNK; \
        _Pragma("unroll") for (int q = 0; q < 2; ++q) { const int I = wid * 2 + q, row = I * 8 + (lane >> 3), ch = (lane & 7) ^ swz128(row); \
            GLDS16((const char*)(Vg + (size_t)(t0_ + row) * 1024 + hd * 256 + e0) + ch * 16, lds + 32768 + ((c_) & 3) * 16384 + I * 1024); } \
        _Pragma("unroll") for (int k = 0; k < 5; ++k) { int tl = (c_) * CHUNK + 2 * rp - 3 + k; tl = tl < 0 ? 0 : tl; raw[set_][k] = *(const u32x4*)(QK + (size_t)(b * SEQ + tl) * 2048 + kcol); } \
        wu[set_][0] = WU[(t0_ + 2 * rp) * 4 + hd]; wu[set_][1] = WU[(t0_ + 2 * rp + 1) * 4 + hd]; dcv[set_] = DEC[c_]; } while (0)
#define SCAN_STORE(c_) do { \
        _Pragma("unroll") for (int j = 0; j < 2; ++j) { u32x2 w; w.x = pk_h2(acc[j][0], acc[j][1]); w.y = pk_h2(acc[j][2], acc[j][3]); \
            *(u32x2*)(CST + (size_t)(c_) * 65536 + (size_t)(e0 + 16 * (2 * ep + j) + fr) * 256 + d0 + 16 * dti + 4 * fq) = w; } \
        if (doN && fr == 0) *(f32x4*)(NST + (c_) * 256 + d0 + 16 * dti + 4 * fq) = nacc; } while (0)
#define SCAN_STEP(c_, set_) do { const int c = (c_); \
        SCAN_STORE(c); \
        LAS unsigned char* kb = lds + (c & 1) * 16384; LAS unsigned char* vb = lds + 32768 + (c & 3) * 16384; \
        if (c == 0) { _Pragma("unroll") for (int k = 0; k < 3; ++k) if (2 * rp - 3 + k < 0) raw[set_][k] = (u32x4){0u, 0u, 0u, 0u}; } \
        _Pragma("unroll") for (int rr = 0; rr < 2; ++rr) { f32x4 y0 = cb[0], y1 = cb[1]; \
            _Pragma("unroll") for (int j = 0; j < 4; ++j) { const h16x8 xr = __builtin_bit_cast(h16x8, raw[set_][rr + j]); \
                _Pragma("unroll") for (int q = 0; q < 4; ++q) { y0[q] += cw[j][0][q] * (float)xr[q]; y1[q] += cw[j][1][q] * (float)xr[4 + q]; } } \
            const float sc = 0.0625f * wu[set_][rr]; \
            _Pragma("unroll") for (int q = 0; q < 4; ++q) { y0[q] = fsilu(y0[q]) * sc; y1[q] = fsilu(y1[q]) * sc; } \
            const int row = 2 * rp + rr; *(LAS u32x4*)(kb + row * 128 + ((cg ^ swz128(row)) * 16)) = pk_h8(y0, y1); } \
        asm volatile("s_waitcnt lgkmcnt(0)" ::: "memory"); __builtin_amdgcn_s_barrier(); asm volatile("" ::: "memory"); \
        const float dec = dcv[set_]; \
        if (c + 3 < NCHUNK - 1) SCAN_LOAD(c + 3, set_); \
        acc[0] *= dec; acc[1] *= dec; nacc *= dec; \
        _Pragma("unroll") for (int ks = 0; ks < 4; ++ks) { const int r0 = 32 * ks + 8 * fq + tq, r1 = r0 + 4; \
            const int o0 = r0 * 128 + (tp & 1) * 8, o1 = r1 * 128 + (tp & 1) * 8, s0 = swz128(r0), s1 = swz128(r1), cx = 2 * dti + (tp >> 1); \
            const h16x8 X = cat8(tr_read4(kb + o0 + ((cx ^ s0) * 16)), tr_read4(kb + o1 + ((cx ^ s1) * 16))); \
            _Pragma("unroll") for (int j = 0; j < 2; ++j) { const int cy = 2 * (2 * ep + j) + (tp >> 1); \
                const h16x8 Y = cat8(tr_read4(vb + o0 + ((cy ^ s0) * 16)), tr_read4(vb + o1 + ((cy ^ s1) * 16))); \
                acc[j] = __builtin_amdgcn_mfma_f32_16x16x32_f16(X, Y, acc[j], 0, 0, 0); } \
            if (doN) nacc = __builtin_amdgcn_mfma_f32_16x16x32_f16(X, ones, nacc, 0, 0, 0); } } while (0)
    SCAN_LOAD(0, 0); SCAN_LOAD(1, 1); SCAN_LOAD(2, 2);
#pragma unroll 1
    for (int c3 = 0; c3 < NCHUNK - 1; c3 += 3) { SCAN_STEP(c3, 0); SCAN_STEP(c3 + 1, 1); SCAN_STEP(c3 + 2, 2); }
    SCAN_STORE(NCHUNK - 1);
#undef SCAN_STEP
#undef SCAN_STORE
#undef SCAN_LOAD
    asm volatile("s_waitcnt vmcnt(0) lgkmcnt(0)" ::: "memory"); __builtin_amdgcn_s_barrier();
}

__device__ __forceinline__ int swz256(int row) { return ((row & 3) + 4 * ((row >> 3) & 1)) << 1; }
__device__ __forceinline__ void sgu_task(LAS unsigned char* lds, const Ptrs& p, unsigned char* ws, int task) {
    int tid = threadIdx.x; asm volatile("" : "+v"(tid));
    const int wid = __builtin_amdgcn_readfirstlane(tid >> 6), lane = tid & 63, fr = lane & 15, fq = lane >> 4;
    const int t0 = task * CHUNK;
    LAS unsigned char* wb = lds; LAS unsigned char* vb = lds + 32768; LAS float* rs = (LAS float*)(lds + 65536);
    const float* ss = (const float*)(ws + OFF_SSSV); const h16* SV = (const h16*)(ws + WS_SV); const h16* UG = (const h16*)(ws + WS_UG); h16* Z = (h16*)(ws + WS_XH);
    if (tid < CHUNK) rs[tid] = rsqrtf(ss[t0 + tid] * (1.f / DM) + EPS);
    __syncthreads();
    const int lrow = tid >> 2, lq = tid & 3, tq = (lane & 15) >> 2, tp = lane & 3, trow = 16 * wid + fr;
    f32x4 wraw[8]; h16x8 vraw[4];
#define SGU_LOAD(g_) do { const float* wsrc = p.w_s + (size_t)((g_) * 128 + lrow) * 128 + 32 * lq; const h16* vsrc = SV + (size_t)(t0 + lrow) * 1024 + (g_) * 128 + 32 * lq; \
        _Pragma("unroll") for (int i = 0; i < 8; ++i) wraw[i] = *(const f32x4*)(wsrc + 4 * i); \
        _Pragma("unroll") for (int i = 0; i < 4; ++i) vraw[i] = *(const h16x8*)(vsrc + 8 * i); } while (0)
    SGU_LOAD(0);
#pragma unroll 1
    for (int g = 0; g < 8; ++g) {
        {
            const float* gsrc = p.sgu_norm_g + g * 128 + 32 * lq; const float r = rs[lrow];
#pragma unroll
            for (int i = 0; i < 4; ++i) { f32x4 a = wraw[2 * i], c = wraw[2 * i + 1];
#pragma unroll
                for (int q = 0; q < 4; ++q) { if (32 * lq + 8 * i + q > lrow) a[q] = 0.f; if (32 * lq + 8 * i + 4 + q > lrow) c[q] = 0.f; }
                *(LAS u32x4*)(wb + lrow * 256 + (((4 * lq + i) ^ (lrow & 15)) * 16)) = pk_h8(a, c); }
#pragma unroll
            for (int i = 0; i < 4; ++i) { const h16x8 v = vraw[i]; const f32x4 g0 = *(const f32x4*)(gsrc + 8 * i), g1 = *(const f32x4*)(gsrc + 8 * i + 4); f32x4 a, c;
#pragma unroll
                for (int q = 0; q < 4; ++q) { a[q] = (float)v[q] * r * g0[q]; c[q] = (float)v[4 + q] * r * g1[q]; }
                *(LAS u32x4*)(vb + lrow * 256 + (((4 * lq + i) ^ swz256(lrow)) * 16)) = pk_h8(a, c); }
        }
        __syncthreads();
        if (g + 1 < 8) SGU_LOAD(g + 1);
        const float bias = p.b_s[g * 128 + trow]; const size_t ro = (size_t)(t0 + trow) * 1024 + g * 128 + 4 * fq;
        h16x4 ur[8];
#pragma unroll
        for (int dt = 0; dt < 8; ++dt) ur[dt] = *(const h16x4*)(UG + ro + 16 * dt);
        f32x4 acc[8];
#pragma unroll
        for (int dt = 0; dt < 8; ++dt) acc[dt] = (f32x4){0.f, 0.f, 0.f, 0.f};
        const int nks = (wid >> 1) + 1;
        for (int ks = 0; ks < nks; ++ks) {
            const h16x8 Y = *(const LAS h16x8*)(wb + trow * 256 + (((4 * ks + fq) ^ (trow & 15)) * 16));
            const int r0 = 32 * ks + 8 * fq + tq, r1 = r0 + 4, o0 = r0 * 256 + (tp & 1) * 8, o1 = r1 * 256 + (tp & 1) * 8, s0 = swz256(r0), s1 = swz256(r1);
#pragma unroll
            for (int dt = 0; dt < 8; ++dt) { const int cx = 2 * dt + (tp >> 1);
                const h16x8 X = cat8(tr_read4(vb + o0 + ((cx ^ s0) * 16)), tr_read4(vb + o1 + ((cx ^ s1) * 16)));
                acc[dt] = __builtin_amdgcn_mfma_f32_16x16x32_f16(X, Y, acc[dt], 0, 0, 0); }
        }
#pragma unroll
        for (int dt = 0; dt < 8; ++dt) { const h16x4 u = ur[dt]; u32x2 w;
            w.x = pk_h2((float)u[0] * (acc[dt][0] + bias), (float)u[1] * (acc[dt][1] + bias)); w.y = pk_h2((float)u[2] * (acc[dt][2] + bias), (float)u[3] * (acc[dt][3] + bias));
            *(u32x2*)(Z + ro + 16 * dt) = w; }
        __syncthreads();
    }
#undef SGU_LOAD
}

__device__ __forceinline__ int swzb(int row) { return (row >> 1) & 7; }
__device__ __forceinline__ void mout_phase(LAS unsigned char* lds, const Ptrs& p, unsigned char* ws, int G, int bx, h16* Zdst) {
    const int wid = __builtin_amdgcn_readfirstlane(threadIdx.x >> 6);
    constexpr int QB = 0, KB = 16384, CB = 32768, VB = 69632, SM = 135168;
    const h16* QK = (const h16*)p.out; const h16* Vg = (const h16*)(ws + WS_V); const h16* OG = (const h16*)(ws + WS_OG); h16* Z = (h16*)(ws + WS_XH);
    const float* ALg = (const float*)(ws + OFF_AL); const float* BEg = (const float*)(ws + OFF_BE); const float* NMg = (const float*)(ws + OFF_NM); const float* MST = (const float*)(ws + OFF_MST);
    LAS float* ALs = (LAS float*)(lds + SM); LAS float* BEs = ALs + 128;
#define OPAQUE_TID() int tid = threadIdx.x; asm volatile("" : "+v"(tid)); const int lane = tid & 63, fr = lane & 15, fq = lane >> 4, cg = tid & 7, rp = tid >> 3, tq = (lane & 15) >> 2, tp = lane & 3, trow = 16 * wid + fr; (void)cg; (void)rp; (void)tq; (void)tp; (void)trow; (void)fq
    for (int L = bx; L < 512; L += G) {
        const int bh = L >> 6, c = L & 63, b = bh >> 2, hd = bh & 3, t0 = b * SEQ + c * CHUNK;
        const h16* Ct = (const h16*)(ws + WS_CST) + ((size_t)(bh * 64 + c)) * 65536; const float* nst = (const float*)(ws + WS_NST) + (size_t)(bh * 64 + c) * 256;
        __syncthreads();
        { OPAQUE_TID();
        if (tid < 128) ALs[tid] = ALg[(t0 + tid) * 4 + hd]; else if (tid < 256) BEs[tid - 128] = BEg[(t0 + tid - 128) * 4 + hd];
#pragma unroll
        for (int q = 0; q < 8; ++q) { const int I = wid * 8 + q, row = I * 2 + (lane >> 5), ch = (lane & 31) ^ ((row & 7) << 1);
            GLDS16((const char*)(Vg + (size_t)(t0 + row) * 1024 + hd * 256) + ch * 16, lds + VB + I * 1024); }
        }
        f32x4 S[8], acc[17];
#pragma unroll
        for (int i = 0; i < 8; ++i) S[i] = (f32x4){0.f, 0.f, 0.f, 0.f};
#pragma unroll
        for (int i = 0; i < 17; ++i) acc[i] = (f32x4){0.f, 0.f, 0.f, 0.f};
#pragma unroll 1
        for (int dch = 0; dch < 4; ++dch) {
            OPAQUE_TID();
#pragma unroll
            for (int q = 0; q < 4; ++q) { const int I = wid * 4 + q, row = I * 8 + (lane >> 3), ch = (lane & 7) ^ swzb(row);
                GLDS16((const char*)(Ct + (size_t)row * 256 + dch * 64) + ch * 16, lds + CB + I * 1024); }
            if (tid < 8) { const f32x4 a = *(const f32x4*)(nst + dch * 64 + 8 * tid), c2 = *(const f32x4*)(nst + dch * 64 + 8 * tid + 4); *(LAS u32x4*)(lds + CB + 32768 + tid * 16) = pk_h8(a, c2); }
#pragma unroll 1
            for (int which = 0; which < 2; ++which) {
                const int col = which * 1024 + hd * 256 + dch * 64 + 8 * cg;
                u32x4 raw[5];
#pragma unroll
                for (int k = 0; k < 5; ++k) { const int tl = c * CHUNK + 2 * rp - 3 + k; raw[k] = (u32x4){0u, 0u, 0u, 0u}; if (tl >= 0) raw[k] = *(const u32x4*)(QK + (size_t)(b * SEQ + tl) * 2048 + col); }
                f32x4 cw[4][2];
#pragma unroll
                for (int j = 0; j < 4; ++j) { cw[j][0] = *(const f32x4*)(p.conv_w + j * 2048 + col); cw[j][1] = *(const f32x4*)(p.conv_w + j * 2048 + col + 4); }
                const f32x4 cb0 = *(const f32x4*)(p.conv_b + col), cb1 = *(const f32x4*)(p.conv_b + col + 4);
                const float sc = which ? 0.0625f : 1.f;
#pragma unroll
                for (int rr = 0; rr < 2; ++rr) { f32x4 y0 = cb0, y1 = cb1;
#pragma unroll
                    for (int j = 0; j < 4; ++j) { const h16x8 xr = __builtin_bit_cast(h16x8, raw[rr + j]);
#pragma unroll
                        for (int q = 0; q < 4; ++q) { y0[q] += cw[j][0][q] * (float)xr[q]; y1[q] += cw[j][1][q] * (float)xr[4 + q]; } }
#pragma unroll
                    for (int q = 0; q < 4; ++q) { y0[q] = fsilu(y0[q]) * sc; y1[q] = fsilu(y1[q]) * sc; }
                    const int row = 2 * rp + rr; *(LAS u32x4*)(lds + (which ? KB : QB) + row * 128 + ((cg ^ swzb(row)) * 16)) = pk_h8(y0, y1); }
            }
            asm volatile("s_waitcnt vmcnt(0) lgkmcnt(0)" ::: "memory"); __builtin_amdgcn_s_barrier(); asm volatile("" ::: "memory");
            h16x8 Y[2];
#pragma unroll
            for (int ks = 0; ks < 2; ++ks) Y[ks] = *(const LAS h16x8*)(lds + QB + trow * 128 + (((4 * ks + fq) ^ swzb(trow)) * 16));
#pragma unroll
            for (int st = 0; st < 8; ++st) if (st <= wid) {
#pragma unroll
                for (int ks = 0; ks < 2; ++ks) { const int krow = 16 * st + fr; const h16x8 X = *(const LAS h16x8*)(lds + KB + krow * 128 + (((4 * ks + fq) ^ swzb(krow)) * 16));
                    S[st] = __builtin_amdgcn_mfma_f32_16x16x32_f16(X, Y[ks], S[st], 0, 0, 0); } }
#pragma unroll
            for (int et = 0; et < 17; ++et) {
#pragma unroll
                for (int ks = 0; ks < 2; ++ks) { const int crow = 16 * et + fr; const h16x8 X = *(const LAS h16x8*)(lds + CB + crow * 128 + (((4 * ks + fq) ^ swzb(crow)) * 16));
                    acc[et] = __builtin_amdgcn_mfma_f32_16x16x32_f16(X, Y[ks], acc[et], 0, 0, 0); }
                if ((et & 3) == 3) __builtin_amdgcn_sched_barrier(0); }
            asm volatile("s_waitcnt lgkmcnt(0)" ::: "memory"); __builtin_amdgcn_s_barrier(); asm volatile("" ::: "memory");
        }
        OPAQUE_TID();
        const float al = ALs[trow], mc = MST[bh * 64 + c], iw = __expf(al + mc);
#pragma unroll
        for (int et = 0; et < 16; ++et) acc[et] *= iw;
        const float qn = __shfl(acc[16][0], fr);
        float den = 0.f;
#pragma unroll
        for (int st = 0; st < 8; ++st) { const f32x4 be = *(const LAS f32x4*)(BEs + 16 * st + 4 * fq);
#pragma unroll
            for (int r = 0; r < 4; ++r) { float v = S[st][r] * __expf(al + be[r]); if (st == wid) v = (4 * fq + r <= fr) ? v : 0.f; if (st > wid) v = 0.f; S[st][r] = v; den += v; } }
        den += __shfl_xor(den, 16); den += __shfl_xor(den, 32);
        den += iw * qn;
        h16x8 pf[4];
#pragma unroll
        for (int i = 0; i < 4; ++i) pf[i] = cat8(cvt4(S[2 * i]), cvt4(S[2 * i + 1]));
#pragma unroll
        for (int ks = 0; ks < 4; ++ks) if (ks <= (wid >> 1)) { const int r0 = 32 * ks + 4 * fq + tq, r1 = r0 + 16;
#pragma unroll
            for (int et = 0; et < 16; ++et) {
                const h16x4 lo = tr_read4(lds + VB + r0 * 512 + (((2 * et + (tp >> 1)) ^ ((r0 & 7) << 1)) * 16) + (tp & 1) * 8);
                const h16x4 hi = tr_read4(lds + VB + r1 * 512 + (((2 * et + (tp >> 1)) ^ ((r1 & 7) << 1)) * 16) + (tp & 1) * 8);
                acc[et] = __builtin_amdgcn_mfma_f32_16x16x32_f16(cat8(lo, hi), pf[ks], acc[et], 0, 0, 0);
                if ((et & 3) == 3) __builtin_amdgcn_sched_barrier(0); } }
        const int tg = t0 + trow; const float inv = 1.f / fmaxf(fabsf(den), __expf(NMg[tg * 4 + hd]));
        float ss = 0.f;
#pragma unroll
        for (int et = 0; et < 16; ++et) { acc[et] *= inv; ss += (acc[et][0] * acc[et][0] + acc[et][1] * acc[et][1]) + (acc[et][2] * acc[et][2] + acc[et][3] * acc[et][3]); }
        ss += __shfl_xor(ss, 16); ss += __shfl_xor(ss, 32);
        const float rstd = rsqrtf(ss * (1.f / DH) + EPS);
#pragma unroll
        for (int et = 0; et < 16; ++et) { const int col = hd * 256 + 16 * et + 4 * fq; const size_t o = (size_t)tg * 1024 + col;
            const f32x4 g = *(const f32x4*)(p.mh_norm_g + col); const h16x4 og = *(const h16x4*)(OG + o); const h16x4 z = *(const h16x4*)(Z + o); u32x2 w;
            w.x = pk_h2((float)z[0] + acc[et][0] * rstd * g[0] * (float)og[0], (float)z[1] + acc[et][1] * rstd * g[1] * (float)og[1]);
            w.y = pk_h2((float)z[2] + acc[et][2] * rstd * g[2] * (float)og[2], (float)z[3] + acc[et][3] * rstd * g[3] * (float)og[3]);
            *(u32x2*)(Zdst + o) = w; }
    }
    asm volatile("s_waitcnt vmcnt(0) lgkmcnt(0)" ::: "memory"); __builtin_amdgcn_s_barrier();
#undef OPAQUE_TID
}

__device__ __forceinline__ void p0_transpose_item(const float* W, int ldw, int srccol0, const float* gk, h16* WT, int K, int destrow0, int k0, LAS unsigned char* scr, int lane) {
    const int col4 = lane & 7, krow = lane >> 3;
    f32x4 v[8];
#pragma unroll
    for (int i = 0; i < 8; ++i) v[i] = *(const f32x4*)(W + (size_t)(k0 + 8 * i + krow) * ldw + srccol0 + 4 * col4);
    if (gk) {
#pragma unroll
        for (int i = 0; i < 8; ++i) v[i] *= gk[k0 + 8 * i + krow];
    }
#pragma unroll
    for (int i = 0; i < 8; ++i) { const int k = 8 * i + krow; u32x2 w; w.x = pk_h2(v[i][0], v[i][1]); w.y = pk_h2(v[i][2], v[i][3]);
        *(LAS u32x2*)(scr + k * 64 + (((col4 >> 1) ^ (2 * (i & 1))) * 16) + (col4 & 1) * 8) = w; }
    LDS_WAIT(); asm volatile("" ::: "memory");
    const int g = lane >> 4, li = lane & 15, q = li >> 2, pp = li & 3;
#pragma unroll
    for (int h = 0; h < 2; ++h)
#pragma unroll
        for (int it = 0; it < 2; ++it) { const int m = g + 4 * it, r0 = 8 * m + q, r1 = r0 + 4, ch = (2 * h + (pp >> 1)) ^ (2 * (m & 1));
            const h16x4 lo = tr_read4(scr + r0 * 64 + ch * 16 + (pp & 1) * 8), hi = tr_read4(scr + r1 * 64 + ch * 16 + (pp & 1) * 8);
            *(GAS h16x8*)(WT + (size_t)(destrow0 + 16 * h + li) * K + k0 + 8 * m) = cat8(lo, hi); }
    LDS_WAIT(); asm volatile("" ::: "memory");
}
__device__ __forceinline__ int win_destrow(int l) {
    if (l < 3072) return l;
    if (l < 4096) { const int c = l - 3072; return 3072 + (c >> 7) * 256 + (c & 127); }
    if (l < 5120) { const int c = l - 4096; return 5120 + (c >> 7) * 256 + (c & 127); }
    if (l < 6144) return 7168 + (l - 5120);
    if (l < 7168) { const int c = l - 6144; return 3072 + (c >> 7) * 256 + 128 + (c & 127); }
    { const int c = l - 7168; return 5120 + (c >> 7) * 256 + 128 + (c & 127); }
}
template <bool GATES>
__device__ __forceinline__ float p0_row(const float* xrow, h16* orow, const LAS float* gt, float (&acc)[8], int lane) {
    const GAS f32x4* xr = (const GAS f32x4*)xrow + lane;
    f32x4 v[4]; float ss = 0.f;
#pragma unroll
    for (int j = 0; j < 4; ++j) { v[j] = xr[64 * j]; ss += (v[j].x * v[j].x + v[j].y * v[j].y) + (v[j].z * v[j].z + v[j].w * v[j].w); }
    GAS u32x2* o8 = (GAS u32x2*)orow + lane;
#pragma unroll
    for (int j = 0; j < 4; ++j) { u32x2 w; w.x = pk_h2(v[j].x, v[j].y); w.y = pk_h2(v[j].z, v[j].w); o8[64 * j] = w; }
    if constexpr (GATES) {
#pragma unroll
        for (int q = 0; q < 8; ++q) acc[q] = 0.f;
#pragma unroll
        for (int j = 0; j < 4; ++j)
#pragma unroll
            for (int c = 0; c < 4; ++c) { const int k = 4 * (64 * j + lane) + c; const f32x4 g0 = *(const LAS f32x4*)(gt + k * 8), g1 = *(const LAS f32x4*)(gt + k * 8 + 4); const float xv = v[j][c];
                acc[0] += xv * g0.x; acc[1] += xv * g0.y; acc[2] += xv * g0.z; acc[3] += xv * g0.w; acc[4] += xv * g1.x; acc[5] += xv * g1.y; acc[6] += xv * g1.z; acc[7] += xv * g1.w; }
#pragma unroll
        for (int q = 0; q < 8; ++q) acc[q] = wave_sum(acc[q]);
    }
    return wave_sum(ss);
}
__device__ __forceinline__ void mstate_wave(const float* ig, const float* lf, float* mst, int bh, int lane) {
    const int b = bh >> 2, h = bh & 3; float B = 0.f, mx = -INFINITY;
    for (int s = 0; s < CHUNK; ++s) { const int t = b * SEQ + lane * CHUNK + s; B += lf[t * 4 + h]; mx = fmaxf(mx, ig[t * 4 + h] - B); }
    const float blast = B, maxw = B + mx; float m = 0.f;
    for (int c = 0; c < NCHUNK; ++c) { const float bl = __shfl(blast, c), mw = __shfl(maxw, c); if (lane == c) mst[bh * 64 + c] = m; m = fmaxf(bl + m, mw); }
}

struct Args { Ptrs p; int ph_lo, ph_hi, li, pad; };
__global__ void __launch_bounds__(NTHREADS, 2) mega(Args a) {
    extern __shared__ __attribute__((aligned(16))) unsigned char lds_[];
    LAS unsigned char* lds = (LAS unsigned char*)lds_;
    volatile LAS unsigned* MISC = (volatile LAS unsigned*)(lds + MISC_OFF);
    const Ptrs& p = a.p;
#define PH_IDS() int tid = threadIdx.x; asm volatile("" : "+v"(tid)); const int lane = tid & 63, wave = __builtin_amdgcn_readfirstlane(tid >> 6); const int gw = vcu * NWAVES + wave, NGW = G * NWAVES; (void)lane; (void)gw; (void)NGW
    const int G = gridDim.x, bx = blockIdx.x, vcu = (G % 8 == 0) ? (bx % 8) * (G / 8) + bx / 8 : bx;
    unsigned char* ws = p.ws;
    unsigned* ctl = (unsigned*)(ws + WS_CTL);
    for (int u = threadIdx.x; u < (LDS_BYTES - LDSCTL_OFF) / 4; u += NTHREADS) ((LAS unsigned*)(lds + LDSCTL_OFF))[u] = 0u;
    __syncthreads();
    XcdBarrier bar = xcd_barrier_post(ctl + CW_BAR + a.li * XCD_BAR_WORDS, MISC + 8);
    const int lo = a.ph_lo, hi = a.ph_hi;
#ifndef PH_MASK
#define PH_MASK 0xFFFF
#endif
#define IN(k) (((PH_MASK >> (k)) & 1) && lo <= (k) && (k) < hi)
#ifndef REPEAT_MASK
#define REPEAT_MASK 0
#endif
#define REP(k) for (int rep_ = 0; rep_ < 1 + ((REPEAT_MASK >> (k)) & 1); ++rep_)
#define BOTH(k) (IN(k) && IN((k) + 1))
#define GRID_BAR() xcd_barrier(bar)

    if (IN(0)) REP(0) {
        PH_IDS();
        __syncthreads();
        LAS float* gt = (LAS float*)lds;
        for (int i = tid; i < 8192; i += NTHREADS) { const int k = i >> 3, j = i & 7; gt[i] = p.norm_mix_g[k] * p.w_in[(size_t)k * IN_DIM + C_I + j]; }
        { float* wrt = (float*)(ws + OFF_WRT); for (int i = bx * NTHREADS + tid; i < 36 * 1024; i += G * NTHREADS) { const int j = i >> 10, k = i & 1023; wrt[i] = p.norm_moe_g[k] * (j < 4 ? p.w_rg[k * 4 + j] : p.w_re[k * 32 + (j - 4)]); } }
        { float* z = (float*)(ws + OFF_SSSV); for (int i = bx * NTHREADS + tid; i < 3 * NTOK; i += G * NTHREADS) z[i] = 0.f; }
        __syncthreads();
        float acc[8];
        for (int m = gw; m < NTOK; m += NGW) {
            const float ss = p0_row<true>(p.x + (size_t)m * DM, (h16*)(ws + WS_XH) + (size_t)m * DM, gt, acc, lane);
            const float rstd = rsqrtf(ss * (1.f / DM) + EPS);
            if (lane == 0) { ((float*)(ws + OFF_RSTD0))[m] = rstd; float* ig = (float*)(ws + OFF_IG) + m * 4; float* lf = (float*)(ws + OFF_LF) + m * 4;
#pragma unroll
                for (int h = 0; h < 4; ++h) { ig[h] = acc[h] * rstd + p.b_if[h]; lf[h] = logsigmoidf_(acc[4 + h] * rstd + p.b_if[4 + h]); } }
        }
        for (int m = gw; m < NB * NMEM; m += NGW) {
            const float ss = p0_row<false>(p.mem + (size_t)m * DM, (h16*)(ws + WS_MEMH) + (size_t)m * DM, gt, acc, lane);
            if (lane == 0) ((float*)(ws + OFF_RSTDM))[m] = rsqrtf(ss * (1.f / DM) + EPS);
        }
        LAS unsigned char* scr = lds + 32768 + wave * 4096;
        constexpr int I_WIN = 16 * 256, I_SQ = 16 * 32, I_KV = 16 * 64, NITEMS = I_WIN + 3 * I_SQ + I_KV;
        h16* wsm = (h16*)(ws + WS_WSM);
        for (int it = gw; it < NITEMS; it += NGW) {
            int r = it;
            if (r < I_WIN) { const int kb = r >> 8, nb = r & 255, l0 = 32 * nb; p0_transpose_item(p.w_in, IN_DIM, l0 < 4096 ? l0 : l0 + 8, p.norm_mix_g, (h16*)(ws + WS_WIN), DM, win_destrow(l0), 64 * kb, scr, lane); continue; } r -= I_WIN;
            if (r < I_SQ) { p0_transpose_item(p.w_out, DM, 32 * (r & 31), nullptr, wsm, DM, 32 * (r & 31), 64 * (r >> 5), scr, lane); continue; } r -= I_SQ;
            if (r < I_SQ) { p0_transpose_item(p.w_xq, DM, 32 * (r & 31), p.norm_x_g, wsm + 1024 * 1024, DM, 32 * (r & 31), 64 * (r >> 5), scr, lane); continue; } r -= I_SQ;
            if (r < I_KV) { p0_transpose_item(p.w_xkv, 2048, 32 * (r & 63), p.norm_mem_g, wsm + 2 * 1024 * 1024, DM, 32 * (r & 63), 64 * (r >> 6), scr, lane); continue; } r -= I_KV;
            p0_transpose_item(p.w_xo, DM, 32 * (r & 31), nullptr, wsm + 4 * 1024 * 1024, DM, 32 * (r & 31), 64 * (r >> 5), scr, lane);
        }
        if (BOTH(0)) GRID_BAR();
    }
    if (IN(1)) REP(1) {
        PH_IDS();
        if (bx < 8) mstate_ext(ws, bx, wave, lane);
        { pg8::StaticOrder S; S.init(ws + WS_XH, ws + WS_WIN, NTOK, 8192, DM, G, bx);
          EpiProj E{(const float*)(ws + OFF_RSTD0), p.b_gate, (h16*)p.out, (h16*)(ws + WS_V), (h16*)(ws + WS_OG), (h16*)(ws + WS_UG), (h16*)(ws + WS_SV), (float*)(ws + OFF_SSSV), rep_ == 0};
          pg8::gemm_phase<EpiProj, pg8::StaticOrder, false, true>(lds, DM, S, E); }
        if (BOTH(1)) GRID_BAR();
    }

    if (IN(2)) REP(2) {
        if (G >= 256) { if (bx < 128) scan_task(lds, p, ws, bx); else if (bx < 256) sgu_task(lds, p, ws, bx - 128); }
        if (bx >= 128 || G < 256) { const int c_ = (G >= 256) ? bx - 128 : bx; __syncthreads();
        { pg8::StaticOrder S; S.init(ws + WS_MEMH, ws + WS_WSM + 2 * 2097152, NB * NMEM, 2048, DM, G, c_);
          EpiKV E{(const float*)(ws + OFF_RSTDM), (h16*)(ws + WS_KM), (h16*)(ws + WS_VTM)};
          pg8::gemm_phase<EpiKV, pg8::StaticOrder, false, true>(lds, DM, S, E); }
        }
        else { for (int t = bx; t < 256; t += G) { if (t < 128) scan_task(lds, p, ws, t); else sgu_task(lds, p, ws, t - 128); } }
        if (BOTH(2)) GRID_BAR();
    }
    if (IN(3)) REP(3) {
        mout_phase(lds, p, ws, G, bx, (((REPEAT_MASK >> 3) & 1) && rep_ == 0) ? (h16*)(ws + WS_UG) : (h16*)(ws + WS_XH));
        if (BOTH(3)) GRID_BAR();
    }
    if (IN(4)) REP(4) {
        PH_IDS();
        { LAS unsigned char* scr = lds + 32768 + wave * 4096;
          h16* W13 = (h16*)(ws + WS_UG); h16* W2T = (h16*)(ws + WS_UG + 64 * MiB);
          for (int it = gw; it < 32 * 768; it += NGW) { const int e = it / 768, r = it % 768;
              if (r < 256) { const int kb = r >> 4, nb = r & 15, f0 = 32 * nb; p0_transpose_item(p.w1 + (size_t)e * DM * FF, FF, f0, p.norm_moe_g, W13 + (size_t)e * 1024 * 1024, DM, (f0 >> 7) * 256 + (f0 & 127), 64 * kb, scr, lane); }
              else if (r < 512) { const int q = r - 256, kb = q >> 4, nb = q & 15, f0 = 32 * nb; p0_transpose_item(p.w3 + (size_t)e * DM * FF, FF, f0, p.norm_moe_g, W13 + (size_t)e * 1024 * 1024, DM, (f0 >> 7) * 256 + 128 + (f0 & 127), 64 * kb, scr, lane); }
              else { const int q = r - 512, kb = q >> 5, nb = q & 31; p0_transpose_item(p.w2 + (size_t)e * FF * DM, DM, 32 * nb, nullptr, W2T + (size_t)e * 1024 * 512, FF, 32 * nb, 64 * kb, scr, lane); } }
          __syncthreads(); }
        { pg8::StaticOrder S; S.init(ws + WS_XH, ws + WS_WSM, NTOK, DM, DM, G, bx);
          EpiResid E{p.x, p.out, (h16*)(ws + WS_V), (float*)(ws + OFF_SS1), rep_ == 0};
          pg8::gemm_phase<EpiResid, pg8::StaticOrder, false, false>(lds, DM, S, E); }
        if (BOTH(4)) GRID_BAR();
    }
    if (IN(5)) REP(5) {
        { pg8::StaticOrder S; S.init(ws + WS_V, ws + WS_WSM + 2097152, NTOK, DM, DM, G, bx);
          EpiQ E{(const float*)(ws + OFF_SS1), (h16*)(ws + WS_XH)};
          pg8::gemm_phase<EpiQ, pg8::StaticOrder, false, false>(lds, DM, S, E); }
        if (BOTH(5)) GRID_BAR();
    }
    if (IN(6)) REP(6) {
        attn_phase(lds, (const h16*)(ws + WS_XH), (const h16*)(ws + WS_KM), (const h16*)(ws + WS_VTM), (h16*)(ws + WS_OG), G, bx);
        if (BOTH(6)) GRID_BAR();
    }
    if (IN(7)) {
        { pg8::StaticOrder S; S.init(ws + WS_OG, ws + WS_WSM + 4 * 2097152, NTOK, DM, DM, G, bx);
          EpiResid E{p.out, p.out, (h16*)(ws + WS_V), (float*)(ws + OFF_SS2), true};
          pg8::gemm_phase<EpiResid, pg8::StaticOrder, false, false>(lds, DM, S, E); }
        if (BOTH(7)) GRID_BAR();
    }
    if (IN(8)) REP(8) {
        PH_IDS();
        if (rep_ == 1) { GRID_BAR(); if (bx == 0 && tid < 32) (ctl + CW_CNT)[tid] = 0u; GRID_BAR(); }
        unsigned* cnt = ctl + CW_CNT; int* list = (int*)(ws + OFF_LIST); float* gate = (float*)(ws + OFF_GATE);
        const float* ss2 = (const float*)(ws + OFF_SS2); const float* WRT = (const float*)(ws + OFF_WRT);
        const bool b5 = (lane & 32) != 0, b4 = (lane & 16) != 0, b3 = (lane & 8) != 0;
        int myE = 0, mySlot = 0; float myG = 0.f; int nmine = 0;
        for (int t = gw; t < NTOK; t += NGW) {
            const GAS f32x4* xr = (const GAS f32x4*)(p.out + (size_t)t * DM) + lane; const float rs = rsqrtf(ss2[t] * (1.f / DM) + EPS);
            f32x4 v[4];
#pragma unroll
            for (int j = 0; j < 4; ++j) v[j] = xr[64 * j] * rs;
            float a0 = 0.f, a1 = 0.f, a2 = 0.f, a3 = 0.f;
#pragma unroll
            for (int j = 0; j < 4; ++j) { const GAS f32x4* wp = (const GAS f32x4*)WRT + 64 * j + lane; const f32x4 w0 = wp[0], w1 = wp[256], w2 = wp[512], w3 = wp[768];
                a0 += (v[j].x * w0.x + v[j].y * w0.y) + (v[j].z * w0.z + v[j].w * w0.w); a1 += (v[j].x * w1.x + v[j].y * w1.y) + (v[j].z * w1.z + v[j].w * w1.w);
                a2 += (v[j].x * w2.x + v[j].y * w2.y) + (v[j].z * w2.z + v[j].w * w2.w); a3 += (v[j].x * w3.x + v[j].y * w3.y) + (v[j].z * w3.z + v[j].w * w3.w); }
            { const float s0 = b5 ? a0 : a2, s1 = b5 ? a1 : a3; float k0 = (b5 ? a2 : a0) + __shfl_xor(s0, 32), k1 = (b5 ? a3 : a1) + __shfl_xor(s1, 32);
              const float s2 = b4 ? k0 : k1; a0 = (b4 ? k1 : k0) + __shfl_xor(s2, 16); }
            a0 += __shfl_xor(a0, 8); a0 += __shfl_xor(a0, 4); a0 += __shfl_xor(a0, 2); a0 += __shfl_xor(a0, 1);
            float gl[4];
#pragma unroll
            for (int j = 0; j < 4; ++j) gl[j] = __builtin_bit_cast(float, __builtin_amdgcn_readlane(__builtin_bit_cast(int, a0), 16 * j)) + p.b_rg[j];
            int gi = 0; float gm = gl[0];
#pragma unroll
            for (int j = 1; j < 4; ++j) if (gl[j] > gm) { gm = gl[j]; gi = j; }
            float gs = 0.f;
#pragma unroll
            for (int j = 0; j < 4; ++j) gs += __expf(gl[j] - gm);
            const float pg = 1.f / gs;
            float e[8];
#pragma unroll
            for (int q = 0; q < 8; ++q) e[q] = 0.f;
            const GAS f32x4* we = (const GAS f32x4*)WRT + (size_t)(4 + gi * 8) * 256 + lane;
#pragma unroll
            for (int j = 0; j < 4; ++j)
#pragma unroll
                for (int q = 0; q < 8; ++q) { const f32x4 w = we[q * 256 + 64 * j]; e[q] += (v[j].x * w.x + v[j].y * w.y) + (v[j].z * w.z + v[j].w * w.w); }
            float k4[4];
#pragma unroll
            for (int q = 0; q < 4; ++q) { const float snd = b5 ? e[q] : e[4 + q]; k4[q] = (b5 ? e[4 + q] : e[q]) + __shfl_xor(snd, 32); }
            float k2[2];
#pragma unroll
            for (int q = 0; q < 2; ++q) { const float snd = b4 ? k4[q] : k4[2 + q]; k2[q] = (b4 ? k4[2 + q] : k4[q]) + __shfl_xor(snd, 16); }
            float k1; { const float snd = b3 ? k2[0] : k2[1]; k1 = (b3 ? k2[1] : k2[0]) + __shfl_xor(snd, 8); }
            k1 += __shfl_xor(k1, 4); k1 += __shfl_xor(k1, 2); k1 += __shfl_xor(k1, 1);
            float ev[8];
#pragma unroll
            for (int q = 0; q < 8; ++q) ev[q] = __builtin_bit_cast(float, __builtin_amdgcn_readlane(__builtin_bit_cast(int, k1), 8 * q)) + p.b_re[gi * 8 + q];
            int i1 = 0; float v1 = ev[0];
#pragma unroll
            for (int q = 1; q < 8; ++q) if (ev[q] > v1) { v1 = ev[q]; i1 = q; }
            int i2 = -1; float v2 = -INFINITY;
#pragma unroll
            for (int q = 0; q < 8; ++q) if (q != i1 && ev[q] > v2) { v2 = ev[q]; i2 = q; }
            const float e2 = __expf(v2 - v1), g1 = pg / (1.f + e2), g2 = pg * e2 / (1.f + e2);
            if (lane == 2 * nmine) { myE = gi * 8 + i1; mySlot = 2 * t; myG = g1; }
            if (lane == 2 * nmine + 1) { myE = gi * 8 + i2; mySlot = 2 * t + 1; myG = g2; }
            ++nmine;
            if (nmine == 32) { { const unsigned pos = atomicAdd(cnt + myE, 1u); list[myE * NTOK + pos] = mySlot; gate[mySlot] = myG; } nmine = 0; }
        }
        if (lane < 2 * nmine) { const unsigned pos = atomicAdd(cnt + myE, 1u); list[myE * NTOK + pos] = mySlot; gate[mySlot] = myG; }
        if (BOTH(8)) GRID_BAR();
    }
    if (IN(9) || IN(10)) {
        PH_IDS();
        LAS int* tab = (LAS int*)(lds + LDSCTL_OFF + 1024);
        if (tid == 0) { const unsigned* cnt = ctl + CW_CNT; int s = 0; for (int e = 0; e < 32; ++e) { tab[e] = s; s += (int)((__hip_atomic_load(cnt + e, RLX_AGENT) + 255u) >> 8); } tab[32] = s; }
        __syncthreads();
        if (IN(9)) REP(9) {
            MoeOrder S{(const char*)(ws + WS_V), (const char*)(ws + WS_UG), DM, (size_t)1024 * 1024 * 2, (const int*)(ws + OFF_LIST), ctl + CW_CNT, tab, G, bx};
            EpiFfn1 E{(const int*)(ws + OFF_LIST), (const float*)(ws + OFF_SS2), (h16*)(ws + WS_H)};
            pg8::gemm_phase<EpiFfn1, MoeOrder, true, true>(lds, DM, S, E);
            if (BOTH(9)) GRID_BAR();
        }
        if (IN(10)) REP(10) {
            MoeOrder S{(const char*)(ws + WS_H), (const char*)(ws + WS_UG + 64 * MiB), FF, (size_t)1024 * 512 * 2, (const int*)(ws + OFF_LIST), ctl + CW_CNT, tab, G, bx};
            EpiFfn2 E{(const int*)(ws + OFF_LIST), (const float*)(ws + OFF_GATE), (h16*)(ws + WS_Y)};
            pg8::gemm_phase<EpiFfn2, MoeOrder, false, true>(lds, FF, S, E);
            if (BOTH(10)) GRID_BAR();
        }
    }
    if (IN(11)) REP(11) {
        PH_IDS();
        float* fdst = (((REPEAT_MASK >> 11) & 1) && rep_ == 0) ? (float*)(ws + WS_UG) : p.out;
        for (int t = gw; t < NTOK; t += NGW) {
            GAS f32x4* xr = (GAS f32x4*)(p.out + (size_t)t * DM) + lane; const GAS u32x2* y0 = (const GAS u32x2*)(ws + WS_Y + (size_t)(2 * t) * DM * 2) + lane; const GAS u32x2* y1 = y0 + DM / 4;
            f32x4 v[4]; float ss = 0.f;
#pragma unroll
            for (int j = 0; j < 4; ++j) { const u32x2 a = y0[64 * j], b = y1[64 * j]; const h16x4 ha = __builtin_bit_cast(h16x4, a), hb = __builtin_bit_cast(h16x4, b);
                v[j] = xr[64 * j];
#pragma unroll
                for (int c = 0; c < 4; ++c) { v[j][c] += (float)ha[c] + (float)hb[c]; ss += v[j][c] * v[j][c]; } }
            ss = wave_sum(ss); const float rs = rsqrtf(ss * (1.f / DM) + EPS);
#pragma unroll
            for (int j = 0; j < 4; ++j) { const f32x4 g = *(const f32x4*)(p.norm_f_g + 4 * (64 * j + lane)); ((GAS f32x4*)(fdst + (size_t)t * DM) + lane)[64 * j] = v[j] * rs * g; }
        }
    }
#undef IN
#undef BOTH
#undef GRID_BAR
}

static int mega_grid() {
    static int grid = 0;
    if (grid == 0) {
        int dev = 0, cus = 0;
        if (hipGetDevice(&dev) != hipSuccess || hipDeviceGetAttribute(&cus, hipDeviceAttributeMultiprocessorCount, dev) != hipSuccess) { grid = -1; return grid; }
        if (hipFuncSetAttribute((const void*)mega, hipFuncAttributeMaxDynamicSharedMemorySize, LDS_BYTES) != hipSuccess) { fprintf(stderr, "hipFuncSetAttribute failed\n"); grid = -1; return grid; }
        (void)hipGetLastError();
        grid = cus;
    }
    return grid;
}
static void launch_mega(const Ptrs& p, int lo, int hi, int li, hipStream_t stream) {
    const int grid = mega_grid(); if (grid <= 0) return;
    Args a{}; a.p = p; a.ph_lo = lo; a.ph_hi = hi; a.li = li; a.pad = 0;
    hipLaunchKernelGGL(mega, dim3(grid), dim3(NTHREADS), LDS_BYTES, stream, a);
}

extern "C" void kernel_launch(void* const* d_in, const int* in_sizes, int n_in, void* d_out, int out_size, void* d_ws, size_t ws_size, hipStream_t stream) {
    if (n_in != 27 || ws_size < WS_END) { fprintf(stderr, "kernel_launch: unexpected n_in %d or ws_size %zu (< %zu)\n", n_in, ws_size, (size_t)WS_END); return; }
    Ptrs p{};
    const float** f = (const float**)&p;
    for (int i = 0; i < 27; ++i) f[i] = (const float*)d_in[i];
    p.out = (float*)d_out; p.ws = (unsigned char*)d_ws;
    (void)hipMemsetAsync((char*)d_ws + WS_CTL, 0, CTL_BYTES, stream);
    launch_mega(p, 0, 12, 0, stream);
}
```

```cpp
#include <hip/hip_runtime.h>
#include <cstdio>
#include <cstdint>
#include <cmath>

typedef _Float16 h16;
typedef unsigned short u16;

constexpr int DM = 1024, NB = 2, SEQ = 8192, NTOK = NB * SEQ;
constexpr int NMEM = 256, NHEAD = 4, DH = 256, CHUNK = 128, NCHUNK = SEQ / CHUNK;
constexpr int IN_DIM = 8200;
constexpr int C_QK = 0, C_V = 2048, C_O = 3072, C_I = 4096, C_F = 4100, C_U = 4104, C_SV = 5128, C_G = 6152;
constexpr int NEXP = 32, NGRP = 4, EPG = 8, FF = 512, NSLOT = NTOK * 2;
constexpr float EPS = 1e-6f;

constexpr size_t MiB = 1u << 20;
constexpr size_t WS_CTL = 0;
constexpr size_t CTL_BYTES = 1 * MiB;
constexpr size_t WS_SMALL = 1 * MiB;
constexpr size_t OFF_RSTD0 = WS_SMALL;
constexpr size_t OFF_SSSV  = OFF_RSTD0 + 65536;
constexpr size_t OFF_SS1   = OFF_SSSV + 65536;
constexpr size_t OFF_SS2   = OFF_SS1 + 65536;
constexpr size_t OFF_IG    = OFF_SS2 + 65536;
constexpr size_t OFF_LF    = OFF_IG + 262144;
constexpr size_t OFF_MST   = OFF_LF + 262144;
constexpr size_t OFF_RSTDM = OFF_MST + 4096;
constexpr size_t OFF_AL    = 4 * MiB + 1048576;
constexpr size_t OFF_BE    = OFF_AL + 262144;
constexpr size_t OFF_NM    = OFF_BE + 262144;
constexpr size_t OFF_WU    = OFF_NM + 262144;
constexpr size_t OFF_DEC   = OFF_WU + 262144;
constexpr size_t OFF_WRT   = 7 * MiB;
constexpr size_t OFF_GATE  = 2 * MiB;
constexpr size_t OFF_SLOTE = OFF_GATE + 131072;
constexpr size_t OFF_SLOTP = OFF_SLOTE + 131072;
constexpr size_t OFF_LIST  = 3 * MiB;
constexpr size_t OFF_NAIVE_C = 262 * MiB;
constexpr size_t OFF_NAIVE_N = 6 * MiB + 8192;
constexpr size_t OFF_NAIVE_S = 6 * MiB + 65536;
constexpr size_t WS_WSM  = 8 * MiB;
constexpr size_t WS_KM   = 18 * MiB;
constexpr size_t WS_VTM  = 19 * MiB;
constexpr size_t WS_WIN  = 20 * MiB;
constexpr size_t WS_XH   = 36 * MiB;
constexpr size_t WS_V    = 68 * MiB;
constexpr size_t WS_OG   = 100 * MiB;
constexpr size_t WS_UG   = 132 * MiB;
constexpr size_t WS_SV   = 164 * MiB;
constexpr size_t WS_CST  = 196 * MiB;
constexpr size_t WS_H    = 228 * MiB;
constexpr size_t WS_NST  = 260 * MiB;
constexpr size_t WS_MEMH = 261 * MiB;
constexpr size_t WS_END  = 268 * MiB;
constexpr size_t WS_Y    = WS_XH;
constexpr size_t WS_QC   = WS_UG;
constexpr size_t WS_KC   = WS_SV;
static_assert(OFF_RSTDM + 4096 <= 2 * MiB && OFF_SLOTP + 131072 <= OFF_LIST && OFF_LIST + 2 * MiB <= OFF_AL && OFF_DEC + 4096 <= OFF_NAIVE_N && OFF_NAIVE_N + 8192 <= OFF_NAIVE_S && OFF_NAIVE_S + 524288 <= WS_WSM && OFF_NAIVE_C + 2 * MiB <= WS_END, "small map");
constexpr int CW_CNT = 64;

struct Ptrs {
    const float *x, *mem, *norm_mix_g, *w_in, *b_gate, *b_if, *conv_w, *conv_b, *mh_norm_g, *sgu_norm_g, *w_s, *b_s, *w_out,
                *norm_x_g, *norm_mem_g, *w_xq, *w_xkv, *w_xo, *norm_moe_g, *w_rg, *b_rg, *w_re, *b_re, *w1, *w3, *w2, *norm_f_g;
    float* out; unsigned char* ws;
};

__device__ __forceinline__ float sigmoidf_(float v) { return 1.f / (1.f + __expf(-v)); }
__device__ __forceinline__ float siluf_(float v) { return v / (1.f + __expf(-v)); }
__device__ __forceinline__ float gelu_tanh(float v) { const float u = 0.7978845608028654f * (v + 0.044715f * v * v * v); return v / (1.f + __expf(-2.f * u)); }
__device__ __forceinline__ float logsigmoidf_(float v) { return fminf(v, 0.f) - log1pf(__expf(-fabsf(v))); }
__device__ __forceinline__ float wave_sum(float v) {
#pragma unroll
    for (int o = 1; o < 64; o <<= 1) v += __shfl_xor(v, o);
    return v;
}
__device__ __forceinline__ float wave_max(float v) {
#pragma unroll
    for (int o = 1; o < 64; o <<= 1) v = fmaxf(v, __shfl_xor(v, o));
    return v;
}
__host__ __device__ __forceinline__ int vt_slot(int key) { const int g = key & ~15, r = key & 15;   const int hh = (r >> 2) & 1, j = ((r >> 3) << 2) | (r & 3); return g + 8 * hh + j; }

__global__ void nk_zero(Ptrs p) {
    float* a = (float*)(p.ws + OFF_SSSV);
    const int i = blockIdx.x * blockDim.x + threadIdx.x;
    if (i < 3 * NTOK) a[i] = 0.f;
}
__global__ void nk_rows0(Ptrs p) {
    const int row = blockIdx.x * 4 + (threadIdx.x >> 6), lane = threadIdx.x & 63;
    const float* xr = p.x + (size_t)row * DM;
    float ss = 0.f; float acc[8];
#pragma unroll
    for (int j = 0; j < 8; ++j) acc[j] = 0.f;
    h16* xh = (h16*)(p.ws + WS_XH) + (size_t)row * DM;
    for (int k = lane; k < DM; k += 64) {
        const float v = xr[k]; ss += v * v; xh[k] = (h16)v;
        const float vg = v * p.norm_mix_g[k];
#pragma unroll
        for (int j = 0; j < 8; ++j) acc[j] += vg * p.w_in[(size_t)k * IN_DIM + C_I + j];
    }
    ss = wave_sum(ss);
    const float rstd = rsqrtf(ss / DM + EPS);
#pragma unroll
    for (int j = 0; j < 8; ++j) acc[j] = wave_sum(acc[j]);
    if (lane == 0) {
        ((float*)(p.ws + OFF_RSTD0))[row] = rstd;
        float* ig = (float*)(p.ws + OFF_IG) + row * 4; float* lf = (float*)(p.ws + OFF_LF) + row * 4;
#pragma unroll
        for (int h = 0; h < 4; ++h) { ig[h] = acc[h] * rstd + p.b_if[h]; lf[h] = logsigmoidf_(acc[4 + h] * rstd + p.b_if[4 + h]); }
    }
}
__global__ void nk_mem(Ptrs p) {
    const int row = blockIdx.x * 4 + (threadIdx.x >> 6), lane = threadIdx.x & 63;
    const float* xr = p.mem + (size_t)row * DM; h16* o = (h16*)(p.ws + WS_MEMH) + (size_t)row * DM;
    float ss = 0.f;
    for (int k = lane; k < DM; k += 64) { const float v = xr[k]; ss += v * v; o[k] = (h16)v; }
    ss = wave_sum(ss);
    if (lane == 0) ((float*)(p.ws + OFF_RSTDM))[row] = rsqrtf(ss / DM + EPS);
}
__global__ void nk_mstate(Ptrs p) {
    const int bh = blockIdx.x, b = bh >> 2, h = bh & 3, lane = threadIdx.x;
    const float* ig = (const float*)(p.ws + OFF_IG); const float* lf = (const float*)(p.ws + OFF_LF);
    float B = 0.f, mx = -INFINITY;
    for (int s = 0; s < CHUNK; ++s) { const int t = b * SEQ + lane * CHUNK + s; B += lf[t * 4 + h]; mx = fmaxf(mx, ig[t * 4 + h] - B); }
    const float blast = B, maxw = B + mx;
    __shared__ float sb[64], sm[64];
    sb[lane] = blast; sm[lane] = maxw; __syncthreads();
    if (lane == 0) { float m = 0.f; float* mst = (float*)(p.ws + OFF_MST) + bh * 64;
        for (int c = 0; c < NCHUNK; ++c) { mst[c] = m; m = fmaxf(sb[c] + m, sm[c]); } }
}
__global__ void nk_proj(Ptrs p) {
    const int l = blockIdx.x * 256 + threadIdx.x;
    const int r0 = blockIdx.y * 8;
    int c0, c1 = -1, kind;
    if (l < 2048) { c0 = C_QK + l; kind = 0; }
    else if (l < 3072) { c0 = C_V + (l - 2048); kind = 1; }
    else if (l < 4096) { c0 = C_O + (l - 3072); c1 = C_G + (l - 3072); kind = 2; }
    else if (l < 5120) { c0 = C_U + (l - 4096); c1 = C_G + 1024 + (l - 4096); kind = 3; }
    else if (l < 6144) { c0 = C_SV + (l - 5120); kind = 4; }
    else return;
    float a0[8], a1[8];
#pragma unroll
    for (int r = 0; r < 8; ++r) { a0[r] = 0.f; a1[r] = 0.f; }
    for (int k = 0; k < DM; ++k) {
        const float g = p.norm_mix_g[k];
        const float w0 = p.w_in[(size_t)k * IN_DIM + c0] * g;
        const float w1 = (c1 >= 0) ? p.w_in[(size_t)k * IN_DIM + c1] * g : 0.f;
#pragma unroll
        for (int r = 0; r < 8; ++r) { const float xv = p.x[(size_t)(r0 + r) * DM + k]; a0[r] += xv * w0; a1[r] += xv * w1; }
    }
    const float* rstd0 = (const float*)(p.ws + OFF_RSTD0);
#pragma unroll
    for (int r = 0; r < 8; ++r) {
        const int t = r0 + r; const float rs = rstd0[t]; const float v0 = a0[r] * rs, v1 = a1[r] * rs;
        if (kind == 0) ((h16*)p.out)[(size_t)t * 2048 + l] = (h16)v0;
        else if (kind == 1) ((h16*)(p.ws + WS_V))[(size_t)t * DM + (l - 2048)] = (h16)v0;
        else if (kind == 2) { const int c = l - 3072; ((h16*)(p.ws + WS_OG))[(size_t)t * DM + c] = (h16)(sigmoidf_(v0) * sigmoidf_(v1 + p.b_gate[c])); }
        else if (kind == 3) { const int c = l - 4096; ((h16*)(p.ws + WS_UG))[(size_t)t * DM + c] = (h16)(gelu_tanh(v0) * sigmoidf_(v1 + p.b_gate[1024 + c])); }
        else { const int c = l - 5120; const float gv = gelu_tanh(v0); ((h16*)(p.ws + WS_SV))[(size_t)t * DM + c] = (h16)gv; atomicAdd((float*)(p.ws + OFF_SSSV) + t, gv * gv); }
    }
}
__global__ void nk_conv(Ptrs p) {
    const size_t i = (size_t)blockIdx.x * 256 + threadIdx.x; const int t = (int)(i >> 11), c = (int)(i & 2047), tl = t & (SEQ - 1);
    const h16* qk = (const h16*)p.out;
    float a = p.conv_b[c];
#pragma unroll
    for (int j = 0; j < 4; ++j) { const int dt = j - 3; if (tl + dt >= 0) a += p.conv_w[j * 2048 + c] * (float)qk[(size_t)(t + dt) * 2048 + c]; }
    a = siluf_(a);
    if (c < 1024) ((h16*)(p.ws + WS_QC))[(size_t)t * DM + c] = (h16)a; else ((h16*)(p.ws + WS_KC))[(size_t)t * DM + (c - 1024)] = (h16)(a * 0.0625f);
}
__global__ void __launch_bounds__(1024) nk_mlstm(Ptrs p) {
    const int bh = blockIdx.x, b = bh >> 2, hd = bh & 3, tid = threadIdx.x;
    const h16* Qc = (const h16*)(p.ws + WS_QC); const h16* Kc = (const h16*)(p.ws + WS_KC); const h16* V = (const h16*)(p.ws + WS_V);
    float* C = (float*)(p.ws + OFF_NAIVE_C) + (size_t)bh * 65536; float* nvec = (float*)(p.ws + OFF_NAIVE_N) + bh * 256; float* Sp = (float*)(p.ws + OFF_NAIVE_S) + (size_t)bh * 16384;
    const float* ig = (const float*)(p.ws + OFF_IG); const float* lf = (const float*)(p.ws + OFF_LF);
    float* Hout = p.out;
    __shared__ float s_b[128], s_ic[128], s_mt[128], s_iw[128], s_ws[128], s_misc[4];
    for (int i = tid; i < 65536; i += 1024) C[i] = 0.f;
    if (tid < 256) nvec[tid] = 0.f;
    float m = 0.f;
    __syncthreads();
    for (int c = 0; c < NCHUNK; ++c) {
        const int t0 = b * SEQ + c * CHUNK;
        if (tid == 0) { float B = 0.f; for (int s = 0; s < CHUNK; ++s) { B += lf[(t0 + s) * 4 + hd]; s_b[s] = B; s_ic[s] = ig[(t0 + s) * 4 + hd]; } }
        __syncthreads();
        if (tid < 128) { const int t = tid; float mx = s_b[t] + m; for (int s = 0; s <= t; ++s) mx = fmaxf(mx, s_b[t] - s_b[s] + s_ic[s]); s_mt[t] = mx; s_iw[t] = __expf(s_b[t] + m - mx); }
        if (tid == 128) { const float bl = s_b[127]; float mx = bl + m; for (int s = 0; s < CHUNK; ++s) mx = fmaxf(mx, bl - s_b[s] + s_ic[s]); s_misc[0] = mx; s_misc[1] = __expf(bl + m - mx); }
        __syncthreads();
        if (tid < 128) s_ws[tid] = __expf(s_b[127] - s_b[tid] + s_ic[tid] - s_misc[0]);
        for (int i = tid; i < 16384; i += 1024) { const int t = i >> 7, s = i & 127; float v = 0.f;
            if (s <= t) { float d = 0.f; const h16* q = Qc + (size_t)(t0 + t) * DM + hd * DH; const h16* k = Kc + (size_t)(t0 + s) * DM + hd * DH;
                for (int e = 0; e < DH; ++e) d += (float)q[e] * (float)k[e];
                v = d * __expf(s_b[t] - s_b[s] + s_ic[s] - s_mt[t]); }
            Sp[i] = v; }
        __threadfence_block(); __syncthreads();
        for (int i = tid; i < 32768; i += 1024) { const int t = i >> 8, e = i & 255; float num = 0.f, den = 0.f;
            for (int s = 0; s <= t; ++s) { const float sv = Sp[t * 128 + s]; num += sv * (float)V[(size_t)(t0 + s) * DM + hd * DH + e]; den += sv; }
            float qc = 0.f, qn = 0.f; const h16* q = Qc + (size_t)(t0 + t) * DM + hd * DH;
            for (int d = 0; d < DH; ++d) { const float qv = (float)q[d]; qc += qv * C[d * 256 + e]; qn += qv * nvec[d]; }
            num += s_iw[t] * qc; den += s_iw[t] * qn;
            Hout[(size_t)(t0 + t) * DM + hd * DH + e] = num / fmaxf(fabsf(den), __expf(-s_mt[t])); }
        __syncthreads();
        const float decay = s_misc[1];
        for (int i = tid; i < 65536; i += 1024) { const int d = i >> 8, e = i & 255; float a = 0.f;
            for (int s = 0; s < CHUNK; ++s) a += s_ws[s] * (float)Kc[(size_t)(t0 + s) * DM + hd * DH + d] * (float)V[(size_t)(t0 + s) * DM + hd * DH + e];
            C[i] = decay * C[i] + a; }
        if (tid < 256) { float a = 0.f; for (int s = 0; s < CHUNK; ++s) a += s_ws[s] * (float)Kc[(size_t)(t0 + s) * DM + hd * DH + tid]; nvec[tid] = decay * nvec[tid] + a; }
        m = s_misc[0];
        __threadfence_block(); __syncthreads();
    }
}

__global__ void __launch_bounds__(1024) nk_mout(Ptrs p) {
    const int bh = blockIdx.x >> 6, c = blockIdx.x & 63, b = bh >> 2, hd = bh & 3, tid = threadIdx.x, t0 = b * SEQ + c * CHUNK;
    const h16* Qc = (const h16*)(p.ws + WS_QC); const h16* Kc = (const h16*)(p.ws + WS_KC); const h16* V = (const h16*)(p.ws + WS_V);
    const h16* Ct = (const h16*)(p.ws + WS_CST) + ((size_t)(bh * 64 + c)) * 65536; const float* nst = (const float*)(p.ws + WS_NST) + (size_t)(bh * 64 + c) * 256;
    const float* AL = (const float*)(p.ws + OFF_AL); const float* BE = (const float*)(p.ws + OFF_BE); const float* NM = (const float*)(p.ws + OFF_NM);
    const float mc = ((const float*)(p.ws + OFF_MST))[bh * 64 + c];
    __shared__ h16 Sp[128 * 128];
    for (int i = tid; i < 16384; i += 1024) { const int t = i >> 7, s = i & 127; float v = 0.f;
        if (s <= t) { float d = 0.f; const h16* q = Qc + (size_t)(t0 + t) * DM + hd * DH; const h16* k = Kc + (size_t)(t0 + s) * DM + hd * DH;
            for (int e = 0; e < DH; ++e) d += (float)q[e] * (float)k[e];
            v = d * __expf(AL[(t0 + t) * 4 + hd] + BE[(t0 + s) * 4 + hd]); }
        Sp[i] = (h16)v; }
    __syncthreads();
    for (int i = tid; i < 32768; i += 1024) { const int t = i >> 8, e = i & 255; float num = 0.f, den = 0.f;
        for (int s = 0; s <= t; ++s) { const float sv = (float)Sp[t * 128 + s]; num += sv * (float)V[(size_t)(t0 + s) * DM + hd * DH + e]; den += sv; }
        float qc = 0.f, qn = 0.f; const h16* q = Qc + (size_t)(t0 + t) * DM + hd * DH;
        for (int d = 0; d < DH; ++d) { const float qv = (float)q[d]; qc += qv * (float)Ct[e * 256 + d]; qn += qv * nst[d]; }
        const float iw = __expf(AL[(t0 + t) * 4 + hd] + mc);
        num += iw * qc; den += iw * qn;
        p.out[(size_t)(t0 + t) * DM + hd * DH + e] = num / fmaxf(fabsf(den), __expf(NM[(t0 + t) * 4 + hd])); }
}
__global__ void nk_sgu(Ptrs p) {
    const size_t i = (size_t)blockIdx.x * 256 + threadIdx.x; const int t = (int)(i >> 10), ch = (int)(i & 1023), g = ch >> 7, tl = t & 127, t0 = t - tl;
    const h16* SV = (const h16*)(p.ws + WS_SV); const float* ss = (const float*)(p.ws + OFF_SSSV);
    float a = 0.f;
    for (int s = 0; s <= tl; ++s) a += p.w_s[(g * 128 + tl) * 128 + s] * (float)SV[(size_t)(t0 + s) * DM + ch] * rsqrtf(ss[t0 + s] / DM + EPS);
    a = a * p.sgu_norm_g[ch] + p.b_s[g * 128 + tl];
    ((h16*)(p.ws + WS_XH))[i] = (h16)((float)((const h16*)(p.ws + WS_UG))[i] * a);
}
__global__ void nk_ya(Ptrs p) {
    const int w = blockIdx.x * 4 + (threadIdx.x >> 6), lane = threadIdx.x & 63, t = w >> 2, hd = w & 3;
    const float* hrow = p.out + (size_t)t * DM + hd * DH; float v[4]; float ss = 0.f;
#pragma unroll
    for (int j = 0; j < 4; ++j) { v[j] = hrow[lane + 64 * j]; ss += v[j] * v[j]; }
    ss = wave_sum(ss); const float rs = rsqrtf(ss / DH + EPS);
    h16* Z = (h16*)(p.ws + WS_XH) + (size_t)t * DM + hd * DH; const h16* OG = (const h16*)(p.ws + WS_OG) + (size_t)t * DM + hd * DH;
#pragma unroll
    for (int j = 0; j < 4; ++j) { const int e = lane + 64 * j; Z[e] = (h16)((float)Z[e] + v[j] * rs * p.mh_norm_g[hd * DH + e] * (float)OG[e]); }
}
__global__ void nk_wout(Ptrs p) {
    const int c = blockIdx.x * 256 + threadIdx.x, r0 = blockIdx.y * 8;
    const h16* Z = (const h16*)(p.ws + WS_XH);
    float a[8];
#pragma unroll
    for (int r = 0; r < 8; ++r) a[r] = 0.f;
    for (int k = 0; k < DM; ++k) { const float w = p.w_out[(size_t)k * DM + c];
#pragma unroll
        for (int r = 0; r < 8; ++r) a[r] += (float)Z[(size_t)(r0 + r) * DM + k] * w; }
#pragma unroll
    for (int r = 0; r < 8; ++r) { const int t = r0 + r; const float v = p.x[(size_t)t * DM + c] + a[r]; p.out[(size_t)t * DM + c] = v; ((h16*)(p.ws + WS_V))[(size_t)t * DM + c] = (h16)v;
        atomicAdd((float*)(p.ws + OFF_SS1) + t, v * v); }
}
__global__ void nk_q(Ptrs p) {
    const int c = blockIdx.x * 256 + threadIdx.x, r0 = blockIdx.y * 8;
    float a[8];
#pragma unroll
    for (int r = 0; r < 8; ++r) a[r] = 0.f;
    for (int k = 0; k < DM; ++k) { const float w = p.w_xq[(size_t)k * DM + c] * p.norm_x_g[k];
#pragma unroll
        for (int r = 0; r < 8; ++r) a[r] += p.out[(size_t)(r0 + r) * DM + k] * w; }
    const float* ss1 = (const float*)(p.ws + OFF_SS1);
#pragma unroll
    for (int r = 0; r < 8; ++r) { const int t = r0 + r; ((h16*)(p.ws + WS_XH))[(size_t)t * DM + c] = (h16)(a[r] * rsqrtf(ss1[t] / DM + EPS) * 0.0625f); }
}
__global__ void nk_kv(Ptrs p) {
    const int c = blockIdx.x * 256 + threadIdx.x, r0 = blockIdx.y * 8;
    float a[8];
#pragma unroll
    for (int r = 0; r < 8; ++r) a[r] = 0.f;
    for (int k = 0; k < DM; ++k) { const float w = p.w_xkv[(size_t)k * 2048 + c] * p.norm_mem_g[k];
#pragma unroll
        for (int r = 0; r < 8; ++r) a[r] += p.mem[(size_t)(r0 + r) * DM + k] * w; }
    const float* rm = (const float*)(p.ws + OFF_RSTDM);
#pragma unroll
    for (int r = 0; r < 8; ++r) { const int m = r0 + r; const float v = a[r] * rm[m];
        if (c < 1024) ((h16*)(p.ws + WS_KM))[(size_t)m * DM + c] = (h16)v;
        else ((h16*)(p.ws + WS_VTM))[(size_t)m * DM + (c - 1024)] = (h16)v; }
}
__global__ void nk_attn(Ptrs p) {
    const int t = blockIdx.x >> 2, hd = blockIdx.x & 3, b = t / SEQ, j = threadIdx.x;
    const h16* q = (const h16*)(p.ws + WS_XH) + (size_t)t * DM + hd * DH;
    const h16* K = (const h16*)(p.ws + WS_KM) + (size_t)(b * 256 + j) * DM + hd * DH;
    __shared__ float sp[256], red[8];
    float s = 0.f;
    for (int d = 0; d < DH; ++d) s += (float)q[d] * (float)K[d];
    float mx = wave_max(s); if ((j & 63) == 0) red[j >> 6] = mx; __syncthreads();
    mx = fmaxf(fmaxf(red[0], red[1]), fmaxf(red[2], red[3]));
    const float e = __expf(s - mx); sp[j] = e;
    float sm = wave_sum(e); if ((j & 63) == 0) red[4 + (j >> 6)] = sm; __syncthreads();
    sm = red[4] + red[5] + red[6] + red[7];
    const h16* VT = (const h16*)(p.ws + WS_VTM) + (size_t)(b * 256) * DM + hd * DH + j;
    float o = 0.f;
    for (int key = 0; key < 256; ++key) o += sp[key] * (float)VT[(size_t)key * DM];
    ((h16*)(p.ws + WS_OG))[(size_t)t * DM + hd * DH + j] = (h16)(o / sm);
}
__global__ void nk_wxo(Ptrs p) {
    const int c = blockIdx.x * 256 + threadIdx.x, r0 = blockIdx.y * 8;
    const h16* A = (const h16*)(p.ws + WS_OG);
    float a[8];
#pragma unroll
    for (int r = 0; r < 8; ++r) a[r] = 0.f;
    for (int k = 0; k < DM; ++k) { const float w = p.w_xo[(size_t)k * DM + c];
#pragma unroll
        for (int r = 0; r < 8; ++r) a[r] += (float)A[(size_t)(r0 + r) * DM + k] * w; }
#pragma unroll
    for (int r = 0; r < 8; ++r) { const int t = r0 + r; const float v = p.out[(size_t)t * DM + c] + a[r]; p.out[(size_t)t * DM + c] = v; ((h16*)(p.ws + WS_V))[(size_t)t * DM + c] = (h16)v;
        atomicAdd((float*)(p.ws + OFF_SS2) + t, v * v); }
}
__global__ void nk_router(Ptrs p) {
    const int t = blockIdx.x * 4 + (threadIdx.x >> 6), lane = threadIdx.x & 63;
    const float* xr = p.out + (size_t)t * DM; const float rs = rsqrtf(((const float*)(p.ws + OFF_SS2))[t] / DM + EPS);
    float acc[36];
#pragma unroll
    for (int j = 0; j < 36; ++j) acc[j] = 0.f;
    for (int k = lane; k < DM; k += 64) { const float v = xr[k] * rs * p.norm_moe_g[k];
#pragma unroll
        for (int j = 0; j < 4; ++j) acc[j] += v * p.w_rg[k * 4 + j];
#pragma unroll
        for (int j = 0; j < 32; ++j) acc[4 + j] += v * p.w_re[k * 32 + j]; }
#pragma unroll
    for (int j = 0; j < 36; ++j) acc[j] = wave_sum(acc[j]);
    if (lane == 0) {
        float gl[4]; int gi = 0;
#pragma unroll
        for (int j = 0; j < 4; ++j) gl[j] = acc[j] + p.b_rg[j];
        float gm = gl[0];
#pragma unroll
        for (int j = 1; j < 4; ++j) if (gl[j] > gm) { gm = gl[j]; gi = j; }
        float gs = 0.f;
#pragma unroll
        for (int j = 0; j < 4; ++j) gs += __expf(gl[j] - gm);
        float ev[8];
#pragma unroll
        for (int j = 0; j < 8; ++j) { float v = acc[4 + j] + p.b_re[j];
#pragma unroll
            for (int g = 1; g < 4; ++g) v = (gi == g) ? acc[4 + g * 8 + j] + p.b_re[g * 8 + j] : v;
            ev[j] = v; }
        float pg = 0.f;
#pragma unroll
        for (int j = 0; j < 4; ++j) pg = (gi == j) ? __expf(gl[j] - gm) / gs : pg;
        int i1 = 0; float v1 = ev[0];
#pragma unroll
        for (int j = 1; j < 8; ++j) if (ev[j] > v1) { v1 = ev[j]; i1 = j; }
        int i2 = -1; float v2 = -INFINITY;
#pragma unroll
        for (int j = 0; j < 8; ++j) if (j != i1 && ev[j] > v2) { v2 = ev[j]; i2 = j; }
        const float e2 = __expf(v2 - v1), g1 = pg / (1.f + e2), g2 = pg * e2 / (1.f + e2);
        unsigned* cnt = (unsigned*)(p.ws + WS_CTL) + CW_CNT;
        int* list = (int*)(p.ws + OFF_LIST); float* gate = (float*)(p.ws + OFF_GATE); int* se = (int*)(p.ws + OFF_SLOTE); int* sp = (int*)(p.ws + OFF_SLOTP);
        const int e1x = gi * 8 + i1, e2x = gi * 8 + i2;
        const unsigned p1 = atomicAdd(cnt + e1x, 1u); list[e1x * NTOK + p1] = t * 2; gate[t * 2] = g1; se[t * 2] = e1x; sp[t * 2] = (int)p1;
        const unsigned p2 = atomicAdd(cnt + e2x, 1u); list[e2x * NTOK + p2] = t * 2 + 1; gate[t * 2 + 1] = g2; se[t * 2 + 1] = e2x; sp[t * 2 + 1] = (int)p2;
    }
}
__device__ __forceinline__ int moe_pstart(const unsigned* cnt, int e) { int s = 0; for (int i = 0; i < e; ++i) s += (int)((cnt[i] + 255u) & ~255u); return s; }
__global__ void nk_ffn1(Ptrs p) {
    const int f = blockIdx.x * 256 + threadIdx.x, s0 = blockIdx.y * 8;
    const unsigned* cnt = (const unsigned*)(p.ws + WS_CTL) + CW_CNT; const int* se = (const int*)(p.ws + OFF_SLOTE); const int* sp = (const int*)(p.ws + OFF_SLOTP);
    const float* ss2 = (const float*)(p.ws + OFF_SS2);
    for (int r = 0; r < 8; ++r) { const int slot = s0 + r, tok = slot >> 1, e = se[slot];
        const float* xr = p.out + (size_t)tok * DM; float a1 = 0.f, a3 = 0.f;
        const float* W1 = p.w1 + (size_t)e * DM * FF; const float* W3 = p.w3 + (size_t)e * DM * FF;
        for (int k = 0; k < DM; ++k) { const float v = xr[k] * p.norm_moe_g[k]; a1 += v * W1[(size_t)k * FF + f]; a3 += v * W3[(size_t)k * FF + f]; }
        const float rs = rsqrtf(ss2[tok] / DM + EPS); a1 *= rs; a3 *= rs;
        const int prow = moe_pstart(cnt, e) + sp[slot];
        ((h16*)(p.ws + WS_H))[(size_t)prow * FF + f] = (h16)(siluf_(a1) * a3); }
}
__global__ void nk_ffn2(Ptrs p) {
    const int c = blockIdx.x * 256 + threadIdx.x, s0 = blockIdx.y * 8;
    const unsigned* cnt = (const unsigned*)(p.ws + WS_CTL) + CW_CNT; const int* se = (const int*)(p.ws + OFF_SLOTE); const int* sp = (const int*)(p.ws + OFF_SLOTP);
    const float* gate = (const float*)(p.ws + OFF_GATE);
    for (int r = 0; r < 8; ++r) { const int slot = s0 + r, e = se[slot]; const int prow = moe_pstart(cnt, e) + sp[slot];
        const h16* hr = (const h16*)(p.ws + WS_H) + (size_t)prow * FF; const float* W2 = p.w2 + (size_t)e * FF * DM; float a = 0.f;
        for (int k = 0; k < FF; ++k) a += (float)hr[k] * W2[(size_t)k * DM + c];
        ((h16*)(p.ws + WS_Y))[(size_t)slot * DM + c] = (h16)(a * gate[slot]); }
}
__global__ void nk_final(Ptrs p) {
    const int t = blockIdx.x * 4 + (threadIdx.x >> 6), lane = threadIdx.x & 63;
    float* xr = p.out + (size_t)t * DM; const h16* y0 = (const h16*)(p.ws + WS_Y) + (size_t)(2 * t) * DM; const h16* y1 = y0 + DM;
    float v[16]; float ss = 0.f;
#pragma unroll
    for (int j = 0; j < 16; ++j) { const int k = lane + 64 * j; v[j] = xr[k] + (float)y0[k] + (float)y1[k]; ss += v[j] * v[j]; }
    ss = wave_sum(ss); const float rs = rsqrtf(ss / DM + EPS);
#pragma unroll
    for (int j = 0; j < 16; ++j) { const int k = lane + 64 * j; xr[k] = v[j] * rs * p.norm_f_g[k]; }
}

#define LAS __attribute__((address_space(3)))
#define GAS __attribute__((address_space(1)))
typedef _Float16 h16x8 __attribute__((ext_vector_type(8)));
typedef _Float16 h16x4 __attribute__((ext_vector_type(4)));
typedef _Float16 h16x2 __attribute__((ext_vector_type(2)));
typedef float f32x4 __attribute__((ext_vector_type(4)));
typedef float f32x2 __attribute__((ext_vector_type(2)));
typedef unsigned u32x4 __attribute__((ext_vector_type(4)));
typedef unsigned u32x2 __attribute__((ext_vector_type(2)));
typedef GAS unsigned gu32;
#define RLX_AGENT __ATOMIC_RELAXED, __HIP_MEMORY_SCOPE_AGENT
#define LDS_WAIT() asm volatile("s_waitcnt lgkmcnt(0)" ::: "memory")
#define VM_WAIT() asm volatile("s_waitcnt vmcnt(0)" ::: "memory")
__device__ __forceinline__ unsigned pk_h2(float lo, float hi) { f32x2 v = {lo, hi}; return __builtin_bit_cast(unsigned, __builtin_convertvector(v, h16x2)); }
__device__ __forceinline__ u32x4 pk_h8(f32x4 a, f32x4 b) { u32x4 w; w.x = pk_h2(a[0], a[1]); w.y = pk_h2(a[2], a[3]); w.z = pk_h2(b[0], b[1]); w.w = pk_h2(b[2], b[3]); return w; }
__device__ __forceinline__ float fsigmoid(float v) { return __builtin_amdgcn_rcpf(1.f + __expf(-v)); }
__device__ __forceinline__ float fgelu(float v) { const float u = 1.5957691216057308f * (v + 0.044715f * v * v * v); return v * __builtin_amdgcn_rcpf(1.f + __expf(-u)); }
__device__ __forceinline__ float fsilu(float v) { return v * __builtin_amdgcn_rcpf(1.f + __expf(-v)); }

constexpr int NWAVES = 8, NTHREADS = 512;
constexpr int RING_BYTES = 143360, LDSCTL_OFF = RING_BYTES, MISC_OFF = LDSCTL_OFF + 320, LDS_BYTES = 147456;
constexpr int CW_TMO = 0, CW_BAR = 4096;

#define XB_TMO      128
#define XB_XCNT(j)  (256  + 64 * (j))
#define XB_XSUB(j)  (1280 + 64 * (j))
#define XB_XGEN(j)  (2304 + 64 * (j))
#define XB_TOP      3328
#define XB_TOPGEN   3392
#define XCD_BAR_WORDS 3456
#define XB_SPIN_CAP (1u << 20)
__device__ __forceinline__ unsigned xb_ld(unsigned* p)              { return __hip_atomic_load(p, __ATOMIC_RELAXED, __HIP_MEMORY_SCOPE_AGENT); }
__device__ __forceinline__ unsigned xb_add(unsigned* p, unsigned v) { return __hip_atomic_fetch_add(p, v, __ATOMIC_RELAXED, __HIP_MEMORY_SCOPE_AGENT); }
__device__ __forceinline__ unsigned xb_xcc_id() { return (unsigned)__builtin_amdgcn_s_getreg((3 << 11) | 20) & 0xFu; }
#define XB_SPIN(cond, bar) do { unsigned _sp = 0; while (cond) { __builtin_amdgcn_s_sleep(1); \
    if ((++_sp & 255u) == 0u) { if (xb_ld(&(bar)[XB_TMO])) break; if (_sp > XB_SPIN_CAP) { atomicAdd(&(bar)[XB_TMO], 1u); break; } } } } while (0)
struct XcdBarrier { unsigned* bar; unsigned x; volatile LAS unsigned* st; };
__device__ __forceinline__ XcdBarrier xcd_barrier_post(unsigned* bar, volatile LAS unsigned* st) {
    XcdBarrier b; b.bar = bar; b.x = xb_xcc_id(); b.st = st;
    if (threadIdx.x == 0) (void)xb_add(&bar[XB_XCNT(b.x)], 1u);
    return b;
}
__device__ __forceinline__ void xcd_barrier_complete(unsigned* bar, unsigned x, unsigned& nloc, unsigned& nx) {
    const unsigned G = gridDim.x * gridDim.y * gridDim.z;
    unsigned sum, cnt, mine, sp = 0u;
    for (;;) {
        sum = 0u; cnt = 0u; mine = 0u;
#pragma unroll
        for (unsigned j = 0; j < 16; ++j) { const unsigned c = xb_ld(&bar[XB_XCNT(j)]); sum += c; cnt += (c > 0u) ? 1u : 0u; mine = (j == x) ? c : mine; }
        if (sum == G) break;
        __builtin_amdgcn_s_sleep(1);
        if ((++sp & 255u) == 0u) { if (xb_ld(&bar[XB_TMO])) break; if (sp > XB_SPIN_CAP) { atomicAdd(&bar[XB_TMO], 1u); break; } }
    }
    nloc = mine > 0u ? mine : 1u; nx = cnt > 0u ? cnt : 1u;
}
__device__ __forceinline__ void xcd_barrier(const XcdBarrier& b) {
    asm volatile("s_waitcnt vmcnt(0)" ::: "memory");
    __syncthreads();
    if (threadIdx.x == 0) {
        unsigned* bar = b.bar;
        __builtin_amdgcn_s_waitcnt(0);
        unsigned nloc = b.st[0], nx = b.st[1];
        if (nloc == 0u) { xcd_barrier_complete(bar, b.x, nloc, nx); b.st[0] = nloc; b.st[1] = nx; }
        const unsigned old = xb_add(&bar[XB_XSUB(b.x)], 1u);
        const unsigned gen = old / nloc;
        if (old + 1u == (gen + 1u) * nloc) {
            __builtin_amdgcn_fence(__ATOMIC_RELEASE, "agent");
            asm volatile("s_waitcnt vmcnt(0)" ::: "memory");
            const unsigned og = xb_add(&bar[XB_TOP], 1u);
            const unsigned tg = og / nx;
            if (og + 1u == (tg + 1u) * nx) xb_add(&bar[XB_TOPGEN], 1u);
            else XB_SPIN(xb_ld(&bar[XB_TOPGEN]) == tg, bar);
            __builtin_amdgcn_fence(__ATOMIC_ACQUIRE, "agent");
            xb_add(&bar[XB_XGEN(b.x)], 1u);
            asm volatile("s_waitcnt vmcnt(0)" ::: "memory");
        } else {
            XB_SPIN(xb_ld(&bar[XB_XGEN(b.x)]) == gen, bar);
            __builtin_amdgcn_fence(__ATOMIC_ACQUIRE, "agent");
            asm volatile("s_waitcnt vmcnt(0)" ::: "memory");
        }
    }
    __syncthreads();
}

namespace pg8 {
constexpr int BM = 256, BK = 64, HALF = 128, HTB = HALF * BK * 2, STAGE_BYTES = 8 * HTB, NXCD = 8, WGM = 8;
__host__ __device__ __forceinline__ int lds_byte(int r, int c) { const int st = (r >> 4) * 2 + (c >> 5), rr = r & 15, cc = c & 31, ob = rr * 64 + cc * 2; return st * 1024 + (ob ^ (((ob >> 9) & 1) << 5)); }
__host__ __device__ __forceinline__ void stage_rc(int b, int& R, int& C) { const int st = b / 1024, sb = b % 1024, swz = sb ^ (((sb >> 9) & 1) << 5); R = (st >> 1) * 16 + swz / 64; C = (st & 1) * 32 + (swz % 64) / 2; }
__host__ __device__ __forceinline__ int perm32(int rho) { const int n = rho >> 4, i = rho & 15; return 8 * (i >> 2) + 4 * n + (i & 3); }
struct Unit { int pm, pn, e, nv, rb; };
struct StaticOrder {
    const char* A; const char* Bt; int K; int nM, nN, nwg, G, c;
    __device__ __forceinline__ void init(const void* A_, const void* Bt_, int M, int N, int K_, int G_, int c_) { A = (const char*)A_; Bt = (const char*)Bt_; K = K_; nM = M / BM; nN = N / BM; nwg = nM * nN; G = G_; c = c_; }
    __device__ __forceinline__ bool next(int i, Unit& u) const {
        const long L = (long)i * G + c; if (L >= nwg) return false;
        int wgid = (int)L; { const int q = nwg / NXCD, r = nwg % NXCD, xcd = wgid % NXCD, off = wgid / NXCD; wgid = (xcd < r ? xcd * (q + 1) : r * (q + 1) + (xcd - r) * q) + off; }
        const int nig = WGM * nN, gid = wgid / nig, fm = gid * WGM, gsz = (nM - fm) < WGM ? (nM - fm) : WGM;
        u.pm = fm + ((wgid % nig) % gsz); u.pn = (wgid % nig) / gsz; u.e = 0; u.nv = 256; u.rb = 0; return true;
    }
    __device__ __forceinline__ const char* a_base(const Unit& u) const { return A + (size_t)u.pm * (size_t)(BM * 2) * K; }
    __device__ __forceinline__ const char* b_base(const Unit& u) const { return Bt + (size_t)u.pn * (size_t)(BM * 2) * K; }
    __device__ __forceinline__ const char* g_base() const { return A; }
    __device__ __forceinline__ unsigned a_off(const Unit& u, int h, int R) const { return 0u; }
};

template <class Epi, class Sched, bool GATHER, bool ALIGN_EPI>
__device__ __forceinline__ void gemm_phase(LAS unsigned char* lds, const int K, const Sched& S, const Epi& E) {
    int tid = threadIdx.x; asm volatile("" : "+v"(tid));
    const int wid = __builtin_amdgcn_readfirstlane(tid >> 6), lane = tid & 63, wr = wid >> 2, wc = wid & 3, fr = lane & 15, fq = lane >> 4;
    const int nt = K / BK;
    unsigned voffA[2], voffB[2]; int Rst[2], Cst2[2];
#pragma unroll
    for (int i = 0; i < 2; ++i) { int R, C; stage_rc(tid * 16 + i * 8192, R, C); const int Rb = Epi::PERM ? ((R & ~31) + perm32(R & 31)) : R;
        voffA[i] = (unsigned)(R * K + C) * 2u; voffB[i] = (unsigned)(Rb * K + C) * 2u; Rst[i] = R; Cst2[i] = C * 2; }
    const size_t kstep = (size_t)(BK * 2);
    const size_t hstep = (size_t)HALF * K * 2;
    const unsigned ldsw = (unsigned)wid * 1024u;
    const int aoff = lds_byte(wr * 64 + fr, fq * 8), boff = lds_byte(wc * 32 + fr, fq * 8);
    const char* const gA = S.g_base();
#define PG8_SA(b, h) (((b) * 2 + (h)) * HTB)
#define PG8_SB(b, h) ((4 + (b) * 2 + (h)) * HTB)
#define PG8_GLDS(src, bufoff, i_) __builtin_amdgcn_global_load_lds((const unsigned*)(src), (LAS unsigned*)(lds + (bufoff) + ldsw + (i_) * 8192), 16, 0, 0)
#define PG8_STAGE_B(bufoff, gbase) do { _Pragma("unroll") for (int _i = 0; _i < 2; ++_i) PG8_GLDS((const char*)(gbase) + voffB[_i], bufoff, _i); } while (0)
#define PG8_STAGE_A(bufoff, pa, offs, h_, kb) do { _Pragma("unroll") for (int _i = 0; _i < 2; ++_i) { \
        if constexpr (GATHER) PG8_GLDS(gA + (size_t)((offs)[h_][_i] + (unsigned)(kb)), bufoff, _i); else PG8_GLDS((const char*)(pa) + (h_) * hstep + voffA[_i], bufoff, _i); } } while (0)
#define PG8_LDA(dst, b, h) do { _Pragma("unroll") for (int m = 0; m < 4; ++m) _Pragma("unroll") for (int k = 0; k < 2; ++k) dst[m][k] = *(const LAS h16x8*)(lds + PG8_SA(b, h) + aoff + m * 2048 + k * 1024); } while (0)
#define PG8_LDB(dst, b, h) do { _Pragma("unroll") for (int n = 0; n < 2; ++n) _Pragma("unroll") for (int k = 0; k < 2; ++k) dst[n][k] = *(const LAS h16x8*)(lds + PG8_SB(b, h) + boff + n * 2048 + k * 1024); } while (0)
#define PG8_MMA(ai, bj, At, Bt) do { __builtin_amdgcn_s_setprio(1); _Pragma("unroll") for (int m = 0; m < 4; ++m) _Pragma("unroll") for (int n = 0; n < 2; ++n) _Pragma("unroll") for (int k = 0; k < 2; ++k) \
        acc[ai][bj][m][n] = __builtin_amdgcn_mfma_f32_16x16x32_f16(Bt[n][k], At[m][k], acc[ai][bj][m][n], 0, 0, 0); __builtin_amdgcn_s_setprio(0); } while (0)
#define PG8_WAIT_V(n) asm volatile("s_waitcnt vmcnt(" #n ")" ::: "memory")
#define PG8_WAIT_L(n) asm volatile("s_waitcnt lgkmcnt(" #n ")" ::: "memory")
#define PG8_BAR __builtin_amdgcn_s_barrier()
#define PG8_SCHED __builtin_amdgcn_sched_barrier(0)
    Unit cur, nxt; int ui = 0;
    if (!S.next(0, cur)) return;
    f32x4 acc[2][2][4][2];
#pragma unroll
    for (int a = 0; a < 2; ++a)
#pragma unroll
        for (int b = 0; b < 2; ++b)
#pragma unroll
            for (int m = 0; m < 4; ++m)
#pragma unroll
                for (int n = 0; n < 2; ++n) acc[a][b][m][n] = (f32x4){0.f, 0.f, 0.f, 0.f};
    h16x8 At[4][2], B0[2][2], B1[2][2];
    const char* cA = S.a_base(cur); const char* cB = S.b_base(cur);
    unsigned aoc[2][2], aon[2][2], ao2[2][2];
    if constexpr (GATHER) {
#pragma unroll
        for (int h = 0; h < 2; ++h)
#pragma unroll
            for (int i = 0; i < 2; ++i) { aoc[h][i] = S.a_off(cur, h, Rst[i]) + (unsigned)Cst2[i]; aon[h][i] = aoc[h][i]; ao2[h][i] = aoc[h][i]; }
    }
    PG8_STAGE_B(PG8_SB(0, 0), cB); PG8_STAGE_B(PG8_SB(0, 1), cB + hstep); PG8_STAGE_A(PG8_SA(0, 0), cA, aoc, 0, 0); PG8_STAGE_A(PG8_SA(0, 1), cA, aoc, 1, 0);
    if (wr == 1) PG8_BAR;
    PG8_WAIT_V(2); PG8_BAR;
    PG8_STAGE_B(PG8_SB(1, 0), cB + kstep); PG8_STAGE_A(PG8_SA(1, 0), cA + kstep, aoc, 0, kstep); PG8_STAGE_B(PG8_SB(1, 1), cB + hstep + kstep);
    PG8_WAIT_V(6); PG8_BAR;
    for (;;) {
        const bool has_next = S.next(ui + 1, nxt);
        const char* nA = has_next ? S.a_base(nxt) : cA; const char* nB = has_next ? S.b_base(nxt) : cB;
        if constexpr (GATHER) {
#pragma unroll
            for (int h = 0; h < 2; ++h)
#pragma unroll
                for (int i = 0; i < 2; ++i) aon[h][i] = has_next ? S.a_off(nxt, h, Rst[i]) + (unsigned)Cst2[i] : aoc[h][i];
        }
        for (int t = 0; t < nt; t += 2) {
            const bool last = (t == nt - 2);
            const char* a1 = cA + (size_t)(t + 1) * kstep;
            const char* a2 = last ? nA : cA + (size_t)(t + 2) * kstep; const char* b2 = last ? nB : cB + (size_t)(t + 2) * kstep;
            const char* a3 = a2 + kstep; const char* b3 = b2 + kstep;
            if constexpr (GATHER) {
#pragma unroll
                for (int h = 0; h < 2; ++h)
#pragma unroll
                    for (int i = 0; i < 2; ++i) ao2[h][i] = last ? aon[h][i] : aoc[h][i] + (unsigned)((t + 2) * (int)kstep);
            }
            PG8_LDB(B0, 0, 0); PG8_LDB(B1, 0, 1); PG8_SCHED; PG8_LDA(At, 0, 0); PG8_STAGE_A(PG8_SA(1, 1), a1, aoc, 1, (t + 1) * (int)kstep);
            PG8_WAIT_V(8); PG8_WAIT_L(0); PG8_BAR; PG8_MMA(0, 0, At, B0); PG8_MMA(0, 1, At, B1); PG8_BAR; PG8_SCHED;
            PG8_LDA(At, 0, 1); PG8_STAGE_B(PG8_SB(0, 0), b2); PG8_STAGE_B(PG8_SB(0, 1), b2 + hstep); PG8_STAGE_A(PG8_SA(0, 0), a2, ao2, 0, 0);
            PG8_WAIT_V(8); PG8_WAIT_L(0); PG8_BAR; PG8_MMA(1, 0, At, B0); PG8_MMA(1, 1, At, B1); PG8_BAR; PG8_SCHED;
            PG8_LDB(B0, 1, 0); PG8_LDB(B1, 1, 1); PG8_SCHED; PG8_LDA(At, 1, 0); PG8_STAGE_A(PG8_SA(0, 1), a2, ao2, 1, 0);
            PG8_WAIT_V(8); PG8_WAIT_L(0); PG8_BAR; PG8_MMA(0, 0, At, B0); PG8_MMA(0, 1, At, B1); PG8_BAR; PG8_SCHED;
            PG8_LDA(At, 1, 1); PG8_STAGE_B(PG8_SB(1, 0), b3); PG8_STAGE_B(PG8_SB(1, 1), b3 + hstep); PG8_STAGE_A(PG8_SA(1, 0), a3, ao2, 0, kstep);
            PG8_WAIT_V(8); PG8_WAIT_L(0); PG8_BAR; PG8_MMA(1, 0, At, B0); PG8_MMA(1, 1, At, B1); PG8_BAR; PG8_SCHED;
        }
        if constexpr (ALIGN_EPI) { if (wr == 0) PG8_BAR; }
        E(acc, cur, wr, wc, fr, fq);
        if (!has_next) break;
#pragma unroll
        for (int a = 0; a < 2; ++a)
#pragma unroll
            for (int b = 0; b < 2; ++b)
#pragma unroll
                for (int m = 0; m < 4; ++m)
#pragma unroll
                    for (int n = 0; n < 2; ++n) acc[a][b][m][n] = (f32x4){0.f, 0.f, 0.f, 0.f};
        cur = nxt; cA = nA; cB = nB; ++ui;
        if constexpr (GATHER) {
#pragma unroll
            for (int h = 0; h < 2; ++h)
#pragma unroll
                for (int i = 0; i < 2; ++i) aoc[h][i] = aon[h][i];
        }
        if constexpr (ALIGN_EPI) { if (wr == 1) PG8_BAR; }
    }
    PG8_WAIT_V(0);
    if constexpr (!ALIGN_EPI) { if (wr == 0) PG8_BAR; }
    PG8_BAR;
#undef PG8_SA
#undef PG8_SB
#undef PG8_GLDS
#undef PG8_STAGE_A
#undef PG8_STAGE_B
#undef PG8_LDA
#undef PG8_LDB
#undef PG8_MMA
#undef PG8_WAIT_V
#undef PG8_WAIT_L
#undef PG8_BAR
#undef PG8_SCHED
}
}
using pg8::Unit;
struct EpiProj {
    static constexpr bool PERM = true;
    const float* rstd0; const float* b_gate; h16* QK; h16* V; h16* OG; h16* UG; h16* SV; float* sssv; bool doat;
    __device__ __forceinline__ void operator()(const f32x4 (&acc)[2][2][4][2], const Unit& u, int wr, int wc, int fr, int fq) const {
        const int row0 = u.pm * 256 + wr * 64 + fr, cw = wc * 32 + 8 * fq, pn = u.pn;
        if (pn < 12) {
            h16* base; int ld, col;
            if (pn < 8) { base = QK; ld = 2048; col = pn * 256; } else { base = V; ld = 1024; col = (pn - 8) * 256; }
#pragma unroll
            for (int ai = 0; ai < 2; ++ai)
#pragma unroll
                for (int m = 0; m < 4; ++m) { const int row = row0 + ai * 128 + m * 16; const float rs = rstd0[row]; h16* rp = base + (size_t)row * ld + col + cw;
#pragma unroll
                    for (int bj = 0; bj < 2; ++bj) *(u32x4*)(rp + bj * 128) = pk_h8(acc[ai][bj][m][0] * rs, acc[ai][bj][m][1] * rs); }
        } else if (pn < 28) {
            const bool isO = pn < 20; h16* base = isO ? OG : UG; const int c0 = (isO ? pn - 12 : pn - 20) * 128 + cw; const float* bg = b_gate + (isO ? 0 : 1024) + c0;
            const f32x4 b0 = *(const f32x4*)bg, b1 = *(const f32x4*)(bg + 4);
#pragma unroll
            for (int ai = 0; ai < 2; ++ai)
#pragma unroll
                for (int m = 0; m < 4; ++m) { const int row = row0 + ai * 128 + m * 16; const float rs = rstd0[row];
                    f32x4 a0 = acc[ai][0][m][0] * rs, a1 = acc[ai][0][m][1] * rs; const f32x4 g0 = acc[ai][1][m][0] * rs + b0, g1 = acc[ai][1][m][1] * rs + b1;
                    if (isO) {
#pragma unroll
                        for (int j = 0; j < 4; ++j) { a0[j] = fsigmoid(a0[j]) * fsigmoid(g0[j]); a1[j] = fsigmoid(a1[j]) * fsigmoid(g1[j]); }
                    } else {
#pragma unroll
                        for (int j = 0; j < 4; ++j) { a0[j] = fgelu(a0[j]) * fsigmoid(g0[j]); a1[j] = fgelu(a1[j]) * fsigmoid(g1[j]); }
                    }
                    *(u32x4*)(base + (size_t)row * 1024 + c0) = pk_h8(a0, a1); }
        } else {
            const int col = (pn - 28) * 256 + cw;
#pragma unroll
            for (int ai = 0; ai < 2; ++ai)
#pragma unroll
                for (int m = 0; m < 4; ++m) { const int row = row0 + ai * 128 + m * 16; const float rs = rstd0[row]; float sum = 0.f;
#pragma unroll
                    for (int bj = 0; bj < 2; ++bj) { f32x4 a0 = acc[ai][bj][m][0] * rs, a1 = acc[ai][bj][m][1] * rs;
#pragma unroll
                        for (int j = 0; j < 4; ++j) { a0[j] = fgelu(a0[j]); a1[j] = fgelu(a1[j]); sum += a0[j] * a0[j] + a1[j] * a1[j]; }
                        *(u32x4*)(SV + (size_t)row * 1024 + col + bj * 128) = pk_h8(a0, a1); }
                    sum += __shfl_xor(sum, 16); sum += __shfl_xor(sum, 32);
                    if (fq == 0 && doat) atomicAdd(sssv + row, sum); }
        }
    }
};
struct EpiKV {
    static constexpr bool PERM = true;
    const float* rstdm; h16* KM; h16* VM;
    __device__ __forceinline__ void operator()(const f32x4 (&acc)[2][2][4][2], const Unit& u, int wr, int wc, int fr, int fq) const {
        const int row0 = u.pm * 256 + wr * 64 + fr, cw = wc * 32 + 8 * fq, pn = u.pn; h16* base = (pn < 4) ? KM + pn * 256 : VM + (pn - 4) * 256;
#pragma unroll
        for (int ai = 0; ai < 2; ++ai)
#pragma unroll
            for (int m = 0; m < 4; ++m) { const int row = row0 + ai * 128 + m * 16; const float rs = rstdm[row];
#pragma unroll
                for (int bj = 0; bj < 2; ++bj) *(u32x4*)(base + (size_t)row * 1024 + bj * 128 + cw) = pk_h8(acc[ai][bj][m][0] * rs, acc[ai][bj][m][1] * rs); }
    }
};
struct EpiResid {
    static constexpr bool PERM = false;
    const float* resid; float* out; h16* outh; float* ss; bool doat;
    __device__ __forceinline__ void operator()(const f32x4 (&acc)[2][2][4][2], const Unit& u, int wr, int wc, int fr, int fq) const {
        const int row0 = u.pm * 256 + wr * 64 + fr, col0 = u.pn * 256 + wc * 32 + 4 * fq;
#pragma unroll
        for (int ai = 0; ai < 2; ++ai)
#pragma unroll
            for (int m = 0; m < 4; ++m) { const int row = row0 + ai * 128 + m * 16; const size_t off = (size_t)row * DM + col0; float sum = 0.f;
#pragma unroll
                for (int bj = 0; bj < 2; ++bj)
#pragma unroll
                    for (int n = 0; n < 2; ++n) { const size_t o = off + bj * 128 + n * 16; const f32x4 v = *(const f32x4*)(resid + o) + acc[ai][bj][m][n];
                        *(f32x4*)(out + o) = v; u32x2 w; w.x = pk_h2(v[0], v[1]); w.y = pk_h2(v[2], v[3]); *(u32x2*)(outh + o) = w;
                        sum += (v[0] * v[0] + v[1] * v[1]) + (v[2] * v[2] + v[3] * v[3]); }
                sum += __shfl_xor(sum, 16); sum += __shfl_xor(sum, 32);
                if (fq == 0 && doat) atomicAdd(ss + row, sum); }
    }
};
struct EpiQ {
    static constexpr bool PERM = true;
    const float* ss1; h16* Q;
    __device__ __forceinline__ void operator()(const f32x4 (&acc)[2][2][4][2], const Unit& u, int wr, int wc, int fr, int fq) const {
        const int row0 = u.pm * 256 + wr * 64 + fr, col0 = u.pn * 256 + wc * 32 + 8 * fq;
#pragma unroll
        for (int ai = 0; ai < 2; ++ai)
#pragma unroll
            for (int m = 0; m < 4; ++m) { const int row = row0 + ai * 128 + m * 16; const float rs = rsqrtf(ss1[row] * (1.f / DM) + EPS) * 0.0625f;
#pragma unroll
                for (int bj = 0; bj < 2; ++bj) *(u32x4*)(Q + (size_t)row * DM + col0 + bj * 128) = pk_h8(acc[ai][bj][m][0] * rs, acc[ai][bj][m][1] * rs); }
    }
};
struct MoeOrder {
    const char* A; const char* Bt; int K; size_t bexp; const int* list; const unsigned* cnt; const LAS int* tab; int G, c;
    __device__ __forceinline__ bool next(int i, Unit& u) const {
        const int L = i * G + c; const int total = tab[32] * 4; if (L >= total) return false;
        const int rbg = L >> 2; int e = 0;
#pragma unroll 1
        for (int j = 1; j < 32; ++j) e = (tab[j] <= rbg) ? j : e;
        u.pm = rbg; u.pn = L & 3; u.e = e; const int rb = rbg - tab[e]; u.rb = rb; const int left = (int)__hip_atomic_load(cnt + e, __ATOMIC_RELAXED, __HIP_MEMORY_SCOPE_AGENT) - rb * 256; u.nv = left < 256 ? left : 256; return true;
    }
    __device__ __forceinline__ const char* a_base(const Unit& u) const { return A + (size_t)u.pm * (size_t)(256 * 2) * K; }
    __device__ __forceinline__ const char* b_base(const Unit& u) const { return Bt + (size_t)u.e * bexp + (size_t)u.pn * (size_t)(256 * 2) * K; }
    __device__ __forceinline__ const char* g_base() const { return A; }
    __device__ __forceinline__ unsigned a_off(const Unit& u, int h, int R) const { const int r = h * 128 + R; const int tok = (r < u.nv) ? (list[u.e * NTOK + u.rb * 256 + r] >> 1) : 0; return (unsigned)tok * (unsigned)(K * 2); }
};
struct EpiFfn1 {
    static constexpr bool PERM = true;
    const int* list; const float* ss2; h16* H;
    __device__ __forceinline__ void operator()(const f32x4 (&acc)[2][2][4][2], const Unit& u, int wr, int wc, int fr, int fq) const {
        const int r0 = wr * 64 + fr, cw = wc * 32 + 8 * fq;
#pragma unroll
        for (int ai = 0; ai < 2; ++ai)
#pragma unroll
            for (int m = 0; m < 4; ++m) { const int r = r0 + ai * 128 + m * 16; const int tok = (r < u.nv) ? (list[u.e * NTOK + u.rb * 256 + r] >> 1) : 0;
                const float rs = rsqrtf(ss2[tok] * (1.f / DM) + EPS);
                f32x4 a0 = acc[ai][0][m][0] * rs, a1 = acc[ai][0][m][1] * rs; const f32x4 b0 = acc[ai][1][m][0] * rs, b1 = acc[ai][1][m][1] * rs;
#pragma unroll
                for (int j = 0; j < 4; ++j) { a0[j] = fsilu(a0[j]) * b0[j]; a1[j] = fsilu(a1[j]) * b1[j]; }
                *(u32x4*)(H + ((size_t)u.pm * 256 + r) * FF + u.pn * 128 + cw) = pk_h8(a0, a1); }
    }
};
struct EpiFfn2 {
    static constexpr bool PERM = true;
    const int* list; const float* gate; h16* Y;
    __device__ __forceinline__ void operator()(const f32x4 (&acc)[2][2][4][2], const Unit& u, int wr, int wc, int fr, int fq) const {
        const int r0 = wr * 64 + fr, cw = u.pn * 256 + wc * 32 + 8 * fq;
#pragma unroll
        for (int ai = 0; ai < 2; ++ai)
#pragma unroll
            for (int m = 0; m < 4; ++m) { const int r = r0 + ai * 128 + m * 16;
                if (r < u.nv) { const int slot = list[u.e * NTOK + u.rb * 256 + r]; const float g = gate[slot];
#pragma unroll
                    for (int bj = 0; bj < 2; ++bj) *(u32x4*)(Y + (size_t)slot * DM + cw + bj * 128) = pk_h8(acc[ai][bj][m][0] * g, acc[ai][bj][m][1] * g); } }
    }
};


typedef short s16x4 __attribute__((ext_vector_type(4)));
__device__ __forceinline__ h16x4 tr_read4(const LAS unsigned char* p) { return __builtin_bit_cast(h16x4, __builtin_amdgcn_ds_read_tr16_b64_v4i16((LAS s16x4*)p)); }
__device__ __forceinline__ h16x8 cat8(h16x4 a, h16x4 b) { return __builtin_shufflevector(a, b, 0, 1, 2, 3, 4, 5, 6, 7); }
__device__ __forceinline__ h16x4 cvt4(f32x4 v) { return __builtin_convertvector(v, h16x4); }
__device__ __forceinline__ void glds16_asm(const void* gsrc, unsigned lds_dst) { unsigned keep;
    asm volatile("s_mov_b32 %0, m0\n\ts_mov_b32 m0, %2\n\ts_nop 0\n\tglobal_load_lds_dwordx4 %1, off\n\ts_mov_b32 m0, %0" : "=&s"(keep) : "v"(gsrc), "s"(lds_dst) : "memory"); }
#define GLDS16(src, dst) glds16_asm((const void*)(src), __builtin_amdgcn_readfirstlane((unsigned)(size_t)(dst)))
constexpr int ATT_UNITS = 512, ATT_CH = 32768;
__device__ __forceinline__ void attn_issue(LAS unsigned char* lds, const h16* KM, const h16* VM, int c, int G, int bx, int wid, int lane) {
    const int i = c >> 3, n = c & 7, L = i * G + bx, hd = L & 3, tile = L >> 2, b = tile >> 6;
    LAS unsigned char* buf = lds + (unsigned)(c % 3) * ATT_CH;
    if (n < 4) { const char* Kb = (const char*)(KM + (size_t)(b * 256) * 1024 + hd * 256) + n * 128;
#pragma unroll
        for (int q = 0; q < 4; ++q) { const int I = wid * 4 + q, row = I * 8 + (lane >> 3), slot = (lane & 7) ^ ((row >> 1) & 7); GLDS16(Kb + (size_t)row * 2048 + slot * 16, buf + I * 1024); }
    } else { const char* Vb = (const char*)(VM + (size_t)(b * 256 + 64 * (n - 4)) * 1024 + hd * 256);
#pragma unroll
        for (int q = 0; q < 4; ++q) { const int I = wid * 4 + q, row = I * 2 + (lane >> 5), ch = (lane & 31) ^ ((row & 7) << 1); GLDS16(Vb + (size_t)row * 2048 + ch * 16, buf + I * 1024); }
    }
}
__device__ __forceinline__ void attn_phase(LAS unsigned char* lds, const h16* Q, const h16* KM, const h16* VM, h16* ATT, int G, int bx) {
    int tid = threadIdx.x; asm volatile("" : "+v"(tid));
    const int wid = __builtin_amdgcn_readfirstlane(tid >> 6), lane = tid & 63, fr = lane & 15, fq = lane >> 4;
    if (bx >= ATT_UNITS) return;
    const int nun = (ATT_UNITS - bx + G - 1) / G, total = nun * 8;
    attn_issue(lds, KM, VM, 0, G, bx, wid, lane); attn_issue(lds, KM, VM, 1, G, bx, wid, lane);
    const int tq = (lane & 15) >> 2, tp = lane & 3;
    for (int i = 0; i < nun; ++i) {
        const int L = i * G + bx, hd = L & 3, tile = L >> 2; const int trow = tile * 128 + wid * 16 + fr;
        f32x4 S[16]; h16x8 qf[8], pf[8]; f32x4 O[16]; float linv = 0.f;
#pragma unroll
        for (int kt = 0; kt < 16; ++kt) S[kt] = (f32x4){0.f, 0.f, 0.f, 0.f};
#pragma unroll
        for (int n = 0; n < 8; ++n) {
            const int c = i * 8 + n;
            asm volatile("s_waitcnt vmcnt(0)" ::: "memory"); __builtin_amdgcn_s_barrier(); asm volatile("" ::: "memory");
            if (n == 0) {
#pragma unroll
                for (int st = 0; st < 8; ++st) qf[st] = *(const h16x8*)(Q + (size_t)trow * 1024 + hd * 256 + 32 * st + 8 * fq);
            }
            if (c + 2 < total) attn_issue(lds, KM, VM, c + 2, G, bx, wid, lane);
            const LAS unsigned char* buf = lds + (unsigned)(c % 3) * ATT_CH;
            if (n < 4) {
#pragma unroll
                for (int kt = 0; kt < 16; ++kt)
#pragma unroll
                    for (int ks = 0; ks < 2; ++ks) { const int key = kt * 16 + fr, slot = 4 * ks + fq;
                        const h16x8 bf = *(const LAS h16x8*)(buf + key * 128 + ((slot ^ ((key >> 1) & 7)) * 16));
                        S[kt] = __builtin_amdgcn_mfma_f32_16x16x32_f16(bf, qf[2 * n + ks], S[kt], 0, 0, 0);
                        if (ks == 1 && (kt & 3) == 3) __builtin_amdgcn_sched_barrier(0); }
                if (n == 3) {
                    float mx = -INFINITY;
#pragma unroll
                    for (int kt = 0; kt < 16; ++kt)
#pragma unroll
                        for (int j = 0; j < 4; ++j) mx = fmaxf(mx, S[kt][j]);
                    mx = fmaxf(mx, __shfl_xor(mx, 16)); mx = fmaxf(mx, __shfl_xor(mx, 32));
                    float l = 0.f;
#pragma unroll
                    for (int kt = 0; kt < 16; ++kt)
#pragma unroll
                        for (int j = 0; j < 4; ++j) { const float e = __expf(S[kt][j] - mx); S[kt][j] = e; l += e; }
                    l += __shfl_xor(l, 16); l += __shfl_xor(l, 32); linv = 1.f / l;
#pragma unroll
                    for (int st = 0; st < 8; ++st) pf[st] = cat8(cvt4(S[2 * st]), cvt4(S[2 * st + 1]));
                }
            } else {
                if (n == 4) {
#pragma unroll
                    for (int dt = 0; dt < 16; ++dt) O[dt] = (f32x4){0.f, 0.f, 0.f, 0.f};
                }
#pragma unroll
                for (int ks = 0; ks < 2; ++ks) { const int r0 = 32 * ks + 4 * fq + tq, r1 = r0 + 16;
#pragma unroll
                    for (int dt = 0; dt < 16; ++dt) {
                        const h16x4 lo = tr_read4(buf + r0 * 512 + (((2 * dt + (tp >> 1)) ^ ((r0 & 7) << 1)) * 16) + (tp & 1) * 8);
                        const h16x4 hi = tr_read4(buf + r1 * 512 + (((2 * dt + (tp >> 1)) ^ ((r1 & 7) << 1)) * 16) + (tp & 1) * 8);
                        O[dt] = __builtin_amdgcn_mfma_f32_16x16x32_f16(cat8(lo, hi), pf[2 * (n - 4) + ks], O[dt], 0, 0, 0);
                        if ((dt & 3) == 3) __builtin_amdgcn_sched_barrier(0); } }
                if (n == 7) {
#pragma unroll
                    for (int dt = 0; dt < 16; ++dt) { const f32x4 o = O[dt] * linv; u32x2 w; w.x = pk_h2(o[0], o[1]); w.y = pk_h2(o[2], o[3]);
                        *(u32x2*)(ATT + (size_t)trow * 1024 + hd * 256 + 16 * dt + 4 * fq) = w; }
                }
            }
        }
    }
    asm volatile("s_waitcnt vmcnt(0)" ::: "memory"); __builtin_amdgcn_s_barrier();
}


__device__ __forceinline__ void mstate_ext(unsigned char* ws, int bh, int wave, int lane) {
    const float* ig = (const float*)(ws + OFF_IG); const float* lf = (const float*)(ws + OFF_LF);
    const int b = bh >> 2, h = bh & 3; float B = 0.f, mx = -INFINITY;
    for (int s = 0; s < CHUNK; ++s) { const int t = b * SEQ + lane * CHUNK + s; B += lf[t * 4 + h]; mx = fmaxf(mx, ig[t * 4 + h] - B); }
    const float blast = B, maxw = B + mx; float m = 0.f, mc = 0.f, mn = 0.f;
    for (int c = 0; c < NCHUNK; ++c) { const float bl = __shfl(blast, c), mw = __shfl(maxw, c); const float m2 = fmaxf(bl + m, mw); if (lane == c) { mc = m; mn = m2; } m = m2; }
    if (wave == 0) { ((float*)(ws + OFF_MST))[bh * 64 + lane] = mc; ((float*)(ws + OFF_DEC))[bh * 64 + lane] = __expf(blast + mc - mn); }
    float* AL = (float*)(ws + OFF_AL); float* BE = (float*)(ws + OFF_BE); float* NM = (float*)(ws + OFF_NM); float* WU = (float*)(ws + OFF_WU);
    B = 0.f; float rm = -INFINITY;
    for (int s = 0; s < CHUNK; ++s) { const int t = b * SEQ + lane * CHUNK + s; const float li = lf[t * 4 + h], ii = ig[t * 4 + h]; B += li; rm = fmaxf(rm, ii - B);
        if ((s >> 4) == wave) { const float mt = B + fmaxf(mc, rm); AL[t * 4 + h] = B - mt; BE[t * 4 + h] = ii - B; NM[t * 4 + h] = -mt; WU[t * 4 + h] = __expf(ii - B + blast - mn); } }
}

__device__ __forceinline__ int swz128(int row) { return (((row >> 1) & 1) | (((row >> 3) & 1) << 1)) << 1; }
__device__ __forceinline__ void scan_task(LAS unsigned char* lds, const Ptrs& p, unsigned char* ws, int task) {
    int tid = threadIdx.x; asm volatile("" : "+v"(tid));
    const int wid = __builtin_amdgcn_readfirstlane(tid >> 6), lane = tid & 63, fr = lane & 15, fq = lane >> 4;
    const int bh = task >> 4, et = (task >> 2) & 3, dtb = task & 3, b = bh >> 2, hd = bh & 3, e0 = et * 64, d0 = dtb * 64;
    const int cg = tid & 7, rp = tid >> 3, kcol = 1024 + hd * 256 + d0 + 8 * cg;
    f32x4 cw[4][2], cb[2];
#pragma unroll
    for (int j = 0; j < 4; ++j) { cw[j][0] = *(const f32x4*)(p.conv_w + j * 2048 + kcol); cw[j][1] = *(const f32x4*)(p.conv_w + j * 2048 + kcol + 4); }
    cb[0] = *(const f32x4*)(p.conv_b + kcol); cb[1] = *(const f32x4*)(p.conv_b + kcol + 4);
    const h16* QK = (const h16*)p.out; const float* WU = (const float*)(ws + OFF_WU); const float* DEC = (const float*)(ws + OFF_DEC) + bh * 64;
    const h16* Vg = (const h16*)(ws + WS_V);
    h16* CST = (h16*)(ws + WS_CST) + (size_t)bh * 64 * 65536; float* NST = (float*)(ws + WS_NST) + (size_t)bh * 64 * 256;
    const int dti = wid & 3, ep = wid >> 2; const bool doN = (et == 0) && (ep == 0);
    const int tq = (lane & 15) >> 2, tp = lane & 3;
    u32x4 raw[3][5]; float wu[3][2]; float dcv[3];
    f32x4 acc[2] = {(f32x4){0.f, 0.f, 0.f, 0.f}, (f32x4){0.f, 0.f, 0.f, 0.f}}; f32x4 nacc = (f32x4){0.f, 0.f, 0.f, 0.f};
    const h16x8 ones = {(h16)1.f, (h16)1.f, (h16)1.f, (h16)1.f, (h16)1.f, (h16)1.f, (h16)1.f, (h16)1.f};
#define SCAN_LOAD(c_, set_) do { const int t0_ = b * SEQ + (c_) * CHUNK; \
        _Pragma("unroll") for (int q = 0; q < 2; ++q) { const int I = wid * 2 + q, row = I * 8 + (lane >> 3), ch = (lane & 7) ^ swz128(row); \
            GLDS16((const char*)(Vg + (size_t)(t0_ + row) * 1024 + hd * 256 + e0) + ch * 16, lds + 32768 + ((c_) & 3) * 16384 + I * 1024); } \
        _Pragma("unroll") for (int k = 0; k < 5; ++k) { int tl = (c_) * CHUNK + 2 * rp - 3 + k; tl = tl < 0 ? 0 : tl; raw[set_][k] = *(const u32x4*)(QK + (size_t)(b * SEQ + tl) * 2048 + kcol); } \
        wu[set_][0] = WU[(t0_ + 2 * rp) * 4 + hd]; wu[set_][1] = WU[(t0_ + 2 * rp + 1) * 4 + hd]; dcv[set_] = DEC[c_]; } while (0)
#define SCAN_STORE(c_) do { \
        _Pragma("unroll") for (int j = 0; j < 2; ++j) { u32x2 w; w.x = pk_h2(acc[j][0], acc[j][1]); w.y = pk_h2(acc[j][2], acc[j][3]); \
            *(u32x2*)(CST + (size_t)(c_) * 65536 + (size_t)(e0 + 16 * (2 * ep + j) + fr) * 256 + d0 + 16 * dti + 4 * fq) = w; } \
        if (doN && fr == 0) *(f32x4*)(NST + (c_) * 256 + d0 + 16 * dti + 4 * fq) = nacc; } while (0)
#define SCAN_STEP(c_, set_) do { const int c = (c_); \
        SCAN_STORE(c); \
        LAS unsigned char* kb = lds + (c & 1) * 16384; LAS unsigned char* vb = lds + 32768 + (c & 3) * 16384; \
        if (c == 0) { _Pragma("unroll") for (int k = 0; k < 3; ++k) if (2 * rp - 3 + k < 0) raw[set_][k] = (u32x4){0u, 0u, 0u, 0u}; } \
        _Pragma("unroll") for (int rr = 0; rr < 2; ++rr) { f32x4 y0 = cb[0], y1 = cb[1]; \
            _Pragma("unroll") for (int j = 0; j < 4; ++j) { const h16x8 xr = __builtin_bit_cast(h16x8, raw[set_][rr + j]); \
                _Pragma("unroll") for (int q = 0; q < 4; ++q) { y0[q] += cw[j][0][q] * (float)xr[q]; y1[q] += cw[j][1][q] * (float)xr[4 + q]; } } \
            const float sc = 0.0625f * wu[set_][rr]; \
            _Pragma("unroll") for (int q = 0; q < 4; ++q) { y0[q] = fsilu(y0[q]) * sc; y1[q] = fsilu(y1[q]) * sc; } \
            const int row = 2 * rp + rr; *(LAS u32x4*)(kb + row * 128 + ((cg ^ swz128(row)) * 16)) = pk_h8(y0, y1); } \
        asm volatile("s_waitcnt lgkmcnt(0)" ::: "memory"); __builtin_amdgcn_s_barrier(); asm volatile("" ::: "memory"); \
        const float dec = dcv[set_]; \
        if (c + 3 < NCHUNK - 1) SCAN_LOAD(c + 3, set_); \
        acc[0] *= dec; acc[1] *= dec; nacc *= dec; \
        _Pragma("unroll") for (int ks = 0; ks < 4; ++ks) { const int r0 = 32 * ks + 8 * fq + tq, r1 = r0 + 4; \
            const int o0 = r0 * 128 + (tp & 1) * 8, o1 = r1 * 128 + (tp & 1) * 8, s0 = swz128(r0), s1 = swz128(r1), cx = 2 * dti + (tp >> 1); \
            const h16x8 X = cat8(tr_read4(kb + o0 + ((cx ^ s0) * 16)), tr_read4(kb + o1 + ((cx ^ s1) * 16))); \
            _Pragma("unroll") for (int j = 0; j < 2; ++j) { const int cy = 2 * (2 * ep + j) + (tp >> 1); \
                const h16x8 Y = cat8(tr_read4(vb + o0 + ((cy ^ s0) * 16)), tr_read4(vb + o1 + ((cy ^ s1) * 16))); \
                acc[j] = __builtin_amdgcn_mfma_f32_16x16x32_f16(X, Y, acc[j], 0, 0, 0); } \
            if (doN) nacc = __builtin_amdgcn_mfma_f32_16x16x32_f16(X, ones, nacc, 0, 0, 0); } } while (0)
    SCAN_LOAD(0, 0); SCAN_LOAD(1, 1); SCAN_LOAD(2, 2);
#pragma unroll 1
    for (int c3 = 0; c3 < NCHUNK - 1; c3 += 3) { SCAN_STEP(c3, 0); SCAN_STEP(c3 + 1, 1); SCAN_STEP(c3 + 2, 2); }
    SCAN_STORE(NCHUNK - 1);
#undef SCAN_STEP
#undef SCAN_STORE
#undef SCAN_LOAD
    asm volatile("s_waitcnt vmcnt(0) lgkmcnt(0)" ::: "memory"); __builtin_amdgcn_s_barrier();
}

__device__ __forceinline__ int swz256(int row) { return ((row & 3) + 4 * ((row >> 3) & 1)) << 1; }
__device__ __forceinline__ void sgu_task(LAS unsigned char* lds, const Ptrs& p, unsigned char* ws, int task) {
    int tid = threadIdx.x; asm volatile("" : "+v"(tid));
    const int wid = __builtin_amdgcn_readfirstlane(tid >> 6), lane = tid & 63, fr = lane & 15, fq = lane >> 4;
    const int t0 = task * CHUNK;
    LAS unsigned char* wb = lds; LAS unsigned char* vb = lds + 32768; LAS float* rs = (LAS float*)(lds + 65536);
    const float* ss = (const float*)(ws + OFF_SSSV); const h16* SV = (const h16*)(ws + WS_SV); const h16* UG = (const h16*)(ws + WS_UG); h16* Z = (h16*)(ws + WS_XH);
    if (tid < CHUNK) rs[tid] = rsqrtf(ss[t0 + tid] * (1.f / DM) + EPS);
    __syncthreads();
    const int lrow = tid >> 2, lq = tid & 3, tq = (lane & 15) >> 2, tp = lane & 3, trow = 16 * wid + fr;
    f32x4 wraw[8]; h16x8 vraw[4];
#define SGU_LOAD(g_) do { const float* wsrc = p.w_s + (size_t)((g_) * 128 + lrow) * 128 + 32 * lq; const h16* vsrc = SV + (size_t)(t0 + lrow) * 1024 + (g_) * 128 + 32 * lq; \
        _Pragma("unroll") for (int i = 0; i < 8; ++i) wraw[i] = *(const f32x4*)(wsrc + 4 * i); \
        _Pragma("unroll") for (int i = 0; i < 4; ++i) vraw[i] = *(const h16x8*)(vsrc + 8 * i); } while (0)
    SGU_LOAD(0);
#pragma unroll 1
    for (int g = 0; g < 8; ++g) {
        {
            const float* gsrc = p.sgu_norm_g + g * 128 + 32 * lq; const float r = rs[lrow];
#pragma unroll
            for (int i = 0; i < 4; ++i) { f32x4 a = wraw[2 * i], c = wraw[2 * i + 1];
#pragma unroll
                for (int q = 0; q < 4; ++q) { if (32 * lq + 8 * i + q > lrow) a[q] = 0.f; if (32 * lq + 8 * i + 4 + q > lrow) c[q] = 0.f; }
                *(LAS u32x4*)(wb + lrow * 256 + (((4 * lq + i) ^ (lrow & 15)) * 16)) = pk_h8(a, c); }
#pragma unroll
            for (int i = 0; i < 4; ++i) { const h16x8 v = vraw[i]; const f32x4 g0 = *(const f32x4*)(gsrc + 8 * i), g1 = *(const f32x4*)(gsrc + 8 * i + 4); f32x4 a, c;
#pragma unroll
                for (int q = 0; q < 4; ++q) { a[q] = (float)v[q] * r * g0[q]; c[q] = (float)v[4 + q] * r * g1[q]; }
                *(LAS u32x4*)(vb + lrow * 256 + (((4 * lq + i) ^ swz256(lrow)) * 16)) = pk_h8(a, c); }
        }
        __syncthreads();
        if (g + 1 < 8) SGU_LOAD(g + 1);
        const float bias = p.b_s[g * 128 + trow]; const size_t ro = (size_t)(t0 + trow) * 1024 + g * 128 + 4 * fq;
        h16x4 ur[8];
#pragma unroll
        for (int dt = 0; dt < 8; ++dt) ur[dt] = *(const h16x4*)(UG + ro + 16 * dt);
        f32x4 acc[8];
#pragma unroll
        for (int dt = 0; dt < 8; ++dt) acc[dt] = (f32x4){0.f, 0.f, 0.f, 0.f};
        const int nks = (wid >> 1) + 1;
        for (int ks = 0; ks < nks; ++ks) {
            const h16x8 Y = *(const LAS h16x8*)(wb + trow * 256 + (((4 * ks + fq) ^ (trow & 15)) * 16));
            const int r0 = 32 * ks + 8 * fq + tq, r1 = r0 + 4, o0 = r0 * 256 + (tp & 1) * 8, o1 = r1 * 256 + (tp & 1) * 8, s0 = swz256(r0), s1 = swz256(r1);
#pragma unroll
            for (int dt = 0; dt < 8; ++dt) { const int cx = 2 * dt + (tp >> 1);
                const h16x8 X = cat8(tr_read4(vb + o0 + ((cx ^ s0) * 16)), tr_read4(vb + o1 + ((cx ^ s1) * 16)));
                acc[dt] = __builtin_amdgcn_mfma_f32_16x16x32_f16(X, Y, acc[dt], 0, 0, 0); }
        }
#pragma unroll
        for (int dt = 0; dt < 8; ++dt) { const h16x4 u = ur[dt]; u32x2 w;
            w.x = pk_h2((float)u[0] * (acc[dt][0] + bias), (float)u[1] * (acc[dt][1] + bias)); w.y = pk_h2((float)u[2] * (acc[dt][2] + bias), (float)u[3] * (acc[dt][3] + bias));
            *(u32x2*)(Z + ro + 16 * dt) = w; }
        __syncthreads();
    }
#undef SGU_LOAD
}

__device__ __forceinline__ int swzb(int row) { return (row >> 1) & 7; }
__device__ __forceinline__ void mout_phase(LAS unsigned char* lds, const Ptrs& p, unsigned char* ws, int G, int bx, h16* Zdst) {
    const int wid = __builtin_amdgcn_readfirstlane(threadIdx.x >> 6);
    constexpr int QB = 0, KB = 16384, CB = 32768, VB = 69632, SM = 135168;
    const h16* QK = (const h16*)p.out; const h16* Vg = (const h16*)(ws + WS_V); const h16* OG = (const h16*)(ws + WS_OG); h16* Z = (h16*)(ws + WS_XH);
    const float* ALg = (const float*)(ws + OFF_AL); const float* BEg = (const float*)(ws + OFF_BE); const float* NMg = (const float*)(ws + OFF_NM); const float* MST = (const float*)(ws + OFF_MST);
    LAS float* ALs = (LAS float*)(lds + SM); LAS float* BEs = ALs + 128;
#define OPAQUE_TID() int tid = threadIdx.x; asm volatile("" : "+v"(tid)); const int lane = tid & 63, fr = lane & 15, fq = lane >> 4, cg = tid & 7, rp = tid >> 3, tq = (lane & 15) >> 2, tp = lane & 3, trow = 16 * wid + fr; (void)cg; (void)rp; (void)tq; (void)tp; (void)trow; (void)fq
    for (int L = bx; L < 512; L += G) {
        const int bh = L >> 6, c = L & 63, b = bh >> 2, hd = bh & 3, t0 = b * SEQ + c * CHUNK;
        const h16* Ct = (const h16*)(ws + WS_CST) + ((size_t)(bh * 64 + c)) * 65536; const float* nst = (const float*)(ws + WS_NST) + (size_t)(bh * 64 + c) * 256;
        __syncthreads();
        { OPAQUE_TID();
        if (tid < 128) ALs[tid] = ALg[(t0 + tid) * 4 + hd]; else if (tid < 256) BEs[tid - 128] = BEg[(t0 + tid - 128) * 4 + hd];
#pragma unroll
        for (int q = 0; q < 8; ++q) { const int I = wid * 8 + q, row = I * 2 + (lane >> 5), ch = (lane & 31) ^ ((row & 7) << 1);
            GLDS16((const char*)(Vg + (size_t)(t0 + row) * 1024 + hd * 256) + ch * 16, lds + VB + I * 1024); }
        }
        f32x4 S[8], acc[17];
#pragma unroll
        for (int i = 0; i < 8; ++i) S[i] = (f32x4){0.f, 0.f, 0.f, 0.f};
#pragma unroll
        for (int i = 0; i < 17; ++i) acc[i] = (f32x4){0.f, 0.f, 0.f, 0.f};
#pragma unroll 1
        for (int dch = 0; dch < 4; ++dch) {
            OPAQUE_TID();
#pragma unroll
            for (int q = 0; q < 4; ++q) { const int I = wid * 4 + q, row = I * 8 + (lane >> 3), ch = (lane & 7) ^ swzb(row);
                GLDS16((const char*)(Ct + (size_t)row * 256 + dch * 64) + ch * 16, lds + CB + I * 1024); }
            if (tid < 8) { const f32x4 a = *(const f32x4*)(nst + dch * 64 + 8 * tid), c2 = *(const f32x4*)(nst + dch * 64 + 8 * tid + 4); *(LAS u32x4*)(lds + CB + 32768 + tid * 16) = pk_h8(a, c2); }
#pragma unroll 1
            for (int which = 0; which < 2; ++which) {
                const int col = which * 1024 + hd * 256 + dch * 64 + 8 * cg;
                u32x4 raw[5];
#pragma unroll
                for (int k = 0; k < 5; ++k) { const int tl = c * CHUNK + 2 * rp - 3 + k; raw[k] = (u32x4){0u, 0u, 0u, 0u}; if (tl >= 0) raw[k] = *(const u32x4*)(QK + (size_t)(b * SEQ + tl) * 2048 + col); }
                f32x4 cw[4][2];
#pragma unroll
                for (int j = 0; j < 4; ++j) { cw[j][0] = *(const f32x4*)(p.conv_w + j * 2048 + col); cw[j][1] = *(const f32x4*)(p.conv_w + j * 2048 + col + 4); }
                const f32x4 cb0 = *(const f32x4*)(p.conv_b + col), cb1 = *(const f32x4*)(p.conv_b + col + 4);
                const float sc = which ? 0.0625f : 1.f;
#pragma unroll
                for (int rr = 0; rr < 2; ++rr) { f32x4 y0 = cb0, y1 = cb1;
#pragma unroll
                    for (int j = 0; j < 4; ++j) { const h16x8 xr = __builtin_bit_cast(h16x8, raw[rr + j]);
#pragma unroll
                        for (int q = 0; q < 4; ++q) { y0[q] += cw[j][0][q] * (float)xr[q]; y1[q] += cw[j][1][q] * (float)xr[4 + q]; } }
#pragma unroll
                    for (int q = 0; q < 4; ++q) { y0[q] = fsilu(y0[q]) * sc; y1[q] = fsilu(y1[q]) * sc; }
                    const int row = 2 * rp + rr; *(LAS u32x4*)(lds + (which ? KB : QB) + row * 128 + ((cg ^ swzb(row)) * 16)) = pk_h8(y0, y1); }
            }
            asm volatile("s_waitcnt vmcnt(0) lgkmcnt(0)" ::: "memory"); __builtin_amdgcn_s_barrier(); asm volatile("" ::: "memory");
            h16x8 Y[2];
#pragma unroll
            for (int ks = 0; ks < 2; ++ks) Y[ks] = *(const LAS h16x8*)(lds + QB + trow * 128 + (((4 * ks + fq) ^ swzb(trow)) * 16));
#pragma unroll
            for (int st = 0; st < 8; ++st) if (st <= wid) {
#pragma unroll
                for (int ks = 0; ks < 2; ++ks) { const int krow = 16 * st + fr; const h16x8 X = *(const LAS h16x8*)(lds + KB + krow * 128 + (((4 * ks + fq) ^ swzb(krow)) * 16));
                    S[st] = __builtin_amdgcn_mfma_f32_16x16x32_f16(X, Y[ks], S[st], 0, 0, 0); } }
#pragma unroll
            for (int et = 0; et < 17; ++et) {
#pragma unroll
                for (int ks = 0; ks < 2; ++ks) { const int crow = 16 * et + fr; const h16x8 X = *(const LAS h16x8*)(lds + CB + crow * 128 + (((4 * ks + fq) ^ swzb(crow)) * 16));
                    acc[et] = __builtin_amdgcn_mfma_f32_16x16x32_f16(X, Y[ks], acc[et], 0, 0, 0); }
                if ((et & 3) == 3) __builtin_amdgcn_sched_barrier(0); }
            asm volatile("s_waitcnt lgkmcnt(0)" ::: "memory"); __builtin_amdgcn_s_barrier(); asm volatile("" ::: "memory");
        }
        OPAQUE_TID();
        const float al = ALs[trow], mc = MST[bh * 64 + c], iw = __expf(al + mc);
#pragma unroll
        for (int et = 0; et < 16; ++et) acc[et] *= iw;
        const float qn = __shfl(acc[16][0], fr);
        float den = 0.f;
#pragma unroll
        for (int st = 0; st < 8; ++st) { const f32x4 be = *(const LAS f32x4*)(BEs + 16 * st + 4 * fq);
#pragma unroll
            for (int r = 0; r < 4; ++r) { float v = S[st][r] * __expf(al + be[r]); if (st == wid) v = (4 * fq + r <= fr) ? v : 0.f; if (st > wid) v = 0.f; S[st][r] = v; den += v; } }
        den += __shfl_xor(den, 16); den += __shfl_xor(den, 32);
        den += iw * qn;
        h16x8 pf[4];
#pragma unroll
        for (int i = 0; i < 4; ++i) pf[i] = cat8(cvt4(S[2 * i]), cvt4(S[2 * i + 1]));
#pragma unroll
        for (int ks = 0; ks < 4; ++ks) if (ks <= (wid >> 1)) { const int r0 = 32 * ks + 4 * fq + tq, r1 = r0 + 16;
#pragma unroll
            for (int et = 0; et < 16; ++et) {
                const h16x4 lo = tr_read4(lds + VB + r0 * 512 + (((2 * et + (tp >> 1)) ^ ((r0 & 7) << 1)) * 16) + (tp & 1) * 8);
                const h16x4 hi = tr_read4(lds + VB + r1 * 512 + (((2 * et + (tp >> 1)) ^ ((r1 & 7) << 1)) * 16) + (tp & 1) * 8);
                acc[et] = __builtin_amdgcn_mfma_f32_16x16x32_f16(cat8(lo, hi), pf[ks], acc[et], 0, 0, 0);
                if ((et & 3) == 3) __builtin_amdgcn_sched_barrier(0); } }
        const int tg = t0 + trow; const float inv = 1.f / fmaxf(fabsf(den), __expf(NMg[tg * 4 + hd]));
        float ss = 0.f;
#pragma unroll
        for (int et = 0; et < 16; ++et) { acc[et] *= inv; ss += (acc[et][0] * acc[et][0] + acc[et][1] * acc[et][1]) + (acc[et][2] * acc[et][2] + acc[et][3] * acc[et][3]); }
        ss += __shfl_xor(ss, 16); ss += __shfl_xor(ss, 32);
        const float rstd = rsqrtf(ss * (1.f / DH) + EPS);
#pragma unroll
        for (int et = 0; et < 16; ++et) { const int col = hd * 256 + 16 * et + 4 * fq; const size_t o = (size_t)tg * 1024 + col;
            const f32x4 g = *(const f32x4*)(p.mh_norm_g + col); const h16x4 og = *(const h16x4*)(OG + o); const h16x4 z = *(const h16x4*)(Z + o); u32x2 w;
            w.x = pk_h2((float)z[0] + acc[et][0] * rstd * g[0] * (float)og[0], (float)z[1] + acc[et][1] * rstd * g[1] * (float)og[1]);
            w.y = pk_h2((float)z[2] + acc[et][2] * rstd * g[2] * (float)og[2], (float)z[3] + acc[et][3] * rstd * g[3] * (float)og[3]);
            *(u32x2*)(Zdst + o) = w; }
    }
    asm volatile("s_waitcnt vmcnt(0) lgkmcnt(0)" ::: "memory"); __builtin_amdgcn_s_barrier();
#undef OPAQUE_TID
}

__device__ __forceinline__ void p0_transpose_item(const float* W, int ldw, int srccol0, const float* gk, h16* WT, int K, int destrow0, int k0, LAS unsigned char* scr, int lane) {
    const int col4 = lane & 7, krow = lane >> 3;
    f32x4 v[8];
#pragma unroll
    for (int i = 0; i < 8; ++i) v[i] = *(const f32x4*)(W + (size_t)(k0 + 8 * i + krow) * ldw + srccol0 + 4 * col4);
    if (gk) {
#pragma unroll
        for (int i = 0; i < 8; ++i) v[i] *= gk[k0 + 8 * i + krow];
    }
#pragma unroll
    for (int i = 0; i < 8; ++i) { const int k = 8 * i + krow; u32x2 w; w.x = pk_h2(v[i][0], v[i][1]); w.y = pk_h2(v[i][2], v[i][3]);
        *(LAS u32x2*)(scr + k * 64 + (((col4 >> 1) ^ (2 * (i & 1))) * 16) + (col4 & 1) * 8) = w; }
    LDS_WAIT(); asm volatile("" ::: "memory");
    const int g = lane >> 4, li = lane & 15, q = li >> 2, pp = li & 3;
#pragma unroll
    for (int h = 0; h < 2; ++h)
#pragma unroll
        for (int it = 0; it < 2; ++it) { const int m = g + 4 * it, r0 = 8 * m + q, r1 = r0 + 4, ch = (2 * h + (pp >> 1)) ^ (2 * (m & 1));
            const h16x4 lo = tr_read4(scr + r0 * 64 + ch * 16 + (pp & 1) * 8), hi = tr_read4(scr + r1 * 64 + ch * 16 + (pp & 1) * 8);
            *(GAS h16x8*)(WT + (size_t)(destrow0 + 16 * h + li) * K + k0 + 8 * m) = cat8(lo, hi); }
    LDS_WAIT(); asm volatile("" ::: "memory");
}
__device__ __forceinline__ int win_destrow(int l) {
    if (l < 3072) return l;
    if (l < 4096) { const int c = l - 3072; return 3072 + (c >> 7) * 256 + (c & 127); }
    if (l < 5120) { const int c = l - 4096; return 5120 + (c >> 7) * 256 + (c & 127); }
    if (l < 6144) return 7168 + (l - 5120);
    if (l < 7168) { const int c = l - 6144; return 3072 + (c >> 7) * 256 + 128 + (c & 127); }
    { const int c = l - 7168; return 5120 + (c >> 7) * 256 + 128 + (c & 127); }
}
template <bool GATES>
__device__ __forceinline__ float p0_row(const float* xrow, h16* orow, const LAS float* gt, float (&acc)[8], int lane) {
    const GAS f32x4* xr = (const GAS f32x4*)xrow + lane;
    f32x4 v[4]; float ss = 0.f;
#pragma unroll
    for (int j = 0; j < 4; ++j) { v[j] = xr[64 * j]; ss += (v[j].x * v[j].x + v[j].y * v[j].y) + (v[j].z * v[j].z + v[j].w * v[j].w); }
    GAS u32x2* o8 = (GAS u32x2*)orow + lane;
#pragma unroll
    for (int j = 0; j < 4; ++j) { u32x2 w; w.x = pk_h2(v[j].x, v[j].y); w.y = pk_h2(v[j].z, v[j].w); o8[64 * j] = w; }
    if constexpr (GATES) {
#pragma unroll
        for (int q = 0; q < 8; ++q) acc[q] = 0.f;
#pragma unroll
        for (int j = 0; j < 4; ++j)
#pragma unroll
            for (int c = 0; c < 4; ++c) { const int k = 4 * (64 * j + lane) + c; const f32x4 g0 = *(const LAS f32x4*)(gt + k * 8), g1 = *(const LAS f32x4*)(gt + k * 8 + 4); const float xv = v[j][c];
                acc[0] += xv * g0.x; acc[1] += xv * g0.y; acc[2] += xv * g0.z; acc[3] += xv * g0.w; acc[4] += xv * g1.x; acc[5] += xv * g1.y; acc[6] += xv * g1.z; acc[7] += xv * g1.w; }
#pragma unroll
        for (int q = 0; q < 8; ++q) acc[q] = wave_sum(acc[q]);
    }
    return wave_sum(ss);
}
__device__ __forceinline__ void mstate_wave(const float* ig, const float* lf, float* mst, int bh, int lane) {
    const int b = bh >> 2, h = bh & 3; float B = 0.f, mx = -INFINITY;
    for (int s = 0; s < CHUNK; ++s) { const int t = b * SEQ + lane * CHUNK + s; B += lf[t * 4 + h]; mx = fmaxf(mx, ig[t * 4 + h] - B); }
    const float blast = B, maxw = B + mx; float m = 0.f;
    for (int c = 0; c < NCHUNK; ++c) { const float bl = __shfl(blast, c), mw = __shfl(maxw, c); if (lane == c) mst[bh * 64 + c] = m; m = fmaxf(bl + m, mw); }
}

struct Args { Ptrs p; int ph_lo, ph_hi, li, pad; };
__global__ void __launch_bounds__(NTHREADS, 2) mega(Args a) {
    extern __shared__ __attribute__((aligned(16))) unsigned char lds_[];
    LAS unsigned char* lds = (LAS unsigned char*)lds_;
    volatile LAS unsigned* MISC = (volatile LAS unsigned*)(lds + MISC_OFF);
    const Ptrs& p = a.p;
#define PH_IDS() int tid = threadIdx.x; asm volatile("" : "+v"(tid)); const int lane = tid & 63, wave = __builtin_amdgcn_readfirstlane(tid >> 6); const int gw = vcu * NWAVES + wave, NGW = G * NWAVES; (void)lane; (void)gw; (void)NGW
    const int G = gridDim.x, bx = blockIdx.x, vcu = (G % 8 == 0) ? (bx % 8) * (G / 8) + bx / 8 : bx;
    unsigned char* ws = p.ws;
    unsigned* ctl = (unsigned*)(ws + WS_CTL);
    for (int u = threadIdx.x; u < (LDS_BYTES - LDSCTL_OFF) / 4; u += NTHREADS) ((LAS unsigned*)(lds + LDSCTL_OFF))[u] = 0u;
    __syncthreads();
    XcdBarrier bar = xcd_barrier_post(ctl + CW_BAR + a.li * XCD_BAR_WORDS, MISC + 8);
    const int lo = a.ph_lo, hi = a.ph_hi;
#ifndef PH_MASK
#define PH_MASK 0xFFFF
#endif
#define IN(k) (((PH_MASK >> (k)) & 1) && lo <= (k) && (k) < hi)
#ifndef REPEAT_MASK
#define REPEAT_MASK 0
#endif
#define REP(k) for (int rep_ = 0; rep_ < 1 + ((REPEAT_MASK >> (k)) & 1); ++rep_)
#define BOTH(k) (IN(k) && IN((k) + 1))
#define GRID_BAR() xcd_barrier(bar)

    if (IN(0)) REP(0) {
        PH_IDS();
        __syncthreads();
        LAS float* gt = (LAS float*)lds;
        for (int i = tid; i < 8192; i += NTHREADS) { const int k = i >> 3, j = i & 7; gt[i] = p.norm_mix_g[k] * p.w_in[(size_t)k * IN_DIM + C_I + j]; }
        { float* wrt = (float*)(ws + OFF_WRT); for (int i = bx * NTHREADS + tid; i < 36 * 1024; i += G * NTHREADS) { const int j = i >> 10, k = i & 1023; wrt[i] = p.norm_moe_g[k] * (j < 4 ? p.w_rg[k * 4 + j] : p.w_re[k * 32 + (j - 4)]); } }
        { float* z = (float*)(ws + OFF_SSSV); for (int i = bx * NTHREADS + tid; i < 3 * NTOK; i += G * NTHREADS) z[i] = 0.f; }
        __syncthreads();
        float acc[8];
        for (int m = gw; m < NTOK; m += NGW) {
            const float ss = p0_row<true>(p.x + (size_t)m * DM, (h16*)(ws + WS_XH) + (size_t)m * DM, gt, acc, lane);
            const float rstd = rsqrtf(ss * (1.f / DM) + EPS);
            if (lane == 0) { ((float*)(ws + OFF_RSTD0))[m] = rstd; float* ig = (float*)(ws + OFF_IG) + m * 4; float* lf = (float*)(ws + OFF_LF) + m * 4;
#pragma unroll
                for (int h = 0; h < 4; ++h) { ig[h] = acc[h] * rstd + p.b_if[h]; lf[h] = logsigmoidf_(acc[4 + h] * rstd + p.b_if[4 + h]); } }
        }
        for (int m = gw; m < NB * NMEM; m += NGW) {
            const float ss = p0_row<false>(p.mem + (size_t)m * DM, (h16*)(ws + WS_MEMH) + (size_t)m * DM, gt, acc, lane);
            if (lane == 0) ((float*)(ws + OFF_RSTDM))[m] = rsqrtf(ss * (1.f / DM) + EPS);
        }
        LAS unsigned char* scr = lds + 32768 + wave * 4096;
        constexpr int I_WIN = 16 * 256, I_SQ = 16 * 32, I_KV = 16 * 64, NITEMS = I_WIN + 3 * I_SQ + I_KV;
        h16* wsm = (h16*)(ws + WS_WSM);
        for (int it = gw; it < NITEMS; it += NGW) {
            int r = it;
            if (r < I_WIN) { const int kb = r >> 8, nb = r & 255, l0 = 32 * nb; p0_transpose_item(p.w_in, IN_DIM, l0 < 4096 ? l0 : l0 + 8, p.norm_mix_g, (h16*)(ws + WS_WIN), DM, win_destrow(l0), 64 * kb, scr, lane); continue; } r -= I_WIN;
            if (r < I_SQ) { p0_transpose_item(p.w_out, DM, 32 * (r & 31), nullptr, wsm, DM, 32 * (r & 31), 64 * (r >> 5), scr, lane); continue; } r -= I_SQ;
            if (r < I_SQ) { p0_transpose_item(p.w_xq, DM, 32 * (r & 31), p.norm_x_g, wsm + 1024 * 1024, DM, 32 * (r & 31), 64 * (r >> 5), scr, lane); continue; } r -= I_SQ;
            if (r < I_KV) { p0_transpose_item(p.w_xkv, 2048, 32 * (r & 63), p.norm_mem_g, wsm + 2 * 1024 * 1024, DM, 32 * (r & 63), 64 * (r >> 6), scr, lane); continue; } r -= I_KV;
            p0_transpose_item(p.w_xo, DM, 32 * (r & 31), nullptr, wsm + 4 * 1024 * 1024, DM, 32 * (r & 31), 64 * (r >> 5), scr, lane);
        }
        if (BOTH(0)) GRID_BAR();
    }
    if (IN(1)) REP(1) {
        PH_IDS();
        if (bx < 8) mstate_ext(ws, bx, wave, lane);
        { pg8::StaticOrder S; S.init(ws + WS_XH, ws + WS_WIN, NTOK, 8192, DM, G, bx);
          EpiProj E{(const float*)(ws + OFF_RSTD0), p.b_gate, (h16*)p.out, (h16*)(ws + WS_V), (h16*)(ws + WS_OG), (h16*)(ws + WS_UG), (h16*)(ws + WS_SV), (float*)(ws + OFF_SSSV), rep_ == 0};
          pg8::gemm_phase<EpiProj, pg8::StaticOrder, false, true>(lds, DM, S, E); }
        { pg8::StaticOrder S; S.init(ws + WS_MEMH, ws + WS_WSM + 2 * 2097152, NB * NMEM, 2048, DM, G, (bx + G - 64) % G);
          EpiKV E{(const float*)(ws + OFF_RSTDM), (h16*)(ws + WS_KM), (h16*)(ws + WS_VTM)};
          pg8::gemm_phase<EpiKV, pg8::StaticOrder, false, true>(lds, DM, S, E); }
        if (BOTH(1)) GRID_BAR();
    }

    if (IN(2)) REP(2) {
        if (G >= 256) { if (bx < 128) scan_task(lds, p, ws, bx); else if (bx < 256) sgu_task(lds, p, ws, bx - 128); }
        else { for (int t = bx; t < 256; t += G) { if (t < 128) scan_task(lds, p, ws, t); else sgu_task(lds, p, ws, t - 128); __syncthreads(); } }
        if (BOTH(2)) GRID_BAR();
    }
    if (IN(3)) REP(3) {
        mout_phase(lds, p, ws, G, bx, (((REPEAT_MASK >> 3) & 1) && rep_ == 0) ? (h16*)(ws + WS_UG) : (h16*)(ws + WS_XH));
        if (BOTH(3)) GRID_BAR();
    }
    if (IN(4)) REP(4) {
        PH_IDS();
        { LAS unsigned char* scr = lds + 32768 + wave * 4096;
          h16* W13 = (h16*)(ws + WS_UG); h16* W2T = (h16*)(ws + WS_UG + 64 * MiB);
          for (int it = gw; it < 32 * 768; it += NGW) { const int e = it / 768, r = it % 768;
              if (r < 256) { const int kb = r >> 4, nb = r & 15, f0 = 32 * nb; p0_transpose_item(p.w1 + (size_t)e * DM * FF, FF, f0, p.norm_moe_g, W13 + (size_t)e * 1024 * 1024, DM, (f0 >> 7) * 256 + (f0 & 127), 64 * kb, scr, lane); }
              else if (r < 512) { const int q = r - 256, kb = q >> 4, nb = q & 15, f0 = 32 * nb; p0_transpose_item(p.w3 + (size_t)e * DM * FF, FF, f0, p.norm_moe_g, W13 + (size_t)e * 1024 * 1024, DM, (f0 >> 7) * 256 + 128 + (f0 & 127), 64 * kb, scr, lane); }
              else { const int q = r - 512, kb = q >> 5, nb = q & 31; p0_transpose_item(p.w2 + (size_t)e * FF * DM, DM, 32 * nb, nullptr, W2T + (size_t)e * 1024 * 512, FF, 32 * nb, 64 * kb, scr, lane); } }
          __syncthreads(); }
        { pg8::StaticOrder S; S.init(ws + WS_XH, ws + WS_WSM, NTOK, DM, DM, G, bx);
          EpiResid E{p.x, p.out, (h16*)(ws + WS_V), (float*)(ws + OFF_SS1), rep_ == 0};
          pg8::gemm_phase<EpiResid, pg8::StaticOrder, false, false>(lds, DM, S, E); }
        if (BOTH(4)) GRID_BAR();
    }
    if (IN(5)) REP(5) {
        { pg8::StaticOrder S; S.init(ws + WS_V, ws + WS_WSM + 2097152, NTOK, DM, DM, G, bx);
          EpiQ E{(const float*)(ws + OFF_SS1), (h16*)(ws + WS_XH)};
          pg8::gemm_phase<EpiQ, pg8::StaticOrder, false, false>(lds, DM, S, E); }
        if (BOTH(5)) GRID_BAR();
    }
    if (IN(6)) REP(6) {
        attn_phase(lds, (const h16*)(ws + WS_XH), (const h16*)(ws + WS_KM), (const h16*)(ws + WS_VTM), (h16*)(ws + WS_OG), G, bx);
        if (BOTH(6)) GRID_BAR();
    }
    if (IN(7)) {
        { pg8::StaticOrder S; S.init(ws + WS_OG, ws + WS_WSM + 4 * 2097152, NTOK, DM, DM, G, bx);
          EpiResid E{p.out, p.out, (h16*)(ws + WS_V), (float*)(ws + OFF_SS2), true};
          pg8::gemm_phase<EpiResid, pg8::StaticOrder, false, false>(lds, DM, S, E); }
        if (BOTH(7)) GRID_BAR();
    }
    if (IN(8)) REP(8) {
        PH_IDS();
        if (rep_ == 1) { GRID_BAR(); if (bx == 0 && tid < 32) (ctl + CW_CNT)[tid] = 0u; GRID_BAR(); }
        unsigned* cnt = ctl + CW_CNT; int* list = (int*)(ws + OFF_LIST); float* gate = (float*)(ws + OFF_GATE);
        const float* ss2 = (const float*)(ws + OFF_SS2); const float* WRT = (const float*)(ws + OFF_WRT);
        const bool b5 = (lane & 32) != 0, b4 = (lane & 16) != 0, b3 = (lane & 8) != 0;
        int myE = 0, mySlot = 0; float myG = 0.f; int nmine = 0;
        for (int t = gw; t < NTOK; t += NGW) {
            const GAS f32x4* xr = (const GAS f32x4*)(p.out + (size_t)t * DM) + lane; const float rs = rsqrtf(ss2[t] * (1.f / DM) + EPS);
            f32x4 v[4];
#pragma unroll
            for (int j = 0; j < 4; ++j) v[j] = xr[64 * j] * rs;
            float a0 = 0.f, a1 = 0.f, a2 = 0.f, a3 = 0.f;
#pragma unroll
            for (int j = 0; j < 4; ++j) { const GAS f32x4* wp = (const GAS f32x4*)WRT + 64 * j + lane; const f32x4 w0 = wp[0], w1 = wp[256], w2 = wp[512], w3 = wp[768];
                a0 += (v[j].x * w0.x + v[j].y * w0.y) + (v[j].z * w0.z + v[j].w * w0.w); a1 += (v[j].x * w1.x + v[j].y * w1.y) + (v[j].z * w1.z + v[j].w * w1.w);
                a2 += (v[j].x * w2.x + v[j].y * w2.y) + (v[j].z * w2.z + v[j].w * w2.w); a3 += (v[j].x * w3.x + v[j].y * w3.y) + (v[j].z * w3.z + v[j].w * w3.w); }
            { const float s0 = b5 ? a0 : a2, s1 = b5 ? a1 : a3; float k0 = (b5 ? a2 : a0) + __shfl_xor(s0, 32), k1 = (b5 ? a3 : a1) + __shfl_xor(s1, 32);
              const float s2 = b4 ? k0 : k1; a0 = (b4 ? k1 : k0) + __shfl_xor(s2, 16); }
            a0 += __shfl_xor(a0, 8); a0 += __shfl_xor(a0, 4); a0 += __shfl_xor(a0, 2); a0 += __shfl_xor(a0, 1);
            float gl[4];
#pragma unroll
            for (int j = 0; j < 4; ++j) gl[j] = __builtin_bit_cast(float, __builtin_amdgcn_readlane(__builtin_bit_cast(int, a0), 16 * j)) + p.b_rg[j];
            int gi = 0; float gm = gl[0];
#pragma unroll
            for (int j = 1; j < 4; ++j) if (gl[j] > gm) { gm = gl[j]; gi = j; }
            float gs = 0.f;
#pragma unroll
            for (int j = 0; j < 4; ++j) gs += __expf(gl[j] - gm);
            const float pg = 1.f / gs;
            float e[8];
#pragma unroll
            for (int q = 0; q < 8; ++q) e[q] = 0.f;
            const GAS f32x4* we = (const GAS f32x4*)WRT + (size_t)(4 + gi * 8) * 256 + lane;
#pragma unroll
            for (int j = 0; j < 4; ++j)
#pragma unroll
                for (int q = 0; q < 8; ++q) { const f32x4 w = we[q * 256 + 64 * j]; e[q] += (v[j].x * w.x + v[j].y * w.y) + (v[j].z * w.z + v[j].w * w.w); }
            float k4[4];
#pragma unroll
            for (int q = 0; q < 4; ++q) { const float snd = b5 ? e[q] : e[4 + q]; k4[q] = (b5 ? e[4 + q] : e[q]) + __shfl_xor(snd, 32); }
            float k2[2];
#pragma unroll
            for (int q = 0; q < 2; ++q) { const float snd = b4 ? k4[q] : k4[2 + q]; k2[q] = (b4 ? k4[2 + q] : k4[q]) + __shfl_xor(snd, 16); }
            float k1; { const float snd = b3 ? k2[0] : k2[1]; k1 = (b3 ? k2[1] : k2[0]) + __shfl_xor(snd, 8); }
            k1 += __shfl_xor(k1, 4); k1 += __shfl_xor(k1, 2); k1 += __shfl_xor(k1, 1);
            float ev[8];
#pragma unroll
            for (int q = 0; q < 8; ++q) ev[q] = __builtin_bit_cast(float, __builtin_amdgcn_readlane(__builtin_bit_cast(int, k1), 8 * q)) + p.b_re[gi * 8 + q];
            int i1 = 0; float v1 = ev[0];
#pragma unroll
            for (int q = 1; q < 8; ++q) if (ev[q] > v1) { v1 = ev[q]; i1 = q; }
            int i2 = -1; float v2 = -INFINITY;
#pragma unroll
            for (int q = 0; q < 8; ++q) if (q != i1 && ev[q] > v2) { v2 = ev[q]; i2 = q; }
            const float e2 = __expf(v2 - v1), g1 = pg / (1.f + e2), g2 = pg * e2 / (1.f + e2);
            if (lane == 2 * nmine) { myE = gi * 8 + i1; mySlot = 2 * t; myG = g1; }
            if (lane == 2 * nmine + 1) { myE = gi * 8 + i2; mySlot = 2 * t + 1; myG = g2; }
            ++nmine;
            if (nmine == 32) { { const unsigned pos = atomicAdd(cnt + myE, 1u); list[myE * NTOK + pos] = mySlot; gate[mySlot] = myG; } nmine = 0; }
        }
        if (lane < 2 * nmine) { const unsigned pos = atomicAdd(cnt + myE, 1u); list[myE * NTOK + pos] = mySlot; gate[mySlot] = myG; }
        if (BOTH(8)) GRID_BAR();
    }
    if (IN(9) || IN(10)) {
        PH_IDS();
        LAS int* tab = (LAS int*)(lds + LDSCTL_OFF + 1024);
        if (tid == 0) { const unsigned* cnt = ctl + CW_CNT; int s = 0; for (int e = 0; e < 32; ++e) { tab[e] = s; s += (int)((__hip_atomic_load(cnt + e, RLX_AGENT) + 255u) >> 8); } tab[32] = s; }
        __syncthreads();
        if (IN(9)) REP(9) {
            MoeOrder S{(const char*)(ws + WS_V), (const char*)(ws + WS_UG), DM, (size_t)1024 * 1024 * 2, (const int*)(ws + OFF_LIST), ctl + CW_CNT, tab, G, bx};
            EpiFfn1 E{(const int*)(ws + OFF_LIST), (const float*)(ws + OFF_SS2), (h16*)(ws + WS_H)};
            pg8::gemm_phase<EpiFfn1, MoeOrder, true, true>(lds, DM, S, E);
            if (BOTH(9)) GRID_BAR();
        }
        if (IN(10)) REP(10) {
            MoeOrder S{(const char*)(ws + WS_H), (const char*)(ws + WS_UG + 64 * MiB), FF, (size_t)1024 * 512 * 2, (const int*)(ws + OFF_LIST), ctl + CW_CNT, tab, G, bx};
            EpiFfn2 E{(const int*)(ws + OFF_LIST), (const float*)(ws + OFF_GATE), (h16*)(ws + WS_Y)};
            pg8::gemm_phase<EpiFfn2, MoeOrder, false, true>(lds, FF, S, E);
            if (BOTH(10)) GRID_BAR();
        }
    }
    if (IN(11)) REP(11) {
        PH_IDS();
        float* fdst = (((REPEAT_MASK >> 11) & 1) && rep_ == 0) ? (float*)(ws + WS_UG) : p.out;
        for (int t = gw; t < NTOK; t += NGW) {
            GAS f32x4* xr = (GAS f32x4*)(p.out + (size_t)t * DM) + lane; const GAS u32x2* y0 = (const GAS u32x2*)(ws + WS_Y + (size_t)(2 * t) * DM * 2) + lane; const GAS u32x2* y1 = y0 + DM / 4;
            f32x4 v[4]; float ss = 0.f;
#pragma unroll
            for (int j = 0; j < 4; ++j) { const u32x2 a = y0[64 * j], b = y1[64 * j]; const h16x4 ha = __builtin_bit_cast(h16x4, a), hb = __builtin_bit_cast(h16x4, b);
                v[j] = xr[64 * j];
#pragma unroll
                for (int c = 0; c < 4; ++c) { v[j][c] += (float)ha[c] + (float)hb[c]; ss += v[j][c] * v[j][c]; } }
            ss = wave_sum(ss); const float rs = rsqrtf(ss * (1.f / DM) + EPS);
#pragma unroll
            for (int j = 0; j < 4; ++j) { const f32x4 g = *(const f32x4*)(p.norm_f_g + 4 * (64 * j + lane)); ((GAS f32x4*)(fdst + (size_t)t * DM) + lane)[64 * j] = v[j] * rs * g; }
        }
    }
#undef IN
#undef BOTH
#undef GRID_BAR
}

static int mega_grid() {
    static int grid = 0;
    if (grid == 0) {
        int dev = 0, cus = 0;
        if (hipGetDevice(&dev) != hipSuccess || hipDeviceGetAttribute(&cus, hipDeviceAttributeMultiprocessorCount, dev) != hipSuccess) { grid = -1; return grid; }
        if (hipFuncSetAttribute((const void*)mega, hipFuncAttributeMaxDynamicSharedMemorySize, LDS_BYTES) != hipSuccess) { fprintf(stderr, "hipFuncSetAttribute failed\n"); grid = -1; return grid; }
        (void)hipGetLastError();
        grid = cus;
    }
    return grid;
}
static void launch_mega(const Ptrs& p, int lo, int hi, int li, hipStream_t stream) {
    const int grid = mega_grid(); if (grid <= 0) return;
    Args a{}; a.p = p; a.ph_lo = lo; a.ph_hi = hi; a.li = li; a.pad = 0;
    hipLaunchKernelGGL(mega, dim3(grid), dim3(NTHREADS), LDS_BYTES, stream, a);
}

extern "C" void kernel_launch(void* const* d_in, const int* in_sizes, int n_in, void* d_out, int out_size, void* d_ws, size_t ws_size, hipStream_t stream) {
    if (n_in != 27 || ws_size < WS_END) { fprintf(stderr, "kernel_launch: unexpected n_in %d or ws_size %zu (< %zu)\n", n_in, ws_size, (size_t)WS_END); return; }
    Ptrs p{};
    const float** f = (const float**)&p;
    for (int i = 0; i < 27; ++i) f[i] = (const float*)d_in[i];
    p.out = (float*)d_out; p.ws = (unsigned char*)d_ws;
    (void)hipMemsetAsync((char*)d_ws + WS_CTL, 0, CTL_BYTES, stream);
    launch_mega(p, 0, 12, 0, stream);
}
```

```cpp
#include <hip/hip_runtime.h>
#include <cstdio>
#include <cstdint>
#include <cmath>

typedef _Float16 h16;
typedef unsigned short u16;

constexpr int DM = 1024, NB = 2, SEQ = 8192, NTOK = NB * SEQ;
constexpr int NMEM = 256, NHEAD = 4, DH = 256, CHUNK = 128, NCHUNK = SEQ / CHUNK;
constexpr int IN_DIM = 8200;
constexpr int C_QK = 0, C_V = 2048, C_O = 3072, C_I = 4096, C_F = 4100, C_U = 4104, C_SV = 5128, C_G = 6152;
constexpr int NEXP = 32, NGRP = 4, EPG = 8, FF = 512, NSLOT = NTOK * 2;
constexpr float EPS = 1e-6f;

constexpr size_t MiB = 1u << 20;
constexpr size_t WS_CTL = 0;
constexpr size_t CTL_BYTES = 1 * MiB;
constexpr size_t WS_SMALL = 1 * MiB;
constexpr size_t OFF_RSTD0 = WS_SMALL;
constexpr size_t OFF_SSSV  = OFF_RSTD0 + 65536;
constexpr size_t OFF_SS1   = OFF_SSSV + 65536;
constexpr size_t OFF_SS2   = OFF_SS1 + 65536;
constexpr size_t OFF_IG    = OFF_SS2 + 65536;
constexpr size_t OFF_LF    = OFF_IG + 262144;
constexpr size_t OFF_MST   = OFF_LF + 262144;
constexpr size_t OFF_RSTDM = OFF_MST + 4096;
constexpr size_t OFF_AL    = 4 * MiB + 1048576;
constexpr size_t OFF_BE    = OFF_AL + 262144;
constexpr size_t OFF_NM    = OFF_BE + 262144;
constexpr size_t OFF_WU    = OFF_NM + 262144;
constexpr size_t OFF_DEC   = OFF_WU + 262144;
constexpr size_t OFF_WRT   = 7 * MiB;
constexpr size_t OFF_GATE  = 2 * MiB;
constexpr size_t OFF_SLOTE = OFF_GATE + 131072;
constexpr size_t OFF_SLOTP = OFF_SLOTE + 131072;
constexpr size_t OFF_LIST  = 3 * MiB;
constexpr size_t OFF_NAIVE_C = 262 * MiB;
constexpr size_t OFF_NAIVE_N = 6 * MiB + 8192;
constexpr size_t OFF_NAIVE_S = 6 * MiB + 65536;
constexpr size_t WS_WSM  = 8 * MiB;
constexpr size_t WS_KM   = 18 * MiB;
constexpr size_t WS_VTM  = 19 * MiB;
constexpr size_t WS_WIN  = 20 * MiB;
constexpr size_t WS_XH   = 36 * MiB;
constexpr size_t WS_V    = 68 * MiB;
constexpr size_t WS_OG   = 100 * MiB;
constexpr size_t WS_UG   = 132 * MiB;
constexpr size_t WS_SV   = 164 * MiB;
constexpr size_t WS_CST  = 196 * MiB;
constexpr size_t WS_H    = 228 * MiB;
constexpr size_t WS_NST  = 260 * MiB;
constexpr size_t WS_MEMH = 261 * MiB;
constexpr size_t WS_END  = 268 * MiB;
constexpr size_t WS_Y    = WS_XH;
constexpr size_t WS_QC   = WS_UG;
constexpr size_t WS_KC   = WS_SV;
static_assert(OFF_RSTDM + 4096 <= 2 * MiB && OFF_SLOTP + 131072 <= OFF_LIST && OFF_LIST + 2 * MiB <= OFF_AL && OFF_DEC + 4096 <= OFF_NAIVE_N && OFF_NAIVE_N + 8192 <= OFF_NAIVE_S && OFF_NAIVE_S + 524288 <= WS_WSM && OFF_NAIVE_C + 2 * MiB <= WS_END, "small map");
constexpr int CW_CNT = 64;

struct Ptrs {
    const float *x, *mem, *norm_mix_g, *w_in, *b_gate, *b_if, *conv_w, *conv_b, *mh_norm_g, *sgu_norm_g, *w_s, *b_s, *w_out,
                *norm_x_g, *norm_mem_g, *w_xq, *w_xkv, *w_xo, *norm_moe_g, *w_rg, *b_rg, *w_re, *b_re, *w1, *w3, *w2, *norm_f_g;
    float* out; unsigned char* ws;
};

__device__ __forceinline__ float sigmoidf_(float v) { return 1.f / (1.f + __expf(-v)); }
__device__ __forceinline__ float siluf_(float v) { return v / (1.f + __expf(-v)); }
__device__ __forceinline__ float gelu_tanh(float v) { const float u = 0.7978845608028654f * (v + 0.044715f * v * v * v); return v / (1.f + __expf(-2.f * u)); }
__device__ __forceinline__ float logsigmoidf_(float v) { return fminf(v, 0.f) - log1pf(__expf(-fabsf(v))); }
__device__ __forceinline__ float wave_sum(float v) {
#pragma unroll
    for (int o = 1; o < 64; o <<= 1) v += __shfl_xor(v, o);
    return v;
}
__device__ __forceinline__ float wave_max(float v) {
#pragma unroll
    for (int o = 1; o < 64; o <<= 1) v = fmaxf(v, __shfl_xor(v, o));
    return v;
}
__host__ __device__ __forceinline__ int vt_slot(int key) { const int g = key & ~15, r = key & 15;   const int hh = (r >> 2) & 1, j = ((r >> 3) << 2) | (r & 3); return g + 8 * hh + j; }

__global__ void nk_zero(Ptrs p) {
    float* a = (float*)(p.ws + OFF_SSSV);
    const int i = blockIdx.x * blockDim.x + threadIdx.x;
    if (i < 3 * NTOK) a[i] = 0.f;
}
__global__ void nk_rows0(Ptrs p) {
    const int row = blockIdx.x * 4 + (threadIdx.x >> 6), lane = threadIdx.x & 63;
    const float* xr = p.x + (size_t)row * DM;
    float ss = 0.f; float acc[8];
#pragma unroll
    for (int j = 0; j < 8; ++j) acc[j] = 0.f;
    h16* xh = (h16*)(p.ws + WS_XH) + (size_t)row * DM;
    for (int k = lane; k < DM; k += 64) {
        const float v = xr[k]; ss += v * v; xh[k] = (h16)v;
        const float vg = v * p.norm_mix_g[k];
#pragma unroll
        for (int j = 0; j < 8; ++j) acc[j] += vg * p.w_in[(size_t)k * IN_DIM + C_I + j];
    }
    ss = wave_sum(ss);
    const float rstd = rsqrtf(ss / DM + EPS);
#pragma unroll
    for (int j = 0; j < 8; ++j) acc[j] = wave_sum(acc[j]);
    if (lane == 0) {
        ((float*)(p.ws + OFF_RSTD0))[row] = rstd;
        float* ig = (float*)(p.ws + OFF_IG) + row * 4; float* lf = (float*)(p.ws + OFF_LF) + row * 4;
#pragma unroll
        for (int h = 0; h < 4; ++h) { ig[h] = acc[h] * rstd + p.b_if[h]; lf[h] = logsigmoidf_(acc[4 + h] * rstd + p.b_if[4 + h]); }
    }
}
__global__ void nk_mem(Ptrs p) {
    const int row = blockIdx.x * 4 + (threadIdx.x >> 6), lane = threadIdx.x & 63;
    const float* xr = p.mem + (size_t)row * DM; h16* o = (h16*)(p.ws + WS_MEMH) + (size_t)row * DM;
    float ss = 0.f;
    for (int k = lane; k < DM; k += 64) { const float v = xr[k]; ss += v * v; o[k] = (h16)v; }
    ss = wave_sum(ss);
    if (lane == 0) ((float*)(p.ws + OFF_RSTDM))[row] = rsqrtf(ss / DM + EPS);
}
__global__ void nk_mstate(Ptrs p) {
    const int bh = blockIdx.x, b = bh >> 2, h = bh & 3, lane = threadIdx.x;
    const float* ig = (const float*)(p.ws + OFF_IG); const float* lf = (const float*)(p.ws + OFF_LF);
    float B = 0.f, mx = -INFINITY;
    for (int s = 0; s < CHUNK; ++s) { const int t = b * SEQ + lane * CHUNK + s; B += lf[t * 4 + h]; mx = fmaxf(mx, ig[t * 4 + h] - B); }
    const float blast = B, maxw = B + mx;
    __shared__ float sb[64], sm[64];
    sb[lane] = blast; sm[lane] = maxw; __syncthreads();
    if (lane == 0) { float m = 0.f; float* mst = (float*)(p.ws + OFF_MST) + bh * 64;
        for (int c = 0; c < NCHUNK; ++c) { mst[c] = m; m = fmaxf(sb[c] + m, sm[c]); } }
}
__global__ void nk_proj(Ptrs p) {
    const int l = blockIdx.x * 256 + threadIdx.x;
    const int r0 = blockIdx.y * 8;
    int c0, c1 = -1, kind;
    if (l < 2048) { c0 = C_QK + l; kind = 0; }
    else if (l < 3072) { c0 = C_V + (l - 2048); kind = 1; }
    else if (l < 4096) { c0 = C_O + (l - 3072); c1 = C_G + (l - 3072); kind = 2; }
    else if (l < 5120) { c0 = C_U + (l - 4096); c1 = C_G + 1024 + (l - 4096); kind = 3; }
    else if (l < 6144) { c0 = C_SV + (l - 5120); kind = 4; }
    else return;
    float a0[8], a1[8];
#pragma unroll
    for (int r = 0; r < 8; ++r) { a0[r] = 0.f; a1[r] = 0.f; }
    for (int k = 0; k < DM; ++k) {
        const float g = p.norm_mix_g[k];
        const float w0 = p.w_in[(size_t)k * IN_DIM + c0] * g;
        const float w1 = (c1 >= 0) ? p.w_in[(size_t)k * IN_DIM + c1] * g : 0.f;
#pragma unroll
        for (int r = 0; r < 8; ++r) { const float xv = p.x[(size_t)(r0 + r) * DM + k]; a0[r] += xv * w0; a1[r] += xv * w1; }
    }
    const float* rstd0 = (const float*)(p.ws + OFF_RSTD0);
#pragma unroll
    for (int r = 0; r < 8; ++r) {
        const int t = r0 + r; const float rs = rstd0[t]; const float v0 = a0[r] * rs, v1 = a1[r] * rs;
        if (kind == 0) ((h16*)p.out)[(size_t)t * 2048 + l] = (h16)v0;
        else if (kind == 1) ((h16*)(p.ws + WS_V))[(size_t)t * DM + (l - 2048)] = (h16)v0;
        else if (kind == 2) { const int c = l - 3072; ((h16*)(p.ws + WS_OG))[(size_t)t * DM + c] = (h16)(sigmoidf_(v0) * sigmoidf_(v1 + p.b_gate[c])); }
        else if (kind == 3) { const int c = l - 4096; ((h16*)(p.ws + WS_UG))[(size_t)t * DM + c] = (h16)(gelu_tanh(v0) * sigmoidf_(v1 + p.b_gate[1024 + c])); }
        else { const int c = l - 5120; const float gv = gelu_tanh(v0); ((h16*)(p.ws + WS_SV))[(size_t)t * DM + c] = (h16)gv; atomicAdd((float*)(p.ws + OFF_SSSV) + t, gv * gv); }
    }
}
__global__ void nk_conv(Ptrs p) {
    const size_t i = (size_t)blockIdx.x * 256 + threadIdx.x; const int t = (int)(i >> 11), c = (int)(i & 2047), tl = t & (SEQ - 1);
    const h16* qk = (const h16*)p.out;
    float a = p.conv_b[c];
#pragma unroll
    for (int j = 0; j < 4; ++j) { const int dt = j - 3; if (tl + dt >= 0) a += p.conv_w[j * 2048 + c] * (float)qk[(size_t)(t + dt) * 2048 + c]; }
    a = siluf_(a);
    if (c < 1024) ((h16*)(p.ws + WS_QC))[(size_t)t * DM + c] = (h16)a; else ((h16*)(p.ws + WS_KC))[(size_t)t * DM + (c - 1024)] = (h16)(a * 0.0625f);
}
__global__ void __launch_bounds__(1024) nk_mlstm(Ptrs p) {
    const int bh = blockIdx.x, b = bh >> 2, hd = bh & 3, tid = threadIdx.x;
    const h16* Qc = (const h16*)(p.ws + WS_QC); const h16* Kc = (const h16*)(p.ws + WS_KC); const h16* V = (const h16*)(p.ws + WS_V);
    float* C = (float*)(p.ws + OFF_NAIVE_C) + (size_t)bh * 65536; float* nvec = (float*)(p.ws + OFF_NAIVE_N) + bh * 256; float* Sp = (float*)(p.ws + OFF_NAIVE_S) + (size_t)bh * 16384;
    const float* ig = (const float*)(p.ws + OFF_IG); const float* lf = (const float*)(p.ws + OFF_LF);
    float* Hout = p.out;
    __shared__ float s_b[128], s_ic[128], s_mt[128], s_iw[128], s_ws[128], s_misc[4];
    for (int i = tid; i < 65536; i += 1024) C[i] = 0.f;
    if (tid < 256) nvec[tid] = 0.f;
    float m = 0.f;
    __syncthreads();
    for (int c = 0; c < NCHUNK; ++c) {
        const int t0 = b * SEQ + c * CHUNK;
        if (tid == 0) { float B = 0.f; for (int s = 0; s < CHUNK; ++s) { B += lf[(t0 + s) * 4 + hd]; s_b[s] = B; s_ic[s] = ig[(t0 + s) * 4 + hd]; } }
        __syncthreads();
        if (tid < 128) { const int t = tid; float mx = s_b[t] + m; for (int s = 0; s <= t; ++s) mx = fmaxf(mx, s_b[t] - s_b[s] + s_ic[s]); s_mt[t] = mx; s_iw[t] = __expf(s_b[t] + m - mx); }
        if (tid == 128) { const float bl = s_b[127]; float mx = bl + m; for (int s = 0; s < CHUNK; ++s) mx = fmaxf(mx, bl - s_b[s] + s_ic[s]); s_misc[0] = mx; s_misc[1] = __expf(bl + m - mx); }
        __syncthreads();
        if (tid < 128) s_ws[tid] = __expf(s_b[127] - s_b[tid] + s_ic[tid] - s_misc[0]);
        for (int i = tid; i < 16384; i += 1024) { const int t = i >> 7, s = i & 127; float v = 0.f;
            if (s <= t) { float d = 0.f; const h16* q = Qc + (size_t)(t0 + t) * DM + hd * DH; const h16* k = Kc + (size_t)(t0 + s) * DM + hd * DH;
                for (int e = 0; e < DH; ++e) d += (float)q[e] * (float)k[e];
                v = d * __expf(s_b[t] - s_b[s] + s_ic[s] - s_mt[t]); }
            Sp[i] = v; }
        __threadfence_block(); __syncthreads();
        for (int i = tid; i < 32768; i += 1024) { const int t = i >> 8, e = i & 255; float num = 0.f, den = 0.f;
            for (int s = 0; s <= t; ++s) { const float sv = Sp[t * 128 + s]; num += sv * (float)V[(size_t)(t0 + s) * DM + hd * DH + e]; den += sv; }
            float qc = 0.f, qn = 0.f; const h16* q = Qc + (size_t)(t0 + t) * DM + hd * DH;
            for (int d = 0; d < DH; ++d) { const float qv = (float)q[d]; qc += qv * C[d * 256 + e]; qn += qv * nvec[d]; }
            num += s_iw[t] * qc; den += s_iw[t] * qn;
            Hout[(size_t)(t0 + t) * DM + hd * DH + e] = num / fmaxf(fabsf(den), __expf(-s_mt[t])); }
        __syncthreads();
        const float decay = s_misc[1];
        for (int i = tid; i < 65536; i += 1024) { const int d = i >> 8, e = i & 255; float a = 0.f;
            for (int s = 0; s < CHUNK; ++s) a += s_ws[s] * (float)Kc[(size_t)(t0 + s) * DM + hd * DH + d] * (float)V[(size_t)(t0 + s) * DM + hd * DH + e];
            C[i] = decay * C[i] + a; }
        if (tid < 256) { float a = 0.f; for (int s = 0; s < CHUNK; ++s) a += s_ws[s] * (float)Kc[(size_t)(t0 + s) * DM + hd * DH + tid]; nvec[tid] = decay * nvec[tid] + a; }
        m = s_misc[0];
        __threadfence_block(); __syncthreads();
    }
}

__global__ void __launch_bounds__(1024) nk_mout(Ptrs p) {
    const int bh = blockIdx.x >> 6, c = blockIdx.x & 63, b = bh >> 2, hd = bh & 3, tid = threadIdx.x, t0 = b * SEQ + c * CHUNK;
    const h16* Qc = (const h16*)(p.ws + WS_QC); const h16* Kc = (const h16*)(p.ws + WS_KC); const h16* V = (const h16*)(p.ws + WS_V);
    const h16* Ct = (const h16*)(p.ws + WS_CST) + ((size_t)(bh * 64 + c)) * 65536; const float* nst = (const float*)(p.ws + WS_NST) + (size_t)(bh * 64 + c) * 256;
    const float* AL = (const float*)(p.ws + OFF_AL); const float* BE = (const float*)(p.ws + OFF_BE); const float* NM = (const float*)(p.ws + OFF_NM);
    const float mc = ((const float*)(p.ws + OFF_MST))[bh * 64 + c];
    __shared__ h16 Sp[128 * 128];
    for (int i = tid; i < 16384; i += 1024) { const int t = i >> 7, s = i & 127; float v = 0.f;
        if (s <= t) { float d = 0.f; const h16* q = Qc + (size_t)(t0 + t) * DM + hd * DH; const h16* k = Kc + (size_t)(t0 + s) * DM + hd * DH;
            for (int e = 0; e < DH; ++e) d += (float)q[e] * (float)k[e];
            v = d * __expf(AL[(t0 + t) * 4 + hd] + BE[(t0 + s) * 4 + hd]); }
        Sp[i] = (h16)v; }
    __syncthreads();
    for (int i = tid; i < 32768; i += 1024) { const int t = i >> 8, e = i & 255; float num = 0.f, den = 0.f;
        for (int s = 0; s <= t; ++s) { const float sv = (float)Sp[t * 128 + s]; num += sv * (float)V[(size_t)(t0 + s) * DM + hd * DH + e]; den += sv; }
        float qc = 0.f, qn = 0.f; const h16* q = Qc + (size_t)(t0 + t) * DM + hd * DH;
        for (int d = 0; d < DH; ++d) { const float qv = (float)q[d]; qc += qv * (float)Ct[e * 256 + d]; qn += qv * nst[d]; }
        const float iw = __expf(AL[(t0 + t) * 4 + hd] + mc);
        num += iw * qc; den += iw * qn;
        p.out[(size_t)(t0 + t) * DM + hd * DH + e] = num / fmaxf(fabsf(den), __expf(NM[(t0 + t) * 4 + hd])); }
}
__global__ void nk_sgu(Ptrs p) {
    const size_t i = (size_t)blockIdx.x * 256 + threadIdx.x; const int t = (int)(i >> 10), ch = (int)(i & 1023), g = ch >> 7, tl = t & 127, t0 = t - tl;
    const h16* SV = (const h16*)(p.ws + WS_SV); const float* ss = (const float*)(p.ws + OFF_SSSV);
    float a = 0.f;
    for (int s = 0; s <= tl; ++s) a += p.w_s[(g * 128 + tl) * 128 + s] * (float)SV[(size_t)(t0 + s) * DM + ch] * rsqrtf(ss[t0 + s] / DM + EPS);
    a = a * p.sgu_norm_g[ch] + p.b_s[g * 128 + tl];
    ((h16*)(p.ws + WS_XH))[i] = (h16)((float)((const h16*)(p.ws + WS_UG))[i] * a);
}
__global__ void nk_ya(Ptrs p) {
    const int w = blockIdx.x * 4 + (threadIdx.x >> 6), lane = threadIdx.x & 63, t = w >> 2, hd = w & 3;
    const float* hrow = p.out + (size_t)t * DM + hd * DH; float v[4]; float ss = 0.f;
#pragma unroll
    for (int j = 0; j < 4; ++j) { v[j] = hrow[lane + 64 * j]; ss += v[j] * v[j]; }
    ss = wave_sum(ss); const float rs = rsqrtf(ss / DH + EPS);
    h16* Z = (h16*)(p.ws + WS_XH) + (size_t)t * DM + hd * DH; const h16* OG = (const h16*)(p.ws + WS_OG) + (size_t)t * DM + hd * DH;
#pragma unroll
    for (int j = 0; j < 4; ++j) { const int e = lane + 64 * j; Z[e] = (h16)((float)Z[e] + v[j] * rs * p.mh_norm_g[hd * DH + e] * (float)OG[e]); }
}
__global__ void nk_wout(Ptrs p) {
    const int c = blockIdx.x * 256 + threadIdx.x, r0 = blockIdx.y * 8;
    const h16* Z = (const h16*)(p.ws + WS_XH);
    float a[8];
#pragma unroll
    for (int r = 0; r < 8; ++r) a[r] = 0.f;
    for (int k = 0; k < DM; ++k) { const float w = p.w_out[(size_t)k * DM + c];
#pragma unroll
        for (int r = 0; r < 8; ++r) a[r] += (float)Z[(size_t)(r0 + r) * DM + k] * w; }
#pragma unroll
    for (int r = 0; r < 8; ++r) { const int t = r0 + r; const float v = p.x[(size_t)t * DM + c] + a[r]; p.out[(size_t)t * DM + c] = v; ((h16*)(p.ws + WS_V))[(size_t)t * DM + c] = (h16)v;
        atomicAdd((float*)(p.ws + OFF_SS1) + t, v * v); }
}
__global__ void nk_q(Ptrs p) {
    const int c = blockIdx.x * 256 + threadIdx.x, r0 = blockIdx.y * 8;
    float a[8];
#pragma unroll
    for (int r = 0; r < 8; ++r) a[r] = 0.f;
    for (int k = 0; k < DM; ++k) { const float w = p.w_xq[(size_t)k * DM + c] * p.norm_x_g[k];
#pragma unroll
        for (int r = 0; r < 8; ++r) a[r] += p.out[(size_t)(r0 + r) * DM + k] * w; }
    const float* ss1 = (const float*)(p.ws + OFF_SS1);
#pragma unroll
    for (int r = 0; r < 8; ++r) { const int t = r0 + r; ((h16*)(p.ws + WS_XH))[(size_t)t * DM + c] = (h16)(a[r] * rsqrtf(ss1[t] / DM + EPS) * 0.0625f); }
}
__global__ void nk_kv(Ptrs p) {
    const int c = blockIdx.x * 256 + threadIdx.x, r0 = blockIdx.y * 8;
    float a[8];
#pragma unroll
    for (int r = 0; r < 8; ++r) a[r] = 0.f;
    for (int k = 0; k < DM; ++k) { const float w = p.w_xkv[(size_t)k * 2048 + c] * p.norm_mem_g[k];
#pragma unroll
        for (int r = 0; r < 8; ++r) a[r] += p.mem[(size_t)(r0 + r) * DM + k] * w; }
    const float* rm = (const float*)(p.ws + OFF_RSTDM);
#pragma unroll
    for (int r = 0; r < 8; ++r) { const int m = r0 + r; const float v = a[r] * rm[m];
        if (c < 1024) ((h16*)(p.ws + WS_KM))[(size_t)m * DM + c] = (h16)v;
        else ((h16*)(p.ws + WS_VTM))[(size_t)m * DM + (c - 1024)] = (h16)v; }
}
__global__ void nk_attn(Ptrs p) {
    const int t = blockIdx.x >> 2, hd = blockIdx.x & 3, b = t / SEQ, j = threadIdx.x;
    const h16* q = (const h16*)(p.ws + WS_XH) + (size_t)t * DM + hd * DH;
    const h16* K = (const h16*)(p.ws + WS_KM) + (size_t)(b * 256 + j) * DM + hd * DH;
    __shared__ float sp[256], red[8];
    float s = 0.f;
    for (int d = 0; d < DH; ++d) s += (float)q[d] * (float)K[d];
    float mx = wave_max(s); if ((j & 63) == 0) red[j >> 6] = mx; __syncthreads();
    mx = fmaxf(fmaxf(red[0], red[1]), fmaxf(red[2], red[3]));
    const float e = __expf(s - mx); sp[j] = e;
    float sm = wave_sum(e); if ((j & 63) == 0) red[4 + (j >> 6)] = sm; __syncthreads();
    sm = red[4] + red[5] + red[6] + red[7];
    const h16* VT = (const h16*)(p.ws + WS_VTM) + (size_t)(b * 256) * DM + hd * DH + j;
    float o = 0.f;
    for (int key = 0; key < 256; ++key) o += sp[key] * (float)VT[(size_t)key * DM];
    ((h16*)(p.ws + WS_OG))[(size_t)t * DM + hd * DH + j] = (h16)(o / sm);
}
__global__ void nk_wxo(Ptrs p) {
    const int c = blockIdx.x * 256 + threadIdx.x, r0 = blockIdx.y * 8;
    const h16* A = (const h16*)(p.ws + WS_OG);
    float a[8];
#pragma unroll
    for (int r = 0; r < 8; ++r) a[r] = 0.f;
    for (int k = 0; k < DM; ++k) { const float w = p.w_xo[(size_t)k * DM + c];
#pragma unroll
        for (int r = 0; r < 8; ++r) a[r] += (float)A[(size_t)(r0 + r) * DM + k] * w; }
#pragma unroll
    for (int r = 0; r < 8; ++r) { const int t = r0 + r; const float v = p.out[(size_t)t * DM + c] + a[r]; p.out[(size_t)t * DM + c] = v; ((h16*)(p.ws + WS_V))[(size_t)t * DM + c] = (h16)v;
        atomicAdd((float*)(p.ws + OFF_SS2) + t, v * v); }
}
__global__ void nk_router(Ptrs p) {
    const int t = blockIdx.x * 4 + (threadIdx.x >> 6), lane = threadIdx.x & 63;
    const float* xr = p.out + (size_t)t * DM; const float rs = rsqrtf(((const float*)(p.ws + OFF_SS2))[t] / DM + EPS);
    float acc[36];
#pragma unroll
    for (int j = 0; j < 36; ++j) acc[j] = 0.f;
    for (int k = lane; k < DM; k += 64) { const float v = xr[k] * rs * p.norm_moe_g[k];
#pragma unroll
        for (int j = 0; j < 4; ++j) acc[j] += v * p.w_rg[k * 4 + j];
#pragma unroll
        for (int j = 0; j < 32; ++j) acc[4 + j] += v * p.w_re[k * 32 + j]; }
#pragma unroll
    for (int j = 0; j < 36; ++j) acc[j] = wave_sum(acc[j]);
    if (lane == 0) {
        float gl[4]; int gi = 0;
#pragma unroll
        for (int j = 0; j < 4; ++j) gl[j] = acc[j] + p.b_rg[j];
        float gm = gl[0];
#pragma unroll
        for (int j = 1; j < 4; ++j) if (gl[j] > gm) { gm = gl[j]; gi = j; }
        float gs = 0.f;
#pragma unroll
        for (int j = 0; j < 4; ++j) gs += __expf(gl[j] - gm);
        float ev[8];
#pragma unroll
        for (int j = 0; j < 8; ++j) { float v = acc[4 + j] + p.b_re[j];
#pragma unroll
            for (int g = 1; g < 4; ++g) v = (gi == g) ? acc[4 + g * 8 + j] + p.b_re[g * 8 + j] : v;
            ev[j] = v; }
        float pg = 0.f;
#pragma unroll
        for (int j = 0; j < 4; ++j) pg = (gi == j) ? __expf(gl[j] - gm) / gs : pg;
        int i1 = 0; float v1 = ev[0];
#pragma unroll
        for (int j = 1; j < 8; ++j) if (ev[j] > v1) { v1 = ev[j]; i1 = j; }
        int i2 = -1; float v2 = -INFINITY;
#pragma unroll
        for (int j = 0; j < 8; ++j) if (j != i1 && ev[j] > v2) { v2 = ev[j]; i2 = j; }
        const float e2 = __expf(v2 - v1), g1 = pg / (1.f + e2), g2 = pg * e2 / (1.f + e2);
        unsigned* cnt = (unsigned*)(p.ws + WS_CTL) + CW_CNT;
        int* list = (int*)(p.ws + OFF_LIST); float* gate = (float*)(p.ws + OFF_GATE); int* se = (int*)(p.ws + OFF_SLOTE); int* sp = (int*)(p.ws + OFF_SLOTP);
        const int e1x = gi * 8 + i1, e2x = gi * 8 + i2;
        const unsigned p1 = atomicAdd(cnt + e1x, 1u); list[e1x * NTOK + p1] = t * 2; gate[t * 2] = g1; se[t * 2] = e1x; sp[t * 2] = (int)p1;
        const unsigned p2 = atomicAdd(cnt + e2x, 1u); list[e2x * NTOK + p2] = t * 2 + 1; gate[t * 2 + 1] = g2; se[t * 2 + 1] = e2x; sp[t * 2 + 1] = (int)p2;
    }
}
__device__ __forceinline__ int moe_pstart(const unsigned* cnt, int e) { int s = 0; for (int i = 0; i < e; ++i) s += (int)((cnt[i] + 255u) & ~255u); return s; }
__global__ void nk_ffn1(Ptrs p) {
    const int f = blockIdx.x * 256 + threadIdx.x, s0 = blockIdx.y * 8;
    const unsigned* cnt = (const unsigned*)(p.ws + WS_CTL) + CW_CNT; const int* se = (const int*)(p.ws + OFF_SLOTE); const int* sp = (const int*)(p.ws + OFF_SLOTP);
    const float* ss2 = (const float*)(p.ws + OFF_SS2);
    for (int r = 0; r < 8; ++r) { const int slot = s0 + r, tok = slot >> 1, e = se[slot];
        const float* xr = p.out + (size_t)tok * DM; float a1 = 0.f, a3 = 0.f;
        const float* W1 = p.w1 + (size_t)e * DM * FF; const float* W3 = p.w3 + (size_t)e * DM * FF;
        for (int k = 0; k < DM; ++k) { const float v = xr[k] * p.norm_moe_g[k]; a1 += v * W1[(size_t)k * FF + f]; a3 += v * W3[(size_t)k * FF + f]; }
        const float rs = rsqrtf(ss2[tok] / DM + EPS); a1 *= rs; a3 *= rs;
        const int prow = moe_pstart(cnt, e) + sp[slot];
        ((h16*)(p.ws + WS_H))[(size_t)prow * FF + f] = (h16)(siluf_(a1) * a3); }
}
__global__ void nk_ffn2(Ptrs p) {
    const int c = blockIdx.x * 256 + threadIdx.x, s0 = blockIdx.y * 8;
    const unsigned* cnt = (const unsigned*)(p.ws + WS_CTL) + CW_CNT; const int* se = (const int*)(p.ws + OFF_SLOTE); const int* sp = (const int*)(p.ws + OFF_SLOTP);
    const float* gate = (const float*)(p.ws + OFF_GATE);
    for (int r = 0; r < 8; ++r) { const int slot = s0 + r, e = se[slot]; const int prow = moe_pstart(cnt, e) + sp[slot];
        const h16* hr = (const h16*)(p.ws + WS_H) + (size_t)prow * FF; const float* W2 = p.w2 + (size_t)e * FF * DM; float a = 0.f;
        for (int k = 0; k < FF; ++k) a += (float)hr[k] * W2[(size_t)k * DM + c];
        ((h16*)(p.ws + WS_Y))[(size_t)slot * DM + c] = (h16)(a * gate[slot]); }
}
__global__ void nk_final(Ptrs p) {
    const int t = blockIdx.x * 4 + (threadIdx.x >> 6), lane = threadIdx.x & 63;
    float* xr = p.out + (size_t)t * DM; const h16* y0 = (const h16*)(p.ws + WS_Y) + (size_t)(2 * t) * DM; const h16* y1 = y0 + DM;
    float v[16]; float ss = 0.f;
#pragma unroll
    for (int j = 0; j < 16; ++j) { const int k = lane + 64 * j; v[j] = xr[k] + (float)y0[k] + (float)y1[k]; ss += v[j] * v[j]; }
    ss = wave_sum(ss); const float rs = rsqrtf(ss / DM + EPS);
#pragma unroll
    for (int j = 0; j < 16; ++j) { const int k = lane + 64 * j; xr[k] = v[j] * rs * p.norm_f_g[k]; }
}

#define LAS __attribute__((address_space(3)))
#define GAS __attribute__((address_space(1)))
typedef _Float16 h16x8 __attribute__((ext_vector_type(8)));
typedef _Float16 h16x4 __attribute__((ext_vector_type(4)));
typedef _Float16 h16x2 __attribute__((ext_vector_type(2)));
typedef float f32x4 __attribute__((ext_vector_type(4)));
typedef float f32x2 __attribute__((ext_vector_type(2)));
typedef unsigned u32x4 __attribute__((ext_vector_type(4)));
typedef unsigned u32x2 __attribute__((ext_vector_type(2)));
typedef GAS unsigned gu32;
#define RLX_AGENT __ATOMIC_RELAXED, __HIP_MEMORY_SCOPE_AGENT
#define LDS_WAIT() asm volatile("s_waitcnt lgkmcnt(0)" ::: "memory")
#define VM_WAIT() asm volatile("s_waitcnt vmcnt(0)" ::: "memory")
__device__ __forceinline__ unsigned pk_h2(float lo, float hi) { f32x2 v = {lo, hi}; return __builtin_bit_cast(unsigned, __builtin_convertvector(v, h16x2)); }
__device__ __forceinline__ u32x4 pk_h8(f32x4 a, f32x4 b) { u32x4 w; w.x = pk_h2(a[0], a[1]); w.y = pk_h2(a[2], a[3]); w.z = pk_h2(b[0], b[1]); w.w = pk_h2(b[2], b[3]); return w; }
__device__ __forceinline__ float fsigmoid(float v) { return __builtin_amdgcn_rcpf(1.f + __expf(-v)); }
__device__ __forceinline__ float fgelu(float v) { const float u = 1.5957691216057308f * (v + 0.044715f * v * v * v); return v * __builtin_amdgcn_rcpf(1.f + __expf(-u)); }
__device__ __forceinline__ float fsilu(float v) { return v * __builtin_amdgcn_rcpf(1.f + __expf(-v)); }

constexpr int NWAVES = 8, NTHREADS = 512;
constexpr int RING_BYTES = 143360, LDSCTL_OFF = RING_BYTES, MISC_OFF = LDSCTL_OFF + 320, LDS_BYTES = 147456;
constexpr int CW_TMO = 0, CW_BAR = 4096;

#define XB_TMO      128
#define XB_XCNT(j)  (256  + 64 * (j))
#define XB_XSUB(j)  (1280 + 64 * (j))
#define XB_XGEN(j)  (2304 + 64 * (j))
#define XB_TOP      3328
#define XB_TOPGEN   3392
#define XCD_BAR_WORDS 3456
#define XB_SPIN_CAP (1u << 20)
__device__ __forceinline__ unsigned xb_ld(unsigned* p)              { return __hip_atomic_load(p, __ATOMIC_RELAXED, __HIP_MEMORY_SCOPE_AGENT); }
__device__ __forceinline__ unsigned xb_add(unsigned* p, unsigned v) { return __hip_atomic_fetch_add(p, v, __ATOMIC_RELAXED, __HIP_MEMORY_SCOPE_AGENT); }
__device__ __forceinline__ unsigned xb_xcc_id() { return (unsigned)__builtin_amdgcn_s_getreg((3 << 11) | 20) & 0xFu; }
#define XB_SPIN(cond, bar) do { unsigned _sp = 0; while (cond) { __builtin_amdgcn_s_sleep(1); \
    if ((++_sp & 255u) == 0u) { if (xb_ld(&(bar)[XB_TMO])) break; if (_sp > XB_SPIN_CAP) { atomicAdd(&(bar)[XB_TMO], 1u); break; } } } } while (0)
struct XcdBarrier { unsigned* bar; unsigned x; volatile LAS unsigned* st; };
__device__ __forceinline__ XcdBarrier xcd_barrier_post(unsigned* bar, volatile LAS unsigned* st) {
    XcdBarrier b; b.bar = bar; b.x = xb_xcc_id(); b.st = st;
    if (threadIdx.x == 0) (void)xb_add(&bar[XB_XCNT(b.x)], 1u);
    return b;
}
__device__ __forceinline__ void xcd_barrier_complete(unsigned* bar, unsigned x, unsigned& nloc, unsigned& nx) {
    const unsigned G = gridDim.x * gridDim.y * gridDim.z;
    unsigned sum, cnt, mine, sp = 0u;
    for (;;) {
        sum = 0u; cnt = 0u; mine = 0u;
#pragma unroll
        for (unsigned j = 0; j < 16; ++j) { const unsigned c = xb_ld(&bar[XB_XCNT(j)]); sum += c; cnt += (c > 0u) ? 1u : 0u; mine = (j == x) ? c : mine; }
        if (sum == G) break;
        __builtin_amdgcn_s_sleep(1);
        if ((++sp & 255u) == 0u) { if (xb_ld(&bar[XB_TMO])) break; if (sp > XB_SPIN_CAP) { atomicAdd(&bar[XB_TMO], 1u); break; } }
    }
    nloc = mine > 0u ? mine : 1u; nx = cnt > 0u ? cnt : 1u;
}
__device__ __forceinline__ void xcd_barrier(const XcdBarrier& b) {
    asm volatile("s_waitcnt vmcnt(0)" ::: "memory");
    __syncthreads();
    if (threadIdx.x == 0) {
        unsigned* bar = b.bar;
        __builtin_amdgcn_s_waitcnt(0);
        unsigned nloc = b.st[0], nx = b.st[1];
        if (nloc == 0u) { xcd_barrier_complete(bar, b.x, nloc, nx); b.st[0] = nloc; b.st[1] = nx; }
        const unsigned old = xb_add(&bar[XB_XSUB(b.x)], 1u);
        const unsigned gen = old / nloc;
        if (old + 1u == (gen + 1u) * nloc) {
            __builtin_amdgcn_fence(__ATOMIC_RELEASE, "agent");
            asm volatile("s_waitcnt vmcnt(0)" ::: "memory");
            const unsigned og = xb_add(&bar[XB_TOP], 1u);
            const unsigned tg = og / nx;
            if (og + 1u == (tg + 1u) * nx) xb_add(&bar[XB_TOPGEN], 1u);
            else XB_SPIN(xb_ld(&bar[XB_TOPGEN]) == tg, bar);
            __builtin_amdgcn_fence(__ATOMIC_ACQUIRE, "agent");
            xb_add(&bar[XB_XGEN(b.x)], 1u);
            asm volatile("s_waitcnt vmcnt(0)" ::: "memory");
        } else {
            XB_SPIN(xb_ld(&bar[XB_XGEN(b.x)]) == gen, bar);
            __builtin_amdgcn_fence(__ATOMIC_ACQUIRE, "agent");
            asm volatile("s_waitcnt vmcnt(0)" ::: "memory");
        }
    }
    __syncthreads();
}

namespace pg8 {
constexpr int BM = 256, BK = 64, HALF = 128, HTB = HALF * BK * 2, STAGE_BYTES = 8 * HTB, NXCD = 8, WGM = 8;
__host__ __device__ __forceinline__ int lds_byte(int r, int c) { const int st = (r >> 4) * 2 + (c >> 5), rr = r & 15, cc = c & 31, ob = rr * 64 + cc * 2; return st * 1024 + (ob ^ (((ob >> 9) & 1) << 5)); }
__host__ __device__ __forceinline__ void stage_rc(int b, int& R, int& C) { const int st = b / 1024, sb = b % 1024, swz = sb ^ (((sb >> 9) & 1) << 5); R = (st >> 1) * 16 + swz / 64; C = (st & 1) * 32 + (swz % 64) / 2; }
__host__ __device__ __forceinline__ int perm32(int rho) { const int n = rho >> 4, i = rho & 15; return 8 * (i >> 2) + 4 * n + (i & 3); }
struct Unit { int pm, pn, e, nv, rb; };
struct StaticOrder {
    const char* A; const char* Bt; int K; int nM, nN, nwg, G, c;
    __device__ __forceinline__ void init(const void* A_, const void* Bt_, int M, int N, int K_, int G_, int c_) { A = (const char*)A_; Bt = (const char*)Bt_; K = K_; nM = M / BM; nN = N / BM; nwg = nM * nN; G = G_; c = c_; }
    __device__ __forceinline__ bool next(int i, Unit& u) const {
        const long L = (long)i * G + c; if (L >= nwg) return false;
        int wgid = (int)L; { const int q = nwg / NXCD, r = nwg % NXCD, xcd = wgid % NXCD, off = wgid / NXCD; wgid = (xcd < r ? xcd * (q + 1) : r * (q + 1) + (xcd - r) * q) + off; }
        const int nig = WGM * nN, gid = wgid / nig, fm = gid * WGM, gsz = (nM - fm) < WGM ? (nM - fm) : WGM;
        u.pm = fm + ((wgid % nig) % gsz); u.pn = (wgid % nig) / gsz; u.e = 0; u.nv = 256; u.rb = 0; return true;
    }
    __device__ __forceinline__ const char* a_base(const Unit& u) const { return A + (size_t)u.pm * (size_t)(BM * 2) * K; }
    __device__ __forceinline__ const char* b_base(const Unit& u) const { return Bt + (size_t)u.pn * (size_t)(BM * 2) * K; }
    __device__ __forceinline__ const char* g_base() const { return A; }
    __device__ __forceinline__ unsigned a_off(const Unit& u, int h, int R) const { return 0u; }
};

template <class Epi, class Sched, bool GATHER, bool ALIGN_EPI>
__device__ __forceinline__ void gemm_phase(LAS unsigned char* lds, const int K, const Sched& S, const Epi& E) {
    int tid = threadIdx.x; asm volatile("" : "+v"(tid));
    const int wid = __builtin_amdgcn_readfirstlane(tid >> 6), lane = tid & 63, wr = wid >> 2, wc = wid & 3, fr = lane & 15, fq = lane >> 4;
    const int nt = K / BK;
    unsigned voffA[2], voffB[2]; int Rst[2], Cst2[2];
#pragma unroll
    for (int i = 0; i < 2; ++i) { int R, C; stage_rc(tid * 16 + i * 8192, R, C); const int Rb = Epi::PERM ? ((R & ~31) + perm32(R & 31)) : R;
        voffA[i] = (unsigned)(R * K + C) * 2u; voffB[i] = (unsigned)(Rb * K + C) * 2u; Rst[i] = R; Cst2[i] = C * 2; }
    const size_t kstep = (size_t)(BK * 2);
    const size_t hstep = (size_t)HALF * K * 2;
    const unsigned ldsw = (unsigned)wid * 1024u;
    const int aoff = lds_byte(wr * 64 + fr, fq * 8), boff = lds_byte(wc * 32 + fr, fq * 8);
    const char* const gA = S.g_base();
#define PG8_SA(b, h) (((b) * 2 + (h)) * HTB)
#define PG8_SB(b, h) ((4 + (b) * 2 + (h)) * HTB)
#define PG8_GLDS(src, bufoff, i_) __builtin_amdgcn_global_load_lds((const unsigned*)(src), (LAS unsigned*)(lds + (bufoff) + ldsw + (i_) * 8192), 16, 0, 0)
#define PG8_STAGE_B(bufoff, gbase) do { _Pragma("unroll") for (int _i = 0; _i < 2; ++_i) PG8_GLDS((const char*)(gbase) + voffB[_i], bufoff, _i); } while (0)
#define PG8_STAGE_A(bufoff, pa, offs, h_, kb) do { _Pragma("unroll") for (int _i = 0; _i < 2; ++_i) { \
        if constexpr (GATHER) PG8_GLDS(gA + (size_t)((offs)[h_][_i] + (unsigned)(kb)), bufoff, _i); else PG8_GLDS((const char*)(pa) + (h_) * hstep + voffA[_i], bufoff, _i); } } while (0)
#define PG8_LDA(dst, b, h) do { _Pragma("unroll") for (int m = 0; m < 4; ++m) _Pragma("unroll") for (int k = 0; k < 2; ++k) dst[m][k] = *(const LAS h16x8*)(lds + PG8_SA(b, h) + aoff + m * 2048 + k * 1024); } while (0)
#define PG8_LDB(dst, b, h) do { _Pragma("unroll") for (int n = 0; n < 2; ++n) _Pragma("unroll") for (int k = 0; k < 2; ++k) dst[n][k] = *(const LAS h16x8*)(lds + PG8_SB(b, h) + boff + n * 2048 + k * 1024); } while (0)
#define PG8_MMA(ai, bj, At, Bt) do { __builtin_amdgcn_s_setprio(1); _Pragma("unroll") for (int m = 0; m < 4; ++m) _Pragma("unroll") for (int n = 0; n < 2; ++n) _Pragma("unroll") for (int k = 0; k < 2; ++k) \
        acc[ai][bj][m][n] = __builtin_amdgcn_mfma_f32_16x16x32_f16(Bt[n][k], At[m][k], acc[ai][bj][m][n], 0, 0, 0); __builtin_amdgcn_s_setprio(0); } while (0)
#define PG8_WAIT_V(n) asm volatile("s_waitcnt vmcnt(" #n ")" ::: "memory")
#define PG8_WAIT_L(n) asm volatile("s_waitcnt lgkmcnt(" #n ")" ::: "memory")
#define PG8_BAR __builtin_amdgcn_s_barrier()
#define PG8_SCHED __builtin_amdgcn_sched_barrier(0)
    Unit cur, nxt; int ui = 0;
    if (!S.next(0, cur)) return;
    f32x4 acc[2][2][4][2];
#pragma unroll
    for (int a = 0; a < 2; ++a)
#pragma unroll
        for (int b = 0; b < 2; ++b)
#pragma unroll
            for (int m = 0; m < 4; ++m)
#pragma unroll
                for (int n = 0; n < 2; ++n) acc[a][b][m][n] = (f32x4){0.f, 0.f, 0.f, 0.f};
    h16x8 At[4][2], B0[2][2], B1[2][2];
    const char* cA = S.a_base(cur); const char* cB = S.b_base(cur);
    unsigned aoc[2][2], aon[2][2], ao2[2][2];
    if constexpr (GATHER) {
#pragma unroll
        for (int h = 0; h < 2; ++h)
#pragma unroll
            for (int i = 0; i < 2; ++i) { aoc[h][i] = S.a_off(cur, h, Rst[i]) + (unsigned)Cst2[i]; aon[h][i] = aoc[h][i]; ao2[h][i] = aoc[h][i]; }
    }
    PG8_STAGE_B(PG8_SB(0, 0), cB); PG8_STAGE_B(PG8_SB(0, 1), cB + hstep); PG8_STAGE_A(PG8_SA(0, 0), cA, aoc, 0, 0); PG8_STAGE_A(PG8_SA(0, 1), cA, aoc, 1, 0);
    if (wr == 1) PG8_BAR;
    PG8_WAIT_V(2); PG8_BAR;
    PG8_STAGE_B(PG8_SB(1, 0), cB + kstep); PG8_STAGE_A(PG8_SA(1, 0), cA + kstep, aoc, 0, kstep); PG8_STAGE_B(PG8_SB(1, 1), cB + hstep + kstep);
    PG8_WAIT_V(6); PG8_BAR;
    for (;;) {
        const bool has_next = S.next(ui + 1, nxt);
        const char* nA = has_next ? S.a_base(nxt) : cA; const char* nB = has_next ? S.b_base(nxt) : cB;
        if constexpr (GATHER) {
#pragma unroll
            for (int h = 0; h < 2; ++h)
#pragma unroll
                for (int i = 0; i < 2; ++i) aon[h][i] = has_next ? S.a_off(nxt, h, Rst[i]) + (unsigned)Cst2[i] : aoc[h][i];
        }
        for (int t = 0; t < nt; t += 2) {
            const bool last = (t == nt - 2);
            const char* a1 = cA + (size_t)(t + 1) * kstep;
            const char* a2 = last ? nA : cA + (size_t)(t + 2) * kstep; const char* b2 = last ? nB : cB + (size_t)(t + 2) * kstep;
            const char* a3 = a2 + kstep; const char* b3 = b2 + kstep;
            if constexpr (GATHER) {
#pragma unroll
                for (int h = 0; h < 2; ++h)
#pragma unroll
                    for (int i = 0; i < 2; ++i) ao2[h][i] = last ? aon[h][i] : aoc[h][i] + (unsigned)((t + 2) * (int)kstep);
            }
            PG8_LDB(B0, 0, 0); PG8_LDB(B1, 0, 1); PG8_SCHED; PG8_LDA(At, 0, 0); PG8_STAGE_A(PG8_SA(1, 1), a1, aoc, 1, (t + 1) * (int)kstep);
            PG8_WAIT_V(8); PG8_WAIT_L(0); PG8_BAR; PG8_MMA(0, 0, At, B0); PG8_MMA(0, 1, At, B1); PG8_BAR; PG8_SCHED;
            PG8_LDA(At, 0, 1); PG8_STAGE_B(PG8_SB(0, 0), b2); PG8_STAGE_B(PG8_SB(0, 1), b2 + hstep); PG8_STAGE_A(PG8_SA(0, 0), a2, ao2, 0, 0);
            PG8_WAIT_V(8); PG8_WAIT_L(0); PG8_BAR; PG8_MMA(1, 0, At, B0); PG8_MMA(1, 1, At, B1); PG8_BAR; PG8_SCHED;
            PG8_LDB(B0, 1, 0); PG8_LDB(B1, 1, 1); PG8_SCHED; PG8_LDA(At, 1, 0); PG8_STAGE_A(PG8_SA(0, 1), a2, ao2, 1, 0);
            PG8_WAIT_V(8); PG8_WAIT_L(0); PG8_BAR; PG8_MMA(0, 0, At, B0); PG8_MMA(0, 1, At, B1); PG8_BAR; PG8_SCHED;
            PG8_LDA(At, 1, 1); PG8_STAGE_B(PG8_SB(1, 0), b3); PG8_STAGE_B(PG8_SB(1, 1), b3 + hstep); PG8_STAGE_A(PG8_SA(1, 0), a3, ao2, 0, kstep);
            PG8_WAIT_V(8); PG8_WAIT_L(0); PG8_BAR; PG8_MMA(1, 0, At, B0); PG8_MMA(1, 1, At, B1); PG8_BAR; PG8_SCHED;
        }
        if constexpr (ALIGN_EPI) { if (wr == 0) PG8_BAR; }
        E(acc, cur, wr, wc, fr, fq);
        if (!has_next) break;
#pragma unroll
        for (int a = 0; a < 2; ++a)
#pragma unroll
            for (int b = 0; b < 2; ++b)
#pragma unroll
                for (int m = 0; m < 4; ++m)
#pragma unroll
                    for (int n = 0; n < 2; ++n) acc[a][b][m][n] = (f32x4){0.f, 0.f, 0.f, 0.f};
        cur = nxt; cA = nA; cB = nB; ++ui;
        if constexpr (GATHER) {
#pragma unroll
            for (int h = 0; h < 2; ++h)
#pragma unroll
                for (int i = 0; i < 2; ++i) aoc[h][i] = aon[h][i];
        }
        if constexpr (ALIGN_EPI) { if (wr == 1) PG8_BAR; }
    }
    PG8_WAIT_V(0);
    if constexpr (!ALIGN_EPI) { if (wr == 0) PG8_BAR; }
    PG8_BAR;
#undef PG8_SA
#undef PG8_SB
#undef PG8_GLDS
#undef PG8_STAGE_A
#undef PG8_STAGE_B
#undef PG8_LDA
#undef PG8_LDB
#undef PG8_MMA
#undef PG8_WAIT_V
#undef PG8_WAIT_L
#undef PG8_BAR
#undef PG8_SCHED
}
}
using pg8::Unit;
struct EpiProj {
    static constexpr bool PERM = true;
    const float* rstd0; const float* b_gate; h16* QK; h16* V; h16* OG; h16* UG; h16* SV; float* sssv; bool doat;
    __device__ __forceinline__ void operator()(const f32x4 (&acc)[2][2][4][2], const Unit& u, int wr, int wc, int fr, int fq) const {
        const int row0 = u.pm * 256 + wr * 64 + fr, cw = wc * 32 + 8 * fq, pn = u.pn;
        if (pn < 12) {
            h16* base; int ld, col;
            if (pn < 8) { base = QK; ld = 2048; col = pn * 256; } else { base = V; ld = 1024; col = (pn - 8) * 256; }
#pragma unroll
            for (int ai = 0; ai < 2; ++ai)
#pragma unroll
                for (int m = 0; m < 4; ++m) { const int row = row0 + ai * 128 + m * 16; const float rs = rstd0[row]; h16* rp = base + (size_t)row * ld + col + cw;
#pragma unroll
                    for (int bj = 0; bj < 2; ++bj) *(u32x4*)(rp + bj * 128) = pk_h8(acc[ai][bj][m][0] * rs, acc[ai][bj][m][1] * rs); }
        } else if (pn < 28) {
            const bool isO = pn < 20; h16* base = isO ? OG : UG; const int c0 = (isO ? pn - 12 : pn - 20) * 128 + cw; const float* bg = b_gate + (isO ? 0 : 1024) + c0;
            const f32x4 b0 = *(const f32x4*)bg, b1 = *(const f32x4*)(bg + 4);
#pragma unroll
            for (int ai = 0; ai < 2; ++ai)
#pragma unroll
                for (int m = 0; m < 4; ++m) { const int row = row0 + ai * 128 + m * 16; const float rs = rstd0[row];
                    f32x4 a0 = acc[ai][0][m][0] * rs, a1 = acc[ai][0][m][1] * rs; const f32x4 g0 = acc[ai][1][m][0] * rs + b0, g1 = acc[ai][1][m][1] * rs + b1;
                    if (isO) {
#pragma unroll
                        for (int j = 0; j < 4; ++j) { a0[j] = fsigmoid(a0[j]) * fsigmoid(g0[j]); a1[j] = fsigmoid(a1[j]) * fsigmoid(g1[j]); }
                    } else {
#pragma unroll
                        for (int j = 0; j < 4; ++j) { a0[j] = fgelu(a0[j]) * fsigmoid(g0[j]); a1[j] = fgelu(a1[j]) * fsigmoid(g1[j]); }
                    }
                    *(u32x4*)(base + (size_t)row * 1024 + c0) = pk_h8(a0, a1); }
        } else {
            const int col = (pn - 28) * 256 + cw;
#pragma unroll
            for (int ai = 0; ai < 2; ++ai)
#pragma unroll
                for (int m = 0; m < 4; ++m) { const int row = row0 + ai * 128 + m * 16; const float rs = rstd0[row]; float sum = 0.f;
#pragma unroll
                    for (int bj = 0; bj < 2; ++bj) { f32x4 a0 = acc[ai][bj][m][0] * rs, a1 = acc[ai][bj][m][1] * rs;
#pragma unroll
                        for (int j = 0; j < 4; ++j) { a0[j] = fgelu(a0[j]); a1[j] = fgelu(a1[j]); sum += a0[j] * a0[j] + a1[j] * a1[j]; }
                        *(u32x4*)(SV + (size_t)row * 1024 + col + bj * 128) = pk_h8(a0, a1); }
                    sum += __shfl_xor(sum, 16); sum += __shfl_xor(sum, 32);
                    if (fq == 0 && doat) atomicAdd(sssv + row, sum); }
        }
    }
};
struct EpiKV {
    static constexpr bool PERM = true;
    const float* rstdm; h16* KM; h16* VM;
    __device__ __forceinline__ void operator()(const f32x4 (&acc)[2][2][4][2], const Unit& u, int wr, int wc, int fr, int fq) const {
        const int row0 = u.pm * 256 + wr * 64 + fr, cw = wc * 32 + 8 * fq, pn = u.pn; h16* base = (pn < 4) ? KM + pn * 256 : VM + (pn - 4) * 256;
#pragma unroll
        for (int ai = 0; ai < 2; ++ai)
#pragma unroll
            for (int m = 0; m < 4; ++m) { const int row = row0 + ai * 128 + m * 16; const float rs = rstdm[row];
#pragma unroll
                for (int bj = 0; bj < 2; ++bj) *(u32x4*)(base + (size_t)row * 1024 + bj * 128 + cw) = pk_h8(acc[ai][bj][m][0] * rs, acc[ai][bj][m][1] * rs); }
    }
};
struct EpiResid {
    static constexpr bool PERM = false;
    const float* resid; float* out; h16* outh; float* ss; bool doat;
    __device__ __forceinline__ void operator()(const f32x4 (&acc)[2][2][4][2], const Unit& u, int wr, int wc, int fr, int fq) const {
        const int row0 = u.pm * 256 + wr * 64 + fr, col0 = u.pn * 256 + wc * 32 + 4 * fq;
#pragma unroll
        for (int ai = 0; ai < 2; ++ai)
#pragma unroll
            for (int m = 0; m < 4; ++m) { const int row = row0 + ai * 128 + m * 16; const size_t off = (size_t)row * DM + col0; float sum = 0.f;
#pragma unroll
                for (int bj = 0; bj < 2; ++bj)
#pragma unroll
                    for (int n = 0; n < 2; ++n) { const size_t o = off + bj * 128 + n * 16; const f32x4 v = *(const f32x4*)(resid + o) + acc[ai][bj][m][n];
                        *(f32x4*)(out + o) = v; u32x2 w; w.x = pk_h2(v[0], v[1]); w.y = pk_h2(v[2], v[3]); *(u32x2*)(outh + o) = w;
                        sum += (v[0] * v[0] + v[1] * v[1]) + (v[2] * v[2] + v[3] * v[3]); }
                sum += __shfl_xor(sum, 16); sum += __shfl_xor(sum, 32);
                if (fq == 0 && doat) atomicAdd(ss + row, sum); }
    }
};
struct EpiQ {
    static constexpr bool PERM = true;
    const float* ss1; h16* Q;
    __device__ __forceinline__ void operator()(const f32x4 (&acc)[2][2][4][2], const Unit& u, int wr, int wc, int fr, int fq) const {
        const int row0 = u.pm * 256 + wr * 64 + fr, col0 = u.pn * 256 + wc * 32 + 8 * fq;
#pragma unroll
        for (int ai = 0; ai < 2; ++ai)
#pragma unroll
            for (int m = 0; m < 4; ++m) { const int row = row0 + ai * 128 + m * 16; const float rs = rsqrtf(ss1[row] * (1.f / DM) + EPS) * 0.0625f;
#pragma unroll
                for (int bj = 0; bj < 2; ++bj) *(u32x4*)(Q + (size_t)row * DM + col0 + bj * 128) = pk_h8(acc[ai][bj][m][0] * rs, acc[ai][bj][m][1] * rs); }
    }
};
struct MoeOrder {
    const char* A; const char* Bt; int K; size_t bexp; const int* list; const unsigned* cnt; const LAS int* tab; int G, c;
    __device__ __forceinline__ bool next(int i, Unit& u) const {
        const int L = i * G + c; const int total = tab[32] * 4; if (L >= total) return false;
        const int rbg = L >> 2; int e = 0;
#pragma unroll 1
        for (int j = 1; j < 32; ++j) e = (tab[j] <= rbg) ? j : e;
        u.pm = rbg; u.pn = L & 3; u.e = e; const int rb = rbg - tab[e]; u.rb = rb; const int left = (int)__hip_atomic_load(cnt + e, __ATOMIC_RELAXED, __HIP_MEMORY_SCOPE_AGENT) - rb * 256; u.nv = left < 256 ? left : 256; return true;
    }
    __device__ __forceinline__ const char* a_base(const Unit& u) const { return A + (size_t)u.pm * (size_t)(256 * 2) * K; }
    __device__ __forceinline__ const char* b_base(const Unit& u) const { return Bt + (size_t)u.e * bexp + (size_t)u.pn * (size_t)(256 * 2) * K; }
    __device__ __forceinline__ const char* g_base() const { return A; }
    __device__ __forceinline__ unsigned a_off(const Unit& u, int h, int R) const { const int r = h * 128 + R; const int tok = (r < u.nv) ? (list[u.e * NTOK + u.rb * 256 + r] >> 1) : 0; return (unsigned)tok * (unsigned)(K * 2); }
};
struct EpiFfn1 {
    static constexpr bool PERM = true;
    const int* list; const float* ss2; h16* H;
    __device__ __forceinline__ void operator()(const f32x4 (&acc)[2][2][4][2], const Unit& u, int wr, int wc, int fr, int fq) const {
        const int r0 = wr * 64 + fr, cw = wc * 32 + 8 * fq;
#pragma unroll
        for (int ai = 0; ai < 2; ++ai)
#pragma unroll
            for (int m = 0; m < 4; ++m) { const int r = r0 + ai * 128 + m * 16; const int tok = (r < u.nv) ? (list[u.e * NTOK + u.rb * 256 + r] >> 1) : 0;
                const float rs = rsqrtf(ss2[tok] * (1.f / DM) + EPS);
                f32x4 a0 = acc[ai][0][m][0] * rs, a1 = acc[ai][0][m][1] * rs; const f32x4 b0 = acc[ai][1][m][0] * rs, b1 = acc[ai][1][m][1] * rs;
#pragma unroll
                for (int j = 0; j < 4; ++j) { a0[j] = fsilu(a0[j]) * b0[j]; a1[j] = fsilu(a1[j]) * b1[j]; }
                *(u32x4*)(H + ((size_t)u.pm * 256 + r) * FF + u.pn * 128 + cw) = pk_h8(a0, a1); }
    }
};
struct EpiFfn2 {
    static constexpr bool PERM = true;
    const int* list; const float* gate; h16* Y;
    __device__ __forceinline__ void operator()(const f32x4 (&acc)[2][2][4][2], const Unit& u, int wr, int wc, int fr, int fq) const {
        const int r0 = wr * 64 + fr, cw = u.pn * 256 + wc * 32 + 8 * fq;
#pragma unroll
        for (int ai = 0; ai < 2; ++ai)
#pragma unroll
            for (int m = 0; m < 4; ++m) { const int r = r0 + ai * 128 + m * 16;
                if (r < u.nv) { const int slot = list[u.e * NTOK + u.rb * 256 + r]; const float g = gate[slot];
#pragma unroll
                    for (int bj = 0; bj < 2; ++bj) *(u32x4*)(Y + (size_t)slot * DM + cw + bj * 128) = pk_h8(acc[ai][bj][m][0] * g, acc[ai][bj][m][1] * g); } }
    }
};


typedef short s16x4 __attribute__((ext_vector_type(4)));
__device__ __forceinline__ h16x4 tr_read4(const LAS unsigned char* p) { return __builtin_bit_cast(h16x4, __builtin_amdgcn_ds_read_tr16_b64_v4i16((LAS s16x4*)p)); }
__device__ __forceinline__ h16x8 cat8(h16x4 a, h16x4 b) { return __builtin_shufflevector(a, b, 0, 1, 2, 3, 4, 5, 6, 7); }
__device__ __forceinline__ h16x4 cvt4(f32x4 v) { return __builtin_convertvector(v, h16x4); }
__device__ __forceinline__ void glds16_asm(const void* gsrc, unsigned lds_dst) { unsigned keep;
    asm volatile("s_mov_b32 %0, m0\n\ts_mov_b32 m0, %2\n\ts_nop 0\n\tglobal_load_lds_dwordx4 %1, off\n\ts_mov_b32 m0, %0" : "=&s"(keep) : "v"(gsrc), "s"(lds_dst) : "memory"); }
#define GLDS16(src, dst) glds16_asm((const void*)(src), __builtin_amdgcn_readfirstlane((unsigned)(size_t)(dst)))
constexpr int ATT_UNITS = 512, ATT_CH = 32768;
__device__ __forceinline__ void attn_issue(LAS unsigned char* lds, const h16* KM, const h16* VM, int c, int G, int bx, int wid, int lane) {
    const int i = c >> 3, n = c & 7, L = i * G + bx, hd = L & 3, tile = L >> 2, b = tile >> 6;
    LAS unsigned char* buf = lds + (unsigned)(c % 3) * ATT_CH;
    if (n < 4) { const char* Kb = (const char*)(KM + (size_t)(b * 256) * 1024 + hd * 256) + n * 128;
#pragma unroll
        for (int q = 0; q < 4; ++q) { const int I = wid * 4 + q, row = I * 8 + (lane >> 3), slot = (lane & 7) ^ ((row >> 1) & 7); GLDS16(Kb + (size_t)row * 2048 + slot * 16, buf + I * 1024); }
    } else { const char* Vb = (const char*)(VM + (size_t)(b * 256 + 64 * (n - 4)) * 1024 + hd * 256);
#pragma unroll
        for (int q = 0; q < 4; ++q) { const int I = wid * 4 + q, row = I * 2 + (lane >> 5), ch = (lane & 31) ^ ((row & 7) << 1); GLDS16(Vb + (size_t)row * 2048 + ch * 16, buf + I * 1024); }
    }
}
__device__ __forceinline__ void attn_phase(LAS unsigned char* lds, const h16* Q, const h16* KM, const h16* VM, h16* ATT, int G, int bx) {
    int tid = threadIdx.x; asm volatile("" : "+v"(tid));
    const int wid = __builtin_amdgcn_readfirstlane(tid >> 6), lane = tid & 63, fr = lane & 15, fq = lane >> 4;
    if (bx >= ATT_UNITS) return;
    const int nun = (ATT_UNITS - bx + G - 1) / G, total = nun * 8;
    attn_issue(lds, KM, VM, 0, G, bx, wid, lane); attn_issue(lds, KM, VM, 1, G, bx, wid, lane);
    const int tq = (lane & 15) >> 2, tp = lane & 3;
    for (int i = 0; i < nun; ++i) {
        const int L = i * G + bx, hd = L & 3, tile = L >> 2; const int trow = tile * 128 + wid * 16 + fr;
        f32x4 S[16]; h16x8 qf[8], pf[8]; f32x4 O[16]; float linv = 0.f;
#pragma unroll
        for (int kt = 0; kt < 16; ++kt) S[kt] = (f32x4){0.f, 0.f, 0.f, 0.f};
#pragma unroll
        for (int n = 0; n < 8; ++n) {
            const int c = i * 8 + n;
            asm volatile("s_waitcnt vmcnt(0)" ::: "memory"); __builtin_amdgcn_s_barrier(); asm volatile("" ::: "memory");
            if (n == 0) {
#pragma unroll
                for (int st = 0; st < 8; ++st) qf[st] = *(const h16x8*)(Q + (size_t)trow * 1024 + hd * 256 + 32 * st + 8 * fq);
            }
            if (c + 2 < total) attn_issue(lds, KM, VM, c + 2, G, bx, wid, lane);
            const LAS unsigned char* buf = lds + (unsigned)(c % 3) * ATT_CH;
            if (n < 4) {
#pragma unroll
                for (int kt = 0; kt < 16; ++kt)
#pragma unroll
                    for (int ks = 0; ks < 2; ++ks) { const int key = kt * 16 + fr, slot = 4 * ks + fq;
                        const h16x8 bf = *(const LAS h16x8*)(buf + key * 128 + ((slot ^ ((key >> 1) & 7)) * 16));
                        S[kt] = __builtin_amdgcn_mfma_f32_16x16x32_f16(bf, qf[2 * n + ks], S[kt], 0, 0, 0);
                        if (ks == 1 && (kt & 3) == 3) __builtin_amdgcn_sched_barrier(0); }
                if (n == 3) {
                    float mx = -INFINITY;
#pragma unroll
                    for (int kt = 0; kt < 16; ++kt)
#pragma unroll
                        for (int j = 0; j < 4; ++j) mx = fmaxf(mx, S[kt][j]);
                    mx = fmaxf(mx, __shfl_xor(mx, 16)); mx = fmaxf(mx, __shfl_xor(mx, 32));
                    float l = 0.f;
#pragma unroll
                    for (int kt = 0; kt < 16; ++kt)
#pragma unroll
                        for (int j = 0; j < 4; ++j) { const float e = __expf(S[kt][j] - mx); S[kt][j] = e; l += e; }
                    l += __shfl_xor(l, 16); l += __shfl_xor(l, 32); linv = 1.f / l;
#pragma unroll
                    for (int st = 0; st < 8; ++st) pf[st] = cat8(cvt4(S[2 * st]), cvt4(S[2 * st + 1]));
                }
            } else {
                if (n == 4) {
#pragma unroll
                    for (int dt = 0; dt < 16; ++dt) O[dt] = (f32x4){0.f, 0.f, 0.f, 0.f};
                }
#pragma unroll
                for (int ks = 0; ks < 2; ++ks) { const int r0 = 32 * ks + 4 * fq + tq, r1 = r0 + 16;
#pragma unroll
                    for (int dt = 0; dt < 16; ++dt) {
                        const h16x4 lo = tr_read4(buf + r0 * 512 + (((2 * dt + (tp >> 1)) ^ ((r0 & 7) << 1)) * 16) + (tp & 1) * 8);
                        const h16x4 hi = tr_read4(buf + r1 * 512 + (((2 * dt + (tp >> 1)) ^ ((r1 & 7) << 1)) * 16) + (tp & 1) * 8);
                        O[dt] = __builtin_amdgcn_mfma_f32_16x16x32_f16(cat8(lo, hi), pf[2 * (n - 4) + ks], O[dt], 0, 0, 0);
                        if ((dt & 3) == 3) __builtin_amdgcn_sched_barrier(0); } }
                if (n == 7) {
#pragma unroll
                    for (int dt = 0; dt < 16; ++dt) { const f32x4 o = O[dt] * linv; u32x2 w; w.x = pk_h2(o[0], o[1]); w.y = pk_h2(o[2], o[3]);
                        *(u32x2*)(ATT + (size_t)trow * 1024 + hd * 256 + 16 * dt + 4 * fq) = w; }
                }
            }
        }
    }
    asm volatile("s_waitcnt vmcnt(0)" ::: "memory"); __builtin_amdgcn_s_barrier();
}


__device__ __forceinline__ void mstate_ext(unsigned char* ws, int bh, int wave, int lane) {
    const float* ig = (const float*)(ws + OFF_IG); const float* lf = (const float*)(ws + OFF_LF);
    const int b = bh >> 2, h = bh & 3; float B = 0.f, mx = -INFINITY;
    for (int s = 0; s < CHUNK; ++s) { const int t = b * SEQ + lane * CHUNK + s; B += lf[t * 4 + h]; mx = fmaxf(mx, ig[t * 4 + h] - B); }
    const float blast = B, maxw = B + mx; float m = 0.f, mc = 0.f, mn = 0.f;
    for (int c = 0; c < NCHUNK; ++c) { const float bl = __shfl(blast, c), mw = __shfl(maxw, c); const float m2 = fmaxf(bl + m, mw); if (lane == c) { mc = m; mn = m2; } m = m2; }
    if (wave == 0) { ((float*)(ws + OFF_MST))[bh * 64 + lane] = mc; ((float*)(ws + OFF_DEC))[bh * 64 + lane] = __expf(blast + mc - mn); }
    float* AL = (float*)(ws + OFF_AL); float* BE = (float*)(ws + OFF_BE); float* NM = (float*)(ws + OFF_NM); float* WU = (float*)(ws + OFF_WU);
    B = 0.f; float rm = -INFINITY;
    for (int s = 0; s < CHUNK; ++s) { const int t = b * SEQ + lane * CHUNK + s; const float li = lf[t * 4 + h], ii = ig[t * 4 + h]; B += li; rm = fmaxf(rm, ii - B);
        if ((s >> 4) == wave) { const float mt = B + fmaxf(mc, rm); AL[t * 4 + h] = B - mt; BE[t * 4 + h] = ii - B; NM[t * 4 + h] = -mt; WU[t * 4 + h] = __expf(ii - B + blast - mn); } }
}

__device__ __forceinline__ int swz128(int row) { return (((row >> 1) & 1) | (((row >> 3) & 1) << 1)) << 1; }
__device__ __forceinline__ void scan_task(LAS unsigned char* lds, const Ptrs& p, unsigned char* ws, int task) {
    int tid = threadIdx.x; asm volatile("" : "+v"(tid));
    const int wid = __builtin_amdgcn_readfirstlane(tid >> 6), lane = tid & 63, fr = lane & 15, fq = lane >> 4;
    const int bh = task >> 4, et = (task >> 2) & 3, dtb = task & 3, b = bh >> 2, hd = bh & 3, e0 = et * 64, d0 = dtb * 64;
    const int cg = tid & 7, rp = tid >> 3, kcol = 1024 + hd * 256 + d0 + 8 * cg;
    f32x4 cw[4][2], cb[2];
#pragma unroll
    for (int j = 0; j < 4; ++j) { cw[j][0] = *(const f32x4*)(p.conv_w + j * 2048 + kcol); cw[j][1] = *(const f32x4*)(p.conv_w + j * 2048 + kcol + 4); }
    cb[0] = *(const f32x4*)(p.conv_b + kcol); cb[1] = *(const f32x4*)(p.conv_b + kcol + 4);
    const h16* QK = (const h16*)p.out; const float* WU = (const float*)(ws + OFF_WU); const float* DEC = (const float*)(ws + OFF_DEC) + bh * 64;
    const h16* Vg = (const h16*)(ws + WS_V);
    h16* CST = (h16*)(ws + WS_CST) + (size_t)bh * 64 * 65536; float* NST = (float*)(ws + WS_NST) + (size_t)bh * 64 * 256;
    const int dti = wid & 3, ep = wid >> 2; const bool doN = (et == 0) && (ep == 0);
    const int tq = (lane & 15) >> 2, tp = lane & 3;
    u32x4 raw[3][5]; float wu[3][2]; float dcv[3];
    f32x4 acc[2] = {(f32x4){0.f, 0.f, 0.f, 0.f}, (f32x4){0.f, 0.f, 0.f, 0.f}}; f32x4 nacc = (f32x4){0.f, 0.f, 0.f, 0.f};
    const h16x8 ones = {(h16)1.f, (h16)1.f, (h16)1.f, (h16)1.f, (h16)1.f, (h16)1.f, (h16)1.f, (h16)1.f};
#define SCAN_LOAD(c_, set_) do { const int t0_ = b * SEQ + (c_) * CHUNK; \
        _Pragma("unroll") for (int q = 0; q < 2; ++q) { const int I = wid * 2 + q, row = I * 8 + (lane >> 3), ch = (lane & 7) ^ swz128(row); \
            GLDS16((const char*)(Vg + (size_t)(t0_ + row) * 1024 + hd * 256 + e0) + ch * 16, lds + 32768 + ((c_) & 3) * 16384 + I * 1024); } \
        _Pragma("unroll") for (int k = 0; k < 5; ++k) { int tl = (c_) * CHUNK + 2 * rp - 3 + k; tl = tl < 0 ? 0 : tl; raw[set_][k] = *(const u32x4*)(QK + (size_t)(b * SEQ + tl) * 2048 + kcol); } \
        wu[set_][0] = WU[(t0_ + 2 * rp) * 4 + hd]; wu[set_][1] = WU[(t0_ + 2 * rp + 1) * 4 + hd]; dcv[set_] = DEC[c_]; } while (0)
#define SCAN_STORE(c_) do { \
        _Pragma("unroll") for (int j = 0; j < 2; ++j) { u32x2 w; w.x = pk_h2(acc[j][0], acc[j][1]); w.y = pk_h2(acc[j][2], acc[j][3]); \
            *(u32x2*)(CST + (size_t)(c_) * 65536 + (size_t)(e0 + 16 * (2 * ep + j) + fr) * 256 + d0 + 16 * dti + 4 * fq) = w; } \
        if (doN && fr == 0) *(f32x4*)(NST + (c_) * 256 + d0 + 16 * dti + 4 * fq) = nacc; } while (0)
#define SCAN_STEP(c_, set_) do { const int c = (c_); \
        SCAN_STORE(c); \
        LAS unsigned char* kb = lds + (c & 1) * 16384; LAS unsigned char* vb = lds + 32768 + (c & 3) * 16384; \
        if (c == 0) { _Pragma("unroll") for (int k = 0; k < 3; ++k) if (2 * rp - 3 + k < 0) raw[set_][k] = (u32x4){0u, 0u, 0u, 0u}; } \
        _Pragma("unroll") for (int rr = 0; rr < 2; ++rr) { f32x4 y0 = cb[0], y1 = cb[1]; \
            _Pragma("unroll") for (int j = 0; j < 4; ++j) { const h16x8 xr = __builtin_bit_cast(h16x8, raw[set_][rr + j]); \
                _Pragma("unroll") for (int q = 0; q < 4; ++q) { y0[q] += cw[j][0][q] * (float)xr[q]; y1[q] += cw[j][1][q] * (float)xr[4 + q]; } } \
            const float sc = 0.0625f * wu[set_][rr]; \
            _Pragma("unroll") for (int q = 0; q < 4; ++q) { y0[q] = fsilu(y0[q]) * sc; y1[q] = fsilu(y1[q]) * sc; } \
            const int row = 2 * rp + rr; *(LAS u32x4*)(kb + row * 128 + ((cg ^ swz128(row)) * 16)) = pk_h8(y0, y1); } \
        asm volatile("s_waitcnt lgkmcnt(0)" ::: "memory"); __builtin_amdgcn_s_barrier(); asm volatile("" ::: "memory"); \
        const float dec = dcv[set_]; \
        if (c + 3 < NCHUNK - 1) SCAN_LOAD(c + 3, set_); \
        acc[0] *= dec; acc[1] *= dec; nacc *= dec; \
        _Pragma("unroll") for (int ks = 0; ks < 4; ++ks) { const int r0 = 32 * ks + 8 * fq + tq, r1 = r0 + 4; \
            const int o0 = r0 * 128 + (tp & 1) * 8, o1 = r1 * 128 + (tp & 1) * 8, s0 = swz128(r0), s1 = swz128(r1), cx = 2 * dti + (tp >> 1); \
            const h16x8 X = cat8(tr_read4(kb + o0 + ((cx ^ s0) * 16)), tr_read4(kb + o1 + ((cx ^ s1) * 16))); \
            _Pragma("unroll") for (int j = 0; j < 2; ++j) { const int cy = 2 * (2 * ep + j) + (tp >> 1); \
                const h16x8 Y = cat8(tr_read4(vb + o0 + ((cy ^ s0) * 16)), tr_read4(vb + o1 + ((cy ^ s1) * 16))); \
                acc[j] = __builtin_amdgcn_mfma_f32_16x16x32_f16(X, Y, acc[j], 0, 0, 0); } \
            if (doN) nacc = __builtin_amdgcn_mfma_f32_16x16x32_f16(X, ones, nacc, 0, 0, 0); } } while (0)
    SCAN_LOAD(0, 0); SCAN_LOAD(1, 1); SCAN_LOAD(2, 2);
#pragma unroll 1
    for (int c3 = 0; c3 < NCHUNK - 1; c3 += 3) { SCAN_STEP(c3, 0); SCAN_STEP(c3 + 1, 1); SCAN_STEP(c3 + 2, 2); }
    SCAN_STORE(NCHUNK - 1);
#undef SCAN_STEP
#undef SCAN_STORE
#undef SCAN_LOAD
    asm volatile("s_waitcnt vmcnt(0) lgkmcnt(0)" ::: "memory"); __builtin_amdgcn_s_barrier();
}

__device__ __forceinline__ int swz256(int row) { return ((row & 3) + 4 * ((row >> 3) & 1)) << 1; }
__device__ __forceinline__ void sgu_task(LAS unsigned char* lds, const Ptrs& p, unsigned char* ws, int task) {
    int tid = threadIdx.x; asm volatile("" : "+v"(tid));
    const int wid = __builtin_amdgcn_readfirstlane(tid >> 6), lane = tid & 63, fr = lane & 15, fq = lane >> 4;
    const int t0 = task * CHUNK;
    LAS unsigned char* wb = lds; LAS unsigned char* vb = lds + 32768; LAS float* rs = (LAS float*)(lds + 65536);
    const float* ss = (const float*)(ws + OFF_SSSV); const h16* SV = (const h16*)(ws + WS_SV); const h16* UG = (const h16*)(ws + WS_UG); h16* Z = (h16*)(ws + WS_XH);
    if (tid < CHUNK) rs[tid] = rsqrtf(ss[t0 + tid] * (1.f / DM) + EPS);
    __syncthreads();
    const int lrow = tid >> 2, lq = tid & 3, tq = (lane & 15) >> 2, tp = lane & 3, trow = 16 * wid + fr;
    f32x4 wraw[8]; h16x8 vraw[4];
#define SGU_LOAD(g_) do { const float* wsrc = p.w_s + (size_t)((g_) * 128 + lrow) * 128 + 32 * lq; const h16* vsrc = SV + (size_t)(t0 + lrow) * 1024 + (g_) * 128 + 32 * lq; \
        _Pragma("unroll") for (int i = 0; i < 8; ++i) wraw[i] = *(const f32x4*)(wsrc + 4 * i); \
        _Pragma("unroll") for (int i = 0; i < 4; ++i) vraw[i] = *(const h16x8*)(vsrc + 8 * i); } while (0)
    SGU_LOAD(0);
#pragma unroll 1
    for (int g = 0; g < 8; ++g) {
        {
            const float* gsrc = p.sgu_norm_g + g * 128 + 32 * lq; const float r = rs[lrow];
#pragma unroll
            for (int i = 0; i < 4; ++i) { f32x4 a = wraw[2 * i], c = wraw[2 * i + 1];
#pragma unroll
                for (int q = 0; q < 4; ++q) { if (32 * lq + 8 * i + q > lrow) a[q] = 0.f; if (32 * lq + 8 * i + 4 + q > lrow) c[q] = 0.f; }
                *(LAS u32x4*)(wb + lrow * 256 + (((4 * lq + i) ^ (lrow & 15)) * 16)) = pk_h8(a, c); }
#pragma unroll
            for (int i = 0; i < 4; ++i) { const h16x8 v = vraw[i]; const f32x4 g0 = *(const f32x4*)(gsrc + 8 * i), g1 = *(const f32x4*)(gsrc + 8 * i + 4); f32x4 a, c;
#pragma unroll
                for (int q = 0; q < 4; ++q) { a[q] = (float)v[q] * r * g0[q]; c[q] = (float)v[4 + q] * r * g1[q]; }
                *(LAS u32x4*)(vb + lrow * 256 + (((4 * lq + i) ^ swz256(lrow)) * 16)) = pk_h8(a, c); }
        }
        __syncthreads();
        if (g + 1 < 8) SGU_LOAD(g + 1);
        const float bias = p.b_s[g * 128 + trow]; const size_t ro = (size_t)(t0 + trow) * 1024 + g * 128 + 4 * fq;
        h16x4 ur[8];
#pragma unroll
        for (int dt = 0; dt < 8; ++dt) ur[dt] = *(const h16x4*)(UG + ro + 16 * dt);
        f32x4 acc[8];
#pragma unroll
        for (int dt = 0; dt < 8; ++dt) acc[dt] = (f32x4){0.f, 0.f, 0.f, 0.f};
        const int nks = (wid >> 1) + 1;
        for (int ks = 0; ks < nks; ++ks) {
            const h16x8 Y = *(const LAS h16x8*)(wb + trow * 256 + (((4 * ks + fq) ^ (trow & 15)) * 16));
            const int r0 = 32 * ks + 8 * fq + tq, r1 = r0 + 4, o0 = r0 * 256 + (tp & 1) * 8, o1 = r1 * 256 + (tp & 1) * 8, s0 = swz256(r0), s1 = swz256(r1);
#pragma unroll
            for (int dt = 0; dt < 8; ++dt) { const int cx = 2 * dt + (tp >> 1);
                const h16x8 X = cat8(tr_read4(vb + o0 + ((cx ^ s0) * 16)), tr_read4(vb + o1 + ((cx ^ s1) * 16)));
                acc[dt] = __builtin_amdgcn_mfma_f32_16x16x32_f16(X, Y, acc[dt], 0, 0, 0); }
        }
#pragma unroll
        for (int dt = 0; dt < 8; ++dt) { const h16x4 u = ur[dt]; u32x2 w;
            w.x = pk_h2((float)u[0] * (acc[dt][0] + bias), (float)u[1] * (acc[dt][1] + bias)); w.y = pk_h2((float)u[2] * (acc[dt][2] + bias), (float)u[3] * (acc[dt][3] + bias));
            *(u32x2*)(Z + ro + 16 * dt) = w; }
        __syncthreads();
    }
#undef SGU_LOAD
}

__device__ __forceinline__ int swzb(int row) { return (row >> 1) & 7; }
__device__ __forceinline__ void mout_phase(LAS unsigned char* lds, const Ptrs& p, unsigned char* ws, int G, int bx, h16* Zdst) {
    const int wid = __builtin_amdgcn_readfirstlane(threadIdx.x >> 6);
    constexpr int QB = 0, KB = 16384, CB = 32768, VB = 69632, SM = 135168;
    const h16* QK = (const h16*)p.out; const h16* Vg = (const h16*)(ws + WS_V); const h16* OG = (const h16*)(ws + WS_OG); h16* Z = (h16*)(ws + WS_XH);
    const float* ALg = (const float*)(ws + OFF_AL); const float* BEg = (const float*)(ws + OFF_BE); const float* NMg = (const float*)(ws + OFF_NM); const float* MST = (const float*)(ws + OFF_MST);
    LAS float* ALs = (LAS float*)(lds + SM); LAS float* BEs = ALs + 128;
#define OPAQUE_TID() int tid = threadIdx.x; asm volatile("" : "+v"(tid)); const int lane = tid & 63, fr = lane & 15, fq = lane >> 4, cg = tid & 7, rp = tid >> 3, tq = (lane & 15) >> 2, tp = lane & 3, trow = 16 * wid + fr; (void)cg; (void)rp; (void)tq; (void)tp; (void)trow; (void)fq
    for (int L = bx; L < 512; L += G) {
        const int bh = L >> 6, c = L & 63, b = bh >> 2, hd = bh & 3, t0 = b * SEQ + c * CHUNK;
        const h16* Ct = (const h16*)(ws + WS_CST) + ((size_t)(bh * 64 + c)) * 65536; const float* nst = (const float*)(ws + WS_NST) + (size_t)(bh * 64 + c) * 256;
        __syncthreads();
        { OPAQUE_TID();
        if (tid < 128) ALs[tid] = ALg[(t0 + tid) * 4 + hd]; else if (tid < 256) BEs[tid - 128] = BEg[(t0 + tid - 128) * 4 + hd];
#pragma unroll
        for (int q = 0; q < 8; ++q) { const int I = wid * 8 + q, row = I * 2 + (lane >> 5), ch = (lane & 31) ^ ((row & 7) << 1);
            GLDS16((const char*)(Vg + (size_t)(t0 + row) * 1024 + hd * 256) + ch * 16, lds + VB + I * 1024); }
        }
        f32x4 S[8], acc[17];
#pragma unroll
        for (int i = 0; i < 8; ++i) S[i] = (f32x4){0.f, 0.f, 0.f, 0.f};
#pragma unroll
        for (int i = 0; i < 17; ++i) acc[i] = (f32x4){0.f, 0.f, 0.f, 0.f};
#pragma unroll 1
        for (int dch = 0; dch < 4; ++dch) {
            OPAQUE_TID();
#pragma unroll
            for (int q = 0; q < 4; ++q) { const int I = wid * 4 + q, row = I * 8 + (lane >> 3), ch = (lane & 7) ^ swzb(row);
                GLDS16((const char*)(Ct + (size_t)row * 256 + dch * 64) + ch * 16, lds + CB + I * 1024); }
            if (tid < 8) { const f32x4 a = *(const f32x4*)(nst + dch * 64 + 8 * tid), c2 = *(const f32x4*)(nst + dch * 64 + 8 * tid + 4); *(LAS u32x4*)(lds + CB + 32768 + tid * 16) = pk_h8(a, c2); }
#pragma unroll 1
            for (int which = 0; which < 2; ++which) {
                const int col = which * 1024 + hd * 256 + dch * 64 + 8 * cg;
                u32x4 raw[5];
#pragma unroll
                for (int k = 0; k < 5; ++k) { const int tl = c * CHUNK + 2 * rp - 3 + k; raw[k] = (u32x4){0u, 0u, 0u, 0u}; if (tl >= 0) raw[k] = *(const u32x4*)(QK + (size_t)(b * SEQ + tl) * 2048 + col); }
                f32x4 cw[4][2];
#pragma unroll
                for (int j = 0; j < 4; ++j) { cw[j][0] = *(const f32x4*)(p.conv_w + j * 2048 + col); cw[j][1] = *(const f32x4*)(p.conv_w + j * 2048 + col + 4); }
                const f32x4 cb0 = *(const f32x4*)(p.conv_b + col), cb1 = *(const f32x4*)(p.conv_b + col + 4);
                const float sc = which ? 0.0625f : 1.f;
#pragma unroll
                for (int rr = 0; rr < 2; ++rr) { f32x4 y0 = cb0, y1 = cb1;
#pragma unroll
                    for (int j = 0; j < 4; ++j) { const h16x8 xr = __builtin_bit_cast(h16x8, raw[rr + j]);
#pragma unroll
                        for (int q = 0; q < 4; ++q) { y0[q] += cw[j][0][q] * (float)xr[q]; y1[q] += cw[j][1][q] * (float)xr[4 + q]; } }
#pragma unroll
                    for (int q = 0; q < 4; ++q) { y0[q] = fsilu(y0[q]) * sc; y1[q] = fsilu(y1[q]) * sc; }
                    const int row = 2 * rp + rr; *(LAS u32x4*)(lds + (which ? KB : QB) + row * 128 + ((cg ^ swzb(row)) * 16)) = pk_h8(y0, y1); }
            }
            asm volatile("s_waitcnt vmcnt(0) lgkmcnt(0)" ::: "memory"); __builtin_amdgcn_s_barrier(); asm volatile("" ::: "memory");
            h16x8 Y[2];
#pragma unroll
            for (int ks = 0; ks < 2; ++ks) Y[ks] = *(const LAS h16x8*)(lds + QB + trow * 128 + (((4 * ks + fq) ^ swzb(trow)) * 16));
#pragma unroll
            for (int st = 0; st < 8; ++st) if (st <= wid) {
#pragma unroll
                for (int ks = 0; ks < 2; ++ks) { const int krow = 16 * st + fr; const h16x8 X = *(const LAS h16x8*)(lds + KB + krow * 128 + (((4 * ks + fq) ^ swzb(krow)) * 16));
                    S[st] = __builtin_amdgcn_mfma_f32_16x16x32_f16(X, Y[ks], S[st], 0, 0, 0); } }
#pragma unroll
            for (int et = 0; et < 17; ++et) {
#pragma unroll
                for (int ks = 0; ks < 2; ++ks) { const int crow = 16 * et + fr; const h16x8 X = *(const LAS h16x8*)(lds + CB + crow * 128 + (((4 * ks + fq) ^ swzb(crow)) * 16));
                    acc[et] = __builtin_amdgcn_mfma_f32_16x16x32_f16(X, Y[ks], acc[et], 0, 0, 0); }
                if ((et & 3) == 3) __builtin_amdgcn_sched_barrier(0); }
            asm volatile("s_waitcnt lgkmcnt(0)" ::: "memory"); __builtin_amdgcn_s_barrier(); asm volatile("" ::: "memory");
        }
        OPAQUE_TID();
        const float al = ALs[trow], mc = MST[bh * 64 + c], iw = __expf(al + mc);
#pragma unroll
        for (int et = 0; et < 16; ++et) acc[et] *= iw;
        const float qn = __shfl(acc[16][0], fr);
        float den = 0.f;
#pragma unroll
        for (int st = 0; st < 8; ++st) { const f32x4 be = *(const LAS f32x4*)(BEs + 16 * st + 4 * fq);
#pragma unroll
            for (int r = 0; r < 4; ++r) { float v = S[st][r] * __expf(al + be[r]); if (st == wid) v = (4 * fq + r <= fr) ? v : 0.f; if (st > wid) v = 0.f; S[st][r] = v; den += v; } }
        den += __shfl_xor(den, 16); den += __shfl_xor(den, 32);
        den += iw * qn;
        h16x8 pf[4];
#pragma unroll
        for (int i = 0; i < 4; ++i) pf[i] = cat8(cvt4(S[2 * i]), cvt4(S[2 * i + 1]));
#pragma unroll
        for (int ks = 0; ks < 4; ++ks) if (ks <= (wid >> 1)) { const int r0 = 32 * ks + 4 * fq + tq, r1 = r0 + 16;
#pragma unroll
            for (int et = 0; et < 16; ++et) {
                const h16x4 lo = tr_read4(lds + VB + r0 * 512 + (((2 * et + (tp >> 1)) ^ ((r0 & 7) << 1)) * 16) + (tp & 1) * 8);
                const h16x4 hi = tr_read4(lds + VB + r1 * 512 + (((2 * et + (tp >> 1)) ^ ((r1 & 7) << 1)) * 16) + (tp & 1) * 8);
                acc[et] = __builtin_amdgcn_mfma_f32_16x16x32_f16(cat8(lo, hi), pf[ks], acc[et], 0, 0, 0);
                if ((et & 3) == 3) __builtin_amdgcn_sched_barrier(0); } }
        const int tg = t0 + trow; const float inv = 1.f / fmaxf(fabsf(den), __expf(NMg[tg * 4 + hd]));
        float ss = 0.f;
#pragma unroll
        for (int et = 0; et < 16; ++et) { acc[et] *= inv; ss += (acc[et][0] * acc[et][0] + acc[et][1] * acc[et][1]) + (acc[et][2] * acc[et][2] + acc[et][3] * acc[et][3]); }
        ss += __shfl_xor(ss, 16); ss += __shfl_xor(ss, 32);
        const float rstd = rsqrtf(ss * (1.f / DH) + EPS);
#pragma unroll
        for (int half = 0; half < 2; ++half) { f32x4 gg[8]; h16x4 ogv[8], zv[8];
#pragma unroll
            for (int e8 = 0; e8 < 8; ++e8) { const int col = hd * 256 + 16 * (8 * half + e8) + 4 * fq; const size_t o = (size_t)tg * 1024 + col;
                gg[e8] = *(const f32x4*)(p.mh_norm_g + col); ogv[e8] = *(const h16x4*)(OG + o); zv[e8] = *(const h16x4*)(Z + o); }
            asm volatile("" ::: "memory");
#pragma unroll
            for (int e8 = 0; e8 < 8; ++e8) { const int et = 8 * half + e8; const size_t o = (size_t)tg * 1024 + hd * 256 + 16 * et + 4 * fq; u32x2 w;
                w.x = pk_h2((float)zv[e8][0] + acc[et][0] * rstd * gg[e8][0] * (float)ogv[e8][0], (float)zv[e8][1] + acc[et][1] * rstd * gg[e8][1] * (float)ogv[e8][1]);
                w.y = pk_h2((float)zv[e8][2] + acc[et][2] * rstd * gg[e8][2] * (float)ogv[e8][2], (float)zv[e8][3] + acc[et][3] * rstd * gg[e8][3] * (float)ogv[e8][3]);
                *(u32x2*)(Zdst + o) = w; }
            asm volatile("" ::: "memory"); }
    }
    asm volatile("s_waitcnt vmcnt(0) lgkmcnt(0)" ::: "memory"); __builtin_amdgcn_s_barrier();
#undef OPAQUE_TID
}

struct TpItem { const float* W; const float* gk; h16* WT; int ldw, srccol0, K, destrow0, k0; };
__device__ __forceinline__ void tp_load(const TpItem& t, f32x4 (&v)[8], float (&g)[8], int lane) {
    const int col4 = lane & 7, krow = lane >> 3;
#pragma unroll
    for (int i = 0; i < 8; ++i) { v[i] = *(const f32x4*)(t.W + (size_t)(t.k0 + 8 * i + krow) * t.ldw + t.srccol0 + 4 * col4); g[i] = t.gk ? t.gk[t.k0 + 8 * i + krow] : 1.f; }
}
__device__ __forceinline__ void tp_store(const TpItem& t, const f32x4 (&v)[8], const float (&g)[8], LAS unsigned char* scr, int lane) {
    const int col4 = lane & 7, krow = lane >> 3;
#pragma unroll
    for (int i = 0; i < 8; ++i) { const int k = 8 * i + krow; const f32x4 x = v[i] * g[i]; u32x2 w; w.x = pk_h2(x[0], x[1]); w.y = pk_h2(x[2], x[3]);
        *(LAS u32x2*)(scr + k * 64 + (((col4 >> 1) ^ (2 * (i & 1))) * 16) + (col4 & 1) * 8) = w; }
    LDS_WAIT(); asm volatile("" ::: "memory");
    const int gq = lane >> 4, li = lane & 15, q = li >> 2, pp = li & 3;
#pragma unroll
    for (int h = 0; h < 2; ++h)
#pragma unroll
        for (int it = 0; it < 2; ++it) { const int m = gq + 4 * it, r0 = 8 * m + q, r1 = r0 + 4, ch = (2 * h + (pp >> 1)) ^ (2 * (m & 1));
            const h16x4 lo = tr_read4(scr + r0 * 64 + ch * 16 + (pp & 1) * 8), hi = tr_read4(scr + r1 * 64 + ch * 16 + (pp & 1) * 8);
            *(GAS h16x8*)(t.WT + (size_t)(t.destrow0 + 16 * h + li) * t.K + t.k0 + 8 * m) = cat8(lo, hi); }
    LDS_WAIT(); asm volatile("" ::: "memory");
}
template <class Dec>
__device__ __forceinline__ void tp_loop(const Dec& dec, int first, int count, int stride, LAS unsigned char* scr, int lane) {
    if (first >= count) return;
    TpItem cur = dec(first); f32x4 v[8]; float g[8]; tp_load(cur, v, g, lane);
    for (int it = first; it < count; it += stride) {
        const int nx = it + stride; TpItem nxt = cur; f32x4 v2[8]; float g2[8];
#pragma unroll
        for (int i = 0; i < 8; ++i) { v2[i] = v[i]; g2[i] = g[i]; }
        if (nx < count) { nxt = dec(nx); tp_load(nxt, v2, g2, lane); }
        asm volatile("" ::: "memory");
        tp_store(cur, v, g, scr, lane);
        cur = nxt;
#pragma unroll
        for (int i = 0; i < 8; ++i) { v[i] = v2[i]; g[i] = g2[i]; }
    }
}
__device__ __forceinline__ int win_destrow(int l) {
    if (l < 3072) return l;
    if (l < 4096) { const int c = l - 3072; return 3072 + (c >> 7) * 256 + (c & 127); }
    if (l < 5120) { const int c = l - 4096; return 5120 + (c >> 7) * 256 + (c & 127); }
    if (l < 6144) return 7168 + (l - 5120);
    if (l < 7168) { const int c = l - 6144; return 3072 + (c >> 7) * 256 + 128 + (c & 127); }
    { const int c = l - 7168; return 5120 + (c >> 7) * 256 + 128 + (c & 127); }
}

struct TpDecP0 { const Ptrs* p; unsigned char* ws;
    __device__ __forceinline__ TpItem operator()(int it) const {
        constexpr int I_WIN = 16 * 256, I_SQ = 16 * 32, I_KV = 16 * 64; h16* wsm = (h16*)(ws + WS_WSM); int r = it; TpItem t;
        if (r < I_WIN) { const int kb = r >> 8, nb = r & 255, l0 = 32 * nb; t = TpItem{p->w_in, p->norm_mix_g, (h16*)(ws + WS_WIN), IN_DIM, l0 < 4096 ? l0 : l0 + 8, DM, win_destrow(l0), 64 * kb}; return t; } r -= I_WIN;
        if (r < I_SQ) { t = TpItem{p->w_out, nullptr, wsm, DM, 32 * (r & 31), DM, 32 * (r & 31), 64 * (r >> 5)}; return t; } r -= I_SQ;
        if (r < I_SQ) { t = TpItem{p->w_xq, p->norm_x_g, wsm + 1024 * 1024, DM, 32 * (r & 31), DM, 32 * (r & 31), 64 * (r >> 5)}; return t; } r -= I_SQ;
        if (r < I_KV) { t = TpItem{p->w_xkv, p->norm_mem_g, wsm + 2 * 1024 * 1024, 2048, 32 * (r & 63), DM, 32 * (r & 63), 64 * (r >> 6)}; return t; } r -= I_KV;
        t = TpItem{p->w_xo, nullptr, wsm + 4 * 1024 * 1024, DM, 32 * (r & 31), DM, 32 * (r & 31), 64 * (r >> 5)}; return t; } };
struct TpDecP4 { const Ptrs* p; unsigned char* ws;
    __device__ __forceinline__ TpItem operator()(int it) const {
        h16* W13 = (h16*)(ws + WS_UG); h16* W2T = (h16*)(ws + WS_UG + 64 * MiB); const int e = it / 768, r = it % 768; TpItem t;
        if (r < 256) { const int kb = r >> 4, nb = r & 15, f0 = 32 * nb; t = TpItem{p->w1 + (size_t)e * DM * FF, p->norm_moe_g, W13 + (size_t)e * 1024 * 1024, FF, f0, DM, (f0 >> 7) * 256 + (f0 & 127), 64 * kb}; return t; }
        if (r < 512) { const int q = r - 256, kb = q >> 4, nb = q & 15, f0 = 32 * nb; t = TpItem{p->w3 + (size_t)e * DM * FF, p->norm_moe_g, W13 + (size_t)e * 1024 * 1024, FF, f0, DM, (f0 >> 7) * 256 + 128 + (f0 & 127), 64 * kb}; return t; }
        const int q = r - 512, kb = q >> 5, nb = q & 31; t = TpItem{p->w2 + (size_t)e * FF * DM, nullptr, W2T + (size_t)e * 1024 * 512, DM, 32 * nb, FF, 32 * nb, 64 * kb}; return t; } };
template <bool GATES>
__device__ __forceinline__ float p0_row(const f32x4 (&v)[4], h16* orow, const LAS float* gt, float (&acc)[8], int lane) {
    float ss = 0.f;
#pragma unroll
    for (int j = 0; j < 4; ++j) ss += (v[j].x * v[j].x + v[j].y * v[j].y) + (v[j].z * v[j].z + v[j].w * v[j].w);
    GAS u32x2* o8 = (GAS u32x2*)orow + lane;
#pragma unroll
    for (int j = 0; j < 4; ++j) { u32x2 w; w.x = pk_h2(v[j].x, v[j].y); w.y = pk_h2(v[j].z, v[j].w); o8[64 * j] = w; }
    if constexpr (GATES) {
#pragma unroll
        for (int q = 0; q < 8; ++q) acc[q] = 0.f;
#pragma unroll
        for (int j = 0; j < 4; ++j)
#pragma unroll
            for (int c = 0; c < 4; ++c) { const int k = 4 * (64 * j + lane) + c; const f32x4 g0 = *(const LAS f32x4*)(gt + k * 8), g1 = *(const LAS f32x4*)(gt + k * 8 + 4); const float xv = v[j][c];
                acc[0] += xv * g0.x; acc[1] += xv * g0.y; acc[2] += xv * g0.z; acc[3] += xv * g0.w; acc[4] += xv * g1.x; acc[5] += xv * g1.y; acc[6] += xv * g1.z; acc[7] += xv * g1.w; }
        const bool b5 = (lane & 32) != 0, b4 = (lane & 16) != 0, b3 = (lane & 8) != 0; float k4[4], k2[2], k1;
#pragma unroll
        for (int q = 0; q < 4; ++q) { const float snd = b5 ? acc[q] : acc[4 + q]; k4[q] = (b5 ? acc[4 + q] : acc[q]) + __shfl_xor(snd, 32); }
#pragma unroll
        for (int q = 0; q < 2; ++q) { const float snd = b4 ? k4[q] : k4[2 + q]; k2[q] = (b4 ? k4[2 + q] : k4[q]) + __shfl_xor(snd, 16); }
        { const float snd = b3 ? k2[0] : k2[1]; k1 = (b3 ? k2[1] : k2[0]) + __shfl_xor(snd, 8); }
        k1 += __shfl_xor(k1, 4); k1 += __shfl_xor(k1, 2); k1 += __shfl_xor(k1, 1);
#pragma unroll
        for (int q = 0; q < 8; ++q) acc[q] = __builtin_bit_cast(float, __builtin_amdgcn_readlane(__builtin_bit_cast(int, k1), 8 * q));
    }
    return wave_sum(ss);
}
__device__ __forceinline__ void mstate_wave(const float* ig, const float* lf, float* mst, int bh, int lane) {
    const int b = bh >> 2, h = bh & 3; float B = 0.f, mx = -INFINITY;
    for (int s = 0; s < CHUNK; ++s) { const int t = b * SEQ + lane * CHUNK + s; B += lf[t * 4 + h]; mx = fmaxf(mx, ig[t * 4 + h] - B); }
    const float blast = B, maxw = B + mx; float m = 0.f;
    for (int c = 0; c < NCHUNK; ++c) { const float bl = __shfl(blast, c), mw = __shfl(maxw, c); if (lane == c) mst[bh * 64 + c] = m; m = fmaxf(bl + m, mw); }
}

struct Args { Ptrs p; int ph_lo, ph_hi, li, pad; };
__global__ void __launch_bounds__(NTHREADS, 2) mega(Args a) {
    extern __shared__ __attribute__((aligned(16))) unsigned char lds_[];
    LAS unsigned char* lds = (LAS unsigned char*)lds_;
    volatile LAS unsigned* MISC = (volatile LAS unsigned*)(lds + MISC_OFF);
    const Ptrs& p = a.p;
#define PH_IDS() int tid = threadIdx.x; asm volatile("" : "+v"(tid)); const int lane = tid & 63, wave = __builtin_amdgcn_readfirstlane(tid >> 6); const int gw = vcu * NWAVES + wave, NGW = G * NWAVES; (void)lane; (void)gw; (void)NGW
    const int G = gridDim.x, bx = blockIdx.x, vcu = (G % 8 == 0) ? (bx % 8) * (G / 8) + bx / 8 : bx;
    unsigned char* ws = p.ws;
    unsigned* ctl = (unsigned*)(ws + WS_CTL);
    for (int u = threadIdx.x; u < (LDS_BYTES - LDSCTL_OFF) / 4; u += NTHREADS) ((LAS unsigned*)(lds + LDSCTL_OFF))[u] = 0u;
    __syncthreads();
    XcdBarrier bar = xcd_barrier_post(ctl + CW_BAR + a.li * XCD_BAR_WORDS, MISC + 8);
    const int lo = a.ph_lo, hi = a.ph_hi;
#ifndef PH_MASK
#define PH_MASK 0xFFFF
#endif
#define IN(k) (((PH_MASK >> (k)) & 1) && lo <= (k) && (k) < hi)
#ifndef REPEAT_MASK
#define REPEAT_MASK 0
#endif
#define REP(k) for (int rep_ = 0; rep_ < 1 + ((REPEAT_MASK >> (k)) & 1); ++rep_)
#define BOTH(k) (IN(k) && IN((k) + 1))
#define GRID_BAR() xcd_barrier(bar)

    if (IN(0)) REP(0) {
        PH_IDS();
        __syncthreads();
        LAS float* gt = (LAS float*)lds;
        for (int i = tid; i < 8192; i += NTHREADS) { const int k = i >> 3, j = i & 7; gt[i] = p.norm_mix_g[k] * p.w_in[(size_t)k * IN_DIM + C_I + j]; }
        { float* wrt = (float*)(ws + OFF_WRT); for (int i = bx * NTHREADS + tid; i < 36 * 1024; i += G * NTHREADS) { const int j = i >> 10, k = i & 1023; wrt[i] = p.norm_moe_g[k] * (j < 4 ? p.w_rg[k * 4 + j] : p.w_re[k * 32 + (j - 4)]); } }
        { float* z = (float*)(ws + OFF_SSSV); for (int i = bx * NTHREADS + tid; i < 3 * NTOK; i += G * NTHREADS) z[i] = 0.f; }
        __syncthreads();
        float acc[8]; float bif[8];
#pragma unroll
        for (int h = 0; h < 8; ++h) bif[h] = p.b_if[h];
        {   f32x4 v[4], nv[4];
            if (gw < NTOK) {
#pragma unroll
                for (int j = 0; j < 4; ++j) v[j] = ((const GAS f32x4*)(p.x + (size_t)gw * DM) + lane)[64 * j]; }
            for (int m = gw; m < NTOK; m += NGW) {
                const int mn = (m + NGW < NTOK) ? m + NGW : m;
#pragma unroll
                for (int j = 0; j < 4; ++j) nv[j] = ((const GAS f32x4*)(p.x + (size_t)mn * DM) + lane)[64 * j];
                asm volatile("" ::: "memory");
                const float ss = p0_row<true>(v, (h16*)(ws + WS_XH) + (size_t)m * DM, gt, acc, lane);
                const float rstd = rsqrtf(ss * (1.f / DM) + EPS);
                if (lane == 0) { ((float*)(ws + OFF_RSTD0))[m] = rstd; f32x4 igv, lfv;
#pragma unroll
                    for (int h = 0; h < 4; ++h) { igv[h] = acc[h] * rstd + bif[h]; lfv[h] = logsigmoidf_(acc[4 + h] * rstd + bif[4 + h]); }
                    *(f32x4*)((float*)(ws + OFF_IG) + m * 4) = igv; *(f32x4*)((float*)(ws + OFF_LF) + m * 4) = lfv; }
#pragma unroll
                for (int j = 0; j < 4; ++j) v[j] = nv[j];
            }
        }
        for (int m = gw; m < NB * NMEM; m += NGW) { f32x4 v[4];
#pragma unroll
            for (int j = 0; j < 4; ++j) v[j] = ((const GAS f32x4*)(p.mem + (size_t)m * DM) + lane)[64 * j];
            const float ss = p0_row<false>(v, (h16*)(ws + WS_MEMH) + (size_t)m * DM, gt, acc, lane);
            if (lane == 0) ((float*)(ws + OFF_RSTDM))[m] = rsqrtf(ss * (1.f / DM) + EPS);
        }
        LAS unsigned char* scr = lds + 32768 + wave * 4096;
        { TpDecP0 dec{&p, ws}; tp_loop(dec, gw, 16 * 256 + 3 * 16 * 32 + 16 * 64, NGW, scr, lane); }
        if (BOTH(0)) GRID_BAR();
    }
    if (IN(1)) REP(1) {
        PH_IDS();
        if (bx < 8) mstate_ext(ws, bx, wave, lane);
        { pg8::StaticOrder S; S.init(ws + WS_XH, ws + WS_WIN, NTOK, 8192, DM, G, bx);
          EpiProj E{(const float*)(ws + OFF_RSTD0), p.b_gate, (h16*)p.out, (h16*)(ws + WS_V), (h16*)(ws + WS_OG), (h16*)(ws + WS_UG), (h16*)(ws + WS_SV), (float*)(ws + OFF_SSSV), rep_ == 0};
          pg8::gemm_phase<EpiProj, pg8::StaticOrder, false, true>(lds, DM, S, E); }
        { pg8::StaticOrder S; S.init(ws + WS_MEMH, ws + WS_WSM + 2 * 2097152, NB * NMEM, 2048, DM, G, (bx + G - 64) % G);
          EpiKV E{(const float*)(ws + OFF_RSTDM), (h16*)(ws + WS_KM), (h16*)(ws + WS_VTM)};
          pg8::gemm_phase<EpiKV, pg8::StaticOrder, false, true>(lds, DM, S, E); }
        if (BOTH(1)) GRID_BAR();
    }

    if (IN(2)) REP(2) {
        if (G >= 256) { if (bx < 128) scan_task(lds, p, ws, bx); else if (bx < 256) sgu_task(lds, p, ws, bx - 128); }
        else { for (int t = bx; t < 256; t += G) { if (t < 128) scan_task(lds, p, ws, t); else sgu_task(lds, p, ws, t - 128); __syncthreads(); } }
        if (BOTH(2)) GRID_BAR();
    }
    if (IN(3)) REP(3) {
        mout_phase(lds, p, ws, G, bx, (((REPEAT_MASK >> 3) & 1) && rep_ == 0) ? (h16*)(ws + WS_UG) : (h16*)(ws + WS_XH));
        if (BOTH(3)) GRID_BAR();
    }
    if (IN(4)) REP(4) {
        PH_IDS();
        { LAS unsigned char* scr = lds + 32768 + wave * 4096;
          TpDecP4 dec{&p, ws}; tp_loop(dec, gw, 32 * 768, NGW, scr, lane);
          __syncthreads(); }
        { pg8::StaticOrder S; S.init(ws + WS_XH, ws + WS_WSM, NTOK, DM, DM, G, bx);
          EpiResid E{p.x, p.out, (h16*)(ws + WS_V), (float*)(ws + OFF_SS1), rep_ == 0};
          pg8::gemm_phase<EpiResid, pg8::StaticOrder, false, false>(lds, DM, S, E); }
        if (BOTH(4)) GRID_BAR();
    }
    if (IN(5)) REP(5) {
        { pg8::StaticOrder S; S.init(ws + WS_V, ws + WS_WSM + 2097152, NTOK, DM, DM, G, bx);
          EpiQ E{(const float*)(ws + OFF_SS1), (h16*)(ws + WS_XH)};
          pg8::gemm_phase<EpiQ, pg8::StaticOrder, false, false>(lds, DM, S, E); }
        if (BOTH(5)) GRID_BAR();
    }
    if (IN(6)) REP(6) {
        attn_phase(lds, (const h16*)(ws + WS_XH), (const h16*)(ws + WS_KM), (const h16*)(ws + WS_VTM), (h16*)(ws + WS_OG), G, bx);
        if (BOTH(6)) GRID_BAR();
    }
    if (IN(7)) {
        { pg8::StaticOrder S; S.init(ws + WS_OG, ws + WS_WSM + 4 * 2097152, NTOK, DM, DM, G, bx);
          EpiResid E{p.out, p.out, (h16*)(ws + WS_V), (float*)(ws + OFF_SS2), true};
          pg8::gemm_phase<EpiResid, pg8::StaticOrder, false, false>(lds, DM, S, E); }
        if (BOTH(7)) GRID_BAR();
    }
    if (IN(8)) REP(8) {
        PH_IDS();
        if (rep_ == 1) { GRID_BAR(); if (bx == 0 && tid < 32) (ctl + CW_CNT)[tid] = 0u; GRID_BAR(); }
        unsigned* cnt = ctl + CW_CNT; int* list = (int*)(ws + OFF_LIST); float* gate = (float*)(ws + OFF_GATE);
        const float* ss2 = (const float*)(ws + OFF_SS2); const float* WRT = (const float*)(ws + OFF_WRT);
        const bool b5 = (lane & 32) != 0, b4 = (lane & 16) != 0, b3 = (lane & 8) != 0;
        int myE = 0, mySlot = 0; float myG = 0.f; int nmine = 0;
        f32x4 xn[4]; float ssc = 1.f;
        if (gw < NTOK) { ssc = ss2[gw];
#pragma unroll
            for (int j = 0; j < 4; ++j) xn[j] = ((const GAS f32x4*)(p.out + (size_t)gw * DM) + lane)[64 * j]; }
        for (int t = gw; t < NTOK; t += NGW) {
            const int tn = (t + NGW < NTOK) ? t + NGW : t; const GAS f32x4* xr = (const GAS f32x4*)(p.out + (size_t)tn * DM) + lane; const float rs = rsqrtf(ssc * (1.f / DM) + EPS);
            f32x4 v[4];
#pragma unroll
            for (int j = 0; j < 4; ++j) { v[j] = xn[j] * rs; xn[j] = xr[64 * j]; }
            ssc = ss2[tn];
            float a0 = 0.f, a1 = 0.f, a2 = 0.f, a3 = 0.f;
            { f32x4 wv[16];
#pragma unroll
              for (int j = 0; j < 4; ++j) { const GAS f32x4* wp = (const GAS f32x4*)WRT + 64 * j + lane; wv[4 * j] = wp[0]; wv[4 * j + 1] = wp[256]; wv[4 * j + 2] = wp[512]; wv[4 * j + 3] = wp[768]; }
              asm volatile("" ::: "memory");
#pragma unroll
              for (int j = 0; j < 4; ++j) { const f32x4 w0 = wv[4 * j], w1 = wv[4 * j + 1], w2 = wv[4 * j + 2], w3 = wv[4 * j + 3];
                a0 += (v[j].x * w0.x + v[j].y * w0.y) + (v[j].z * w0.z + v[j].w * w0.w); a1 += (v[j].x * w1.x + v[j].y * w1.y) + (v[j].z * w1.z + v[j].w * w1.w);
                a2 += (v[j].x * w2.x + v[j].y * w2.y) + (v[j].z * w2.z + v[j].w * w2.w); a3 += (v[j].x * w3.x + v[j].y * w3.y) + (v[j].z * w3.z + v[j].w * w3.w); } }
            { const float s0 = b5 ? a0 : a2, s1 = b5 ? a1 : a3; float k0 = (b5 ? a2 : a0) + __shfl_xor(s0, 32), k1 = (b5 ? a3 : a1) + __shfl_xor(s1, 32);
              const float s2 = b4 ? k0 : k1; a0 = (b4 ? k1 : k0) + __shfl_xor(s2, 16); }
            a0 += __shfl_xor(a0, 8); a0 += __shfl_xor(a0, 4); a0 += __shfl_xor(a0, 2); a0 += __shfl_xor(a0, 1);
            float gl[4];
#pragma unroll
            for (int j = 0; j < 4; ++j) gl[j] = __builtin_bit_cast(float, __builtin_amdgcn_readlane(__builtin_bit_cast(int, a0), 16 * j)) + p.b_rg[j];
            int gi = 0; float gm = gl[0];
#pragma unroll
            for (int j = 1; j < 4; ++j) if (gl[j] > gm) { gm = gl[j]; gi = j; }
            float gs = 0.f;
#pragma unroll
            for (int j = 0; j < 4; ++j) gs += __expf(gl[j] - gm);
            const float pg = 1.f / gs;
            float e[8];
#pragma unroll
            for (int q = 0; q < 8; ++q) e[q] = 0.f;
            const GAS f32x4* we = (const GAS f32x4*)WRT + (size_t)(4 + gi * 8) * 256 + lane;
#pragma unroll
            for (int hq = 0; hq < 2; ++hq) { f32x4 wv[16];
#pragma unroll
                for (int q = 0; q < 4; ++q)
#pragma unroll
                    for (int j = 0; j < 4; ++j) wv[4 * q + j] = we[(4 * hq + q) * 256 + 64 * j];
                asm volatile("" ::: "memory");
#pragma unroll
                for (int q = 0; q < 4; ++q)
#pragma unroll
                    for (int j = 0; j < 4; ++j) { const f32x4 w = wv[4 * q + j]; e[4 * hq + q] += (v[j].x * w.x + v[j].y * w.y) + (v[j].z * w.z + v[j].w * w.w); } }
            float k4[4];
#pragma unroll
            for (int q = 0; q < 4; ++q) { const float snd = b5 ? e[q] : e[4 + q]; k4[q] = (b5 ? e[4 + q] : e[q]) + __shfl_xor(snd, 32); }
            float k2[2];
#pragma unroll
            for (int q = 0; q < 2; ++q) { const float snd = b4 ? k4[q] : k4[2 + q]; k2[q] = (b4 ? k4[2 + q] : k4[q]) + __shfl_xor(snd, 16); }
            float k1; { const float snd = b3 ? k2[0] : k2[1]; k1 = (b3 ? k2[1] : k2[0]) + __shfl_xor(snd, 8); }
            k1 += __shfl_xor(k1, 4); k1 += __shfl_xor(k1, 2); k1 += __shfl_xor(k1, 1);
            float ev[8];
#pragma unroll
            for (int q = 0; q < 8; ++q) ev[q] = __builtin_bit_cast(float, __builtin_amdgcn_readlane(__builtin_bit_cast(int, k1), 8 * q)) + p.b_re[gi * 8 + q];
            int i1 = 0; float v1 = ev[0];
#pragma unroll
            for (int q = 1; q < 8; ++q) if (ev[q] > v1) { v1 = ev[q]; i1 = q; }
            int i2 = -1; float v2 = -INFINITY;
#pragma unroll
            for (int q = 0; q < 8; ++q) if (q != i1 && ev[q] > v2) { v2 = ev[q]; i2 = q; }
            const float e2 = __expf(v2 - v1), g1 = pg / (1.f + e2), g2 = pg * e2 / (1.f + e2);
            if (lane == 2 * nmine) { myE = gi * 8 + i1; mySlot = 2 * t; myG = g1; }
            if (lane == 2 * nmine + 1) { myE = gi * 8 + i2; mySlot = 2 * t + 1; myG = g2; }
            ++nmine;
            if (nmine == 32) { { const unsigned pos = atomicAdd(cnt + myE, 1u); list[myE * NTOK + pos] = mySlot; gate[mySlot] = myG; } nmine = 0; }
        }
        if (lane < 2 * nmine) { const unsigned pos = atomicAdd(cnt + myE, 1u); list[myE * NTOK + pos] = mySlot; gate[mySlot] = myG; }
        if (BOTH(8)) GRID_BAR();
    }
    if (IN(9) || IN(10)) {
        PH_IDS();
        LAS int* tab = (LAS int*)(lds + LDSCTL_OFF + 1024);
        if (tid == 0) { const unsigned* cnt = ctl + CW_CNT; int s = 0; for (int e = 0; e < 32; ++e) { tab[e] = s; s += (int)((__hip_atomic_load(cnt + e, RLX_AGENT) + 255u) >> 8); } tab[32] = s; }
        __syncthreads();
        if (IN(9)) REP(9) {
            MoeOrder S{(const char*)(ws + WS_V), (const char*)(ws + WS_UG), DM, (size_t)1024 * 1024 * 2, (const int*)(ws + OFF_LIST), ctl + CW_CNT, tab, G, bx};
            EpiFfn1 E{(const int*)(ws + OFF_LIST), (const float*)(ws + OFF_SS2), (h16*)(ws + WS_H)};
            pg8::gemm_phase<EpiFfn1, MoeOrder, true, true>(lds, DM, S, E);
            if (BOTH(9)) GRID_BAR();
        }
        if (IN(10)) REP(10) {
            MoeOrder S{(const char*)(ws + WS_H), (const char*)(ws + WS_UG + 64 * MiB), FF, (size_t)1024 * 512 * 2, (const int*)(ws + OFF_LIST), ctl + CW_CNT, tab, G, bx};
            EpiFfn2 E{(const int*)(ws + OFF_LIST), (const float*)(ws + OFF_GATE), (h16*)(ws + WS_Y)};
            pg8::gemm_phase<EpiFfn2, MoeOrder, false, true>(lds, FF, S, E);
            if (BOTH(10)) GRID_BAR();
        }
    }
    if (IN(11)) REP(11) {
        PH_IDS();
        float* fdst = (((REPEAT_MASK >> 11) & 1) && rep_ == 0) ? (float*)(ws + WS_UG) : p.out;
        for (int t = gw; t < NTOK; t += NGW) {
            GAS f32x4* xr = (GAS f32x4*)(p.out + (size_t)t * DM) + lane; const GAS u32x2* y0 = (const GAS u32x2*)(ws + WS_Y + (size_t)(2 * t) * DM * 2) + lane; const GAS u32x2* y1 = y0 + DM / 4;
            f32x4 v[4]; float ss = 0.f;
#pragma unroll
            for (int j = 0; j < 4; ++j) { const u32x2 a = y0[64 * j], b = y1[64 * j]; const h16x4 ha = __builtin_bit_cast(h16x4, a), hb = __builtin_bit_cast(h16x4, b);
                v[j] = xr[64 * j];
#pragma unroll
                for (int c = 0; c < 4; ++c) { v[j][c] += (float)ha[c] + (float)hb[c]; ss += v[j][c] * v[j][c]; } }
            ss = wave_sum(ss); const float rs = rsqrtf(ss * (1.f / DM) + EPS);
#pragma unroll
            for (int j = 0; j < 4; ++j) { const f32x4 g = *(const f32x4*)(p.norm_f_g + 4 * (64 * j + lane)); ((GAS f32x4*)(fdst + (size_t)t * DM) + lane)[64 * j] = v[j] * rs * g; }
        }
    }
#undef IN
#undef BOTH
#undef GRID_BAR
}

static int mega_grid() {
    static int grid = 0;
    if (grid == 0) {
        int dev = 0, cus = 0;
        if (hipGetDevice(&dev) != hipSuccess || hipDeviceGetAttribute(&cus, hipDeviceAttributeMultiprocessorCount, dev) != hipSuccess) { grid = -1; return grid; }
        if (hipFuncSetAttribute((const void*)mega, hipFuncAttributeMaxDynamicSharedMemorySize, LDS_BYTES) != hipSuccess) { fprintf(stderr, "hipFuncSetAttribute failed\n"); grid = -1; return grid; }
        (void)hipGetLastError();
        grid = cus;
    }
    return grid;
}
static void launch_mega(const Ptrs& p, int lo, int hi, int li, hipStream_t stream) {
    const int grid = mega_grid(); if (grid <= 0) return;
    Args a{}; a.p = p; a.ph_lo = lo; a.ph_hi = hi; a.li = li; a.pad = 0;
    hipLaunchKernelGGL(mega, dim3(grid), dim3(NTHREADS), LDS_BYTES, stream, a);
}

extern "C" void kernel_launch(void* const* d_in, const int* in_sizes, int n_in, void* d_out, int out_size, void* d_ws, size_t ws_size, hipStream_t stream) {
    if (n_in != 27 || ws_size < WS_END) { fprintf(stderr, "kernel_launch: unexpected n_in %d or ws_size %zu (< %zu)\n", n_in, ws_size, (size_t)WS_END); return; }
    Ptrs p{};
    const float** f = (const float**)&p;
    for (int i = 0; i < 27; ++i) f[i] = (const float*)d_in[i];
    p.out = (float*)d_out; p.ws = (unsigned char*)d_ws;
    (void)hipMemsetAsync((char*)d_ws + WS_CTL, 0, CTL_BYTES, stream);
    launch_mega(p, 0, 12, 0, stream);
}
```

```cpp
#include <hip/hip_runtime.h>
#include <cstdio>
#include <cstdint>
#include <cmath>

typedef _Float16 h16;
typedef unsigned short u16;

constexpr int DM = 1024, NB = 2, SEQ = 8192, NTOK = NB * SEQ;
constexpr int NMEM = 256, NHEAD = 4, DH = 256, CHUNK = 128, NCHUNK = SEQ / CHUNK;
constexpr int IN_DIM = 8200;
constexpr int C_QK = 0, C_V = 2048, C_O = 3072, C_I = 4096, C_F = 4100, C_U = 4104, C_SV = 5128, C_G = 6152;
constexpr int NEXP = 32, NGRP = 4, EPG = 8, FF = 512, NSLOT = NTOK * 2;
constexpr float EPS = 1e-6f;

constexpr size_t MiB = 1u << 20;
constexpr size_t WS_CTL = 0;
constexpr size_t CTL_BYTES = 1 * MiB;
constexpr size_t WS_SMALL = 1 * MiB;
constexpr size_t OFF_RSTD0 = WS_SMALL;
constexpr size_t OFF_SSSV  = OFF_RSTD0 + 65536;
constexpr size_t OFF_SS1   = OFF_SSSV + 65536;
constexpr size_t OFF_SS2   = OFF_SS1 + 65536;
constexpr size_t OFF_IG    = OFF_SS2 + 65536;
constexpr size_t OFF_LF    = OFF_IG + 262144;
constexpr size_t OFF_MST   = OFF_LF + 262144;
constexpr size_t OFF_RSTDM = OFF_MST + 4096;
constexpr size_t OFF_AL    = 4 * MiB + 1048576;
constexpr size_t OFF_BE    = OFF_AL + 262144;
constexpr size_t OFF_NM    = OFF_BE + 262144;
constexpr size_t OFF_WU    = OFF_NM + 262144;
constexpr size_t OFF_DEC   = OFF_WU + 262144;
constexpr size_t OFF_WRT   = 7 * MiB;
constexpr size_t OFF_GATE  = 2 * MiB;
constexpr size_t OFF_SLOTE = OFF_GATE + 131072;
constexpr size_t OFF_SLOTP = OFF_SLOTE + 131072;
constexpr size_t OFF_LIST  = 3 * MiB;
constexpr size_t OFF_NAIVE_C = 262 * MiB;
constexpr size_t OFF_NAIVE_N = 6 * MiB + 8192;
constexpr size_t OFF_NAIVE_S = 6 * MiB + 65536;
constexpr size_t WS_WSM  = 8 * MiB;
constexpr size_t WS_KM   = 18 * MiB;
constexpr size_t WS_VTM  = 19 * MiB;
constexpr size_t WS_WIN  = 20 * MiB;
constexpr size_t WS_XH   = 36 * MiB;
constexpr size_t WS_V    = 68 * MiB;
constexpr size_t WS_OG   = 100 * MiB;
constexpr size_t WS_UG   = 132 * MiB;
constexpr size_t WS_SV   = 164 * MiB;
constexpr size_t WS_CST  = 196 * MiB;
constexpr size_t WS_H    = 228 * MiB;
constexpr size_t WS_NST  = 260 * MiB;
constexpr size_t WS_MEMH = 261 * MiB;
constexpr size_t WS_END  = 268 * MiB;
constexpr size_t WS_Y    = WS_XH;
constexpr size_t WS_QC   = WS_UG;
constexpr size_t WS_KC   = WS_SV;
static_assert(OFF_RSTDM + 4096 <= 2 * MiB && OFF_SLOTP + 131072 <= OFF_LIST && OFF_LIST + 2 * MiB <= OFF_AL && OFF_DEC + 4096 <= OFF_NAIVE_N && OFF_NAIVE_N + 8192 <= OFF_NAIVE_S && OFF_NAIVE_S + 524288 <= WS_WSM && OFF_NAIVE_C + 2 * MiB <= WS_END, "small map");
constexpr int CW_CNT = 64;

struct Ptrs {
    const float *x, *mem, *norm_mix_g, *w_in, *b_gate, *b_if, *conv_w, *conv_b, *mh_norm_g, *sgu_norm_g, *w_s, *b_s, *w_out,
                *norm_x_g, *norm_mem_g, *w_xq, *w_xkv, *w_xo, *norm_moe_g, *w_rg, *b_rg, *w_re, *b_re, *w1, *w3, *w2, *norm_f_g;
    float* out; unsigned char* ws;
};

__device__ __forceinline__ float sigmoidf_(float v) { return 1.f / (1.f + __expf(-v)); }
__device__ __forceinline__ float siluf_(float v) { return v / (1.f + __expf(-v)); }
__device__ __forceinline__ float gelu_tanh(float v) { const float u = 0.7978845608028654f * (v + 0.044715f * v * v * v); return v / (1.f + __expf(-2.f * u)); }
__device__ __forceinline__ float logsigmoidf_(float v) { return fminf(v, 0.f) - log1pf(__expf(-fabsf(v))); }
__device__ __forceinline__ float wave_sum(float v) {
#pragma unroll
    for (int o = 1; o < 64; o <<= 1) v += __shfl_xor(v, o);
    return v;
}
__device__ __forceinline__ float wave_max(float v) {
#pragma unroll
    for (int o = 1; o < 64; o <<= 1) v = fmaxf(v, __shfl_xor(v, o));
    return v;
}
__host__ __device__ __forceinline__ int vt_slot(int key) { const int g = key & ~15, r = key & 15;   const int hh = (r >> 2) & 1, j = ((r >> 3) << 2) | (r & 3); return g + 8 * hh + j; }

__global__ void nk_zero(Ptrs p) {
    float* a = (float*)(p.ws + OFF_SSSV);
    const int i = blockIdx.x * blockDim.x + threadIdx.x;
    if (i < 3 * NTOK) a[i] = 0.f;
}
__global__ void nk_rows0(Ptrs p) {
    const int row = blockIdx.x * 4 + (threadIdx.x >> 6), lane = threadIdx.x & 63;
    const float* xr = p.x + (size_t)row * DM;
    float ss = 0.f; float acc[8];
#pragma unroll
    for (int j = 0; j < 8; ++j) acc[j] = 0.f;
    h16* xh = (h16*)(p.ws + WS_XH) + (size_t)row * DM;
    for (int k = lane; k < DM; k += 64) {
        const float v = xr[k]; ss += v * v; xh[k] = (h16)v;
        const float vg = v * p.norm_mix_g[k];
#pragma unroll
        for (int j = 0; j < 8; ++j) acc[j] += vg * p.w_in[(size_t)k * IN_DIM + C_I + j];
    }
    ss = wave_sum(ss);
    const float rstd = rsqrtf(ss / DM + EPS);
#pragma unroll
    for (int j = 0; j < 8; ++j) acc[j] = wave_sum(acc[j]);
    if (lane == 0) {
        ((float*)(p.ws + OFF_RSTD0))[row] = rstd;
        float* ig = (float*)(p.ws + OFF_IG) + row * 4; float* lf = (float*)(p.ws + OFF_LF) + row * 4;
#pragma unroll
        for (int h = 0; h < 4; ++h) { ig[h] = acc[h] * rstd + p.b_if[h]; lf[h] = logsigmoidf_(acc[4 + h] * rstd + p.b_if[4 + h]); }
    }
}
__global__ void nk_mem(Ptrs p) {
    const int row = blockIdx.x * 4 + (threadIdx.x >> 6), lane = threadIdx.x & 63;
    const float* xr = p.mem + (size_t)row * DM; h16* o = (h16*)(p.ws + WS_MEMH) + (size_t)row * DM;
    float ss = 0.f;
    for (int k = lane; k < DM; k += 64) { const float v = xr[k]; ss += v * v; o[k] = (h16)v; }
    ss = wave_sum(ss);
    if (lane == 0) ((float*)(p.ws + OFF_RSTDM))[row] = rsqrtf(ss / DM + EPS);
}
__global__ void nk_mstate(Ptrs p) {
    const int bh = blockIdx.x, b = bh >> 2, h = bh & 3, lane = threadIdx.x;
    const float* ig = (const float*)(p.ws + OFF_IG); const float* lf = (const float*)(p.ws + OFF_LF);
    float B = 0.f, mx = -INFINITY;
    for (int s = 0; s < CHUNK; ++s) { const int t = b * SEQ + lane * CHUNK + s; B += lf[t * 4 + h]; mx = fmaxf(mx, ig[t * 4 + h] - B); }
    const float blast = B, maxw = B + mx;
    __shared__ float sb[64], sm[64];
    sb[lane] = blast; sm[lane] = maxw; __syncthreads();
    if (lane == 0) { float m = 0.f; float* mst = (float*)(p.ws + OFF_MST) + bh * 64;
        for (int c = 0; c < NCHUNK; ++c) { mst[c] = m; m = fmaxf(sb[c] + m, sm[c]); } }
}
__global__ void nk_proj(Ptrs p) {
    const int l = blockIdx.x * 256 + threadIdx.x;
    const int r0 = blockIdx.y * 8;
    int c0, c1 = -1, kind;
    if (l < 2048) { c0 = C_QK + l; kind = 0; }
    else if (l < 3072) { c0 = C_V + (l - 2048); kind = 1; }
    else if (l < 4096) { c0 = C_O + (l - 3072); c1 = C_G + (l - 3072); kind = 2; }
    else if (l < 5120) { c0 = C_U + (l - 4096); c1 = C_G + 1024 + (l - 4096); kind = 3; }
    else if (l < 6144) { c0 = C_SV + (l - 5120); kind = 4; }
    else return;
    float a0[8], a1[8];
#pragma unroll
    for (int r = 0; r < 8; ++r) { a0[r] = 0.f; a1[r] = 0.f; }
    for (int k = 0; k < DM; ++k) {
        const float g = p.norm_mix_g[k];
        const float w0 = p.w_in[(size_t)k * IN_DIM + c0] * g;
        const float w1 = (c1 >= 0) ? p.w_in[(size_t)k * IN_DIM + c1] * g : 0.f;
#pragma unroll
        for (int r = 0; r < 8; ++r) { const float xv = p.x[(size_t)(r0 + r) * DM + k]; a0[r] += xv * w0; a1[r] += xv * w1; }
    }
    const float* rstd0 = (const float*)(p.ws + OFF_RSTD0);
#pragma unroll
    for (int r = 0; r < 8; ++r) {
        const int t = r0 + r; const float rs = rstd0[t]; const float v0 = a0[r] * rs, v1 = a1[r] * rs;
        if (kind == 0) ((h16*)p.out)[(size_t)t * 2048 + l] = (h16)v0;
        else if (kind == 1) ((h16*)(p.ws + WS_V))[(size_t)t * DM + (l - 2048)] = (h16)v0;
        else if (kind == 2) { const int c = l - 3072; ((h16*)(p.ws + WS_OG))[(size_t)t * DM + c] = (h16)(sigmoidf_(v0) * sigmoidf_(v1 + p.b_gate[c])); }
        else if (kind == 3) { const int c = l - 4096; ((h16*)(p.ws + WS_UG))[(size_t)t * DM + c] = (h16)(gelu_tanh(v0) * sigmoidf_(v1 + p.b_gate[1024 + c])); }
        else { const int c = l - 5120; const float gv = gelu_tanh(v0); ((h16*)(p.ws + WS_SV))[(size_t)t * DM + c] = (h16)gv; atomicAdd((float*)(p.ws + OFF_SSSV) + t, gv * gv); }
    }
}
__global__ void nk_conv(Ptrs p) {
    const size_t i = (size_t)blockIdx.x * 256 + threadIdx.x; const int t = (int)(i >> 11), c = (int)(i & 2047), tl = t & (SEQ - 1);
    const h16* qk = (const h16*)p.out;
    float a = p.conv_b[c];
#pragma unroll
    for (int j = 0; j < 4; ++j) { const int dt = j - 3; if (tl + dt >= 0) a += p.conv_w[j * 2048 + c] * (float)qk[(size_t)(t + dt) * 2048 + c]; }
    a = siluf_(a);
    if (c < 1024) ((h16*)(p.ws + WS_QC))[(size_t)t * DM + c] = (h16)a; else ((h16*)(p.ws + WS_KC))[(size_t)t * DM + (c - 1024)] = (h16)(a * 0.0625f);
}
__global__ void __launch_bounds__(1024) nk_mlstm(Ptrs p) {
    const int bh = blockIdx.x, b = bh >> 2, hd = bh & 3, tid = threadIdx.x;
    const h16* Qc = (const h16*)(p.ws + WS_QC); const h16* Kc = (const h16*)(p.ws + WS_KC); const h16* V = (const h16*)(p.ws + WS_V);
    float* C = (float*)(p.ws + OFF_NAIVE_C) + (size_t)bh * 65536; float* nvec = (float*)(p.ws + OFF_NAIVE_N) + bh * 256; float* Sp = (float*)(p.ws + OFF_NAIVE_S) + (size_t)bh * 16384;
    const float* ig = (const float*)(p.ws + OFF_IG); const float* lf = (const float*)(p.ws + OFF_LF);
    float* Hout = p.out;
    __shared__ float s_b[128], s_ic[128], s_mt[128], s_iw[128], s_ws[128], s_misc[4];
    for (int i = tid; i < 65536; i += 1024) C[i] = 0.f;
    if (tid < 256) nvec[tid] = 0.f;
    float m = 0.f;
    __syncthreads();
    for (int c = 0; c < NCHUNK; ++c) {
        const int t0 = b * SEQ + c * CHUNK;
        if (tid == 0) { float B = 0.f; for (int s = 0; s < CHUNK; ++s) { B += lf[(t0 + s) * 4 + hd]; s_b[s] = B; s_ic[s] = ig[(t0 + s) * 4 + hd]; } }
        __syncthreads();
        if (tid < 128) { const int t = tid; float mx = s_b[t] + m; for (int s = 0; s <= t; ++s) mx = fmaxf(mx, s_b[t] - s_b[s] + s_ic[s]); s_mt[t] = mx; s_iw[t] = __expf(s_b[t] + m - mx); }
        if (tid == 128) { const float bl = s_b[127]; float mx = bl + m; for (int s = 0; s < CHUNK; ++s) mx = fmaxf(mx, bl - s_b[s] + s_ic[s]); s_misc[0] = mx; s_misc[1] = __expf(bl + m - mx); }
        __syncthreads();
        if (tid < 128) s_ws[tid] = __expf(s_b[127] - s_b[tid] + s_ic[tid] - s_misc[0]);
        for (int i = tid; i < 16384; i += 1024) { const int t = i >> 7, s = i & 127; float v = 0.f;
            if (s <= t) { float d = 0.f; const h16* q = Qc + (size_t)(t0 + t) * DM + hd * DH; const h16* k = Kc + (size_t)(t0 + s) * DM + hd * DH;
                for (int e = 0; e < DH; ++e) d += (float)q[e] * (float)k[e];
                v = d * __expf(s_b[t] - s_b[s] + s_ic[s] - s_mt[t]); }
            Sp[i] = v; }
        __threadfence_block(); __syncthreads();
        for (int i = tid; i < 32768; i += 1024) { const int t = i >> 8, e = i & 255; float num = 0.f, den = 0.f;
            for (int s = 0; s <= t; ++s) { const float sv = Sp[t * 128 + s]; num += sv * (float)V[(size_t)(t0 + s) * DM + hd * DH + e]; den += sv; }
            float qc = 0.f, qn = 0.f; const h16* q = Qc + (size_t)(t0 + t) * DM + hd * DH;
            for (int d = 0; d < DH; ++d) { const float qv = (float)q[d]; qc += qv * C[d * 256 + e]; qn += qv * nvec[d]; }
            num += s_iw[t] * qc; den += s_iw[t] * qn;
            Hout[(size_t)(t0 + t) * DM + hd * DH + e] = num / fmaxf(fabsf(den), __expf(-s_mt[t])); }
        __syncthreads();
        const float decay = s_misc[1];
        for (int i = tid; i < 65536; i += 1024) { const int d = i >> 8, e = i & 255; float a = 0.f;
            for (int s = 0; s < CHUNK; ++s) a += s_ws[s] * (float)Kc[(size_t)(t0 + s) * DM + hd * DH + d] * (float)V[(size_t)(t0 + s) * DM + hd * DH + e];
            C[i] = decay * C[i] + a; }
        if (tid < 256) { float a = 0.f; for (int s = 0; s < CHUNK; ++s) a += s_ws[s] * (float)Kc[(size_t)(t0 + s) * DM + hd * DH + tid]; nvec[tid] = decay * nvec[tid] + a; }
        m = s_misc[0];
        __threadfence_block(); __syncthreads();
    }
}

__global__ void __launch_bounds__(1024) nk_mout(Ptrs p) {
    const int bh = blockIdx.x >> 6, c = blockIdx.x & 63, b = bh >> 2, hd = bh & 3, tid = threadIdx.x, t0 = b * SEQ + c * CHUNK;
    const h16* Qc = (const h16*)(p.ws + WS_QC); const h16* Kc = (const h16*)(p.ws + WS_KC); const h16* V = (const h16*)(p.ws + WS_V);
    const h16* Ct = (const h16*)(p.ws + WS_CST) + ((size_t)(bh * 64 + c)) * 65536; const float* nst = (const float*)(p.ws + WS_NST) + (size_t)(bh * 64 + c) * 256;
    const float* AL = (const float*)(p.ws + OFF_AL); const float* BE = (const float*)(p.ws + OFF_BE); const float* NM = (const float*)(p.ws + OFF_NM);
    const float mc = ((const float*)(p.ws + OFF_MST))[bh * 64 + c];
    __shared__ h16 Sp[128 * 128];
    for (int i = tid; i < 16384; i += 1024) { const int t = i >> 7, s = i & 127; float v = 0.f;
        if (s <= t) { float d = 0.f; const h16* q = Qc + (size_t)(t0 + t) * DM + hd * DH; const h16* k = Kc + (size_t)(t0 + s) * DM + hd * DH;
            for (int e = 0; e < DH; ++e) d += (float)q[e] * (float)k[e];
            v = d * __expf(AL[(t0 + t) * 4 + hd] + BE[(t0 + s) * 4 + hd]); }
        Sp[i] = (h16)v; }
    __syncthreads();
    for (int i = tid; i < 32768; i += 1024) { const int t = i >> 8, e = i & 255; float num = 0.f, den = 0.f;
        for (int s = 0; s <= t; ++s) { const float sv = (float)Sp[t * 128 + s]; num += sv * (float)V[(size_t)(t0 + s) * DM + hd * DH + e]; den += sv; }
        float qc = 0.f, qn = 0.f; const h16* q = Qc + (size_t)(t0 + t) * DM + hd * DH;
        for (int d = 0; d < DH; ++d) { const float qv = (float)q[d]; qc += qv * (float)Ct[e * 256 + d]; qn += qv * nst[d]; }
        const float iw = __expf(AL[(t0 + t) * 4 + hd] + mc);
        num += iw * qc; den += iw * qn;
        p.out[(size_t)(t0 + t) * DM + hd * DH + e] = num / fmaxf(fabsf(den), __expf(NM[(t0 + t) * 4 + hd])); }
}
__global__ void nk_sgu(Ptrs p) {
    const size_t i = (size_t)blockIdx.x * 256 + threadIdx.x; const int t = (int)(i >> 10), ch = (int)(i & 1023), g = ch >> 7, tl = t & 127, t0 = t - tl;
    const h16* SV = (const h16*)(p.ws + WS_SV); const float* ss = (const float*)(p.ws + OFF_SSSV);
    float a = 0.f;
    for (int s = 0; s <= tl; ++s) a += p.w_s[(g * 128 + tl) * 128 + s] * (float)SV[(size_t)(t0 + s) * DM + ch] * rsqrtf(ss[t0 + s] / DM + EPS);
    a = a * p.sgu_norm_g[ch] + p.b_s[g * 128 + tl];
    ((h16*)(p.ws + WS_XH))[i] = (h16)((float)((const h16*)(p.ws + WS_UG))[i] * a);
}
__global__ void nk_ya(Ptrs p) {
    const int w = blockIdx.x * 4 + (threadIdx.x >> 6), lane = threadIdx.x & 63, t = w >> 2, hd = w & 3;
    const float* hrow = p.out + (size_t)t * DM + hd * DH; float v[4]; float ss = 0.f;
#pragma unroll
    for (int j = 0; j < 4; ++j) { v[j] = hrow[lane + 64 * j]; ss += v[j] * v[j]; }
    ss = wave_sum(ss); const float rs = rsqrtf(ss / DH + EPS);
    h16* Z = (h16*)(p.ws + WS_XH) + (size_t)t * DM + hd * DH; const h16* OG = (const h16*)(p.ws + WS_OG) + (size_t)t * DM + hd * DH;
#pragma unroll
    for (int j = 0; j < 4; ++j) { const int e = lane + 64 * j; Z[e] = (h16)((float)Z[e] + v[j] * rs * p.mh_norm_g[hd * DH + e] * (float)OG[e]); }
}
__global__ void nk_wout(Ptrs p) {
    const int c = blockIdx.x * 256 + threadIdx.x, r0 = blockIdx.y * 8;
    const h16* Z = (const h16*)(p.ws + WS_XH);
    float a[8];
#pragma unroll
    for (int r = 0; r < 8; ++r) a[r] = 0.f;
    for (int k = 0; k < DM; ++k) { const float w = p.w_out[(size_t)k * DM + c];
#pragma unroll
        for (int r = 0; r < 8; ++r) a[r] += (float)Z[(size_t)(r0 + r) * DM + k] * w; }
#pragma unroll
    for (int r = 0; r < 8; ++r) { const int t = r0 + r; const float v = p.x[(size_t)t * DM + c] + a[r]; p.out[(size_t)t * DM + c] = v; ((h16*)(p.ws + WS_V))[(size_t)t * DM + c] = (h16)v;
        atomicAdd((float*)(p.ws + OFF_SS1) + t, v * v); }
}
__global__ void nk_q(Ptrs p) {
    const int c = blockIdx.x * 256 + threadIdx.x, r0 = blockIdx.y * 8;
    float a[8];
#pragma unroll
    for (int r = 0; r < 8; ++r) a[r] = 0.f;
    for (int k = 0; k < DM; ++k) { const float w = p.w_xq[(size_t)k * DM + c] * p.norm_x_g[k];
#pragma unroll
        for (int r = 0; r < 8; ++r) a[r] += p.out[(size_t)(r0 + r) * DM + k] * w; }
    const float* ss1 = (const float*)(p.ws + OFF_SS1);
#pragma unroll
    for (int r = 0; r < 8; ++r) { const int t = r0 + r; ((h16*)(p.ws + WS_XH))[(size_t)t * DM + c] = (h16)(a[r] * rsqrtf(ss1[t] / DM + EPS) * 0.0625f); }
}
__global__ void nk_kv(Ptrs p) {
    const int c = blockIdx.x * 256 + threadIdx.x, r0 = blockIdx.y * 8;
    float a[8];
#pragma unroll
    for (int r = 0; r < 8; ++r) a[r] = 0.f;
    for (int k = 0; k < DM; ++k) { const float w = p.w_xkv[(size_t)k * 2048 + c] * p.norm_mem_g[k];
#pragma unroll
        for (int r = 0; r < 8; ++r) a[r] += p.mem[(size_t)(r0 + r) * DM + k] * w; }
    const float* rm = (const float*)(p.ws + OFF_RSTDM);
#pragma unroll
    for (int r = 0; r < 8; ++r) { const int m = r0 + r; const float v = a[r] * rm[m];
        if (c < 1024) ((h16*)(p.ws + WS_KM))[(size_t)m * DM + c] = (h16)v;
        else ((h16*)(p.ws + WS_VTM))[(size_t)m * DM + (c - 1024)] = (h16)v; }
}
__global__ void nk_attn(Ptrs p) {
    const int t = blockIdx.x >> 2, hd = blockIdx.x & 3, b = t / SEQ, j = threadIdx.x;
    const h16* q = (const h16*)(p.ws + WS_XH) + (size_t)t * DM + hd * DH;
    const h16* K = (const h16*)(p.ws + WS_KM) + (size_t)(b * 256 + j) * DM + hd * DH;
    __shared__ float sp[256], red[8];
    float s = 0.f;
    for (int d = 0; d < DH; ++d) s += (float)q[d] * (float)K[d];
    float mx = wave_max(s); if ((j & 63) == 0) red[j >> 6] = mx; __syncthreads();
    mx = fmaxf(fmaxf(red[0], red[1]), fmaxf(red[2], red[3]));
    const float e = __expf(s - mx); sp[j] = e;
    float sm = wave_sum(e); if ((j & 63) == 0) red[4 + (j >> 6)] = sm; __syncthreads();
    sm = red[4] + red[5] + red[6] + red[7];
    const h16* VT = (const h16*)(p.ws + WS_VTM) + (size_t)(b * 256) * DM + hd * DH + j;
    float o = 0.f;
    for (int key = 0; key < 256; ++key) o += sp[key] * (float)VT[(size_t)key * DM];
    ((h16*)(p.ws + WS_OG))[(size_t)t * DM + hd * DH + j] = (h16)(o / sm);
}
__global__ void nk_wxo(Ptrs p) {
    const int c = blockIdx.x * 256 + threadIdx.x, r0 = blockIdx.y * 8;
    const h16* A = (const h16*)(p.ws + WS_OG);
    float a[8];
#pragma unroll
    for (int r = 0; r < 8; ++r) a[r] = 0.f;
    for (int k = 0; k < DM; ++k) { const float w = p.w_xo[(size_t)k * DM + c];
#pragma unroll
        for (int r = 0; r < 8; ++r) a[r] += (float)A[(size_t)(r0 + r) * DM + k] * w; }
#pragma unroll
    for (int r = 0; r < 8; ++r) { const int t = r0 + r; const float v = p.out[(size_t)t * DM + c] + a[r]; p.out[(size_t)t * DM + c] = v; ((h16*)(p.ws + WS_V))[(size_t)t * DM + c] = (h16)v;
        atomicAdd((float*)(p.ws + OFF_SS2) + t, v * v); }
}
__global__ void nk_router(Ptrs p) {
    const int t = blockIdx.x * 4 + (threadIdx.x >> 6), lane = threadIdx.x & 63;
    const float* xr = p.out + (size_t)t * DM; const float rs = rsqrtf(((const float*)(p.ws + OFF_SS2))[t] / DM + EPS);
    float acc[36];
#pragma unroll
    for (int j = 0; j < 36; ++j) acc[j] = 0.f;
    for (int k = lane; k < DM; k += 64) { const float v = xr[k] * rs * p.norm_moe_g[k];
#pragma unroll
        for (int j = 0; j < 4; ++j) acc[j] += v * p.w_rg[k * 4 + j];
#pragma unroll
        for (int j = 0; j < 32; ++j) acc[4 + j] += v * p.w_re[k * 32 + j]; }
#pragma unroll
    for (int j = 0; j < 36; ++j) acc[j] = wave_sum(acc[j]);
    if (lane == 0) {
        float gl[4]; int gi = 0;
#pragma unroll
        for (int j = 0; j < 4; ++j) gl[j] = acc[j] + p.b_rg[j];
        float gm = gl[0];
#pragma unroll
        for (int j = 1; j < 4; ++j) if (gl[j] > gm) { gm = gl[j]; gi = j; }
        float gs = 0.f;
#pragma unroll
        for (int j = 0; j < 4; ++j) gs += __expf(gl[j] - gm);
        float ev[8];
#pragma unroll
        for (int j = 0; j < 8; ++j) { float v = acc[4 + j] + p.b_re[j];
#pragma unroll
            for (int g = 1; g < 4; ++g) v = (gi == g) ? acc[4 + g * 8 + j] + p.b_re[g * 8 + j] : v;
            ev[j] = v; }
        float pg = 0.f;
#pragma unroll
        for (int j = 0; j < 4; ++j) pg = (gi == j) ? __expf(gl[j] - gm) / gs : pg;
        int i1 = 0; float v1 = ev[0];
#pragma unroll
        for (int j = 1; j < 8; ++j) if (ev[j] > v1) { v1 = ev[j]; i1 = j; }
        int i2 = -1; float v2 = -INFINITY;
#pragma unroll
        for (int j = 0; j < 8; ++j) if (j != i1 && ev[j] > v2) { v2 = ev[j]; i2 = j; }
        const float e2 = __expf(v2 - v1), g1 = pg / (1.f + e2), g2 = pg * e2 / (1.f + e2);
        unsigned* cnt = (unsigned*)(p.ws + WS_CTL) + CW_CNT;
        int* list = (int*)(p.ws + OFF_LIST); float* gate = (float*)(p.ws + OFF_GATE); int* se = (int*)(p.ws + OFF_SLOTE); int* sp = (int*)(p.ws + OFF_SLOTP);
        const int e1x = gi * 8 + i1, e2x = gi * 8 + i2;
        const unsigned p1 = atomicAdd(cnt + e1x, 1u); list[e1x * NTOK + p1] = t * 2; gate[t * 2] = g1; se[t * 2] = e1x; sp[t * 2] = (int)p1;
        const unsigned p2 = atomicAdd(cnt + e2x, 1u); list[e2x * NTOK + p2] = t * 2 + 1; gate[t * 2 + 1] = g2; se[t * 2 + 1] = e2x; sp[t * 2 + 1] = (int)p2;
    }
}
__device__ __forceinline__ int moe_pstart(const unsigned* cnt, int e) { int s = 0; for (int i = 0; i < e; ++i) s += (int)((cnt[i] + 255u) & ~255u); return s; }
__global__ void nk_ffn1(Ptrs p) {
    const int f = blockIdx.x * 256 + threadIdx.x, s0 = blockIdx.y * 8;
    const unsigned* cnt = (const unsigned*)(p.ws + WS_CTL) + CW_CNT; const int* se = (const int*)(p.ws + OFF_SLOTE); const int* sp = (const int*)(p.ws + OFF_SLOTP);
    const float* ss2 = (const float*)(p.ws + OFF_SS2);
    for (int r = 0; r < 8; ++r) { const int slot = s0 + r, tok = slot >> 1, e = se[slot];
        const float* xr = p.out + (size_t)tok * DM; float a1 = 0.f, a3 = 0.f;
        const float* W1 = p.w1 + (size_t)e * DM * FF; const float* W3 = p.w3 + (size_t)e * DM * FF;
        for (int k = 0; k < DM; ++k) { const float v = xr[k] * p.norm_moe_g[k]; a1 += v * W1[(size_t)k * FF + f]; a3 += v * W3[(size_t)k * FF + f]; }
        const float rs = rsqrtf(ss2[tok] / DM + EPS); a1 *= rs; a3 *= rs;
        const int prow = moe_pstart(cnt, e) + sp[slot];
        ((h16*)(p.ws + WS_H))[(size_t)prow * FF + f] = (h16)(siluf_(a1) * a3); }
}
__global__ void nk_ffn2(Ptrs p) {
    const int c = blockIdx.x * 256 + threadIdx.x, s0 = blockIdx.y * 8;
    const unsigned* cnt = (const unsigned*)(p.ws + WS_CTL) + CW_CNT; const int* se = (const int*)(p.ws + OFF_SLOTE); const int* sp = (const int*)(p.ws + OFF_SLOTP);
    const float* gate = (const float*)(p.ws + OFF_GATE);
    for (int r = 0; r < 8; ++r) { const int slot = s0 + r, e = se[slot]; const int prow = moe_pstart(cnt, e) + sp[slot];
        const h16* hr = (const h16*)(p.ws + WS_H) + (size_t)prow * FF; const float* W2 = p.w2 + (size_t)e * FF * DM; float a = 0.f;
        for (int k = 0; k < FF; ++k) a += (float)hr[k] * W2[(size_t)k * DM + c];
        ((h16*)(p.ws + WS_Y))[(size_t)slot * DM + c] = (h16)(a * gate[slot]); }
}
__global__ void nk_final(Ptrs p) {
    const int t = blockIdx.x * 4 + (threadIdx.x >> 6), lane = threadIdx.x & 63;
    float* xr = p.out + (size_t)t * DM; const h16* y0 = (const h16*)(p.ws + WS_Y) + (size_t)(2 * t) * DM; const h16* y1 = y0 + DM;
    float v[16]; float ss = 0.f;
#pragma unroll
    for (int j = 0; j < 16; ++j) { const int k = lane + 64 * j; v[j] = xr[k] + (float)y0[k] + (float)y1[k]; ss += v[j] * v[j]; }
    ss = wave_sum(ss); const float rs = rsqrtf(ss / DM + EPS);
#pragma unroll
    for (int j = 0; j < 16; ++j) { const int k = lane + 64 * j; xr[k] = v[j] * rs * p.norm_f_g[k]; }
}

#define LAS __attribute__((address_space(3)))
#define GAS __attribute__((address_space(1)))
typedef _Float16 h16x8 __attribute__((ext_vector_type(8)));
typedef _Float16 h16x4 __attribute__((ext_vector_type(4)));
typedef _Float16 h16x2 __attribute__((ext_vector_type(2)));
typedef float f32x4 __attribute__((ext_vector_type(4)));
typedef float f32x2 __attribute__((ext_vector_type(2)));
typedef unsigned u32x4 __attribute__((ext_vector_type(4)));
typedef unsigned u32x2 __attribute__((ext_vector_type(2)));
typedef GAS unsigned gu32;
#define RLX_AGENT __ATOMIC_RELAXED, __HIP_MEMORY_SCOPE_AGENT
#define LDS_WAIT() asm volatile("s_waitcnt lgkmcnt(0)" ::: "memory")
#define VM_WAIT() asm volatile("s_waitcnt vmcnt(0)" ::: "memory")
__device__ __forceinline__ unsigned pk_h2(float lo, float hi) { f32x2 v = {lo, hi}; return __builtin_bit_cast(unsigned, __builtin_convertvector(v, h16x2)); }
__device__ __forceinline__ u32x4 pk_h8(f32x4 a, f32x4 b) { u32x4 w; w.x = pk_h2(a[0], a[1]); w.y = pk_h2(a[2], a[3]); w.z = pk_h2(b[0], b[1]); w.w = pk_h2(b[2], b[3]); return w; }
__device__ __forceinline__ float fsigmoid(float v) { return __builtin_amdgcn_rcpf(1.f + __expf(-v)); }
__device__ __forceinline__ float fgelu(float v) { const float u = 1.5957691216057308f * (v + 0.044715f * v * v * v); return v * __builtin_amdgcn_rcpf(1.f + __expf(-u)); }
__device__ __forceinline__ float fsilu(float v) { return v * __builtin_amdgcn_rcpf(1.f + __expf(-v)); }

constexpr int NWAVES = 8, NTHREADS = 512;
constexpr int RING_BYTES = 143360, LDSCTL_OFF = RING_BYTES, MISC_OFF = LDSCTL_OFF + 320, LDS_BYTES = 147456;
constexpr int CW_TMO = 0, CW_BAR = 4096;

#define XB_TMO      128
#define XB_XCNT(j)  (256  + 64 * (j))
#define XB_XSUB(j)  (1280 + 64 * (j))
#define XB_XGEN(j)  (2304 + 64 * (j))
#define XB_TOP      3328
#define XB_TOPGEN   3392
#define XCD_BAR_WORDS 3456
#define XB_SPIN_CAP (1u << 20)
__device__ __forceinline__ unsigned xb_ld(unsigned* p)              { return __hip_atomic_load(p, __ATOMIC_RELAXED, __HIP_MEMORY_SCOPE_AGENT); }
__device__ __forceinline__ unsigned xb_add(unsigned* p, unsigned v) { return __hip_atomic_fetch_add(p, v, __ATOMIC_RELAXED, __HIP_MEMORY_SCOPE_AGENT); }
__device__ __forceinline__ unsigned xb_xcc_id() { return (unsigned)__builtin_amdgcn_s_getreg((3 << 11) | 20) & 0xFu; }
#define XB_SPIN(cond, bar) do { unsigned _sp = 0; while (cond) { __builtin_amdgcn_s_sleep(1); \
    if ((++_sp & 255u) == 0u) { if (xb_ld(&(bar)[XB_TMO])) break; if (_sp > XB_SPIN_CAP) { atomicAdd(&(bar)[XB_TMO], 1u); break; } } } } while (0)
struct XcdBarrier { unsigned* bar; unsigned x; volatile LAS unsigned* st; };
__device__ __forceinline__ XcdBarrier xcd_barrier_post(unsigned* bar, volatile LAS unsigned* st) {
    XcdBarrier b; b.bar = bar; b.x = xb_xcc_id(); b.st = st;
    if (threadIdx.x == 0) (void)xb_add(&bar[XB_XCNT(b.x)], 1u);
    return b;
}
__device__ __forceinline__ void xcd_barrier_complete(unsigned* bar, unsigned x, unsigned& nloc, unsigned& nx) {
    const unsigned G = gridDim.x * gridDim.y * gridDim.z;
    unsigned sum, cnt, mine, sp = 0u;
    for (;;) {
        sum = 0u; cnt = 0u; mine = 0u;
#pragma unroll
        for (unsigned j = 0; j < 16; ++j) { const unsigned c = xb_ld(&bar[XB_XCNT(j)]); sum += c; cnt += (c > 0u) ? 1u : 0u; mine = (j == x) ? c : mine; }
        if (sum == G) break;
        __builtin_amdgcn_s_sleep(1);
        if ((++sp & 255u) == 0u) { if (xb_ld(&bar[XB_TMO])) break; if (sp > XB_SPIN_CAP) { atomicAdd(&bar[XB_TMO], 1u); break; } }
    }
    nloc = mine > 0u ? mine : 1u; nx = cnt > 0u ? cnt : 1u;
}
__device__ __forceinline__ void xcd_barrier(const XcdBarrier& b) {
    asm volatile("s_waitcnt vmcnt(0)" ::: "memory");
    __syncthreads();
    if (threadIdx.x == 0) {
        unsigned* bar = b.bar;
        __builtin_amdgcn_s_waitcnt(0);
        unsigned nloc = b.st[0], nx = b.st[1];
        if (nloc == 0u) { xcd_barrier_complete(bar, b.x, nloc, nx); b.st[0] = nloc; b.st[1] = nx; }
        const unsigned old = xb_add(&bar[XB_XSUB(b.x)], 1u);
        const unsigned gen = old / nloc;
        if (old + 1u == (gen + 1u) * nloc) {
            __builtin_amdgcn_fence(__ATOMIC_RELEASE, "agent");
            asm volatile("s_waitcnt vmcnt(0)" ::: "memory");
            const unsigned og = xb_add(&bar[XB_TOP], 1u);
            const unsigned tg = og / nx;
            if (og + 1u == (tg + 1u) * nx) xb_add(&bar[XB_TOPGEN], 1u);
            else XB_SPIN(xb_ld(&bar[XB_TOPGEN]) == tg, bar);
            __builtin_amdgcn_fence(__ATOMIC_ACQUIRE, "agent");
            xb_add(&bar[XB_XGEN(b.x)], 1u);
            asm volatile("s_waitcnt vmcnt(0)" ::: "memory");
        } else {
            XB_SPIN(xb_ld(&bar[XB_XGEN(b.x)]) == gen, bar);
            __builtin_amdgcn_fence(__ATOMIC_ACQUIRE, "agent");
            asm volatile("s_waitcnt vmcnt(0)" ::: "memory");
        }
    }
    __syncthreads();
}

namespace pg8 {
constexpr int BM = 256, BK = 64, HALF = 128, HTB = HALF * BK * 2, STAGE_BYTES = 8 * HTB, NXCD = 8, WGM = 8;
__host__ __device__ __forceinline__ int lds_byte(int r, int c) { const int st = (r >> 4) * 2 + (c >> 5), rr = r & 15, cc = c & 31, ob = rr * 64 + cc * 2; return st * 1024 + (ob ^ (((ob >> 9) & 1) << 5)); }
__host__ __device__ __forceinline__ void stage_rc(int b, int& R, int& C) { const int st = b / 1024, sb = b % 1024, swz = sb ^ (((sb >> 9) & 1) << 5); R = (st >> 1) * 16 + swz / 64; C = (st & 1) * 32 + (swz % 64) / 2; }
__host__ __device__ __forceinline__ int perm32(int rho) { const int n = rho >> 4, i = rho & 15; return 8 * (i >> 2) + 4 * n + (i & 3); }
struct Unit { int pm, pn, e, nv, rb; };
struct StaticOrder {
    const char* A; const char* Bt; int K; int nM, nN, nwg, G, c;
    __device__ __forceinline__ void init(const void* A_, const void* Bt_, int M, int N, int K_, int G_, int c_) { A = (const char*)A_; Bt = (const char*)Bt_; K = K_; nM = M / BM; nN = N / BM; nwg = nM * nN; G = G_; c = c_; }
    __device__ __forceinline__ bool next(int i, Unit& u) const {
        const long L = (long)i * G + c; if (L >= nwg) return false;
        int wgid = (int)L; { const int q = nwg / NXCD, r = nwg % NXCD, xcd = wgid % NXCD, off = wgid / NXCD; wgid = (xcd < r ? xcd * (q + 1) : r * (q + 1) + (xcd - r) * q) + off; }
        const int nig = WGM * nN, gid = wgid / nig, fm = gid * WGM, gsz = (nM - fm) < WGM ? (nM - fm) : WGM;
        u.pm = fm + ((wgid % nig) % gsz); u.pn = (wgid % nig) / gsz; u.e = 0; u.nv = 256; u.rb = 0; return true;
    }
    __device__ __forceinline__ const char* a_base(const Unit& u) const { return A + (size_t)u.pm * (size_t)(BM * 2) * K; }
    __device__ __forceinline__ const char* b_base(const Unit& u) const { return Bt + (size_t)u.pn * (size_t)(BM * 2) * K; }
    __device__ __forceinline__ const char* g_base() const { return A; }
    __device__ __forceinline__ unsigned a_off(const Unit& u, int h, int R) const { return 0u; }
};

template <class Epi, class Sched, bool GATHER, bool ALIGN_EPI>
__device__ __forceinline__ void gemm_phase(LAS unsigned char* lds, const int K, const Sched& S, const Epi& E) {
    int tid = threadIdx.x; asm volatile("" : "+v"(tid));
    const int wid = __builtin_amdgcn_readfirstlane(tid >> 6), lane = tid & 63, wr = wid >> 2, wc = wid & 3, fr = lane & 15, fq = lane >> 4;
    const int nt = K / BK;
    unsigned voffA[2], voffB[2]; int Rst[2], Cst2[2];
#pragma unroll
    for (int i = 0; i < 2; ++i) { int R, C; stage_rc(tid * 16 + i * 8192, R, C); const int Rb = Epi::PERM ? ((R & ~31) + perm32(R & 31)) : R;
        voffA[i] = (unsigned)(R * K + C) * 2u; voffB[i] = (unsigned)(Rb * K + C) * 2u; Rst[i] = R; Cst2[i] = C * 2; }
    const size_t kstep = (size_t)(BK * 2);
    const size_t hstep = (size_t)HALF * K * 2;
    const unsigned ldsw = (unsigned)wid * 1024u;
    const int aoff = lds_byte(wr * 64 + fr, fq * 8), boff = lds_byte(wc * 32 + fr, fq * 8);
    const char* const gA = S.g_base();
#define PG8_SA(b, h) (((b) * 2 + (h)) * HTB)
#define PG8_SB(b, h) ((4 + (b) * 2 + (h)) * HTB)
#define PG8_GLDS(src, bufoff, i_) __builtin_amdgcn_global_load_lds((const unsigned*)(src), (LAS unsigned*)(lds + (bufoff) + ldsw + (i_) * 8192), 16, 0, 0)
#define PG8_STAGE_B(bufoff, gbase) do { _Pragma("unroll") for (int _i = 0; _i < 2; ++_i) PG8_GLDS((const char*)(gbase) + voffB[_i], bufoff, _i); } while (0)
#define PG8_STAGE_A(bufoff, pa, offs, h_, kb) do { _Pragma("unroll") for (int _i = 0; _i < 2; ++_i) { \
        if constexpr (GATHER) PG8_GLDS(gA + (size_t)((offs)[h_][_i] + (unsigned)(kb)), bufoff, _i); else PG8_GLDS((const char*)(pa) + (h_) * hstep + voffA[_i], bufoff, _i); } } while (0)
#define PG8_LDA(dst, b, h) do { _Pragma("unroll") for (int m = 0; m < 4; ++m) _Pragma("unroll") for (int k = 0; k < 2; ++k) dst[m][k] = *(const LAS h16x8*)(lds + PG8_SA(b, h) + aoff + m * 2048 + k * 1024); } while (0)
#define PG8_LDB(dst, b, h) do { _Pragma("unroll") for (int n = 0; n < 2; ++n) _Pragma("unroll") for (int k = 0; k < 2; ++k) dst[n][k] = *(const LAS h16x8*)(lds + PG8_SB(b, h) + boff + n * 2048 + k * 1024); } while (0)
#define PG8_MMA(ai, bj, At, Bt) do { __builtin_amdgcn_s_setprio(1); _Pragma("unroll") for (int m = 0; m < 4; ++m) _Pragma("unroll") for (int n = 0; n < 2; ++n) _Pragma("unroll") for (int k = 0; k < 2; ++k) \
        acc[ai][bj][m][n] = __builtin_amdgcn_mfma_f32_16x16x32_f16(Bt[n][k], At[m][k], acc[ai][bj][m][n], 0, 0, 0); __builtin_amdgcn_s_setprio(0); } while (0)
#define PG8_WAIT_V(n) asm volatile("s_waitcnt vmcnt(" #n ")" ::: "memory")
#define PG8_WAIT_L(n) asm volatile("s_waitcnt lgkmcnt(" #n ")" ::: "memory")
#define PG8_BAR __builtin_amdgcn_s_barrier()
#define PG8_SCHED __builtin_amdgcn_sched_barrier(0)
    Unit cur, nxt; int ui = 0;
    if (!S.next(0, cur)) return;
    f32x4 acc[2][2][4][2];
#pragma unroll
    for (int a = 0; a < 2; ++a)
#pragma unroll
        for (int b = 0; b < 2; ++b)
#pragma unroll
            for (int m = 0; m < 4; ++m)
#pragma unroll
                for (int n = 0; n < 2; ++n) acc[a][b][m][n] = (f32x4){0.f, 0.f, 0.f, 0.f};
    h16x8 At[4][2], B0[2][2], B1[2][2];
    const char* cA = S.a_base(cur); const char* cB = S.b_base(cur);
    unsigned aoc[2][2], aon[2][2], ao2[2][2];
    if constexpr (GATHER) {
#pragma unroll
        for (int h = 0; h < 2; ++h)
#pragma unroll
            for (int i = 0; i < 2; ++i) { aoc[h][i] = S.a_off(cur, h, Rst[i]) + (unsigned)Cst2[i]; aon[h][i] = aoc[h][i]; ao2[h][i] = aoc[h][i]; }
    }
    PG8_STAGE_B(PG8_SB(0, 0), cB); PG8_STAGE_B(PG8_SB(0, 1), cB + hstep); PG8_STAGE_A(PG8_SA(0, 0), cA, aoc, 0, 0); PG8_STAGE_A(PG8_SA(0, 1), cA, aoc, 1, 0);
    if (wr == 1) PG8_BAR;
    PG8_WAIT_V(2); PG8_BAR;
    PG8_STAGE_B(PG8_SB(1, 0), cB + kstep); PG8_STAGE_A(PG8_SA(1, 0), cA + kstep, aoc, 0, kstep); PG8_STAGE_B(PG8_SB(1, 1), cB + hstep + kstep);
    PG8_WAIT_V(6); PG8_BAR;
    for (;;) {
        const bool has_next = S.next(ui + 1, nxt);
        const char* nA = has_next ? S.a_base(nxt) : cA; const char* nB = has_next ? S.b_base(nxt) : cB;
        if constexpr (GATHER) {
#pragma unroll
            for (int h = 0; h < 2; ++h)
#pragma unroll
                for (int i = 0; i < 2; ++i) aon[h][i] = has_next ? S.a_off(nxt, h, Rst[i]) + (unsigned)Cst2[i] : aoc[h][i];
        }
        for (int t = 0; t < nt; t += 2) {
            const bool last = (t == nt - 2);
            const char* a1 = cA + (size_t)(t + 1) * kstep;
            const char* a2 = last ? nA : cA + (size_t)(t + 2) * kstep; const char* b2 = last ? nB : cB + (size_t)(t + 2) * kstep;
            const char* a3 = a2 + kstep; const char* b3 = b2 + kstep;
            if constexpr (GATHER) {
#pragma unroll
                for (int h = 0; h < 2; ++h)
#pragma unroll
                    for (int i = 0; i < 2; ++i) ao2[h][i] = last ? aon[h][i] : aoc[h][i] + (unsigned)((t + 2) * (int)kstep);
            }
            PG8_LDB(B0, 0, 0); PG8_LDB(B1, 0, 1); PG8_SCHED; PG8_LDA(At, 0, 0); PG8_STAGE_A(PG8_SA(1, 1), a1, aoc, 1, (t + 1) * (int)kstep);
            PG8_WAIT_V(8); PG8_WAIT_L(0); PG8_BAR; PG8_MMA(0, 0, At, B0); PG8_MMA(0, 1, At, B1); PG8_BAR; PG8_SCHED;
            PG8_LDA(At, 0, 1); PG8_STAGE_B(PG8_SB(0, 0), b2); PG8_STAGE_B(PG8_SB(0, 1), b2 + hstep); PG8_STAGE_A(PG8_SA(0, 0), a2, ao2, 0, 0);
            PG8_WAIT_V(8); PG8_WAIT_L(0); PG8_BAR; PG8_MMA(1, 0, At, B0); PG8_MMA(1, 1, At, B1); PG8_BAR; PG8_SCHED;
            PG8_LDB(B0, 1, 0); PG8_LDB(B1, 1, 1); PG8_SCHED; PG8_LDA(At, 1, 0); PG8_STAGE_A(PG8_SA(0, 1), a2, ao2, 1, 0);
            PG8_WAIT_V(8); PG8_WAIT_L(0); PG8_BAR; PG8_MMA(0, 0, At, B0); PG8_MMA(0, 1, At, B1); PG8_BAR; PG8_SCHED;
            PG8_LDA(At, 1, 1); PG8_STAGE_B(PG8_SB(1, 0), b3); PG8_STAGE_B(PG8_SB(1, 1), b3 + hstep); PG8_STAGE_A(PG8_SA(1, 0), a3, ao2, 0, kstep);
            PG8_WAIT_V(8); PG8_WAIT_L(0); PG8_BAR; PG8_MMA(1, 0, At, B0); PG8_MMA(1, 1, At, B1); PG8_BAR; PG8_SCHED;
        }
        if constexpr (ALIGN_EPI) { if (wr == 0) PG8_BAR; }
        E(acc, cur, wr, wc, fr, fq);
        if (!has_next) break;
#pragma unroll
        for (int a = 0; a < 2; ++a)
#pragma unroll
            for (int b = 0; b < 2; ++b)
#pragma unroll
                for (int m = 0; m < 4; ++m)
#pragma unroll
                    for (int n = 0; n < 2; ++n) acc[a][b][m][n] = (f32x4){0.f, 0.f, 0.f, 0.f};
        cur = nxt; cA = nA; cB = nB; ++ui;
        if constexpr (GATHER) {
#pragma unroll
            for (int h = 0; h < 2; ++h)
#pragma unroll
                for (int i = 0; i < 2; ++i) aoc[h][i] = aon[h][i];
        }
        if constexpr (ALIGN_EPI) { if (wr == 1) PG8_BAR; }
    }
    PG8_WAIT_V(0);
    if constexpr (!ALIGN_EPI) { if (wr == 0) PG8_BAR; }
    PG8_BAR;
#undef PG8_SA
#undef PG8_SB
#undef PG8_GLDS
#undef PG8_STAGE_A
#undef PG8_STAGE_B
#undef PG8_LDA
#undef PG8_LDB
#undef PG8_MMA
#undef PG8_WAIT_V
#undef PG8_WAIT_L
#undef PG8_BAR
#undef PG8_SCHED
}
}
using pg8::Unit;
struct EpiProj {
    static constexpr bool PERM = true;
    const float* rstd0; const float* b_gate; h16* QK; h16* V; h16* OG; h16* UG; h16* SV; float* sssv; bool doat;
    __device__ __forceinline__ void operator()(const f32x4 (&acc)[2][2][4][2], const Unit& u, int wr, int wc, int fr, int fq) const {
        const int row0 = u.pm * 256 + wr * 64 + fr, cw = wc * 32 + 8 * fq, pn = u.pn;
        if (pn < 12) {
            h16* base; int ld, col;
            if (pn < 8) { base = QK; ld = 2048; col = pn * 256; } else { base = V; ld = 1024; col = (pn - 8) * 256; }
#pragma unroll
            for (int ai = 0; ai < 2; ++ai)
#pragma unroll
                for (int m = 0; m < 4; ++m) { const int row = row0 + ai * 128 + m * 16; const float rs = rstd0[row]; h16* rp = base + (size_t)row * ld + col + cw;
#pragma unroll
                    for (int bj = 0; bj < 2; ++bj) *(u32x4*)(rp + bj * 128) = pk_h8(acc[ai][bj][m][0] * rs, acc[ai][bj][m][1] * rs); }
        } else if (pn < 28) {
            const bool isO = pn < 20; h16* base = isO ? OG : UG; const int c0 = (isO ? pn - 12 : pn - 20) * 128 + cw; const float* bg = b_gate + (isO ? 0 : 1024) + c0;
            const f32x4 b0 = *(const f32x4*)bg, b1 = *(const f32x4*)(bg + 4);
#pragma unroll
            for (int ai = 0; ai < 2; ++ai)
#pragma unroll
                for (int m = 0; m < 4; ++m) { const int row = row0 + ai * 128 + m * 16; const float rs = rstd0[row];
                    f32x4 a0 = acc[ai][0][m][0] * rs, a1 = acc[ai][0][m][1] * rs; const f32x4 g0 = acc[ai][1][m][0] * rs + b0, g1 = acc[ai][1][m][1] * rs + b1;
                    if (isO) {
#pragma unroll
                        for (int j = 0; j < 4; ++j) { a0[j] = fsigmoid(a0[j]) * fsigmoid(g0[j]); a1[j] = fsigmoid(a1[j]) * fsigmoid(g1[j]); }
                    } else {
#pragma unroll
                        for (int j = 0; j < 4; ++j) { a0[j] = fgelu(a0[j]) * fsigmoid(g0[j]); a1[j] = fgelu(a1[j]) * fsigmoid(g1[j]); }
                    }
                    *(u32x4*)(base + (size_t)row * 1024 + c0) = pk_h8(a0, a1); }
        } else {
            const int col = (pn - 28) * 256 + cw;
#pragma unroll
            for (int ai = 0; ai < 2; ++ai)
#pragma unroll
                for (int m = 0; m < 4; ++m) { const int row = row0 + ai * 128 + m * 16; const float rs = rstd0[row]; float sum = 0.f;
#pragma unroll
                    for (int bj = 0; bj < 2; ++bj) { f32x4 a0 = acc[ai][bj][m][0] * rs, a1 = acc[ai][bj][m][1] * rs;
#pragma unroll
                        for (int j = 0; j < 4; ++j) { a0[j] = fgelu(a0[j]); a1[j] = fgelu(a1[j]); sum += a0[j] * a0[j] + a1[j] * a1[j]; }
                        *(u32x4*)(SV + (size_t)row * 1024 + col + bj * 128) = pk_h8(a0, a1); }
                    sum += __shfl_xor(sum, 16); sum += __shfl_xor(sum, 32);
                    if (fq == 0 && doat) atomicAdd(sssv + row, sum); }
        }
    }
};
struct EpiKV {
    static constexpr bool PERM = true;
    const float* rstdm; h16* KM; h16* VM;
    __device__ __forceinline__ void operator()(const f32x4 (&acc)[2][2][4][2], const Unit& u, int wr, int wc, int fr, int fq) const {
        const int row0 = u.pm * 256 + wr * 64 + fr, cw = wc * 32 + 8 * fq, pn = u.pn; h16* base = (pn < 4) ? KM + pn * 256 : VM + (pn - 4) * 256;
#pragma unroll
        for (int ai = 0; ai < 2; ++ai)
#pragma unroll
            for (int m = 0; m < 4; ++m) { const int row = row0 + ai * 128 + m * 16; const float rs = rstdm[row];
#pragma unroll
                for (int bj = 0; bj < 2; ++bj) *(u32x4*)(base + (size_t)row * 1024 + bj * 128 + cw) = pk_h8(acc[ai][bj][m][0] * rs, acc[ai][bj][m][1] * rs); }
    }
};
struct EpiResid {
    static constexpr bool PERM = false;
    const float* resid; float* out; h16* outh; float* ss; bool doat;
    __device__ __forceinline__ void operator()(const f32x4 (&acc)[2][2][4][2], const Unit& u, int wr, int wc, int fr, int fq) const {
        const int row0 = u.pm * 256 + wr * 64 + fr, col0 = u.pn * 256 + wc * 32 + 4 * fq;
#pragma unroll
        for (int ai = 0; ai < 2; ++ai)
#pragma unroll
            for (int m = 0; m < 4; ++m) { const int row = row0 + ai * 128 + m * 16; const size_t off = (size_t)row * DM + col0; float sum = 0.f;
#pragma unroll
                for (int bj = 0; bj < 2; ++bj)
#pragma unroll
                    for (int n = 0; n < 2; ++n) { const size_t o = off + bj * 128 + n * 16; const f32x4 v = *(const f32x4*)(resid + o) + acc[ai][bj][m][n];
                        *(f32x4*)(out + o) = v; u32x2 w; w.x = pk_h2(v[0], v[1]); w.y = pk_h2(v[2], v[3]); *(u32x2*)(outh + o) = w;
                        sum += (v[0] * v[0] + v[1] * v[1]) + (v[2] * v[2] + v[3] * v[3]); }
                sum += __shfl_xor(sum, 16); sum += __shfl_xor(sum, 32);
                if (fq == 0 && doat) atomicAdd(ss + row, sum); }
    }
};
struct EpiQ {
    static constexpr bool PERM = true;
    const float* ss1; h16* Q;
    __device__ __forceinline__ void operator()(const f32x4 (&acc)[2][2][4][2], const Unit& u, int wr, int wc, int fr, int fq) const {
        const int row0 = u.pm * 256 + wr * 64 + fr, col0 = u.pn * 256 + wc * 32 + 8 * fq;
#pragma unroll
        for (int ai = 0; ai < 2; ++ai)
#pragma unroll
            for (int m = 0; m < 4; ++m) { const int row = row0 + ai * 128 + m * 16; const float rs = rsqrtf(ss1[row] * (1.f / DM) + EPS) * 0.0625f;
#pragma unroll
                for (int bj = 0; bj < 2; ++bj) *(u32x4*)(Q + (size_t)row * DM + col0 + bj * 128) = pk_h8(acc[ai][bj][m][0] * rs, acc[ai][bj][m][1] * rs); }
    }
};
struct MoeOrder {
    const char* A; const char* Bt; int K; size_t bexp; const int* list; const unsigned* cnt; const LAS int* tab; int G, c;
    __device__ __forceinline__ bool next(int i, Unit& u) const {
        const int L = i * G + c; const int total = tab[32] * 4; if (L >= total) return false;
        const int rbg = L >> 2; int e = 0;
#pragma unroll 1
        for (int j = 1; j < 32; ++j) e = (tab[j] <= rbg) ? j : e;
        u.pm = rbg; u.pn = L & 3; u.e = e; const int rb = rbg - tab[e]; u.rb = rb; const int left = (int)__hip_atomic_load(cnt + e, __ATOMIC_RELAXED, __HIP_MEMORY_SCOPE_AGENT) - rb * 256; u.nv = left < 256 ? left : 256; return true;
    }
    __device__ __forceinline__ const char* a_base(const Unit& u) const { return A + (size_t)u.pm * (size_t)(256 * 2) * K; }
    __device__ __forceinline__ const char* b_base(const Unit& u) const { return Bt + (size_t)u.e * bexp + (size_t)u.pn * (size_t)(256 * 2) * K; }
    __device__ __forceinline__ const char* g_base() const { return A; }
    __device__ __forceinline__ unsigned a_off(const Unit& u, int h, int R) const { const int r = h * 128 + R; const int tok = (r < u.nv) ? (list[u.e * NTOK + u.rb * 256 + r] >> 1) : 0; return (unsigned)tok * (unsigned)(K * 2); }
};
struct EpiFfn1 {
    static constexpr bool PERM = true;
    const int* list; const float* ss2; h16* H;
    __device__ __forceinline__ void operator()(const f32x4 (&acc)[2][2][4][2], const Unit& u, int wr, int wc, int fr, int fq) const {
        const int r0 = wr * 64 + fr, cw = wc * 32 + 8 * fq;
#pragma unroll
        for (int ai = 0; ai < 2; ++ai)
#pragma unroll
            for (int m = 0; m < 4; ++m) { const int r = r0 + ai * 128 + m * 16; const int tok = (r < u.nv) ? (list[u.e * NTOK + u.rb * 256 + r] >> 1) : 0;
                const float rs = rsqrtf(ss2[tok] * (1.f / DM) + EPS);
                f32x4 a0 = acc[ai][0][m][0] * rs, a1 = acc[ai][0][m][1] * rs; const f32x4 b0 = acc[ai][1][m][0] * rs, b1 = acc[ai][1][m][1] * rs;
#pragma unroll
                for (int j = 0; j < 4; ++j) { a0[j] = fsilu(a0[j]) * b0[j]; a1[j] = fsilu(a1[j]) * b1[j]; }
                *(u32x4*)(H + ((size_t)u.pm * 256 + r) * FF + u.pn * 128 + cw) = pk_h8(a0, a1); }
    }
};
struct EpiFfn2 {
    static constexpr bool PERM = true;
    const int* list; const float* gate; h16* Y;
    __device__ __forceinline__ void operator()(const f32x4 (&acc)[2][2][4][2], const Unit& u, int wr, int wc, int fr, int fq) const {
        const int r0 = wr * 64 + fr, cw = u.pn * 256 + wc * 32 + 8 * fq;
#pragma unroll
        for (int ai = 0; ai < 2; ++ai)
#pragma unroll
            for (int m = 0; m < 4; ++m) { const int r = r0 + ai * 128 + m * 16;
                if (r < u.nv) { const int slot = list[u.e * NTOK + u.rb * 256 + r]; const float g = gate[slot];
#pragma unroll
                    for (int bj = 0; bj < 2; ++bj) *(u32x4*)(Y + (size_t)slot * DM + cw + bj * 128) = pk_h8(acc[ai][bj][m][0] * g, acc[ai][bj][m][1] * g); } }
    }
};


typedef short s16x4 __attribute__((ext_vector_type(4)));
__device__ __forceinline__ h16x4 tr_read4(const LAS unsigned char* p) { return __builtin_bit_cast(h16x4, __builtin_amdgcn_ds_read_tr16_b64_v4i16((LAS s16x4*)p)); }
__device__ __forceinline__ h16x8 cat8(h16x4 a, h16x4 b) { return __builtin_shufflevector(a, b, 0, 1, 2, 3, 4, 5, 6, 7); }
__device__ __forceinline__ h16x4 cvt4(f32x4 v) { return __builtin_convertvector(v, h16x4); }
__device__ __forceinline__ void glds16_asm(const void* gsrc, unsigned lds_dst) { unsigned keep;
    asm volatile("s_mov_b32 %0, m0\n\ts_mov_b32 m0, %2\n\ts_nop 0\n\tglobal_load_lds_dwordx4 %1, off\n\ts_mov_b32 m0, %0" : "=&s"(keep) : "v"(gsrc), "s"(lds_dst) : "memory"); }
#define REGBAR16(a) asm volatile("" : "+v"(a[0]), "+v"(a[1]), "+v"(a[2]), "+v"(a[3]), "+v"(a[4]), "+v"(a[5]), "+v"(a[6]), "+v"(a[7]), "+v"(a[8]), "+v"(a[9]), "+v"(a[10]), "+v"(a[11]), "+v"(a[12]), "+v"(a[13]), "+v"(a[14]), "+v"(a[15]))
#define REGBAR8(a) asm volatile("" : "+v"(a[0]), "+v"(a[1]), "+v"(a[2]), "+v"(a[3]), "+v"(a[4]), "+v"(a[5]), "+v"(a[6]), "+v"(a[7]))
#define REGBAR4(a) asm volatile("" : "+v"(a[0]), "+v"(a[1]), "+v"(a[2]), "+v"(a[3]))
#define GLDS16(src, dst) glds16_asm((const void*)(src), __builtin_amdgcn_readfirstlane((unsigned)(size_t)(dst)))
constexpr int ATT_UNITS = 512, ATT_CH = 32768;
__device__ __forceinline__ void attn_issue(LAS unsigned char* lds, const h16* KM, const h16* VM, int c, int G, int bx, int wid, int lane) {
    const int i = c >> 3, n = c & 7, L = i * G + bx, hd = L & 3, tile = L >> 2, b = tile >> 6;
    LAS unsigned char* buf = lds + (unsigned)(c % 3) * ATT_CH;
    if (n < 4) { const char* Kb = (const char*)(KM + (size_t)(b * 256) * 1024 + hd * 256) + n * 128;
#pragma unroll
        for (int q = 0; q < 4; ++q) { const int I = wid * 4 + q, row = I * 8 + (lane >> 3), slot = (lane & 7) ^ ((row >> 1) & 7); GLDS16(Kb + (size_t)row * 2048 + slot * 16, buf + I * 1024); }
    } else { const char* Vb = (const char*)(VM + (size_t)(b * 256 + 64 * (n - 4)) * 1024 + hd * 256);
#pragma unroll
        for (int q = 0; q < 4; ++q) { const int I = wid * 4 + q, row = I * 2 + (lane >> 5), ch = (lane & 31) ^ ((row & 7) << 1); GLDS16(Vb + (size_t)row * 2048 + ch * 16, buf + I * 1024); }
    }
}
__device__ __forceinline__ void attn_phase(LAS unsigned char* lds, const h16* Q, const h16* KM, const h16* VM, h16* ATT, int G, int bx) {
    int tid = threadIdx.x; asm volatile("" : "+v"(tid));
    const int wid = __builtin_amdgcn_readfirstlane(tid >> 6), lane = tid & 63, fr = lane & 15, fq = lane >> 4;
    if (bx >= ATT_UNITS) return;
    const int nun = (ATT_UNITS - bx + G - 1) / G, total = nun * 8;
    attn_issue(lds, KM, VM, 0, G, bx, wid, lane); attn_issue(lds, KM, VM, 1, G, bx, wid, lane);
    const int tq = (lane & 15) >> 2, tp = lane & 3;
    for (int i = 0; i < nun; ++i) {
        const int L = i * G + bx, hd = L & 3, tile = L >> 2; const int trow = tile * 128 + wid * 16 + fr;
        f32x4 S[16]; h16x8 qf[8], pf[8]; f32x4 O[16]; float linv = 0.f;
#pragma unroll
        for (int kt = 0; kt < 16; ++kt) S[kt] = (f32x4){0.f, 0.f, 0.f, 0.f};
#pragma unroll
        for (int n = 0; n < 8; ++n) {
            const int c = i * 8 + n;
            asm volatile("s_waitcnt vmcnt(0)" ::: "memory"); __builtin_amdgcn_s_barrier(); asm volatile("" ::: "memory");
            if (n == 0) {
#pragma unroll
                for (int st = 0; st < 8; ++st) qf[st] = *(const h16x8*)(Q + (size_t)trow * 1024 + hd * 256 + 32 * st + 8 * fq);
            }
            if (c + 2 < total) attn_issue(lds, KM, VM, c + 2, G, bx, wid, lane);
            const LAS unsigned char* buf = lds + (unsigned)(c % 3) * ATT_CH;
            if (n < 4) {
#pragma unroll
                for (int kt = 0; kt < 16; ++kt)
#pragma unroll
                    for (int ks = 0; ks < 2; ++ks) { const int key = kt * 16 + fr, slot = 4 * ks + fq;
                        const h16x8 bf = *(const LAS h16x8*)(buf + key * 128 + ((slot ^ ((key >> 1) & 7)) * 16));
                        S[kt] = __builtin_amdgcn_mfma_f32_16x16x32_f16(bf, qf[2 * n + ks], S[kt], 0, 0, 0);
                        if (ks == 1 && (kt & 3) == 3) __builtin_amdgcn_sched_barrier(0); }
                if (n == 3) {
                    float mx = -INFINITY;
#pragma unroll
                    for (int kt = 0; kt < 16; ++kt)
#pragma unroll
                        for (int j = 0; j < 4; ++j) mx = fmaxf(mx, S[kt][j]);
                    mx = fmaxf(mx, __shfl_xor(mx, 16)); mx = fmaxf(mx, __shfl_xor(mx, 32));
                    float l = 0.f;
#pragma unroll
                    for (int kt = 0; kt < 16; ++kt)
#pragma unroll
                        for (int j = 0; j < 4; ++j) { const float e = __expf(S[kt][j] - mx); S[kt][j] = e; l += e; }
                    l += __shfl_xor(l, 16); l += __shfl_xor(l, 32); linv = 1.f / l;
#pragma unroll
                    for (int st = 0; st < 8; ++st) pf[st] = cat8(cvt4(S[2 * st]), cvt4(S[2 * st + 1]));
                }
            } else {
                if (n == 4) {
#pragma unroll
                    for (int dt = 0; dt < 16; ++dt) O[dt] = (f32x4){0.f, 0.f, 0.f, 0.f};
                }
#pragma unroll
                for (int ks = 0; ks < 2; ++ks) { const int r0 = 32 * ks + 4 * fq + tq, r1 = r0 + 16;
#pragma unroll
                    for (int dt = 0; dt < 16; ++dt) {
                        const h16x4 lo = tr_read4(buf + r0 * 512 + (((2 * dt + (tp >> 1)) ^ ((r0 & 7) << 1)) * 16) + (tp & 1) * 8);
                        const h16x4 hi = tr_read4(buf + r1 * 512 + (((2 * dt + (tp >> 1)) ^ ((r1 & 7) << 1)) * 16) + (tp & 1) * 8);
                        O[dt] = __builtin_amdgcn_mfma_f32_16x16x32_f16(cat8(lo, hi), pf[2 * (n - 4) + ks], O[dt], 0, 0, 0);
                        if ((dt & 3) == 3) __builtin_amdgcn_sched_barrier(0); } }
                if (n == 7) {
#pragma unroll
                    for (int dt = 0; dt < 16; ++dt) { const f32x4 o = O[dt] * linv; u32x2 w; w.x = pk_h2(o[0], o[1]); w.y = pk_h2(o[2], o[3]);
                        *(u32x2*)(ATT + (size_t)trow * 1024 + hd * 256 + 16 * dt + 4 * fq) = w; }
                }
            }
        }
    }
    asm volatile("s_waitcnt vmcnt(0)" ::: "memory"); __builtin_amdgcn_s_barrier();
}


__device__ __forceinline__ void mstate_ext(unsigned char* ws, int bh, int wave, int lane) {
    const float* ig = (const float*)(ws + OFF_IG); const float* lf = (const float*)(ws + OFF_LF);
    const int b = bh >> 2, h = bh & 3; float B = 0.f, mx = -INFINITY;
    for (int s = 0; s < CHUNK; ++s) { const int t = b * SEQ + lane * CHUNK + s; B += lf[t * 4 + h]; mx = fmaxf(mx, ig[t * 4 + h] - B); }
    const float blast = B, maxw = B + mx; float m = 0.f, mc = 0.f, mn = 0.f;
    for (int c = 0; c < NCHUNK; ++c) { const float bl = __shfl(blast, c), mw = __shfl(maxw, c); const float m2 = fmaxf(bl + m, mw); if (lane == c) { mc = m; mn = m2; } m = m2; }
    if (wave == 0) { ((float*)(ws + OFF_MST))[bh * 64 + lane] = mc; ((float*)(ws + OFF_DEC))[bh * 64 + lane] = __expf(blast + mc - mn); }
    float* AL = (float*)(ws + OFF_AL); float* BE = (float*)(ws + OFF_BE); float* NM = (float*)(ws + OFF_NM); float* WU = (float*)(ws + OFF_WU);
    B = 0.f; float rm = -INFINITY;
    for (int s = 0; s < CHUNK; ++s) { const int t = b * SEQ + lane * CHUNK + s; const float li = lf[t * 4 + h], ii = ig[t * 4 + h]; B += li; rm = fmaxf(rm, ii - B);
        if ((s >> 4) == wave) { const float mt = B + fmaxf(mc, rm); AL[t * 4 + h] = B - mt; BE[t * 4 + h] = ii - B; NM[t * 4 + h] = -mt; WU[t * 4 + h] = __expf(ii - B + blast - mn); } }
}

__device__ __forceinline__ int swz128(int row) { return (((row >> 1) & 1) | (((row >> 3) & 1) << 1)) << 1; }
__device__ __forceinline__ void scan_task(LAS unsigned char* lds, const Ptrs& p, unsigned char* ws, int task) {
    int tid = threadIdx.x; asm volatile("" : "+v"(tid));
    const int wid = __builtin_amdgcn_readfirstlane(tid >> 6), lane = tid & 63, fr = lane & 15, fq = lane >> 4;
    const int bh = task >> 4, et = (task >> 2) & 3, dtb = task & 3, b = bh >> 2, hd = bh & 3, e0 = et * 64, d0 = dtb * 64;
    const int cg = tid & 7, rp = tid >> 3, kcol = 1024 + hd * 256 + d0 + 8 * cg;
    f32x4 cw[4][2], cb[2];
#pragma unroll
    for (int j = 0; j < 4; ++j) { cw[j][0] = *(const f32x4*)(p.conv_w + j * 2048 + kcol); cw[j][1] = *(const f32x4*)(p.conv_w + j * 2048 + kcol + 4); }
    cb[0] = *(const f32x4*)(p.conv_b + kcol); cb[1] = *(const f32x4*)(p.conv_b + kcol + 4);
    const h16* QK = (const h16*)p.out; const float* WU = (const float*)(ws + OFF_WU); const float* DEC = (const float*)(ws + OFF_DEC) + bh * 64;
    const h16* Vg = (const h16*)(ws + WS_V);
    h16* CST = (h16*)(ws + WS_CST) + (size_t)bh * 64 * 65536; float* NST = (float*)(ws + WS_NST) + (size_t)bh * 64 * 256;
    const int dti = wid & 3, ep = wid >> 2; const bool doN = (et == 0) && (ep == 0);
    const int tq = (lane & 15) >> 2, tp = lane & 3;
    u32x4 raw[3][5]; float wu[3][2]; float dcv[3];
    f32x4 acc[2] = {(f32x4){0.f, 0.f, 0.f, 0.f}, (f32x4){0.f, 0.f, 0.f, 0.f}}; f32x4 nacc = (f32x4){0.f, 0.f, 0.f, 0.f};
    const h16x8 ones = {(h16)1.f, (h16)1.f, (h16)1.f, (h16)1.f, (h16)1.f, (h16)1.f, (h16)1.f, (h16)1.f};
#define SCAN_LOAD(c_, set_) do { const int t0_ = b * SEQ + (c_) * CHUNK; \
        _Pragma("unroll") for (int q = 0; q < 2; ++q) { const int I = wid * 2 + q, row = I * 8 + (lane >> 3), ch = (lane & 7) ^ swz128(row); \
            GLDS16((const char*)(Vg + (size_t)(t0_ + row) * 1024 + hd * 256 + e0) + ch * 16, lds + 32768 + ((c_) & 3) * 16384 + I * 1024); } \
        _Pragma("unroll") for (int k = 0; k < 5; ++k) { int tl = (c_) * CHUNK + 2 * rp - 3 + k; tl = tl < 0 ? 0 : tl; raw[set_][k] = *(const u32x4*)(QK + (size_t)(b * SEQ + tl) * 2048 + kcol); } \
        wu[set_][0] = WU[(t0_ + 2 * rp) * 4 + hd]; wu[set_][1] = WU[(t0_ + 2 * rp + 1) * 4 + hd]; dcv[set_] = DEC[c_]; } while (0)
#define SCAN_STORE(c_) do { \
        _Pragma("unroll") for (int j = 0; j < 2; ++j) { u32x2 w; w.x = pk_h2(acc[j][0], acc[j][1]); w.y = pk_h2(acc[j][2], acc[j][3]); \
            *(u32x2*)(CST + (size_t)(c_) * 65536 + (size_t)(e0 + 16 * (2 * ep + j) + fr) * 256 + d0 + 16 * dti + 4 * fq) = w; } \
        if (doN && fr == 0) *(f32x4*)(NST + (c_) * 256 + d0 + 16 * dti + 4 * fq) = nacc; } while (0)
#define SCAN_STEP(c_, set_) do { const int c = (c_); \
        SCAN_STORE(c); \
        LAS unsigned char* kb = lds + (c & 1) * 16384; LAS unsigned char* vb = lds + 32768 + (c & 3) * 16384; \
        if (c == 0) { _Pragma("unroll") for (int k = 0; k < 3; ++k) if (2 * rp - 3 + k < 0) raw[set_][k] = (u32x4){0u, 0u, 0u, 0u}; } \
        _Pragma("unroll") for (int rr = 0; rr < 2; ++rr) { f32x4 y0 = cb[0], y1 = cb[1]; \
            _Pragma("unroll") for (int j = 0; j < 4; ++j) { const h16x8 xr = __builtin_bit_cast(h16x8, raw[set_][rr + j]); \
                _Pragma("unroll") for (int q = 0; q < 4; ++q) { y0[q] += cw[j][0][q] * (float)xr[q]; y1[q] += cw[j][1][q] * (float)xr[4 + q]; } } \
            const float sc = 0.0625f * wu[set_][rr]; \
            _Pragma("unroll") for (int q = 0; q < 4; ++q) { y0[q] = fsilu(y0[q]) * sc; y1[q] = fsilu(y1[q]) * sc; } \
            const int row = 2 * rp + rr; *(LAS u32x4*)(kb + row * 128 + ((cg ^ swz128(row)) * 16)) = pk_h8(y0, y1); } \
        asm volatile("s_waitcnt lgkmcnt(0)" ::: "memory"); __builtin_amdgcn_s_barrier(); asm volatile("" ::: "memory"); \
        const float dec = dcv[set_]; \
        if (c + 3 < NCHUNK - 1) SCAN_LOAD(c + 3, set_); \
        acc[0] *= dec; acc[1] *= dec; nacc *= dec; \
        _Pragma("unroll") for (int ks = 0; ks < 4; ++ks) { const int r0 = 32 * ks + 8 * fq + tq, r1 = r0 + 4; \
            const int o0 = r0 * 128 + (tp & 1) * 8, o1 = r1 * 128 + (tp & 1) * 8, s0 = swz128(r0), s1 = swz128(r1), cx = 2 * dti + (tp >> 1); \
            const h16x8 X = cat8(tr_read4(kb + o0 + ((cx ^ s0) * 16)), tr_read4(kb + o1 + ((cx ^ s1) * 16))); \
            _Pragma("unroll") for (int j = 0; j < 2; ++j) { const int cy = 2 * (2 * ep + j) + (tp >> 1); \
                const h16x8 Y = cat8(tr_read4(vb + o0 + ((cy ^ s0) * 16)), tr_read4(vb + o1 + ((cy ^ s1) * 16))); \
                acc[j] = __builtin_amdgcn_mfma_f32_16x16x32_f16(X, Y, acc[j], 0, 0, 0); } \
            if (doN) nacc = __builtin_amdgcn_mfma_f32_16x16x32_f16(X, ones, nacc, 0, 0, 0); } } while (0)
    SCAN_LOAD(0, 0); SCAN_LOAD(1, 1); SCAN_LOAD(2, 2);
#pragma unroll 1
    for (int c3 = 0; c3 < NCHUNK - 1; c3 += 3) { SCAN_STEP(c3, 0); SCAN_STEP(c3 + 1, 1); SCAN_STEP(c3 + 2, 2); }
    SCAN_STORE(NCHUNK - 1);
#undef SCAN_STEP
#undef SCAN_STORE
#undef SCAN_LOAD
    asm volatile("s_waitcnt vmcnt(0) lgkmcnt(0)" ::: "memory"); __builtin_amdgcn_s_barrier();
}

__device__ __forceinline__ int swz256(int row) { return ((row & 3) + 4 * ((row >> 3) & 1)) << 1; }
__device__ __forceinline__ void sgu_task(LAS unsigned char* lds, const Ptrs& p, unsigned char* ws, int task) {
    int tid = threadIdx.x; asm volatile("" : "+v"(tid));
    const int wid = __builtin_amdgcn_readfirstlane(tid >> 6), lane = tid & 63, fr = lane & 15, fq = lane >> 4;
    const int t0 = task * CHUNK;
    LAS unsigned char* wb = lds; LAS unsigned char* vb = lds + 32768; LAS float* rs = (LAS float*)(lds + 65536);
    const float* ss = (const float*)(ws + OFF_SSSV); const h16* SV = (const h16*)(ws + WS_SV); const h16* UG = (const h16*)(ws + WS_UG); h16* Z = (h16*)(ws + WS_XH);
    if (tid < CHUNK) rs[tid] = rsqrtf(ss[t0 + tid] * (1.f / DM) + EPS);
    __syncthreads();
    const int lrow = tid >> 2, lq = tid & 3, tq = (lane & 15) >> 2, tp = lane & 3, trow = 16 * wid + fr;
    f32x4 wraw[8]; h16x8 vraw[4];
#define SGU_LOAD(g_) do { const float* wsrc = p.w_s + (size_t)((g_) * 128 + lrow) * 128 + 32 * lq; const h16* vsrc = SV + (size_t)(t0 + lrow) * 1024 + (g_) * 128 + 32 * lq; \
        _Pragma("unroll") for (int i = 0; i < 8; ++i) wraw[i] = *(const f32x4*)(wsrc + 4 * i); \
        _Pragma("unroll") for (int i = 0; i < 4; ++i) vraw[i] = *(const h16x8*)(vsrc + 8 * i); } while (0)
    SGU_LOAD(0);
#pragma unroll 1
    for (int g = 0; g < 8; ++g) {
        {
            const float* gsrc = p.sgu_norm_g + g * 128 + 32 * lq; const float r = rs[lrow];
#pragma unroll
            for (int i = 0; i < 4; ++i) { f32x4 a = wraw[2 * i], c = wraw[2 * i + 1];
#pragma unroll
                for (int q = 0; q < 4; ++q) { if (32 * lq + 8 * i + q > lrow) a[q] = 0.f; if (32 * lq + 8 * i + 4 + q > lrow) c[q] = 0.f; }
                *(LAS u32x4*)(wb + lrow * 256 + (((4 * lq + i) ^ (lrow & 15)) * 16)) = pk_h8(a, c); }
#pragma unroll
            for (int i = 0; i < 4; ++i) { const h16x8 v = vraw[i]; const f32x4 g0 = *(const f32x4*)(gsrc + 8 * i), g1 = *(const f32x4*)(gsrc + 8 * i + 4); f32x4 a, c;
#pragma unroll
                for (int q = 0; q < 4; ++q) { a[q] = (float)v[q] * r * g0[q]; c[q] = (float)v[4 + q] * r * g1[q]; }
                *(LAS u32x4*)(vb + lrow * 256 + (((4 * lq + i) ^ swz256(lrow)) * 16)) = pk_h8(a, c); }
        }
        __syncthreads();
        if (g + 1 < 8) SGU_LOAD(g + 1);
        const float bias = p.b_s[g * 128 + trow]; const size_t ro = (size_t)(t0 + trow) * 1024 + g * 128 + 4 * fq;
        h16x4 ur[8];
#pragma unroll
        for (int dt = 0; dt < 8; ++dt) ur[dt] = *(const h16x4*)(UG + ro + 16 * dt);
        f32x4 acc[8];
#pragma unroll
        for (int dt = 0; dt < 8; ++dt) acc[dt] = (f32x4){0.f, 0.f, 0.f, 0.f};
        const int nks = (wid >> 1) + 1;
        for (int ks = 0; ks < nks; ++ks) {
            const h16x8 Y = *(const LAS h16x8*)(wb + trow * 256 + (((4 * ks + fq) ^ (trow & 15)) * 16));
            const int r0 = 32 * ks + 8 * fq + tq, r1 = r0 + 4, o0 = r0 * 256 + (tp & 1) * 8, o1 = r1 * 256 + (tp & 1) * 8, s0 = swz256(r0), s1 = swz256(r1);
#pragma unroll
            for (int dt = 0; dt < 8; ++dt) { const int cx = 2 * dt + (tp >> 1);
                const h16x8 X = cat8(tr_read4(vb + o0 + ((cx ^ s0) * 16)), tr_read4(vb + o1 + ((cx ^ s1) * 16)));
                acc[dt] = __builtin_amdgcn_mfma_f32_16x16x32_f16(X, Y, acc[dt], 0, 0, 0); }
        }
#pragma unroll
        for (int dt = 0; dt < 8; ++dt) { const h16x4 u = ur[dt]; u32x2 w;
            w.x = pk_h2((float)u[0] * (acc[dt][0] + bias), (float)u[1] * (acc[dt][1] + bias)); w.y = pk_h2((float)u[2] * (acc[dt][2] + bias), (float)u[3] * (acc[dt][3] + bias));
            *(u32x2*)(Z + ro + 16 * dt) = w; }
        __syncthreads();
    }
#undef SGU_LOAD
}

__device__ __forceinline__ int swzb(int row) { return (row >> 1) & 7; }
__device__ __forceinline__ void mout_phase(LAS unsigned char* lds, const Ptrs& p, unsigned char* ws, int G, int bx, h16* Zdst) {
    const int wid = __builtin_amdgcn_readfirstlane(threadIdx.x >> 6);
    constexpr int QB = 0, KB = 16384, CB = 32768, VB = 69632, SM = 135168;
    const h16* QK = (const h16*)p.out; const h16* Vg = (const h16*)(ws + WS_V); const h16* OG = (const h16*)(ws + WS_OG); h16* Z = (h16*)(ws + WS_XH);
    const float* ALg = (const float*)(ws + OFF_AL); const float* BEg = (const float*)(ws + OFF_BE); const float* NMg = (const float*)(ws + OFF_NM); const float* MST = (const float*)(ws + OFF_MST);
    LAS float* ALs = (LAS float*)(lds + SM); LAS float* BEs = ALs + 128;
#define OPAQUE_TID() int tid = threadIdx.x; asm volatile("" : "+v"(tid)); const int lane = tid & 63, fr = lane & 15, fq = lane >> 4, cg = tid & 7, rp = tid >> 3, tq = (lane & 15) >> 2, tp = lane & 3, trow = 16 * wid + fr; (void)cg; (void)rp; (void)tq; (void)tp; (void)trow; (void)fq
    for (int L = bx; L < 512; L += G) {
        const int bh = L >> 6, c = L & 63, b = bh >> 2, hd = bh & 3, t0 = b * SEQ + c * CHUNK;
        const h16* Ct = (const h16*)(ws + WS_CST) + ((size_t)(bh * 64 + c)) * 65536; const float* nst = (const float*)(ws + WS_NST) + (size_t)(bh * 64 + c) * 256;
        __syncthreads();
        { OPAQUE_TID();
        if (tid < 128) ALs[tid] = ALg[(t0 + tid) * 4 + hd]; else if (tid < 256) BEs[tid - 128] = BEg[(t0 + tid - 128) * 4 + hd];
#pragma unroll
        for (int q = 0; q < 8; ++q) { const int I = wid * 8 + q, row = I * 2 + (lane >> 5), ch = (lane & 31) ^ ((row & 7) << 1);
            GLDS16((const char*)(Vg + (size_t)(t0 + row) * 1024 + hd * 256) + ch * 16, lds + VB + I * 1024); }
        }
        f32x4 S[8], acc[17];
#pragma unroll
        for (int i = 0; i < 8; ++i) S[i] = (f32x4){0.f, 0.f, 0.f, 0.f};
#pragma unroll
        for (int i = 0; i < 17; ++i) acc[i] = (f32x4){0.f, 0.f, 0.f, 0.f};
#pragma unroll 1
        for (int dch = 0; dch < 4; ++dch) {
            OPAQUE_TID();
#pragma unroll
            for (int q = 0; q < 4; ++q) { const int I = wid * 4 + q, row = I * 8 + (lane >> 3), ch = (lane & 7) ^ swzb(row);
                GLDS16((const char*)(Ct + (size_t)row * 256 + dch * 64) + ch * 16, lds + CB + I * 1024); }
            if (tid < 8) { const f32x4 a = *(const f32x4*)(nst + dch * 64 + 8 * tid), c2 = *(const f32x4*)(nst + dch * 64 + 8 * tid + 4); *(LAS u32x4*)(lds + CB + 32768 + tid * 16) = pk_h8(a, c2); }
#pragma unroll 1
            for (int which = 0; which < 2; ++which) {
                const int col = which * 1024 + hd * 256 + dch * 64 + 8 * cg;
                u32x4 raw[5];
#pragma unroll
                for (int k = 0; k < 5; ++k) { const int tl = c * CHUNK + 2 * rp - 3 + k; raw[k] = (u32x4){0u, 0u, 0u, 0u}; if (tl >= 0) raw[k] = *(const u32x4*)(QK + (size_t)(b * SEQ + tl) * 2048 + col); }
                f32x4 cw[4][2];
#pragma unroll
                for (int j = 0; j < 4; ++j) { cw[j][0] = *(const f32x4*)(p.conv_w + j * 2048 + col); cw[j][1] = *(const f32x4*)(p.conv_w + j * 2048 + col + 4); }
                const f32x4 cb0 = *(const f32x4*)(p.conv_b + col), cb1 = *(const f32x4*)(p.conv_b + col + 4);
                const float sc = which ? 0.0625f : 1.f;
#pragma unroll
                for (int rr = 0; rr < 2; ++rr) { f32x4 y0 = cb0, y1 = cb1;
#pragma unroll
                    for (int j = 0; j < 4; ++j) { const h16x8 xr = __builtin_bit_cast(h16x8, raw[rr + j]);
#pragma unroll
                        for (int q = 0; q < 4; ++q) { y0[q] += cw[j][0][q] * (float)xr[q]; y1[q] += cw[j][1][q] * (float)xr[4 + q]; } }
#pragma unroll
                    for (int q = 0; q < 4; ++q) { y0[q] = fsilu(y0[q]) * sc; y1[q] = fsilu(y1[q]) * sc; }
                    const int row = 2 * rp + rr; *(LAS u32x4*)(lds + (which ? KB : QB) + row * 128 + ((cg ^ swzb(row)) * 16)) = pk_h8(y0, y1); }
            }
            asm volatile("s_waitcnt vmcnt(0) lgkmcnt(0)" ::: "memory"); __builtin_amdgcn_s_barrier(); asm volatile("" ::: "memory");
            h16x8 Y[2];
#pragma unroll
            for (int ks = 0; ks < 2; ++ks) Y[ks] = *(const LAS h16x8*)(lds + QB + trow * 128 + (((4 * ks + fq) ^ swzb(trow)) * 16));
#pragma unroll
            for (int st = 0; st < 8; ++st) if (st <= wid) {
#pragma unroll
                for (int ks = 0; ks < 2; ++ks) { const int krow = 16 * st + fr; const h16x8 X = *(const LAS h16x8*)(lds + KB + krow * 128 + (((4 * ks + fq) ^ swzb(krow)) * 16));
                    S[st] = __builtin_amdgcn_mfma_f32_16x16x32_f16(X, Y[ks], S[st], 0, 0, 0); } }
#pragma unroll
            for (int et = 0; et < 17; ++et) {
#pragma unroll
                for (int ks = 0; ks < 2; ++ks) { const int crow = 16 * et + fr; const h16x8 X = *(const LAS h16x8*)(lds + CB + crow * 128 + (((4 * ks + fq) ^ swzb(crow)) * 16));
                    acc[et] = __builtin_amdgcn_mfma_f32_16x16x32_f16(X, Y[ks], acc[et], 0, 0, 0); }
                if ((et & 3) == 3) __builtin_amdgcn_sched_barrier(0); }
            asm volatile("s_waitcnt lgkmcnt(0)" ::: "memory"); __builtin_amdgcn_s_barrier(); asm volatile("" ::: "memory");
        }
        OPAQUE_TID();
        const float al = ALs[trow], mc = MST[bh * 64 + c], iw = __expf(al + mc);
#pragma unroll
        for (int et = 0; et < 16; ++et) acc[et] *= iw;
        const float qn = __shfl(acc[16][0], fr);
        float den = 0.f;
#pragma unroll
        for (int st = 0; st < 8; ++st) { const f32x4 be = *(const LAS f32x4*)(BEs + 16 * st + 4 * fq);
#pragma unroll
            for (int r = 0; r < 4; ++r) { float v = S[st][r] * __expf(al + be[r]); if (st == wid) v = (4 * fq + r <= fr) ? v : 0.f; if (st > wid) v = 0.f; S[st][r] = v; den += v; } }
        den += __shfl_xor(den, 16); den += __shfl_xor(den, 32);
        den += iw * qn;
        h16x8 pf[4];
#pragma unroll
        for (int i = 0; i < 4; ++i) pf[i] = cat8(cvt4(S[2 * i]), cvt4(S[2 * i + 1]));
#pragma unroll
        for (int ks = 0; ks < 4; ++ks) if (ks <= (wid >> 1)) { const int r0 = 32 * ks + 4 * fq + tq, r1 = r0 + 16;
#pragma unroll
            for (int et = 0; et < 16; ++et) {
                const h16x4 lo = tr_read4(lds + VB + r0 * 512 + (((2 * et + (tp >> 1)) ^ ((r0 & 7) << 1)) * 16) + (tp & 1) * 8);
                const h16x4 hi = tr_read4(lds + VB + r1 * 512 + (((2 * et + (tp >> 1)) ^ ((r1 & 7) << 1)) * 16) + (tp & 1) * 8);
                acc[et] = __builtin_amdgcn_mfma_f32_16x16x32_f16(cat8(lo, hi), pf[ks], acc[et], 0, 0, 0);
                if ((et & 3) == 3) __builtin_amdgcn_sched_barrier(0); } }
        const int tg = t0 + trow; const float inv = 1.f / fmaxf(fabsf(den), __expf(NMg[tg * 4 + hd]));
        float ss = 0.f;
#pragma unroll
        for (int et = 0; et < 16; ++et) { acc[et] *= inv; ss += (acc[et][0] * acc[et][0] + acc[et][1] * acc[et][1]) + (acc[et][2] * acc[et][2] + acc[et][3] * acc[et][3]); }
        ss += __shfl_xor(ss, 16); ss += __shfl_xor(ss, 32);
        const float rstd = rsqrtf(ss * (1.f / DH) + EPS);
#pragma unroll
        for (int half = 0; half < 2; ++half) { f32x4 gg[8]; h16x4 ogv[8], zv[8];
#pragma unroll
            for (int e8 = 0; e8 < 8; ++e8) { const int col = hd * 256 + 16 * (8 * half + e8) + 4 * fq; const size_t o = (size_t)tg * 1024 + col;
                gg[e8] = *(const f32x4*)(p.mh_norm_g + col); ogv[e8] = *(const h16x4*)(OG + o); zv[e8] = *(const h16x4*)(Z + o); }
            REGBAR8(gg); REGBAR8(ogv); REGBAR8(zv);
#pragma unroll
            for (int e8 = 0; e8 < 8; ++e8) { const int et = 8 * half + e8; const size_t o = (size_t)tg * 1024 + hd * 256 + 16 * et + 4 * fq; u32x2 w;
                w.x = pk_h2((float)zv[e8][0] + acc[et][0] * rstd * gg[e8][0] * (float)ogv[e8][0], (float)zv[e8][1] + acc[et][1] * rstd * gg[e8][1] * (float)ogv[e8][1]);
                w.y = pk_h2((float)zv[e8][2] + acc[et][2] * rstd * gg[e8][2] * (float)ogv[e8][2], (float)zv[e8][3] + acc[et][3] * rstd * gg[e8][3] * (float)ogv[e8][3]);
                *(u32x2*)(Zdst + o) = w; }
            asm volatile("" ::: "memory"); }
    }
    asm volatile("s_waitcnt vmcnt(0) lgkmcnt(0)" ::: "memory"); __builtin_amdgcn_s_barrier();
#undef OPAQUE_TID
}

struct TpItem { const float* W; const float* gk; h16* WT; int ldw, srccol0, K, destrow0, k0; };
__device__ __forceinline__ void tp_load(const TpItem& t, f32x4 (&v)[8], float (&g)[8], int lane) {
    const int col4 = lane & 7, krow = lane >> 3;
#pragma unroll
    for (int i = 0; i < 8; ++i) { v[i] = *(const f32x4*)(t.W + (size_t)(t.k0 + 8 * i + krow) * t.ldw + t.srccol0 + 4 * col4); g[i] = t.gk ? t.gk[t.k0 + 8 * i + krow] : 1.f; }
}
__device__ __forceinline__ void tp_store(const TpItem& t, const f32x4 (&v)[8], const float (&g)[8], LAS unsigned char* scr, int lane) {
    const int col4 = lane & 7, krow = lane >> 3;
#pragma unroll
    for (int i = 0; i < 8; ++i) { const int k = 8 * i + krow; const f32x4 x = v[i] * g[i]; u32x2 w; w.x = pk_h2(x[0], x[1]); w.y = pk_h2(x[2], x[3]);
        *(LAS u32x2*)(scr + k * 64 + (((col4 >> 1) ^ (2 * (i & 1))) * 16) + (col4 & 1) * 8) = w; }
    LDS_WAIT(); asm volatile("" ::: "memory");
    const int gq = lane >> 4, li = lane & 15, q = li >> 2, pp = li & 3;
#pragma unroll
    for (int h = 0; h < 2; ++h)
#pragma unroll
        for (int it = 0; it < 2; ++it) { const int m = gq + 4 * it, r0 = 8 * m + q, r1 = r0 + 4, ch = (2 * h + (pp >> 1)) ^ (2 * (m & 1));
            const h16x4 lo = tr_read4(scr + r0 * 64 + ch * 16 + (pp & 1) * 8), hi = tr_read4(scr + r1 * 64 + ch * 16 + (pp & 1) * 8);
            *(GAS h16x8*)(t.WT + (size_t)(t.destrow0 + 16 * h + li) * t.K + t.k0 + 8 * m) = cat8(lo, hi); }
    LDS_WAIT(); asm volatile("" ::: "memory");
}
template <class Dec>
__device__ __forceinline__ void tp_loop(const Dec& dec, int first, int count, int stride, LAS unsigned char* scr, int lane) {
    if (first >= count) return;
    TpItem cur = dec(first); f32x4 v[8]; float g[8]; tp_load(cur, v, g, lane);
    for (int it = first; it < count; it += stride) {
        const int nx = it + stride; TpItem nxt = cur; f32x4 v2[8]; float g2[8];
#pragma unroll
        for (int i = 0; i < 8; ++i) { v2[i] = v[i]; g2[i] = g[i]; }
        if (nx < count) { nxt = dec(nx); tp_load(nxt, v2, g2, lane); }
        asm volatile("" ::: "memory");
        tp_store(cur, v, g, scr, lane);
        cur = nxt;
#pragma unroll
        for (int i = 0; i < 8; ++i) { v[i] = v2[i]; g[i] = g2[i]; }
    }
}
__device__ __forceinline__ int win_destrow(int l) {
    if (l < 3072) return l;
    if (l < 4096) { const int c = l - 3072; return 3072 + (c >> 7) * 256 + (c & 127); }
    if (l < 5120) { const int c = l - 4096; return 5120 + (c >> 7) * 256 + (c & 127); }
    if (l < 6144) return 7168 + (l - 5120);
    if (l < 7168) { const int c = l - 6144; return 3072 + (c >> 7) * 256 + 128 + (c & 127); }
    { const int c = l - 7168; return 5120 + (c >> 7) * 256 + 128 + (c & 127); }
}

struct TpDecP0 { const Ptrs* p; unsigned char* ws;
    __device__ __forceinline__ TpItem operator()(int it) const {
        constexpr int I_WIN = 16 * 256, I_SQ = 16 * 32, I_KV = 16 * 64; h16* wsm = (h16*)(ws + WS_WSM); int r = it; TpItem t;
        if (r < I_WIN) { const int kb = r >> 8, nb = r & 255, l0 = 32 * nb; t = TpItem{p->w_in, p->norm_mix_g, (h16*)(ws + WS_WIN), IN_DIM, l0 < 4096 ? l0 : l0 + 8, DM, win_destrow(l0), 64 * kb}; return t; } r -= I_WIN;
        if (r < I_SQ) { t = TpItem{p->w_out, nullptr, wsm, DM, 32 * (r & 31), DM, 32 * (r & 31), 64 * (r >> 5)}; return t; } r -= I_SQ;
        if (r < I_SQ) { t = TpItem{p->w_xq, p->norm_x_g, wsm + 1024 * 1024, DM, 32 * (r & 31), DM, 32 * (r & 31), 64 * (r >> 5)}; return t; } r -= I_SQ;
        if (r < I_KV) { t = TpItem{p->w_xkv, p->norm_mem_g, wsm + 2 * 1024 * 1024, 2048, 32 * (r & 63), DM, 32 * (r & 63), 64 * (r >> 6)}; return t; } r -= I_KV;
        t = TpItem{p->w_xo, nullptr, wsm + 4 * 1024 * 1024, DM, 32 * (r & 31), DM, 32 * (r & 31), 64 * (r >> 5)}; return t; } };
struct TpDecP4 { const Ptrs* p; unsigned char* ws;
    __device__ __forceinline__ TpItem operator()(int it) const {
        h16* W13 = (h16*)(ws + WS_UG); h16* W2T = (h16*)(ws + WS_UG + 64 * MiB); const int e = it / 768, r = it % 768; TpItem t;
        if (r < 256) { const int kb = r >> 4, nb = r & 15, f0 = 32 * nb; t = TpItem{p->w1 + (size_t)e * DM * FF, p->norm_moe_g, W13 + (size_t)e * 1024 * 1024, FF, f0, DM, (f0 >> 7) * 256 + (f0 & 127), 64 * kb}; return t; }
        if (r < 512) { const int q = r - 256, kb = q >> 4, nb = q & 15, f0 = 32 * nb; t = TpItem{p->w3 + (size_t)e * DM * FF, p->norm_moe_g, W13 + (size_t)e * 1024 * 1024, FF, f0, DM, (f0 >> 7) * 256 + 128 + (f0 & 127), 64 * kb}; return t; }
        const int q = r - 512, kb = q >> 5, nb = q & 31; t = TpItem{p->w2 + (size_t)e * FF * DM, nullptr, W2T + (size_t)e * 1024 * 512, DM, 32 * nb, FF, 32 * nb, 64 * kb}; return t; } };
template <bool GATES>
__device__ __forceinline__ float p0_row(const f32x4 (&v)[4], h16* orow, const LAS float* gt, float (&acc)[8], int lane) {
    float ss = 0.f;
#pragma unroll
    for (int j = 0; j < 4; ++j) ss += (v[j].x * v[j].x + v[j].y * v[j].y) + (v[j].z * v[j].z + v[j].w * v[j].w);
    GAS u32x2* o8 = (GAS u32x2*)orow + lane;
#pragma unroll
    for (int j = 0; j < 4; ++j) { u32x2 w; w.x = pk_h2(v[j].x, v[j].y); w.y = pk_h2(v[j].z, v[j].w); o8[64 * j] = w; }
    if constexpr (GATES) {
#pragma unroll
        for (int q = 0; q < 8; ++q) acc[q] = 0.f;
#pragma unroll
        for (int j = 0; j < 4; ++j)
#pragma unroll
            for (int c = 0; c < 4; ++c) { const int k = 4 * (64 * j + lane) + c; const f32x4 g0 = *(const LAS f32x4*)(gt + k * 8), g1 = *(const LAS f32x4*)(gt + k * 8 + 4); const float xv = v[j][c];
                acc[0] += xv * g0.x; acc[1] += xv * g0.y; acc[2] += xv * g0.z; acc[3] += xv * g0.w; acc[4] += xv * g1.x; acc[5] += xv * g1.y; acc[6] += xv * g1.z; acc[7] += xv * g1.w; }
        const bool b5 = (lane & 32) != 0, b4 = (lane & 16) != 0, b3 = (lane & 8) != 0; float k4[4], k2[2], k1;
#pragma unroll
        for (int q = 0; q < 4; ++q) { const float snd = b5 ? acc[q] : acc[4 + q]; k4[q] = (b5 ? acc[4 + q] : acc[q]) + __shfl_xor(snd, 32); }
#pragma unroll
        for (int q = 0; q < 2; ++q) { const float snd = b4 ? k4[q] : k4[2 + q]; k2[q] = (b4 ? k4[2 + q] : k4[q]) + __shfl_xor(snd, 16); }
        { const float snd = b3 ? k2[0] : k2[1]; k1 = (b3 ? k2[1] : k2[0]) + __shfl_xor(snd, 8); }
        k1 += __shfl_xor(k1, 4); k1 += __shfl_xor(k1, 2); k1 += __shfl_xor(k1, 1);
#pragma unroll
        for (int q = 0; q < 8; ++q) acc[q] = __builtin_bit_cast(float, __builtin_amdgcn_readlane(__builtin_bit_cast(int, k1), 8 * q));
    }
    return wave_sum(ss);
}
__device__ __forceinline__ void mstate_wave(const float* ig, const float* lf, float* mst, int bh, int lane) {
    const int b = bh >> 2, h = bh & 3; float B = 0.f, mx = -INFINITY;
    for (int s = 0; s < CHUNK; ++s) { const int t = b * SEQ + lane * CHUNK + s; B += lf[t * 4 + h]; mx = fmaxf(mx, ig[t * 4 + h] - B); }
    const float blast = B, maxw = B + mx; float m = 0.f;
    for (int c = 0; c < NCHUNK; ++c) { const float bl = __shfl(blast, c), mw = __shfl(maxw, c); if (lane == c) mst[bh * 64 + c] = m; m = fmaxf(bl + m, mw); }
}

struct Args { Ptrs p; int ph_lo, ph_hi, li, pad; };
__global__ void __launch_bounds__(NTHREADS, 2) mega(Args a) {
    extern __shared__ __attribute__((aligned(16))) unsigned char lds_[];
    LAS unsigned char* lds = (LAS unsigned char*)lds_;
    volatile LAS unsigned* MISC = (volatile LAS unsigned*)(lds + MISC_OFF);
    const Ptrs& p = a.p;
#define PH_IDS() int tid = threadIdx.x; asm volatile("" : "+v"(tid)); const int lane = tid & 63, wave = __builtin_amdgcn_readfirstlane(tid >> 6); const int gw = vcu * NWAVES + wave, NGW = G * NWAVES; (void)lane; (void)gw; (void)NGW
    const int G = gridDim.x, bx = blockIdx.x, vcu = (G % 8 == 0) ? (bx % 8) * (G / 8) + bx / 8 : bx;
    unsigned char* ws = p.ws;
    unsigned* ctl = (unsigned*)(ws + WS_CTL);
    for (int u = threadIdx.x; u < (LDS_BYTES - LDSCTL_OFF) / 4; u += NTHREADS) ((LAS unsigned*)(lds + LDSCTL_OFF))[u] = 0u;
    __syncthreads();
    XcdBarrier bar = xcd_barrier_post(ctl + CW_BAR + a.li * XCD_BAR_WORDS, MISC + 8);
    const int lo = a.ph_lo, hi = a.ph_hi;
#ifndef PH_MASK
#define PH_MASK 0xFFFF
#endif
#define IN(k) (((PH_MASK >> (k)) & 1) && lo <= (k) && (k) < hi)
#ifndef REPEAT_MASK
#define REPEAT_MASK 0
#endif
#define REP(k) for (int rep_ = 0; rep_ < 1 + ((REPEAT_MASK >> (k)) & 1); ++rep_)
#define BOTH(k) (IN(k) && IN((k) + 1))
#define GRID_BAR() xcd_barrier(bar)

    if (IN(0)) REP(0) {
        PH_IDS();
        __syncthreads();
        LAS float* gt = (LAS float*)lds;
        for (int i = tid; i < 8192; i += NTHREADS) { const int k = i >> 3, j = i & 7; gt[i] = p.norm_mix_g[k] * p.w_in[(size_t)k * IN_DIM + C_I + j]; }
        { float* wrt = (float*)(ws + OFF_WRT); for (int i = bx * NTHREADS + tid; i < 36 * 1024; i += G * NTHREADS) { const int j = i >> 10, k = i & 1023; wrt[i] = p.norm_moe_g[k] * (j < 4 ? p.w_rg[k * 4 + j] : p.w_re[k * 32 + (j - 4)]); } }
        { float* z = (float*)(ws + OFF_SSSV); for (int i = bx * NTHREADS + tid; i < 3 * NTOK; i += G * NTHREADS) z[i] = 0.f; }
        __syncthreads();
        float acc[8]; float bif[8];
#pragma unroll
        for (int h = 0; h < 8; ++h) bif[h] = p.b_if[h];
        {   f32x4 v[4], nv[4];
            if (gw < NTOK) {
#pragma unroll
                for (int j = 0; j < 4; ++j) v[j] = ((const GAS f32x4*)(p.x + (size_t)gw * DM) + lane)[64 * j]; }
            for (int m = gw; m < NTOK; m += NGW) {
                const int mn = (m + NGW < NTOK) ? m + NGW : m;
#pragma unroll
                for (int j = 0; j < 4; ++j) nv[j] = ((const GAS f32x4*)(p.x + (size_t)mn * DM) + lane)[64 * j];
                asm volatile("" ::: "memory");
                const float ss = p0_row<true>(v, (h16*)(ws + WS_XH) + (size_t)m * DM, gt, acc, lane);
                const float rstd = rsqrtf(ss * (1.f / DM) + EPS);
                if (lane == 0) { ((float*)(ws + OFF_RSTD0))[m] = rstd; f32x4 igv, lfv;
#pragma unroll
                    for (int h = 0; h < 4; ++h) { igv[h] = acc[h] * rstd + bif[h]; lfv[h] = logsigmoidf_(acc[4 + h] * rstd + bif[4 + h]); }
                    *(f32x4*)((float*)(ws + OFF_IG) + m * 4) = igv; *(f32x4*)((float*)(ws + OFF_LF) + m * 4) = lfv; }
#pragma unroll
                for (int j = 0; j < 4; ++j) v[j] = nv[j];
            }
        }
        for (int m = gw; m < NB * NMEM; m += NGW) { f32x4 v[4];
#pragma unroll
            for (int j = 0; j < 4; ++j) v[j] = ((const GAS f32x4*)(p.mem + (size_t)m * DM) + lane)[64 * j];
            const float ss = p0_row<false>(v, (h16*)(ws + WS_MEMH) + (size_t)m * DM, gt, acc, lane);
            if (lane == 0) ((float*)(ws + OFF_RSTDM))[m] = rsqrtf(ss * (1.f / DM) + EPS);
        }
        LAS unsigned char* scr = lds + 32768 + wave * 4096;
        { TpDecP0 dec{&p, ws}; tp_loop(dec, gw, 16 * 256 + 3 * 16 * 32 + 16 * 64, NGW, scr, lane); }
        if (BOTH(0)) GRID_BAR();
    }
    if (IN(1)) REP(1) {
        PH_IDS();
        if (bx < 8) mstate_ext(ws, bx, wave, lane);
        { pg8::StaticOrder S; S.init(ws + WS_XH, ws + WS_WIN, NTOK, 8192, DM, G, bx);
          EpiProj E{(const float*)(ws + OFF_RSTD0), p.b_gate, (h16*)p.out, (h16*)(ws + WS_V), (h16*)(ws + WS_OG), (h16*)(ws + WS_UG), (h16*)(ws + WS_SV), (float*)(ws + OFF_SSSV), rep_ == 0};
          pg8::gemm_phase<EpiProj, pg8::StaticOrder, false, true>(lds, DM, S, E); }
        { pg8::StaticOrder S; S.init(ws + WS_MEMH, ws + WS_WSM + 2 * 2097152, NB * NMEM, 2048, DM, G, (bx + G - 64) % G);
          EpiKV E{(const float*)(ws + OFF_RSTDM), (h16*)(ws + WS_KM), (h16*)(ws + WS_VTM)};
          pg8::gemm_phase<EpiKV, pg8::StaticOrder, false, true>(lds, DM, S, E); }
        if (BOTH(1)) GRID_BAR();
    }

    if (IN(2)) REP(2) {
        if (G >= 256) { if (bx < 128) scan_task(lds, p, ws, bx); else if (bx < 256) sgu_task(lds, p, ws, bx - 128); }
        else { for (int t = bx; t < 256; t += G) { if (t < 128) scan_task(lds, p, ws, t); else sgu_task(lds, p, ws, t - 128); __syncthreads(); } }
        if (BOTH(2)) GRID_BAR();
    }
    if (IN(3)) REP(3) {
        mout_phase(lds, p, ws, G, bx, (((REPEAT_MASK >> 3) & 1) && rep_ == 0) ? (h16*)(ws + WS_UG) : (h16*)(ws + WS_XH));
        if (BOTH(3)) GRID_BAR();
    }
    if (IN(4)) REP(4) {
        PH_IDS();
        { LAS unsigned char* scr = lds + 32768 + wave * 4096;
          TpDecP4 dec{&p, ws}; tp_loop(dec, gw, 32 * 768, NGW, scr, lane);
          __syncthreads(); }
        { pg8::StaticOrder S; S.init(ws + WS_XH, ws + WS_WSM, NTOK, DM, DM, G, bx);
          EpiResid E{p.x, p.out, (h16*)(ws + WS_V), (float*)(ws + OFF_SS1), rep_ == 0};
          pg8::gemm_phase<EpiResid, pg8::StaticOrder, false, false>(lds, DM, S, E); }
        if (BOTH(4)) GRID_BAR();
    }
    if (IN(5)) REP(5) {
        { pg8::StaticOrder S; S.init(ws + WS_V, ws + WS_WSM + 2097152, NTOK, DM, DM, G, bx);
          EpiQ E{(const float*)(ws + OFF_SS1), (h16*)(ws + WS_XH)};
          pg8::gemm_phase<EpiQ, pg8::StaticOrder, false, false>(lds, DM, S, E); }
        if (BOTH(5)) GRID_BAR();
    }
    if (IN(6)) REP(6) {
        attn_phase(lds, (const h16*)(ws + WS_XH), (const h16*)(ws + WS_KM), (const h16*)(ws + WS_VTM), (h16*)(ws + WS_OG), G, bx);
        if (BOTH(6)) GRID_BAR();
    }
    if (IN(7)) {
        { pg8::StaticOrder S; S.init(ws + WS_OG, ws + WS_WSM + 4 * 2097152, NTOK, DM, DM, G, bx);
          EpiResid E{p.out, p.out, (h16*)(ws + WS_V), (float*)(ws + OFF_SS2), true};
          pg8::gemm_phase<EpiResid, pg8::StaticOrder, false, false>(lds, DM, S, E); }
        if (BOTH(7)) GRID_BAR();
    }
    if (IN(8)) REP(8) {
        PH_IDS();
        if (rep_ == 1) { GRID_BAR(); if (bx == 0 && tid < 32) (ctl + CW_CNT)[tid] = 0u; GRID_BAR(); }
        unsigned* cnt = ctl + CW_CNT; int* list = (int*)(ws + OFF_LIST); float* gate = (float*)(ws + OFF_GATE);
        const float* ss2 = (const float*)(ws + OFF_SS2); const float* WRT = (const float*)(ws + OFF_WRT);
        const bool b5 = (lane & 32) != 0, b4 = (lane & 16) != 0, b3 = (lane & 8) != 0;
        int myE = 0, mySlot = 0; float myG = 0.f; int nmine = 0;
        f32x4 xn[4]; float ssc = 1.f;
        if (gw < NTOK) { ssc = ss2[gw];
#pragma unroll
            for (int j = 0; j < 4; ++j) xn[j] = ((const GAS f32x4*)(p.out + (size_t)gw * DM) + lane)[64 * j]; }
        for (int t = gw; t < NTOK; t += NGW) {
            const int tn = (t + NGW < NTOK) ? t + NGW : t; const GAS f32x4* xr = (const GAS f32x4*)(p.out + (size_t)tn * DM) + lane; const float rs = rsqrtf(ssc * (1.f / DM) + EPS);
            f32x4 v[4];
#pragma unroll
            for (int j = 0; j < 4; ++j) { v[j] = xn[j] * rs; xn[j] = xr[64 * j]; }
            ssc = ss2[tn];
            float a0 = 0.f, a1 = 0.f, a2 = 0.f, a3 = 0.f;
            { f32x4 wv[16];
#pragma unroll
              for (int j = 0; j < 4; ++j) { const GAS f32x4* wp = (const GAS f32x4*)WRT + 64 * j + lane; wv[4 * j] = wp[0]; wv[4 * j + 1] = wp[256]; wv[4 * j + 2] = wp[512]; wv[4 * j + 3] = wp[768]; }
              REGBAR16(wv);
#pragma unroll
              for (int j = 0; j < 4; ++j) { const f32x4 w0 = wv[4 * j], w1 = wv[4 * j + 1], w2 = wv[4 * j + 2], w3 = wv[4 * j + 3];
                a0 += (v[j].x * w0.x + v[j].y * w0.y) + (v[j].z * w0.z + v[j].w * w0.w); a1 += (v[j].x * w1.x + v[j].y * w1.y) + (v[j].z * w1.z + v[j].w * w1.w);
                a2 += (v[j].x * w2.x + v[j].y * w2.y) + (v[j].z * w2.z + v[j].w * w2.w); a3 += (v[j].x * w3.x + v[j].y * w3.y) + (v[j].z * w3.z + v[j].w * w3.w); } }
            { const float s0 = b5 ? a0 : a2, s1 = b5 ? a1 : a3; float k0 = (b5 ? a2 : a0) + __shfl_xor(s0, 32), k1 = (b5 ? a3 : a1) + __shfl_xor(s1, 32);
              const float s2 = b4 ? k0 : k1; a0 = (b4 ? k1 : k0) + __shfl_xor(s2, 16); }
            a0 += __shfl_xor(a0, 8); a0 += __shfl_xor(a0, 4); a0 += __shfl_xor(a0, 2); a0 += __shfl_xor(a0, 1);
            float gl[4];
#pragma unroll
            for (int j = 0; j < 4; ++j) gl[j] = __builtin_bit_cast(float, __builtin_amdgcn_readlane(__builtin_bit_cast(int, a0), 16 * j)) + p.b_rg[j];
            int gi = 0; float gm = gl[0];
#pragma unroll
            for (int j = 1; j < 4; ++j) if (gl[j] > gm) { gm = gl[j]; gi = j; }
            float gs = 0.f;
#pragma unroll
            for (int j = 0; j < 4; ++j) gs += __expf(gl[j] - gm);
            const float pg = 1.f / gs;
            float e[8];
#pragma unroll
            for (int q = 0; q < 8; ++q) e[q] = 0.f;
            const GAS f32x4* we = (const GAS f32x4*)WRT + (size_t)(4 + gi * 8) * 256 + lane;
#pragma unroll
            for (int hq = 0; hq < 2; ++hq) { f32x4 wv[16];
#pragma unroll
                for (int q = 0; q < 4; ++q)
#pragma unroll
                    for (int j = 0; j < 4; ++j) wv[4 * q + j] = we[(4 * hq + q) * 256 + 64 * j];
                REGBAR16(wv);
#pragma unroll
                for (int q = 0; q < 4; ++q)
#pragma unroll
                    for (int j = 0; j < 4; ++j) { const f32x4 w = wv[4 * q + j]; e[4 * hq + q] += (v[j].x * w.x + v[j].y * w.y) + (v[j].z * w.z + v[j].w * w.w); } }
            float k4[4];
#pragma unroll
            for (int q = 0; q < 4; ++q) { const float snd = b5 ? e[q] : e[4 + q]; k4[q] = (b5 ? e[4 + q] : e[q]) + __shfl_xor(snd, 32); }
            float k2[2];
#pragma unroll
            for (int q = 0; q < 2; ++q) { const float snd = b4 ? k4[q] : k4[2 + q]; k2[q] = (b4 ? k4[2 + q] : k4[q]) + __shfl_xor(snd, 16); }
            float k1; { const float snd = b3 ? k2[0] : k2[1]; k1 = (b3 ? k2[1] : k2[0]) + __shfl_xor(snd, 8); }
            k1 += __shfl_xor(k1, 4); k1 += __shfl_xor(k1, 2); k1 += __shfl_xor(k1, 1);
            float ev[8];
#pragma unroll
            for (int q = 0; q < 8; ++q) ev[q] = __builtin_bit_cast(float, __builtin_amdgcn_readlane(__builtin_bit_cast(int, k1), 8 * q)) + p.b_re[gi * 8 + q];
            int i1 = 0; float v1 = ev[0];
#pragma unroll
            for (int q = 1; q < 8; ++q) if (ev[q] > v1) { v1 = ev[q]; i1 = q; }
            int i2 = -1; float v2 = -INFINITY;
#pragma unroll
            for (int q = 0; q < 8; ++q) if (q != i1 && ev[q] > v2) { v2 = ev[q]; i2 = q; }
            const float e2 = __expf(v2 - v1), g1 = pg / (1.f + e2), g2 = pg * e2 / (1.f + e2);
            if (lane == 2 * nmine) { myE = gi * 8 + i1; mySlot = 2 * t; myG = g1; }
            if (lane == 2 * nmine + 1) { myE = gi * 8 + i2; mySlot = 2 * t + 1; myG = g2; }
            ++nmine;
            if (nmine == 32) { { const unsigned pos = atomicAdd(cnt + myE, 1u); list[myE * NTOK + pos] = mySlot; gate[mySlot] = myG; } nmine = 0; }
        }
        if (lane < 2 * nmine) { const unsigned pos = atomicAdd(cnt + myE, 1u); list[myE * NTOK + pos] = mySlot; gate[mySlot] = myG; }
        if (BOTH(8)) GRID_BAR();
    }
    if (IN(9) || IN(10)) {
        PH_IDS();
        LAS int* tab = (LAS int*)(lds + LDSCTL_OFF + 1024);
        if (tid == 0) { const unsigned* cnt = ctl + CW_CNT; int s = 0; for (int e = 0; e < 32; ++e) { tab[e] = s; s += (int)((__hip_atomic_load(cnt + e, RLX_AGENT) + 255u) >> 8); } tab[32] = s; }
        __syncthreads();
        if (IN(9)) REP(9) {
            MoeOrder S{(const char*)(ws + WS_V), (const char*)(ws + WS_UG), DM, (size_t)1024 * 1024 * 2, (const int*)(ws + OFF_LIST), ctl + CW_CNT, tab, G, bx};
            EpiFfn1 E{(const int*)(ws + OFF_LIST), (const float*)(ws + OFF_SS2), (h16*)(ws + WS_H)};
            pg8::gemm_phase<EpiFfn1, MoeOrder, true, true>(lds, DM, S, E);
            if (BOTH(9)) GRID_BAR();
        }
        if (IN(10)) REP(10) {
            MoeOrder S{(const char*)(ws + WS_H), (const char*)(ws + WS_UG + 64 * MiB), FF, (size_t)1024 * 512 * 2, (const int*)(ws + OFF_LIST), ctl + CW_CNT, tab, G, bx};
            EpiFfn2 E{(const int*)(ws + OFF_LIST), (const float*)(ws + OFF_GATE), (h16*)(ws + WS_Y)};
            pg8::gemm_phase<EpiFfn2, MoeOrder, false, true>(lds, FF, S, E);
            if (BOTH(10)) GRID_BAR();
        }
    }
    if (IN(11)) REP(11) {
        PH_IDS();
        float* fdst = (((REPEAT_MASK >> 11) & 1) && rep_ == 0) ? (float*)(ws + WS_UG) : p.out;
        for (int t = gw; t < NTOK; t += NGW) {
            GAS f32x4* xr = (GAS f32x4*)(p.out + (size_t)t * DM) + lane; const GAS u32x2* y0 = (const GAS u32x2*)(ws + WS_Y + (size_t)(2 * t) * DM * 2) + lane; const GAS u32x2* y1 = y0 + DM / 4;
            f32x4 v[4]; float ss = 0.f;
#pragma unroll
            for (int j = 0; j < 4; ++j) { const u32x2 a = y0[64 * j], b = y1[64 * j]; const h16x4 ha = __builtin_bit_cast(h16x4, a), hb = __builtin_bit_cast(h16x4, b);
                v[j] = xr[64 * j];
#pragma unroll
                for (int c = 0; c < 4; ++c) { v[j][c] += (float)ha[c] + (float)hb[c]; ss += v[j][c] * v[j][c]; } }
            ss = wave_sum(ss); const float rs = rsqrtf(ss * (1.f / DM) + EPS);
#pragma unroll
            for (int j = 0; j < 4; ++j) { const f32x4 g = *(const f32x4*)(p.norm_f_g + 4 * (64 * j + lane)); ((GAS f32x4*)(fdst + (size_t)t * DM) + lane)[64 * j] = v[j] * rs * g; }
        }
    }
#undef IN
#undef BOTH
#undef GRID_BAR
}

static int mega_grid() {
    static int grid = 0;
    if (grid == 0) {
        int dev = 0, cus = 0;
        if (hipGetDevice(&dev) != hipSuccess || hipDeviceGetAttribute(&cus, hipDeviceAttributeMultiprocessorCount, dev) != hipSuccess) { grid = -1; return grid; }
        if (hipFuncSetAttribute((const void*)mega, hipFuncAttributeMaxDynamicSharedMemorySize, LDS_BYTES) != hipSuccess) { fprintf(stderr, "hipFuncSetAttribute failed\n"); grid = -1; return grid; }
        (void)hipGetLastError();
        grid = cus;
    }
    return grid;
}
static void launch_mega(const Ptrs& p, int lo, int hi, int li, hipStream_t stream) {
    const int grid = mega_grid(); if (grid <= 0) return;
    Args a{}; a.p = p; a.ph_lo = lo; a.ph_hi = hi; a.li = li; a.pad = 0;
    hipLaunchKernelGGL(mega, dim3(grid), dim3(NTHREADS), LDS_BYTES, stream, a);
}

extern "C" void kernel_launch(void* const* d_in, const int* in_sizes, int n_in, void* d_out, int out_size, void* d_ws, size_t ws_size, hipStream_t stream) {
    if (n_in != 27 || ws_size < WS_END) { fprintf(stderr, "kernel_launch: unexpected n_in %d or ws_size %zu (< %zu)\n", n_in, ws_size, (size_t)WS_END); return; }
    Ptrs p{};
    const float** f = (const float**)&p;
    for (int i = 0; i < 27; ++i) f[i] = (const float*)d_in[i];
    p.out = (float*)d_out; p.ws = (unsigned char*)d_ws;
    (void)hipMemsetAsync((char*)d_ws + WS_CTL, 0, CTL_BYTES, stream);
    launch_mega(p, 0, 12, 0, stream);
}
```

```cpp
#include <hip/hip_runtime.h>
#include <cstdio>
#include <cstdint>
#include <cmath>

typedef _Float16 h16;
typedef unsigned short u16;

constexpr int DM = 1024, NB = 2, SEQ = 8192, NTOK = NB * SEQ;
constexpr int NMEM = 256, NHEAD = 4, DH = 256, CHUNK = 128, NCHUNK = SEQ / CHUNK;
constexpr int IN_DIM = 8200;
constexpr int C_QK = 0, C_V = 2048, C_O = 3072, C_I = 4096, C_F = 4100, C_U = 4104, C_SV = 5128, C_G = 6152;
constexpr int NEXP = 32, NGRP = 4, EPG = 8, FF = 512, NSLOT = NTOK * 2;
constexpr float EPS = 1e-6f;

constexpr size_t MiB = 1u << 20;
constexpr size_t WS_CTL = 0;
constexpr size_t CTL_BYTES = 1 * MiB;
constexpr size_t WS_SMALL = 1 * MiB;
constexpr size_t OFF_RSTD0 = WS_SMALL;
constexpr size_t OFF_SSSV  = OFF_RSTD0 + 65536;
constexpr size_t OFF_SS1   = OFF_SSSV + 65536;
constexpr size_t OFF_SS2   = OFF_SS1 + 65536;
constexpr size_t OFF_IG    = OFF_SS2 + 65536;
constexpr size_t OFF_LF    = OFF_IG + 262144;
constexpr size_t OFF_MST   = OFF_LF + 262144;
constexpr size_t OFF_RSTDM = OFF_MST + 4096;
constexpr size_t OFF_AL    = 4 * MiB + 1048576;
constexpr size_t OFF_BE    = OFF_AL + 262144;
constexpr size_t OFF_NM    = OFF_BE + 262144;
constexpr size_t OFF_WU    = OFF_NM + 262144;
constexpr size_t OFF_DEC   = OFF_WU + 262144;
constexpr size_t OFF_WRT   = 7 * MiB;
constexpr size_t OFF_GATE  = 2 * MiB;
constexpr size_t OFF_SLOTE = OFF_GATE + 131072;
constexpr size_t OFF_SLOTP = OFF_SLOTE + 131072;
constexpr size_t OFF_LIST  = 3 * MiB;
constexpr size_t OFF_NAIVE_C = 262 * MiB;
constexpr size_t OFF_NAIVE_N = 6 * MiB + 8192;
constexpr size_t OFF_NAIVE_S = 6 * MiB + 65536;
constexpr size_t WS_WSM  = 8 * MiB;
constexpr size_t WS_KM   = 18 * MiB;
constexpr size_t WS_VTM  = 19 * MiB;
constexpr size_t WS_WIN  = 20 * MiB;
constexpr size_t WS_XH   = 36 * MiB;
constexpr size_t WS_V    = 68 * MiB;
constexpr size_t WS_OG   = 100 * MiB;
constexpr size_t WS_UG   = 132 * MiB;
constexpr size_t WS_SV   = 164 * MiB;
constexpr size_t WS_CST  = 196 * MiB;
constexpr size_t WS_H    = 228 * MiB;
constexpr size_t WS_NST  = 260 * MiB;
constexpr size_t WS_MEMH = 261 * MiB;
constexpr size_t WS_END  = 268 * MiB;
constexpr size_t WS_Y    = WS_XH;
constexpr size_t WS_QC   = WS_UG;
constexpr size_t WS_KC   = WS_SV;
static_assert(OFF_RSTDM + 4096 <= 2 * MiB && OFF_SLOTP + 131072 <= OFF_LIST && OFF_LIST + 2 * MiB <= OFF_AL && OFF_DEC + 4096 <= OFF_NAIVE_N && OFF_NAIVE_N + 8192 <= OFF_NAIVE_S && OFF_NAIVE_S + 524288 <= WS_WSM && OFF_NAIVE_C + 2 * MiB <= WS_END, "small map");
constexpr int CW_CNT = 64;

struct Ptrs {
    const float *x, *mem, *norm_mix_g, *w_in, *b_gate, *b_if, *conv_w, *conv_b, *mh_norm_g, *sgu_norm_g, *w_s, *b_s, *w_out,
                *norm_x_g, *norm_mem_g, *w_xq, *w_xkv, *w_xo, *norm_moe_g, *w_rg, *b_rg, *w_re, *b_re, *w1, *w3, *w2, *norm_f_g;
    float* out; unsigned char* ws;
};

__device__ __forceinline__ float sigmoidf_(float v) { return 1.f / (1.f + __expf(-v)); }
__device__ __forceinline__ float siluf_(float v) { return v / (1.f + __expf(-v)); }
__device__ __forceinline__ float gelu_tanh(float v) { const float u = 0.7978845608028654f * (v + 0.044715f * v * v * v); return v / (1.f + __expf(-2.f * u)); }
__device__ __forceinline__ float logsigmoidf_(float v) { return fminf(v, 0.f) - log1pf(__expf(-fabsf(v))); }
__device__ __forceinline__ float wave_sum(float v) {
#pragma unroll
    for (int o = 1; o < 64; o <<= 1) v += __shfl_xor(v, o);
    return v;
}
__device__ __forceinline__ float wave_max(float v) {
#pragma unroll
    for (int o = 1; o < 64; o <<= 1) v = fmaxf(v, __shfl_xor(v, o));
    return v;
}
__host__ __device__ __forceinline__ int vt_slot(int key) { const int g = key & ~15, r = key & 15;   const int hh = (r >> 2) & 1, j = ((r >> 3) << 2) | (r & 3); return g + 8 * hh + j; }

__global__ void nk_zero(Ptrs p) {
    float* a = (float*)(p.ws + OFF_SSSV);
    const int i = blockIdx.x * blockDim.x + threadIdx.x;
    if (i < 3 * NTOK) a[i] = 0.f;
}
__global__ void nk_rows0(Ptrs p) {
    const int row = blockIdx.x * 4 + (threadIdx.x >> 6), lane = threadIdx.x & 63;
    const float* xr = p.x + (size_t)row * DM;
    float ss = 0.f; float acc[8];
#pragma unroll
    for (int j = 0; j < 8; ++j) acc[j] = 0.f;
    h16* xh = (h16*)(p.ws + WS_XH) + (size_t)row * DM;
    for (int k = lane; k < DM; k += 64) {
        const float v = xr[k]; ss += v * v; xh[k] = (h16)v;
        const float vg = v * p.norm_mix_g[k];
#pragma unroll
        for (int j = 0; j < 8; ++j) acc[j] += vg * p.w_in[(size_t)k * IN_DIM + C_I + j];
    }
    ss = wave_sum(ss);
    const float rstd = rsqrtf(ss / DM + EPS);
#pragma unroll
    for (int j = 0; j < 8; ++j) acc[j] = wave_sum(acc[j]);
    if (lane == 0) {
        ((float*)(p.ws + OFF_RSTD0))[row] = rstd;
        float* ig = (float*)(p.ws + OFF_IG) + row * 4; float* lf = (float*)(p.ws + OFF_LF) + row * 4;
#pragma unroll
        for (int h = 0; h < 4; ++h) { ig[h] = acc[h] * rstd + p.b_if[h]; lf[h] = logsigmoidf_(acc[4 + h] * rstd + p.b_if[4 + h]); }
    }
}
__global__ void nk_mem(Ptrs p) {
    const int row = blockIdx.x * 4 + (threadIdx.x >> 6), lane = threadIdx.x & 63;
    const float* xr = p.mem + (size_t)row * DM; h16* o = (h16*)(p.ws + WS_MEMH) + (size_t)row * DM;
    float ss = 0.f;
    for (int k = lane; k < DM; k += 64) { const float v = xr[k]; ss += v * v; o[k] = (h16)v; }
    ss = wave_sum(ss);
    if (lane == 0) ((float*)(p.ws + OFF_RSTDM))[row] = rsqrtf(ss / DM + EPS);
}
__global__ void nk_mstate(Ptrs p) {
    const int bh = blockIdx.x, b = bh >> 2, h = bh & 3, lane = threadIdx.x;
    const float* ig = (const float*)(p.ws + OFF_IG); const float* lf = (const float*)(p.ws + OFF_LF);
    float B = 0.f, mx = -INFINITY;
    for (int s = 0; s < CHUNK; ++s) { const int t = b * SEQ + lane * CHUNK + s; B += lf[t * 4 + h]; mx = fmaxf(mx, ig[t * 4 + h] - B); }
    const float blast = B, maxw = B + mx;
    __shared__ float sb[64], sm[64];
    sb[lane] = blast; sm[lane] = maxw; __syncthreads();
    if (lane == 0) { float m = 0.f; float* mst = (float*)(p.ws + OFF_MST) + bh * 64;
        for (int c = 0; c < NCHUNK; ++c) { mst[c] = m; m = fmaxf(sb[c] + m, sm[c]); } }
}
__global__ void nk_proj(Ptrs p) {
    const int l = blockIdx.x * 256 + threadIdx.x;
    const int r0 = blockIdx.y * 8;
    int c0, c1 = -1, kind;
    if (l < 2048) { c0 = C_QK + l; kind = 0; }
    else if (l < 3072) { c0 = C_V + (l - 2048); kind = 1; }
    else if (l < 4096) { c0 = C_O + (l - 3072); c1 = C_G + (l - 3072); kind = 2; }
    else if (l < 5120) { c0 = C_U + (l - 4096); c1 = C_G + 1024 + (l - 4096); kind = 3; }
    else if (l < 6144) { c0 = C_SV + (l - 5120); kind = 4; }
    else return;
    float a0[8], a1[8];
#pragma unroll
    for (int r = 0; r < 8; ++r) { a0[r] = 0.f; a1[r] = 0.f; }
    for (int k = 0; k < DM; ++k) {
        const float g = p.norm_mix_g[k];
        const float w0 = p.w_in[(size_t)k * IN_DIM + c0] * g;
        const float w1 = (c1 >= 0) ? p.w_in[(size_t)k * IN_DIM + c1] * g : 0.f;
#pragma unroll
        for (int r = 0; r < 8; ++r) { const float xv = p.x[(size_t)(r0 + r) * DM + k]; a0[r] += xv * w0; a1[r] += xv * w1; }
    }
    const float* rstd0 = (const float*)(p.ws + OFF_RSTD0);
#pragma unroll
    for (int r = 0; r < 8; ++r) {
        const int t = r0 + r; const float rs = rstd0[t]; const float v0 = a0[r] * rs, v1 = a1[r] * rs;
        if (kind == 0) ((h16*)p.out)[(size_t)t * 2048 + l] = (h16)v0;
        else if (kind == 1) ((h16*)(p.ws + WS_V))[(size_t)t * DM + (l - 2048)] = (h16)v0;
        else if (kind == 2) { const int c = l - 3072; ((h16*)(p.ws + WS_OG))[(size_t)t * DM + c] = (h16)(sigmoidf_(v0) * sigmoidf_(v1 + p.b_gate[c])); }
        else if (kind == 3) { const int c = l - 4096; ((h16*)(p.ws + WS_UG))[(size_t)t * DM + c] = (h16)(gelu_tanh(v0) * sigmoidf_(v1 + p.b_gate[1024 + c])); }
        else { const int c = l - 5120; const float gv = gelu_tanh(v0); ((h16*)(p.ws + WS_SV))[(size_t)t * DM + c] = (h16)gv; atomicAdd((float*)(p.ws + OFF_SSSV) + t, gv * gv); }
    }
}
__global__ void nk_conv(Ptrs p) {
    const size_t i = (size_t)blockIdx.x * 256 + threadIdx.x; const int t = (int)(i >> 11), c = (int)(i & 2047), tl = t & (SEQ - 1);
    const h16* qk = (const h16*)p.out;
    float a = p.conv_b[c];
#pragma unroll
    for (int j = 0; j < 4; ++j) { const int dt = j - 3; if (tl + dt >= 0) a += p.conv_w[j * 2048 + c] * (float)qk[(size_t)(t + dt) * 2048 + c]; }
    a = siluf_(a);
    if (c < 1024) ((h16*)(p.ws + WS_QC))[(size_t)t * DM + c] = (h16)a; else ((h16*)(p.ws + WS_KC))[(size_t)t * DM + (c - 1024)] = (h16)(a * 0.0625f);
}
__global__ void __launch_bounds__(1024) nk_mlstm(Ptrs p) {
    const int bh = blockIdx.x, b = bh >> 2, hd = bh & 3, tid = threadIdx.x;
    const h16* Qc = (const h16*)(p.ws + WS_QC); const h16* Kc = (const h16*)(p.ws + WS_KC); const h16* V = (const h16*)(p.ws + WS_V);
    float* C = (float*)(p.ws + OFF_NAIVE_C) + (size_t)bh * 65536; float* nvec = (float*)(p.ws + OFF_NAIVE_N) + bh * 256; float* Sp = (float*)(p.ws + OFF_NAIVE_S) + (size_t)bh * 16384;
    const float* ig = (const float*)(p.ws + OFF_IG); const float* lf = (const float*)(p.ws + OFF_LF);
    float* Hout = p.out;
    __shared__ float s_b[128], s_ic[128], s_mt[128], s_iw[128], s_ws[128], s_misc[4];
    for (int i = tid; i < 65536; i += 1024) C[i] = 0.f;
    if (tid < 256) nvec[tid] = 0.f;
    float m = 0.f;
    __syncthreads();
    for (int c = 0; c < NCHUNK; ++c) {
        const int t0 = b * SEQ + c * CHUNK;
        if (tid == 0) { float B = 0.f; for (int s = 0; s < CHUNK; ++s) { B += lf[(t0 + s) * 4 + hd]; s_b[s] = B; s_ic[s] = ig[(t0 + s) * 4 + hd]; } }
        __syncthreads();
        if (tid < 128) { const int t = tid; float mx = s_b[t] + m; for (int s = 0; s <= t; ++s) mx = fmaxf(mx, s_b[t] - s_b[s] + s_ic[s]); s_mt[t] = mx; s_iw[t] = __expf(s_b[t] + m - mx); }
        if (tid == 128) { const float bl = s_b[127]; float mx = bl + m; for (int s = 0; s < CHUNK; ++s) mx = fmaxf(mx, bl - s_b[s] + s_ic[s]); s_misc[0] = mx; s_misc[1] = __expf(bl + m - mx); }
        __syncthreads();
        if (tid < 128) s_ws[tid] = __expf(s_b[127] - s_b[tid] + s_ic[tid] - s_misc[0]);
        for (int i = tid; i < 16384; i += 1024) { const int t = i >> 7, s = i & 127; float v = 0.f;
            if (s <= t) { float d = 0.f; const h16* q = Qc + (size_t)(t0 + t) * DM + hd * DH; const h16* k = Kc + (size_t)(t0 + s) * DM + hd * DH;
                for (int e = 0; e < DH; ++e) d += (float)q[e] * (float)k[e];
                v = d * __expf(s_b[t] - s_b[s] + s_ic[s] - s_mt[t]); }
            Sp[i] = v; }
        __threadfence_block(); __syncthreads();
        for (int i = tid; i < 32768; i += 1024) { const int t = i >> 8, e = i & 255; float num = 0.f, den = 0.f;
            for (int s = 0; s <= t; ++s) { const float sv = Sp[t * 128 + s]; num += sv * (float)V[(size_t)(t0 + s) * DM + hd * DH + e]; den += sv; }
            float qc = 0.f, qn = 0.f; const h16* q = Qc + (size_t)(t0 + t) * DM + hd * DH;
            for (int d = 0; d < DH; ++d) { const float qv = (float)q[d]; qc += qv * C[d * 256 + e]; qn += qv * nvec[d]; }
            num += s_iw[t] * qc; den += s_iw[t] * qn;
            Hout[(size_t)(t0 + t) * DM + hd * DH + e] = num / fmaxf(fabsf(den), __expf(-s_mt[t])); }
        __syncthreads();
        const float decay = s_misc[1];
        for (int i = tid; i < 65536; i += 1024) { const int d = i >> 8, e = i & 255; float a = 0.f;
            for (int s = 0; s < CHUNK; ++s) a += s_ws[s] * (float)Kc[(size_t)(t0 + s) * DM + hd * DH + d] * (float)V[(size_t)(t0 + s) * DM + hd * DH + e];
            C[i] = decay * C[i] + a; }
        if (tid < 256) { float a = 0.f; for (int s = 0; s < CHUNK; ++s) a += s_ws[s] * (float)Kc[(size_t)(t0 + s) * DM + hd * DH + tid]; nvec[tid] = decay * nvec[tid] + a; }
        m = s_misc[0];
        __threadfence_block(); __syncthreads();
    }
}

__global__ void __launch_bounds__(1024) nk_mout(Ptrs p) {
    const int bh = blockIdx.x >> 6, c = blockIdx.x & 63, b = bh >> 2, hd = bh & 3, tid = threadIdx.x, t0 = b * SEQ + c * CHUNK;
    const h16* Qc = (const h16*)(p.ws + WS_QC); const h16* Kc = (const h16*)(p.ws + WS_KC); const h16* V = (const h16*)(p.ws + WS_V);
    const h16* Ct = (const h16*)(p.ws + WS_CST) + ((size_t)(bh * 64 + c)) * 65536; const float* nst = (const float*)(p.ws + WS_NST) + (size_t)(bh * 64 + c) * 256;
    const float* AL = (const float*)(p.ws + OFF_AL); const float* BE = (const float*)(p.ws + OFF_BE); const float* NM = (const float*)(p.ws + OFF_NM);
    const float mc = ((const float*)(p.ws + OFF_MST))[bh * 64 + c];
    __shared__ h16 Sp[128 * 128];
    for (int i = tid; i < 16384; i += 1024) { const int t = i >> 7, s = i & 127; float v = 0.f;
        if (s <= t) { float d = 0.f; const h16* q = Qc + (size_t)(t0 + t) * DM + hd * DH; const h16* k = Kc + (size_t)(t0 + s) * DM + hd * DH;
            for (int e = 0; e < DH; ++e) d += (float)q[e] * (float)k[e];
            v = d * __expf(AL[(t0 + t) * 4 + hd] + BE[(t0 + s) * 4 + hd]); }
        Sp[i] = (h16)v; }
    __syncthreads();
    for (int i = tid; i < 32768; i += 1024) { const int t = i >> 8, e = i & 255; float num = 0.f, den = 0.f;
        for (int s = 0; s <= t; ++s) { const float sv = (float)Sp[t * 128 + s]; num += sv * (float)V[(size_t)(t0 + s) * DM + hd * DH + e]; den += sv; }
        float qc = 0.f, qn = 0.f; const h16* q = Qc + (size_t)(t0 + t) * DM + hd * DH;
        for (int d = 0; d < DH; ++d) { const float qv = (float)q[d]; qc += qv * (float)Ct[e * 256 + d]; qn += qv * nst[d]; }
        const float iw = __expf(AL[(t0 + t) * 4 + hd] + mc);
        num += iw * qc; den += iw * qn;
        p.out[(size_t)(t0 + t) * DM + hd * DH + e] = num / fmaxf(fabsf(den), __expf(NM[(t0 + t) * 4 + hd])); }
}
__global__ void nk_sgu(Ptrs p) {
    const size_t i = (size_t)blockIdx.x * 256 + threadIdx.x; const int t = (int)(i >> 10), ch = (int)(i & 1023), g = ch >> 7, tl = t & 127, t0 = t - tl;
    const h16* SV = (const h16*)(p.ws + WS_SV); const float* ss = (const float*)(p.ws + OFF_SSSV);
    float a = 0.f;
    for (int s = 0; s <= tl; ++s) a += p.w_s[(g * 128 + tl) * 128 + s] * (float)SV[(size_t)(t0 + s) * DM + ch] * rsqrtf(ss[t0 + s] / DM + EPS);
    a = a * p.sgu_norm_g[ch] + p.b_s[g * 128 + tl];
    ((h16*)(p.ws + WS_XH))[i] = (h16)((float)((const h16*)(p.ws + WS_UG))[i] * a);
}
__global__ void nk_ya(Ptrs p) {
    const int w = blockIdx.x * 4 + (threadIdx.x >> 6), lane = threadIdx.x & 63, t = w >> 2, hd = w & 3;
    const float* hrow = p.out + (size_t)t * DM + hd * DH; float v[4]; float ss = 0.f;
#pragma unroll
    for (int j = 0; j < 4; ++j) { v[j] = hrow[lane + 64 * j]; ss += v[j] * v[j]; }
    ss = wave_sum(ss); const float rs = rsqrtf(ss / DH + EPS);
    h16* Z = (h16*)(p.ws + WS_XH) + (size_t)t * DM + hd * DH; const h16* OG = (const h16*)(p.ws + WS_OG) + (size_t)t * DM + hd * DH;
#pragma unroll
    for (int j = 0; j < 4; ++j) { const int e = lane + 64 * j; Z[e] = (h16)((float)Z[e] + v[j] * rs * p.mh_norm_g[hd * DH + e] * (float)OG[e]); }
}
__global__ void nk_wout(Ptrs p) {
    const int c = blockIdx.x * 256 + threadIdx.x, r0 = blockIdx.y * 8;
    const h16* Z = (const h16*)(p.ws + WS_XH);
    float a[8];
#pragma unroll
    for (int r = 0; r < 8; ++r) a[r] = 0.f;
    for (int k = 0; k < DM; ++k) { const float w = p.w_out[(size_t)k * DM + c];
#pragma unroll
        for (int r = 0; r < 8; ++r) a[r] += (float)Z[(size_t)(r0 + r) * DM + k] * w; }
#pragma unroll
    for (int r = 0; r < 8; ++r) { const int t = r0 + r; const float v = p.x[(size_t)t * DM + c] + a[r]; p.out[(size_t)t * DM + c] = v; ((h16*)(p.ws + WS_V))[(size_t)t * DM + c] = (h16)v;
        atomicAdd((float*)(p.ws + OFF_SS1) + t, v * v); }
}
__global__ void nk_q(Ptrs p) {
    const int c = blockIdx.x * 256 + threadIdx.x, r0 = blockIdx.y * 8;
    float a[8];
#pragma unroll
    for (int r = 0; r < 8; ++r) a[r] = 0.f;
    for (int k = 0; k < DM; ++k) { const float w = p.w_xq[(size_t)k * DM + c] * p.norm_x_g[k];
#pragma unroll
        for (int r = 0; r < 8; ++r) a[r] += p.out[(size_t)(r0 + r) * DM + k] * w; }
    const float* ss1 = (const float*)(p.ws + OFF_SS1);
#pragma unroll
    for (int r = 0; r < 8; ++r) { const int t = r0 + r; ((h16*)(p.ws + WS_XH))[(size_t)t * DM + c] = (h16)(a[r] * rsqrtf(ss1[t] / DM + EPS) * 0.0625f); }
}
__global__ void nk_kv(Ptrs p) {
    const int c = blockIdx.x * 256 + threadIdx.x, r0 = blockIdx.y * 8;
    float a[8];
#pragma unroll
    for (int r = 0; r < 8; ++r) a[r] = 0.f;
    for (int k = 0; k < DM; ++k) { const float w = p.w_xkv[(size_t)k * 2048 + c] * p.norm_mem_g[k];
#pragma unroll
        for (int r = 0; r < 8; ++r) a[r] += p.mem[(size_t)(r0 + r) * DM + k] * w; }
    const float* rm = (const float*)(p.ws + OFF_RSTDM);
#pragma unroll
    for (int r = 0; r < 8; ++r) { const int m = r0 + r; const float v = a[r] * rm[m];
        if (c < 1024) ((h16*)(p.ws + WS_KM))[(size_t)m * DM + c] = (h16)v;
        else ((h16*)(p.ws + WS_VTM))[(size_t)m * DM + (c - 1024)] = (h16)v; }
}
__global__ void nk_attn(Ptrs p) {
    const int t = blockIdx.x >> 2, hd = blockIdx.x & 3, b = t / SEQ, j = threadIdx.x;
    const h16* q = (const h16*)(p.ws + WS_XH) + (size_t)t * DM + hd * DH;
    const h16* K = (const h16*)(p.ws + WS_KM) + (size_t)(b * 256 + j) * DM + hd * DH;
    __shared__ float sp[256], red[8];
    float s = 0.f;
    for (int d = 0; d < DH; ++d) s += (float)q[d] * (float)K[d];
    float mx = wave_max(s); if ((j & 63) == 0) red[j >> 6] = mx; __syncthreads();
    mx = fmaxf(fmaxf(red[0], red[1]), fmaxf(red[2], red[3]));
    const float e = __expf(s - mx); sp[j] = e;
    float sm = wave_sum(e); if ((j & 63) == 0) red[4 + (j >> 6)] = sm; __syncthreads();
    sm = red[4] + red[5] + red[6] + red[7];
    const h16* VT = (const h16*)(p.ws + WS_VTM) + (size_t)(b * 256) * DM + hd * DH + j;
    float o = 0.f;
    for (int key = 0; key < 256; ++key) o += sp[key] * (float)VT[(size_t)key * DM];
    ((h16*)(p.ws + WS_OG))[(size_t)t * DM + hd * DH + j] = (h16)(o / sm);
}
__global__ void nk_wxo(Ptrs p) {
    const int c = blockIdx.x * 256 + threadIdx.x, r0 = blockIdx.y * 8;
    const h16* A = (const h16*)(p.ws + WS_OG);
    float a[8];
#pragma unroll
    for (int r = 0; r < 8; ++r) a[r] = 0.f;
    for (int k = 0; k < DM; ++k) { const float w = p.w_xo[(size_t)k * DM + c];
#pragma unroll
        for (int r = 0; r < 8; ++r) a[r] += (float)A[(size_t)(r0 + r) * DM + k] * w; }
#pragma unroll
    for (int r = 0; r < 8; ++r) { const int t = r0 + r; const float v = p.out[(size_t)t * DM + c] + a[r]; p.out[(size_t)t * DM + c] = v; ((h16*)(p.ws + WS_V))[(size_t)t * DM + c] = (h16)v;
        atomicAdd((float*)(p.ws + OFF_SS2) + t, v * v); }
}
__global__ void nk_router(Ptrs p) {
    const int t = blockIdx.x * 4 + (threadIdx.x >> 6), lane = threadIdx.x & 63;
    const float* xr = p.out + (size_t)t * DM; const float rs = rsqrtf(((const float*)(p.ws + OFF_SS2))[t] / DM + EPS);
    float acc[36];
#pragma unroll
    for (int j = 0; j < 36; ++j) acc[j] = 0.f;
    for (int k = lane; k < DM; k += 64) { const float v = xr[k] * rs * p.norm_moe_g[k];
#pragma unroll
        for (int j = 0; j < 4; ++j) acc[j] += v * p.w_rg[k * 4 + j];
#pragma unroll
        for (int j = 0; j < 32; ++j) acc[4 + j] += v * p.w_re[k * 32 + j]; }
#pragma unroll
    for (int j = 0; j < 36; ++j) acc[j] = wave_sum(acc[j]);
    if (lane == 0) {
        float gl[4]; int gi = 0;
#pragma unroll
        for (int j = 0; j < 4; ++j) gl[j] = acc[j] + p.b_rg[j];
        float gm = gl[0];
#pragma unroll
        for (int j = 1; j < 4; ++j) if (gl[j] > gm) { gm = gl[j]; gi = j; }
        float gs = 0.f;
#pragma unroll
        for (int j = 0; j < 4; ++j) gs += __expf(gl[j] - gm);
        float ev[8];
#pragma unroll
        for (int j = 0; j < 8; ++j) { float v = acc[4 + j] + p.b_re[j];
#pragma unroll
            for (int g = 1; g < 4; ++g) v = (gi == g) ? acc[4 + g * 8 + j] + p.b_re[g * 8 + j] : v;
            ev[j] = v; }
        float pg = 0.f;
#pragma unroll
        for (int j = 0; j < 4; ++j) pg = (gi == j) ? __expf(gl[j] - gm) / gs : pg;
        int i1 = 0; float v1 = ev[0];
#pragma unroll
        for (int j = 1; j < 8; ++j) if (ev[j] > v1) { v1 = ev[j]; i1 = j; }
        int i2 = -1; float v2 = -INFINITY;
#pragma unroll
        for (int j = 0; j < 8; ++j) if (j != i1 && ev[j] > v2) { v2 = ev[j]; i2 = j; }
        const float e2 = __expf(v2 - v1), g1 = pg / (1.f + e2), g2 = pg * e2 / (1.f + e2);
        unsigned* cnt = (unsigned*)(p.ws + WS_CTL) + CW_CNT;
        int* list = (int*)(p.ws + OFF_LIST); float* gate = (float*)(p.ws + OFF_GATE); int* se = (int*)(p.ws + OFF_SLOTE); int* sp = (int*)(p.ws + OFF_SLOTP);
        const int e1x = gi * 8 + i1, e2x = gi * 8 + i2;
        const unsigned p1 = atomicAdd(cnt + e1x, 1u); list[e1x * NTOK + p1] = t * 2; gate[t * 2] = g1; se[t * 2] = e1x; sp[t * 2] = (int)p1;
        const unsigned p2 = atomicAdd(cnt + e2x, 1u); list[e2x * NTOK + p2] = t * 2 + 1; gate[t * 2 + 1] = g2; se[t * 2 + 1] = e2x; sp[t * 2 + 1] = (int)p2;
    }
}
__device__ __forceinline__ int moe_pstart(const unsigned* cnt, int e) { int s = 0; for (int i = 0; i < e; ++i) s += (int)((cnt[i] + 255u) & ~255u); return s; }
__global__ void nk_ffn1(Ptrs p) {
    const int f = blockIdx.x * 256 + threadIdx.x, s0 = blockIdx.y * 8;
    const unsigned* cnt = (const unsigned*)(p.ws + WS_CTL) + CW_CNT; const int* se = (const int*)(p.ws + OFF_SLOTE); const int* sp = (const int*)(p.ws + OFF_SLOTP);
    const float* ss2 = (const float*)(p.ws + OFF_SS2);
    for (int r = 0; r < 8; ++r) { const int slot = s0 + r, tok = slot >> 1, e = se[slot];
        const float* xr = p.out + (size_t)tok * DM; float a1 = 0.f, a3 = 0.f;
        const float* W1 = p.w1 + (size_t)e * DM * FF; const float* W3 = p.w3 + (size_t)e * DM * FF;
        for (int k = 0; k < DM; ++k) { const float v = xr[k] * p.norm_moe_g[k]; a1 += v * W1[(size_t)k * FF + f]; a3 += v * W3[(size_t)k * FF + f]; }
        const float rs = rsqrtf(ss2[tok] / DM + EPS); a1 *= rs; a3 *= rs;
        const int prow = moe_pstart(cnt, e) + sp[slot];
        ((h16*)(p.ws + WS_H))[(size_t)prow * FF + f] = (h16)(siluf_(a1) * a3); }
}
__global__ void nk_ffn2(Ptrs p) {
    const int c = blockIdx.x * 256 + threadIdx.x, s0 = blockIdx.y * 8;
    const unsigned* cnt = (const unsigned*)(p.ws + WS_CTL) + CW_CNT; const int* se = (const int*)(p.ws + OFF_SLOTE); const int* sp = (const int*)(p.ws + OFF_SLOTP);
    const float* gate = (const float*)(p.ws + OFF_GATE);
    for (int r = 0; r < 8; ++r) { const int slot = s0 + r, e = se[slot]; const int prow = moe_pstart(cnt, e) + sp[slot];
        const h16* hr = (const h16*)(p.ws + WS_H) + (size_t)prow * FF; const float* W2 = p.w2 + (size_t)e * FF * DM; float a = 0.f;
        for (int k = 0; k < FF; ++k) a += (float)hr[k] * W2[(size_t)k * DM + c];
        ((h16*)(p.ws + WS_Y))[(size_t)slot * DM + c] = (h16)(a * gate[slot]); }
}
__global__ void nk_final(Ptrs p) {
    const int t = blockIdx.x * 4 + (threadIdx.x >> 6), lane = threadIdx.x & 63;
    float* xr = p.out + (size_t)t * DM; const h16* y0 = (const h16*)(p.ws + WS_Y) + (size_t)(2 * t) * DM; const h16* y1 = y0 + DM;
    float v[16]; float ss = 0.f;
#pragma unroll
    for (int j = 0; j < 16; ++j) { const int k = lane + 64 * j; v[j] = xr[k] + (float)y0[k] + (float)y1[k]; ss += v[j] * v[j]; }
    ss = wave_sum(ss); const float rs = rsqrtf(ss / DM + EPS);
#pragma unroll
    for (int j = 0; j < 16; ++j) { const int k = lane + 64 * j; xr[k] = v[j] * rs * p.norm_f_g[k]; }
}

#define LAS __attribute__((address_space(3)))
#define GAS __attribute__((address_space(1)))
typedef _Float16 h16x8 __attribute__((ext_vector_type(8)));
typedef _Float16 h16x4 __attribute__((ext_vector_type(4)));
typedef _Float16 h16x2 __attribute__((ext_vector_type(2)));
typedef float f32x4 __attribute__((ext_vector_type(4)));
typedef float f32x2 __attribute__((ext_vector_type(2)));
typedef unsigned u32x4 __attribute__((ext_vector_type(4)));
typedef unsigned u32x2 __attribute__((ext_vector_type(2)));
typedef GAS unsigned gu32;
#define RLX_AGENT __ATOMIC_RELAXED, __HIP_MEMORY_SCOPE_AGENT
#define LDS_WAIT() asm volatile("s_waitcnt lgkmcnt(0)" ::: "memory")
#define VM_WAIT() asm volatile("s_waitcnt vmcnt(0)" ::: "memory")
__device__ __forceinline__ unsigned pk_h2(float lo, float hi) { f32x2 v = {lo, hi}; return __builtin_bit_cast(unsigned, __builtin_convertvector(v, h16x2)); }
__device__ __forceinline__ u32x4 pk_h8(f32x4 a, f32x4 b) { u32x4 w; w.x = pk_h2(a[0], a[1]); w.y = pk_h2(a[2], a[3]); w.z = pk_h2(b[0], b[1]); w.w = pk_h2(b[2], b[3]); return w; }
__device__ __forceinline__ float fsigmoid(float v) { return __builtin_amdgcn_rcpf(1.f + __expf(-v)); }
__device__ __forceinline__ float fgelu(float v) { const float u = 1.5957691216057308f * (v + 0.044715f * v * v * v); return v * __builtin_amdgcn_rcpf(1.f + __expf(-u)); }
__device__ __forceinline__ float fsilu(float v) { return v * __builtin_amdgcn_rcpf(1.f + __expf(-v)); }

constexpr int NWAVES = 8, NTHREADS = 512;
constexpr int RING_BYTES = 143360, LDSCTL_OFF = RING_BYTES, MISC_OFF = LDSCTL_OFF + 320, LDS_BYTES = 147456;
constexpr int CW_TMO = 0, CW_BAR = 4096;

#define XB_TMO      128
#define XB_XCNT(j)  (256  + 64 * (j))
#define XB_XSUB(j)  (1280 + 64 * (j))
#define XB_XGEN(j)  (2304 + 64 * (j))
#define XB_TOP      3328
#define XB_TOPGEN   3392
#define XCD_BAR_WORDS 3456
#define XB_SPIN_CAP (1u << 20)
__device__ __forceinline__ unsigned xb_ld(unsigned* p)              { return __hip_atomic_load(p, __ATOMIC_RELAXED, __HIP_MEMORY_SCOPE_AGENT); }
__device__ __forceinline__ unsigned xb_add(unsigned* p, unsigned v) { return __hip_atomic_fetch_add(p, v, __ATOMIC_RELAXED, __HIP_MEMORY_SCOPE_AGENT); }
__device__ __forceinline__ unsigned xb_xcc_id() { return (unsigned)__builtin_amdgcn_s_getreg((3 << 11) | 20) & 0xFu; }
#define XB_SPIN(cond, bar) do { unsigned _sp = 0; while (cond) { __builtin_amdgcn_s_sleep(1); \
    if ((++_sp & 255u) == 0u) { if (xb_ld(&(bar)[XB_TMO])) break; if (_sp > XB_SPIN_CAP) { atomicAdd(&(bar)[XB_TMO], 1u); break; } } } } while (0)
struct XcdBarrier { unsigned* bar; unsigned x; volatile LAS unsigned* st; };
__device__ __forceinline__ XcdBarrier xcd_barrier_post(unsigned* bar, volatile LAS unsigned* st) {
    XcdBarrier b; b.bar = bar; b.x = xb_xcc_id(); b.st = st;
    if (threadIdx.x == 0) (void)xb_add(&bar[XB_XCNT(b.x)], 1u);
    return b;
}
__device__ __forceinline__ void xcd_barrier_complete(unsigned* bar, unsigned x, unsigned& nloc, unsigned& nx) {
    const unsigned G = gridDim.x * gridDim.y * gridDim.z;
    unsigned sum, cnt, mine, sp = 0u;
    for (;;) {
        sum = 0u; cnt = 0u; mine = 0u;
#pragma unroll
        for (unsigned j = 0; j < 16; ++j) { const unsigned c = xb_ld(&bar[XB_XCNT(j)]); sum += c; cnt += (c > 0u) ? 1u : 0u; mine = (j == x) ? c : mine; }
        if (sum == G) break;
        __builtin_amdgcn_s_sleep(1);
        if ((++sp & 255u) == 0u) { if (xb_ld(&bar[XB_TMO])) break; if (sp > XB_SPIN_CAP) { atomicAdd(&bar[XB_TMO], 1u); break; } }
    }
    nloc = mine > 0u ? mine : 1u; nx = cnt > 0u ? cnt : 1u;
}
__device__ __forceinline__ void xcd_barrier(const XcdBarrier& b) {
    asm volatile("s_waitcnt vmcnt(0)" ::: "memory");
    __syncthreads();
    if (threadIdx.x == 0) {
        unsigned* bar = b.bar;
        __builtin_amdgcn_s_waitcnt(0);
        unsigned nloc = b.st[0], nx = b.st[1];
        if (nloc == 0u) { xcd_barrier_complete(bar, b.x, nloc, nx); b.st[0] = nloc; b.st[1] = nx; }
        const unsigned old = xb_add(&bar[XB_XSUB(b.x)], 1u);
        const unsigned gen = old / nloc;
        if (old + 1u == (gen + 1u) * nloc) {
            __builtin_amdgcn_fence(__ATOMIC_RELEASE, "agent");
            asm volatile("s_waitcnt vmcnt(0)" ::: "memory");
            const unsigned og = xb_add(&bar[XB_TOP], 1u);
            const unsigned tg = og / nx;
            if (og + 1u == (tg + 1u) * nx) xb_add(&bar[XB_TOPGEN], 1u);
            else XB_SPIN(xb_ld(&bar[XB_TOPGEN]) == tg, bar);
            __builtin_amdgcn_fence(__ATOMIC_ACQUIRE, "agent");
            xb_add(&bar[XB_XGEN(b.x)], 1u);
            asm volatile("s_waitcnt vmcnt(0)" ::: "memory");
        } else {
            XB_SPIN(xb_ld(&bar[XB_XGEN(b.x)]) == gen, bar);
            __builtin_amdgcn_fence(__ATOMIC_ACQUIRE, "agent");
            asm volatile("s_waitcnt vmcnt(0)" ::: "memory");
        }
    }
    __syncthreads();
}

namespace pg8 {
constexpr int BM = 256, BK = 64, HALF = 128, HTB = HALF * BK * 2, STAGE_BYTES = 8 * HTB, NXCD = 8, WGM = 8;
__host__ __device__ __forceinline__ int lds_byte(int r, int c) { const int st = (r >> 4) * 2 + (c >> 5), rr = r & 15, cc = c & 31, ob = rr * 64 + cc * 2; return st * 1024 + (ob ^ (((ob >> 9) & 1) << 5)); }
__host__ __device__ __forceinline__ void stage_rc(int b, int& R, int& C) { const int st = b / 1024, sb = b % 1024, swz = sb ^ (((sb >> 9) & 1) << 5); R = (st >> 1) * 16 + swz / 64; C = (st & 1) * 32 + (swz % 64) / 2; }
__host__ __device__ __forceinline__ int perm32(int rho) { const int n = rho >> 4, i = rho & 15; return 8 * (i >> 2) + 4 * n + (i & 3); }
struct Unit { int pm, pn, e, nv, rb; };
struct StaticOrder {
    const char* A; const char* Bt; int K; int nM, nN, nwg, G, c;
    __device__ __forceinline__ void init(const void* A_, const void* Bt_, int M, int N, int K_, int G_, int c_) { A = (const char*)A_; Bt = (const char*)Bt_; K = K_; nM = M / BM; nN = N / BM; nwg = nM * nN; G = G_; c = c_; }
    __device__ __forceinline__ bool next(int i, Unit& u) const {
        const long L = (long)i * G + c; if (L >= nwg) return false;
        int wgid = (int)L; { const int q = nwg / NXCD, r = nwg % NXCD, xcd = wgid % NXCD, off = wgid / NXCD; wgid = (xcd < r ? xcd * (q + 1) : r * (q + 1) + (xcd - r) * q) + off; }
        const int nig = WGM * nN, gid = wgid / nig, fm = gid * WGM, gsz = (nM - fm) < WGM ? (nM - fm) : WGM;
        u.pm = fm + ((wgid % nig) % gsz); u.pn = (wgid % nig) / gsz; u.e = 0; u.nv = 256; u.rb = 0; return true;
    }
    __device__ __forceinline__ const char* a_base(const Unit& u) const { return A + (size_t)u.pm * (size_t)(BM * 2) * K; }
    __device__ __forceinline__ const char* b_base(const Unit& u) const { return Bt + (size_t)u.pn * (size_t)(BM * 2) * K; }
    __device__ __forceinline__ const char* g_base() const { return A; }
    __device__ __forceinline__ unsigned a_off(const Unit& u, int h, int R) const { return 0u; }
};

template <class Epi, class Sched, bool GATHER, bool ALIGN_EPI>
__device__ __forceinline__ void gemm_phase(LAS unsigned char* lds, const int K, const Sched& S, const Epi& E) {
    int tid = threadIdx.x; asm volatile("" : "+v"(tid));
    const int wid = __builtin_amdgcn_readfirstlane(tid >> 6), lane = tid & 63, wr = wid >> 2, wc = wid & 3, fr = lane & 15, fq = lane >> 4;
    const int nt = K / BK;
    unsigned voffA[2], voffB[2]; int Rst[2], Cst2[2];
#pragma unroll
    for (int i = 0; i < 2; ++i) { int R, C; stage_rc(tid * 16 + i * 8192, R, C); const int Rb = Epi::PERM ? ((R & ~31) + perm32(R & 31)) : R;
        voffA[i] = (unsigned)(R * K + C) * 2u; voffB[i] = (unsigned)(Rb * K + C) * 2u; Rst[i] = R; Cst2[i] = C * 2; }
    const size_t kstep = (size_t)(BK * 2);
    const size_t hstep = (size_t)HALF * K * 2;
    const unsigned ldsw = (unsigned)wid * 1024u;
    const int aoff = lds_byte(wr * 64 + fr, fq * 8), boff = lds_byte(wc * 32 + fr, fq * 8);
    const char* const gA = S.g_base();
#define PG8_SA(b, h) (((b) * 2 + (h)) * HTB)
#define PG8_SB(b, h) ((4 + (b) * 2 + (h)) * HTB)
#define PG8_GLDS(src, bufoff, i_) __builtin_amdgcn_global_load_lds((const unsigned*)(src), (LAS unsigned*)(lds + (bufoff) + ldsw + (i_) * 8192), 16, 0, 0)
#define PG8_STAGE_B(bufoff, gbase) do { _Pragma("unroll") for (int _i = 0; _i < 2; ++_i) PG8_GLDS((const char*)(gbase) + voffB[_i], bufoff, _i); } while (0)
#define PG8_STAGE_A(bufoff, pa, offs, h_, kb) do { _Pragma("unroll") for (int _i = 0; _i < 2; ++_i) { \
        if constexpr (GATHER) PG8_GLDS(gA + (size_t)((offs)[h_][_i] + (unsigned)(kb)), bufoff, _i); else PG8_GLDS((const char*)(pa) + (h_) * hstep + voffA[_i], bufoff, _i); } } while (0)
#define PG8_LDA(dst, b, h) do { _Pragma("unroll") for (int m = 0; m < 4; ++m) _Pragma("unroll") for (int k = 0; k < 2; ++k) dst[m][k] = *(const LAS h16x8*)(lds + PG8_SA(b, h) + aoff + m * 2048 + k * 1024); } while (0)
#define PG8_LDB(dst, b, h) do { _Pragma("unroll") for (int n = 0; n < 2; ++n) _Pragma("unroll") for (int k = 0; k < 2; ++k) dst[n][k] = *(const LAS h16x8*)(lds + PG8_SB(b, h) + boff + n * 2048 + k * 1024); } while (0)
#define PG8_MMA(ai, bj, At, Bt) do { __builtin_amdgcn_s_setprio(1); _Pragma("unroll") for (int m = 0; m < 4; ++m) _Pragma("unroll") for (int n = 0; n < 2; ++n) _Pragma("unroll") for (int k = 0; k < 2; ++k) \
        acc[ai][bj][m][n] = __builtin_amdgcn_mfma_f32_16x16x32_f16(Bt[n][k], At[m][k], acc[ai][bj][m][n], 0, 0, 0); __builtin_amdgcn_s_setprio(0); } while (0)
#define PG8_WAIT_V(n) asm volatile("s_waitcnt vmcnt(" #n ")" ::: "memory")
#define PG8_WAIT_L(n) asm volatile("s_waitcnt lgkmcnt(" #n ")" ::: "memory")
#define PG8_BAR __builtin_amdgcn_s_barrier()
#define PG8_SCHED __builtin_amdgcn_sched_barrier(0)
    Unit cur, nxt; int ui = 0;
    if (!S.next(0, cur)) return;
    f32x4 acc[2][2][4][2];
#pragma unroll
    for (int a = 0; a < 2; ++a)
#pragma unroll
        for (int b = 0; b < 2; ++b)
#pragma unroll
            for (int m = 0; m < 4; ++m)
#pragma unroll
                for (int n = 0; n < 2; ++n) acc[a][b][m][n] = (f32x4){0.f, 0.f, 0.f, 0.f};
    h16x8 At[4][2], B0[2][2], B1[2][2];
    const char* cA = S.a_base(cur); const char* cB = S.b_base(cur);
    unsigned aoc[2][2], aon[2][2], ao2[2][2];
    if constexpr (GATHER) {
#pragma unroll
        for (int h = 0; h < 2; ++h)
#pragma unroll
            for (int i = 0; i < 2; ++i) { aoc[h][i] = S.a_off(cur, h, Rst[i]) + (unsigned)Cst2[i]; aon[h][i] = aoc[h][i]; ao2[h][i] = aoc[h][i]; }
    }
    PG8_STAGE_B(PG8_SB(0, 0), cB); PG8_STAGE_B(PG8_SB(0, 1), cB + hstep); PG8_STAGE_A(PG8_SA(0, 0), cA, aoc, 0, 0); PG8_STAGE_A(PG8_SA(0, 1), cA, aoc, 1, 0);
    if (wr == 1) PG8_BAR;
    PG8_WAIT_V(2); PG8_BAR;
    PG8_STAGE_B(PG8_SB(1, 0), cB + kstep); PG8_STAGE_A(PG8_SA(1, 0), cA + kstep, aoc, 0, kstep); PG8_STAGE_B(PG8_SB(1, 1), cB + hstep + kstep);
    PG8_WAIT_V(6); PG8_BAR;
    for (;;) {
        const bool has_next = S.next(ui + 1, nxt);
        const char* nA = has_next ? S.a_base(nxt) : cA; const char* nB = has_next ? S.b_base(nxt) : cB;
        if constexpr (GATHER) {
#pragma unroll
            for (int h = 0; h < 2; ++h)
#pragma unroll
                for (int i = 0; i < 2; ++i) aon[h][i] = has_next ? S.a_off(nxt, h, Rst[i]) + (unsigned)Cst2[i] : aoc[h][i];
        }
        for (int t = 0; t < nt; t += 2) {
            const bool last = (t == nt - 2);
            const char* a1 = cA + (size_t)(t + 1) * kstep;
            const char* a2 = last ? nA : cA + (size_t)(t + 2) * kstep; const char* b2 = last ? nB : cB + (size_t)(t + 2) * kstep;
            const char* a3 = a2 + kstep; const char* b3 = b2 + kstep;
            if constexpr (GATHER) {
#pragma unroll
                for (int h = 0; h < 2; ++h)
#pragma unroll
                    for (int i = 0; i < 2; ++i) ao2[h][i] = last ? aon[h][i] : aoc[h][i] + (unsigned)((t + 2) * (int)kstep);
            }
            PG8_LDB(B0, 0, 0); PG8_LDB(B1, 0, 1); PG8_SCHED; PG8_LDA(At, 0, 0); PG8_STAGE_A(PG8_SA(1, 1), a1, aoc, 1, (t + 1) * (int)kstep);
            PG8_WAIT_V(8); PG8_WAIT_L(0); PG8_BAR; PG8_MMA(0, 0, At, B0); PG8_MMA(0, 1, At, B1); PG8_BAR; PG8_SCHED;
            PG8_LDA(At, 0, 1); PG8_STAGE_B(PG8_SB(0, 0), b2); PG8_STAGE_B(PG8_SB(0, 1), b2 + hstep); PG8_STAGE_A(PG8_SA(0, 0), a2, ao2, 0, 0);
            PG8_WAIT_V(8); PG8_WAIT_L(0); PG8_BAR; PG8_MMA(1, 0, At, B0); PG8_MMA(1, 1, At, B1); PG8_BAR; PG8_SCHED;
            PG8_LDB(B0, 1, 0); PG8_LDB(B1, 1, 1); PG8_SCHED; PG8_LDA(At, 1, 0); PG8_STAGE_A(PG8_SA(0, 1), a2, ao2, 1, 0);
            PG8_WAIT_V(8); PG8_WAIT_L(0); PG8_BAR; PG8_MMA(0, 0, At, B0); PG8_MMA(0, 1, At, B1); PG8_BAR; PG8_SCHED;
            PG8_LDA(At, 1, 1); PG8_STAGE_B(PG8_SB(1, 0), b3); PG8_STAGE_B(PG8_SB(1, 1), b3 + hstep); PG8_STAGE_A(PG8_SA(1, 0), a3, ao2, 0, kstep);
            PG8_WAIT_V(8); PG8_WAIT_L(0); PG8_BAR; PG8_MMA(1, 0, At, B0); PG8_MMA(1, 1, At, B1); PG8_BAR; PG8_SCHED;
        }
        if constexpr (ALIGN_EPI) { if (wr == 0) PG8_BAR; }
        E(acc, cur, wr, wc, fr, fq);
        if (!has_next) break;
#pragma unroll
        for (int a = 0; a < 2; ++a)
#pragma unroll
            for (int b = 0; b < 2; ++b)
#pragma unroll
                for (int m = 0; m < 4; ++m)
#pragma unroll
                    for (int n = 0; n < 2; ++n) acc[a][b][m][n] = (f32x4){0.f, 0.f, 0.f, 0.f};
        cur = nxt; cA = nA; cB = nB; ++ui;
        if constexpr (GATHER) {
#pragma unroll
            for (int h = 0; h < 2; ++h)
#pragma unroll
                for (int i = 0; i < 2; ++i) aoc[h][i] = aon[h][i];
        }
        if constexpr (ALIGN_EPI) { if (wr == 1) PG8_BAR; }
    }
    PG8_WAIT_V(0);
    if constexpr (!ALIGN_EPI) { if (wr == 0) PG8_BAR; }
    PG8_BAR;
#undef PG8_SA
#undef PG8_SB
#undef PG8_GLDS
#undef PG8_STAGE_A
#undef PG8_STAGE_B
#undef PG8_LDA
#undef PG8_LDB
#undef PG8_MMA
#undef PG8_WAIT_V
#undef PG8_WAIT_L
#undef PG8_BAR
#undef PG8_SCHED
}
}
using pg8::Unit;
struct EpiProj {
    static constexpr bool PERM = true;
    const float* rstd0; const float* b_gate; h16* QK; h16* V; h16* OG; h16* UG; h16* SV; float* sssv; bool doat;
    __device__ __forceinline__ void operator()(const f32x4 (&acc)[2][2][4][2], const Unit& u, int wr, int wc, int fr, int fq) const {
        const int row0 = u.pm * 256 + wr * 64 + fr, cw = wc * 32 + 8 * fq, pn = u.pn;
        if (pn < 12) {
            h16* base; int ld, col;
            if (pn < 8) { base = QK; ld = 2048; col = pn * 256; } else { base = V; ld = 1024; col = (pn - 8) * 256; }
#pragma unroll
            for (int ai = 0; ai < 2; ++ai)
#pragma unroll
                for (int m = 0; m < 4; ++m) { const int row = row0 + ai * 128 + m * 16; const float rs = rstd0[row]; h16* rp = base + (size_t)row * ld + col + cw;
#pragma unroll
                    for (int bj = 0; bj < 2; ++bj) *(u32x4*)(rp + bj * 128) = pk_h8(acc[ai][bj][m][0] * rs, acc[ai][bj][m][1] * rs); }
        } else if (pn < 28) {
            const bool isO = pn < 20; h16* base = isO ? OG : UG; const int c0 = (isO ? pn - 12 : pn - 20) * 128 + cw; const float* bg = b_gate + (isO ? 0 : 1024) + c0;
            const f32x4 b0 = *(const f32x4*)bg, b1 = *(const f32x4*)(bg + 4);
#pragma unroll
            for (int ai = 0; ai < 2; ++ai)
#pragma unroll
                for (int m = 0; m < 4; ++m) { const int row = row0 + ai * 128 + m * 16; const float rs = rstd0[row];
                    f32x4 a0 = acc[ai][0][m][0] * rs, a1 = acc[ai][0][m][1] * rs; const f32x4 g0 = acc[ai][1][m][0] * rs + b0, g1 = acc[ai][1][m][1] * rs + b1;
                    if (isO) {
#pragma unroll
                        for (int j = 0; j < 4; ++j) { a0[j] = fsigmoid(a0[j]) * fsigmoid(g0[j]); a1[j] = fsigmoid(a1[j]) * fsigmoid(g1[j]); }
                    } else {
#pragma unroll
                        for (int j = 0; j < 4; ++j) { a0[j] = fgelu(a0[j]) * fsigmoid(g0[j]); a1[j] = fgelu(a1[j]) * fsigmoid(g1[j]); }
                    }
                    *(u32x4*)(base + (size_t)row * 1024 + c0) = pk_h8(a0, a1); }
        } else {
            const int col = (pn - 28) * 256 + cw;
#pragma unroll
            for (int ai = 0; ai < 2; ++ai)
#pragma unroll
                for (int m = 0; m < 4; ++m) { const int row = row0 + ai * 128 + m * 16; const float rs = rstd0[row]; float sum = 0.f;
#pragma unroll
                    for (int bj = 0; bj < 2; ++bj) { f32x4 a0 = acc[ai][bj][m][0] * rs, a1 = acc[ai][bj][m][1] * rs;
#pragma unroll
                        for (int j = 0; j < 4; ++j) { a0[j] = fgelu(a0[j]); a1[j] = fgelu(a1[j]); sum += a0[j] * a0[j] + a1[j] * a1[j]; }
                        *(u32x4*)(SV + (size_t)row * 1024 + col + bj * 128) = pk_h8(a0, a1); }
                    sum += __shfl_xor(sum, 16); sum += __shfl_xor(sum, 32);
                    if (fq == 0 && doat) atomicAdd(sssv + row, sum); }
        }
    }
};
struct EpiKV {
    static constexpr bool PERM = true;
    const float* rstdm; h16* KM; h16* VM;
    __device__ __forceinline__ void operator()(const f32x4 (&acc)[2][2][4][2], const Unit& u, int wr, int wc, int fr, int fq) const {
        const int row0 = u.pm * 256 + wr * 64 + fr, cw = wc * 32 + 8 * fq, pn = u.pn; h16* base = (pn < 4) ? KM + pn * 256 : VM + (pn - 4) * 256;
#pragma unroll
        for (int ai = 0; ai < 2; ++ai)
#pragma unroll
            for (int m = 0; m < 4; ++m) { const int row = row0 + ai * 128 + m * 16; const float rs = rstdm[row];
#pragma unroll
                for (int bj = 0; bj < 2; ++bj) *(u32x4*)(base + (size_t)row * 1024 + bj * 128 + cw) = pk_h8(acc[ai][bj][m][0] * rs, acc[ai][bj][m][1] * rs); }
    }
};
struct EpiResid {
    static constexpr bool PERM = false;
    const float* resid; float* out; h16* outh; float* ss; bool doat;
    __device__ __forceinline__ void operator()(const f32x4 (&acc)[2][2][4][2], const Unit& u, int wr, int wc, int fr, int fq) const {
        const int row0 = u.pm * 256 + wr * 64 + fr, col0 = u.pn * 256 + wc * 32 + 4 * fq;
#pragma unroll
        for (int ai = 0; ai < 2; ++ai)
#pragma unroll
            for (int m = 0; m < 4; ++m) { const int row = row0 + ai * 128 + m * 16; const size_t off = (size_t)row * DM + col0; float sum = 0.f;
#pragma unroll
                for (int bj = 0; bj < 2; ++bj)
#pragma unroll
                    for (int n = 0; n < 2; ++n) { const size_t o = off + bj * 128 + n * 16; const f32x4 v = *(const f32x4*)(resid + o) + acc[ai][bj][m][n];
                        *(f32x4*)(out + o) = v; u32x2 w; w.x = pk_h2(v[0], v[1]); w.y = pk_h2(v[2], v[3]); *(u32x2*)(outh + o) = w;
                        sum += (v[0] * v[0] + v[1] * v[1]) + (v[2] * v[2] + v[3] * v[3]); }
                sum += __shfl_xor(sum, 16); sum += __shfl_xor(sum, 32);
                if (fq == 0 && doat) atomicAdd(ss + row, sum); }
    }
};
struct EpiQ {
    static constexpr bool PERM = true;
    const float* ss1; h16* Q;
    __device__ __forceinline__ void operator()(const f32x4 (&acc)[2][2][4][2], const Unit& u, int wr, int wc, int fr, int fq) const {
        const int row0 = u.pm * 256 + wr * 64 + fr, col0 = u.pn * 256 + wc * 32 + 8 * fq;
#pragma unroll
        for (int ai = 0; ai < 2; ++ai)
#pragma unroll
            for (int m = 0; m < 4; ++m) { const int row = row0 + ai * 128 + m * 16; const float rs = rsqrtf(ss1[row] * (1.f / DM) + EPS) * 0.0625f;
#pragma unroll
                for (int bj = 0; bj < 2; ++bj) *(u32x4*)(Q + (size_t)row * DM + col0 + bj * 128) = pk_h8(acc[ai][bj][m][0] * rs, acc[ai][bj][m][1] * rs); }
    }
};
struct MoeOrder {
    const char* A; const char* Bt; int K; size_t bexp; const int* list; const unsigned* cnt; const LAS int* tab; int G, c;
    __device__ __forceinline__ bool next(int i, Unit& u) const {
        const int L = i * G + c; const int total = tab[32] * 4; if (L >= total) return false;
        const int rbg = L >> 2; int e = 0;
#pragma unroll 1
        for (int j = 1; j < 32; ++j) e = (tab[j] <= rbg) ? j : e;
        u.pm = rbg; u.pn = L & 3; u.e = e; const int rb = rbg - tab[e]; u.rb = rb; const int left = (int)__hip_atomic_load(cnt + e * 64, __ATOMIC_RELAXED, __HIP_MEMORY_SCOPE_AGENT) - rb * 256; u.nv = left < 256 ? left : 256; return true;
    }
    __device__ __forceinline__ const char* a_base(const Unit& u) const { return A + (size_t)u.pm * (size_t)(256 * 2) * K; }
    __device__ __forceinline__ const char* b_base(const Unit& u) const { return Bt + (size_t)u.e * bexp + (size_t)u.pn * (size_t)(256 * 2) * K; }
    __device__ __forceinline__ const char* g_base() const { return A; }
    __device__ __forceinline__ unsigned a_off(const Unit& u, int h, int R) const { const int r = h * 128 + R; const int tok = (r < u.nv) ? (list[u.e * NTOK + u.rb * 256 + r] >> 1) : 0; return (unsigned)tok * (unsigned)(K * 2); }
};
struct EpiFfn1 {
    static constexpr bool PERM = true;
    const int* list; const float* ss2; h16* H;
    __device__ __forceinline__ void operator()(const f32x4 (&acc)[2][2][4][2], const Unit& u, int wr, int wc, int fr, int fq) const {
        const int r0 = wr * 64 + fr, cw = wc * 32 + 8 * fq;
#pragma unroll
        for (int ai = 0; ai < 2; ++ai)
#pragma unroll
            for (int m = 0; m < 4; ++m) { const int r = r0 + ai * 128 + m * 16; const int tok = (r < u.nv) ? (list[u.e * NTOK + u.rb * 256 + r] >> 1) : 0;
                const float rs = rsqrtf(ss2[tok] * (1.f / DM) + EPS);
                f32x4 a0 = acc[ai][0][m][0] * rs, a1 = acc[ai][0][m][1] * rs; const f32x4 b0 = acc[ai][1][m][0] * rs, b1 = acc[ai][1][m][1] * rs;
#pragma unroll
                for (int j = 0; j < 4; ++j) { a0[j] = fsilu(a0[j]) * b0[j]; a1[j] = fsilu(a1[j]) * b1[j]; }
                *(u32x4*)(H + ((size_t)u.pm * 256 + r) * FF + u.pn * 128 + cw) = pk_h8(a0, a1); }
    }
};
struct EpiFfn2 {
    static constexpr bool PERM = true;
    const int* list; const float* gate; h16* Y;
    __device__ __forceinline__ void operator()(const f32x4 (&acc)[2][2][4][2], const Unit& u, int wr, int wc, int fr, int fq) const {
        const int r0 = wr * 64 + fr, cw = u.pn * 256 + wc * 32 + 8 * fq;
#pragma unroll
        for (int ai = 0; ai < 2; ++ai)
#pragma unroll
            for (int m = 0; m < 4; ++m) { const int r = r0 + ai * 128 + m * 16;
                if (r < u.nv) { const int slot = list[u.e * NTOK + u.rb * 256 + r]; const float g = gate[slot];
#pragma unroll
                    for (int bj = 0; bj < 2; ++bj) *(u32x4*)(Y + (size_t)slot * DM + cw + bj * 128) = pk_h8(acc[ai][bj][m][0] * g, acc[ai][bj][m][1] * g); } }
    }
};


typedef short s16x4 __attribute__((ext_vector_type(4)));
__device__ __forceinline__ h16x4 tr_read4(const LAS unsigned char* p) { return __builtin_bit_cast(h16x4, __builtin_amdgcn_ds_read_tr16_b64_v4i16((LAS s16x4*)p)); }
__device__ __forceinline__ h16x8 cat8(h16x4 a, h16x4 b) { return __builtin_shufflevector(a, b, 0, 1, 2, 3, 4, 5, 6, 7); }
__device__ __forceinline__ h16x4 cvt4(f32x4 v) { return __builtin_convertvector(v, h16x4); }
__device__ __forceinline__ void glds16_asm(const void* gsrc, unsigned lds_dst) { unsigned keep;
    asm volatile("s_mov_b32 %0, m0\n\ts_mov_b32 m0, %2\n\ts_nop 0\n\tglobal_load_lds_dwordx4 %1, off\n\ts_mov_b32 m0, %0" : "=&s"(keep) : "v"(gsrc), "s"(lds_dst) : "memory"); }
#define REGBAR16(a) asm volatile("" : "+v"(a[0]), "+v"(a[1]), "+v"(a[2]), "+v"(a[3]), "+v"(a[4]), "+v"(a[5]), "+v"(a[6]), "+v"(a[7]), "+v"(a[8]), "+v"(a[9]), "+v"(a[10]), "+v"(a[11]), "+v"(a[12]), "+v"(a[13]), "+v"(a[14]), "+v"(a[15]))
#define REGBAR8(a) asm volatile("" : "+v"(a[0]), "+v"(a[1]), "+v"(a[2]), "+v"(a[3]), "+v"(a[4]), "+v"(a[5]), "+v"(a[6]), "+v"(a[7]))
#define REGBAR4(a) asm volatile("" : "+v"(a[0]), "+v"(a[1]), "+v"(a[2]), "+v"(a[3]))
#define GLDS16(src, dst) glds16_asm((const void*)(src), __builtin_amdgcn_readfirstlane((unsigned)(size_t)(dst)))
constexpr int ATT_UNITS = 512, ATT_CH = 32768;
__device__ __forceinline__ void attn_issue(LAS unsigned char* lds, const h16* KM, const h16* VM, int c, int G, int bx, int wid, int lane) {
    const int i = c >> 3, n = c & 7, L = i * G + bx, hd = L & 3, tile = L >> 2, b = tile >> 6;
    LAS unsigned char* buf = lds + (unsigned)(c % 3) * ATT_CH;
    if (n < 4) { const char* Kb = (const char*)(KM + (size_t)(b * 256) * 1024 + hd * 256) + n * 128;
#pragma unroll
        for (int q = 0; q < 4; ++q) { const int I = wid * 4 + q, row = I * 8 + (lane >> 3), slot = (lane & 7) ^ ((row >> 1) & 7); GLDS16(Kb + (size_t)row * 2048 + slot * 16, buf + I * 1024); }
    } else { const char* Vb = (const char*)(VM + (size_t)(b * 256 + 64 * (n - 4)) * 1024 + hd * 256);
#pragma unroll
        for (int q = 0; q < 4; ++q) { const int I = wid * 4 + q, row = I * 2 + (lane >> 5), ch = (lane & 31) ^ ((row & 7) << 1); GLDS16(Vb + (size_t)row * 2048 + ch * 16, buf + I * 1024); }
    }
}
__device__ __forceinline__ void attn_phase(LAS unsigned char* lds, const h16* Q, const h16* KM, const h16* VM, h16* ATT, int G, int bx) {
    int tid = threadIdx.x; asm volatile("" : "+v"(tid));
    const int wid = __builtin_amdgcn_readfirstlane(tid >> 6), lane = tid & 63, fr = lane & 15, fq = lane >> 4;
    if (bx >= ATT_UNITS) return;
    const int nun = (ATT_UNITS - bx + G - 1) / G, total = nun * 8;
    attn_issue(lds, KM, VM, 0, G, bx, wid, lane); attn_issue(lds, KM, VM, 1, G, bx, wid, lane);
    const int tq = (lane & 15) >> 2, tp = lane & 3;
    for (int i = 0; i < nun; ++i) {
        const int L = i * G + bx, hd = L & 3, tile = L >> 2; const int trow = tile * 128 + wid * 16 + fr;
        f32x4 S[16]; h16x8 qf[8], pf[8]; f32x4 O[16]; float linv = 0.f;
#pragma unroll
        for (int kt = 0; kt < 16; ++kt) S[kt] = (f32x4){0.f, 0.f, 0.f, 0.f};
#pragma unroll
        for (int n = 0; n < 8; ++n) {
            const int c = i * 8 + n;
            asm volatile("s_waitcnt vmcnt(0)" ::: "memory"); __builtin_amdgcn_s_barrier(); asm volatile("" ::: "memory");
            if (n == 0) {
#pragma unroll
                for (int st = 0; st < 8; ++st) qf[st] = *(const h16x8*)(Q + (size_t)trow * 1024 + hd * 256 + 32 * st + 8 * fq);
            }
            if (c + 2 < total) attn_issue(lds, KM, VM, c + 2, G, bx, wid, lane);
            const LAS unsigned char* buf = lds + (unsigned)(c % 3) * ATT_CH;
            if (n < 4) {
#pragma unroll
                for (int kt = 0; kt < 16; ++kt)
#pragma unroll
                    for (int ks = 0; ks < 2; ++ks) { const int key = kt * 16 + fr, slot = 4 * ks + fq;
                        const h16x8 bf = *(const LAS h16x8*)(buf + key * 128 + ((slot ^ ((key >> 1) & 7)) * 16));
                        S[kt] = __builtin_amdgcn_mfma_f32_16x16x32_f16(bf, qf[2 * n + ks], S[kt], 0, 0, 0);
                        if (ks == 1 && (kt & 3) == 3) __builtin_amdgcn_sched_barrier(0); }
                if (n == 3) {
                    float mx = -INFINITY;
#pragma unroll
                    for (int kt = 0; kt < 16; ++kt)
#pragma unroll
                        for (int j = 0; j < 4; ++j) mx = fmaxf(mx, S[kt][j]);
                    mx = fmaxf(mx, __shfl_xor(mx, 16)); mx = fmaxf(mx, __shfl_xor(mx, 32));
                    float l = 0.f;
#pragma unroll
                    for (int kt = 0; kt < 16; ++kt)
#pragma unroll
                        for (int j = 0; j < 4; ++j) { const float e = __expf(S[kt][j] - mx); S[kt][j] = e; l += e; }
                    l += __shfl_xor(l, 16); l += __shfl_xor(l, 32); linv = 1.f / l;
#pragma unroll
                    for (int st = 0; st < 8; ++st) pf[st] = cat8(cvt4(S[2 * st]), cvt4(S[2 * st + 1]));
                }
            } else {
                if (n == 4) {
#pragma unroll
                    for (int dt = 0; dt < 16; ++dt) O[dt] = (f32x4){0.f, 0.f, 0.f, 0.f};
                }
#pragma unroll
                for (int ks = 0; ks < 2; ++ks) { const int r0 = 32 * ks + 4 * fq + tq, r1 = r0 + 16;
#pragma unroll
                    for (int dt = 0; dt < 16; ++dt) {
                        const h16x4 lo = tr_read4(buf + r0 * 512 + (((2 * dt + (tp >> 1)) ^ ((r0 & 7) << 1)) * 16) + (tp & 1) * 8);
                        const h16x4 hi = tr_read4(buf + r1 * 512 + (((2 * dt + (tp >> 1)) ^ ((r1 & 7) << 1)) * 16) + (tp & 1) * 8);
                        O[dt] = __builtin_amdgcn_mfma_f32_16x16x32_f16(cat8(lo, hi), pf[2 * (n - 4) + ks], O[dt], 0, 0, 0);
                        if ((dt & 3) == 3) __builtin_amdgcn_sched_barrier(0); } }
                if (n == 7) {
#pragma unroll
                    for (int dt = 0; dt < 16; ++dt) { const f32x4 o = O[dt] * linv; u32x2 w; w.x = pk_h2(o[0], o[1]); w.y = pk_h2(o[2], o[3]);
                        *(u32x2*)(ATT + (size_t)trow * 1024 + hd * 256 + 16 * dt + 4 * fq) = w; }
                }
            }
        }
    }
    asm volatile("s_waitcnt vmcnt(0)" ::: "memory"); __builtin_amdgcn_s_barrier();
}


__device__ __forceinline__ void mstate_ext(unsigned char* ws, int bh, int wave, int lane) {
    const float* ig = (const float*)(ws + OFF_IG); const float* lf = (const float*)(ws + OFF_LF);
    const int b = bh >> 2, h = bh & 3; float B = 0.f, mx = -INFINITY;
    for (int s = 0; s < CHUNK; ++s) { const int t = b * SEQ + lane * CHUNK + s; B += lf[t * 4 + h]; mx = fmaxf(mx, ig[t * 4 + h] - B); }
    const float blast = B, maxw = B + mx; float m = 0.f, mc = 0.f, mn = 0.f;
    for (int c = 0; c < NCHUNK; ++c) { const float bl = __shfl(blast, c), mw = __shfl(maxw, c); const float m2 = fmaxf(bl + m, mw); if (lane == c) { mc = m; mn = m2; } m = m2; }
    if (wave == 0) { ((float*)(ws + OFF_MST))[bh * 64 + lane] = mc; ((float*)(ws + OFF_DEC))[bh * 64 + lane] = __expf(blast + mc - mn); }
    float* AL = (float*)(ws + OFF_AL); float* BE = (float*)(ws + OFF_BE); float* NM = (float*)(ws + OFF_NM); float* WU = (float*)(ws + OFF_WU);
    B = 0.f; float rm = -INFINITY;
    for (int s = 0; s < CHUNK; ++s) { const int t = b * SEQ + lane * CHUNK + s; const float li = lf[t * 4 + h], ii = ig[t * 4 + h]; B += li; rm = fmaxf(rm, ii - B);
        if ((s >> 4) == wave) { const float mt = B + fmaxf(mc, rm); AL[t * 4 + h] = B - mt; BE[t * 4 + h] = ii - B; NM[t * 4 + h] = -mt; WU[t * 4 + h] = __expf(ii - B + blast - mn); } }
}

__device__ __forceinline__ int swz128(int row) { return (((row >> 1) & 1) | (((row >> 3) & 1) << 1)) << 1; }
__device__ __forceinline__ void scan_task(LAS unsigned char* lds, const Ptrs& p, unsigned char* ws, int task) {
    int tid = threadIdx.x; asm volatile("" : "+v"(tid));
    const int wid = __builtin_amdgcn_readfirstlane(tid >> 6), lane = tid & 63, fr = lane & 15, fq = lane >> 4;
    const int bh = task >> 4, et = (task >> 2) & 3, dtb = task & 3, b = bh >> 2, hd = bh & 3, e0 = et * 64, d0 = dtb * 64;
    const int cg = tid & 7, rp = tid >> 3, kcol = 1024 + hd * 256 + d0 + 8 * cg;
    f32x4 cw[4][2], cb[2];
#pragma unroll
    for (int j = 0; j < 4; ++j) { cw[j][0] = *(const f32x4*)(p.conv_w + j * 2048 + kcol); cw[j][1] = *(const f32x4*)(p.conv_w + j * 2048 + kcol + 4); }
    cb[0] = *(const f32x4*)(p.conv_b + kcol); cb[1] = *(const f32x4*)(p.conv_b + kcol + 4);
    const h16* QK = (const h16*)p.out; const float* WU = (const float*)(ws + OFF_WU); const float* DEC = (const float*)(ws + OFF_DEC) + bh * 64;
    const h16* Vg = (const h16*)(ws + WS_V);
    h16* CST = (h16*)(ws + WS_CST) + (size_t)bh * 64 * 65536; float* NST = (float*)(ws + WS_NST) + (size_t)bh * 64 * 256;
    const int dti = wid & 3, ep = wid >> 2; const bool doN = (et == 0) && (ep == 0);
    const int tq = (lane & 15) >> 2, tp = lane & 3;
    u32x4 raw[3][5]; float wu[3][2]; float dcv[3];
    f32x4 acc[2] = {(f32x4){0.f, 0.f, 0.f, 0.f}, (f32x4){0.f, 0.f, 0.f, 0.f}}; f32x4 nacc = (f32x4){0.f, 0.f, 0.f, 0.f};
    const h16x8 ones = {(h16)1.f, (h16)1.f, (h16)1.f, (h16)1.f, (h16)1.f, (h16)1.f, (h16)1.f, (h16)1.f};
#define SCAN_LOAD(c_, set_) do { const int t0_ = b * SEQ + (c_) * CHUNK; \
        _Pragma("unroll") for (int q = 0; q < 2; ++q) { const int I = wid * 2 + q, row = I * 8 + (lane >> 3), ch = (lane & 7) ^ swz128(row); \
            GLDS16((const char*)(Vg + (size_t)(t0_ + row) * 1024 + hd * 256 + e0) + ch * 16, lds + 32768 + ((c_) & 3) * 16384 + I * 1024); } \
        _Pragma("unroll") for (int k = 0; k < 5; ++k) { int tl = (c_) * CHUNK + 2 * rp - 3 + k; tl = tl < 0 ? 0 : tl; raw[set_][k] = *(const u32x4*)(QK + (size_t)(b * SEQ + tl) * 2048 + kcol); } \
        wu[set_][0] = WU[(t0_ + 2 * rp) * 4 + hd]; wu[set_][1] = WU[(t0_ + 2 * rp + 1) * 4 + hd]; dcv[set_] = DEC[c_]; } while (0)
#define SCAN_STORE(c_) do { \
        _Pragma("unroll") for (int j = 0; j < 2; ++j) { u32x2 w; w.x = pk_h2(acc[j][0], acc[j][1]); w.y = pk_h2(acc[j][2], acc[j][3]); \
            *(u32x2*)(CST + (size_t)(c_) * 65536 + (size_t)(e0 + 16 * (2 * ep + j) + fr) * 256 + d0 + 16 * dti + 4 * fq) = w; } \
        if (doN && fr == 0) *(f32x4*)(NST + (c_) * 256 + d0 + 16 * dti + 4 * fq) = nacc; } while (0)
#define SCAN_STEP(c_, set_) do { const int c = (c_); \
        SCAN_STORE(c); \
        LAS unsigned char* kb = lds + (c & 1) * 16384; LAS unsigned char* vb = lds + 32768 + (c & 3) * 16384; \
        if (c == 0) { _Pragma("unroll") for (int k = 0; k < 3; ++k) if (2 * rp - 3 + k < 0) raw[set_][k] = (u32x4){0u, 0u, 0u, 0u}; } \
        _Pragma("unroll") for (int rr = 0; rr < 2; ++rr) { f32x4 y0 = cb[0], y1 = cb[1]; \
            _Pragma("unroll") for (int j = 0; j < 4; ++j) { const h16x8 xr = __builtin_bit_cast(h16x8, raw[set_][rr + j]); \
                _Pragma("unroll") for (int q = 0; q < 4; ++q) { y0[q] += cw[j][0][q] * (float)xr[q]; y1[q] += cw[j][1][q] * (float)xr[4 + q]; } } \
            const float sc = 0.0625f * wu[set_][rr]; \
            _Pragma("unroll") for (int q = 0; q < 4; ++q) { y0[q] = fsilu(y0[q]) * sc; y1[q] = fsilu(y1[q]) * sc; } \
            const int row = 2 * rp + rr; *(LAS u32x4*)(kb + row * 128 + ((cg ^ swz128(row)) * 16)) = pk_h8(y0, y1); } \
        asm volatile("s_waitcnt lgkmcnt(0)" ::: "memory"); __builtin_amdgcn_s_barrier(); asm volatile("" ::: "memory"); \
        const float dec = dcv[set_]; \
        if (c + 3 < NCHUNK - 1) SCAN_LOAD(c + 3, set_); \
        acc[0] *= dec; acc[1] *= dec; nacc *= dec; \
        _Pragma("unroll") for (int ks = 0; ks < 4; ++ks) { const int r0 = 32 * ks + 8 * fq + tq, r1 = r0 + 4; \
            const int o0 = r0 * 128 + (tp & 1) * 8, o1 = r1 * 128 + (tp & 1) * 8, s0 = swz128(r0), s1 = swz128(r1), cx = 2 * dti + (tp >> 1); \
            const h16x8 X = cat8(tr_read4(kb + o0 + ((cx ^ s0) * 16)), tr_read4(kb + o1 + ((cx ^ s1) * 16))); \
            _Pragma("unroll") for (int j = 0; j < 2; ++j) { const int cy = 2 * (2 * ep + j) + (tp >> 1); \
                const h16x8 Y = cat8(tr_read4(vb + o0 + ((cy ^ s0) * 16)), tr_read4(vb + o1 + ((cy ^ s1) * 16))); \
                acc[j] = __builtin_amdgcn_mfma_f32_16x16x32_f16(X, Y, acc[j], 0, 0, 0); } \
            if (doN) nacc = __builtin_amdgcn_mfma_f32_16x16x32_f16(X, ones, nacc, 0, 0, 0); } } while (0)
    SCAN_LOAD(0, 0); SCAN_LOAD(1, 1); SCAN_LOAD(2, 2);
#pragma unroll 1
    for (int c3 = 0; c3 < NCHUNK - 1; c3 += 3) { SCAN_STEP(c3, 0); SCAN_STEP(c3 + 1, 1); SCAN_STEP(c3 + 2, 2); }
    SCAN_STORE(NCHUNK - 1);
#undef SCAN_STEP
#undef SCAN_STORE
#undef SCAN_LOAD
    asm volatile("s_waitcnt vmcnt(0) lgkmcnt(0)" ::: "memory"); __builtin_amdgcn_s_barrier();
}

__device__ __forceinline__ int swz256(int row) { return ((row & 3) + 4 * ((row >> 3) & 1)) << 1; }
__device__ __forceinline__ void sgu_task(LAS unsigned char* lds, const Ptrs& p, unsigned char* ws, int task) {
    int tid = threadIdx.x; asm volatile("" : "+v"(tid));
    const int wid = __builtin_amdgcn_readfirstlane(tid >> 6), lane = tid & 63, fr = lane & 15, fq = lane >> 4;
    const int t0 = task * CHUNK;
    LAS unsigned char* wb = lds; LAS unsigned char* vb = lds + 32768; LAS float* rs = (LAS float*)(lds + 65536);
    const float* ss = (const float*)(ws + OFF_SSSV); const h16* SV = (const h16*)(ws + WS_SV); const h16* UG = (const h16*)(ws + WS_UG); h16* Z = (h16*)(ws + WS_XH);
    if (tid < CHUNK) rs[tid] = rsqrtf(ss[t0 + tid] * (1.f / DM) + EPS);
    __syncthreads();
    const int lrow = tid >> 2, lq = tid & 3, tq = (lane & 15) >> 2, tp = lane & 3, trow = 16 * wid + fr;
    f32x4 wraw[8]; h16x8 vraw[4];
#define SGU_LOAD(g_) do { const float* wsrc = p.w_s + (size_t)((g_) * 128 + lrow) * 128 + 32 * lq; const h16* vsrc = SV + (size_t)(t0 + lrow) * 1024 + (g_) * 128 + 32 * lq; \
        _Pragma("unroll") for (int i = 0; i < 8; ++i) wraw[i] = *(const f32x4*)(wsrc + 4 * i); \
        _Pragma("unroll") for (int i = 0; i < 4; ++i) vraw[i] = *(const h16x8*)(vsrc + 8 * i); } while (0)
    SGU_LOAD(0);
#pragma unroll 1
    for (int g = 0; g < 8; ++g) {
        {
            const float* gsrc = p.sgu_norm_g + g * 128 + 32 * lq; const float r = rs[lrow];
#pragma unroll
            for (int i = 0; i < 4; ++i) { f32x4 a = wraw[2 * i], c = wraw[2 * i + 1];
#pragma unroll
                for (int q = 0; q < 4; ++q) { if (32 * lq + 8 * i + q > lrow) a[q] = 0.f; if (32 * lq + 8 * i + 4 + q > lrow) c[q] = 0.f; }
                *(LAS u32x4*)(wb + lrow * 256 + (((4 * lq + i) ^ (lrow & 15)) * 16)) = pk_h8(a, c); }
#pragma unroll
            for (int i = 0; i < 4; ++i) { const h16x8 v = vraw[i]; const f32x4 g0 = *(const f32x4*)(gsrc + 8 * i), g1 = *(const f32x4*)(gsrc + 8 * i + 4); f32x4 a, c;
#pragma unroll
                for (int q = 0; q < 4; ++q) { a[q] = (float)v[q] * r * g0[q]; c[q] = (float)v[4 + q] * r * g1[q]; }
                *(LAS u32x4*)(vb + lrow * 256 + (((4 * lq + i) ^ swz256(lrow)) * 16)) = pk_h8(a, c); }
        }
        __syncthreads();
        if (g + 1 < 8) SGU_LOAD(g + 1);
        const float bias = p.b_s[g * 128 + trow]; const size_t ro = (size_t)(t0 + trow) * 1024 + g * 128 + 4 * fq;
        h16x4 ur[8];
#pragma unroll
        for (int dt = 0; dt < 8; ++dt) ur[dt] = *(const h16x4*)(UG + ro + 16 * dt);
        f32x4 acc[8];
#pragma unroll
        for (int dt = 0; dt < 8; ++dt) acc[dt] = (f32x4){0.f, 0.f, 0.f, 0.f};
        const int nks = (wid >> 1) + 1;
        for (int ks = 0; ks < nks; ++ks) {
            const h16x8 Y = *(const LAS h16x8*)(wb + trow * 256 + (((4 * ks + fq) ^ (trow & 15)) * 16));
            const int r0 = 32 * ks + 8 * fq + tq, r1 = r0 + 4, o0 = r0 * 256 + (tp & 1) * 8, o1 = r1 * 256 + (tp & 1) * 8, s0 = swz256(r0), s1 = swz256(r1);
#pragma unroll
            for (int dt = 0; dt < 8; ++dt) { const int cx = 2 * dt + (tp >> 1);
                const h16x8 X = cat8(tr_read4(vb + o0 + ((cx ^ s0) * 16)), tr_read4(vb + o1 + ((cx ^ s1) * 16)));
                acc[dt] = __builtin_amdgcn_mfma_f32_16x16x32_f16(X, Y, acc[dt], 0, 0, 0); }
        }
#pragma unroll
        for (int dt = 0; dt < 8; ++dt) { const h16x4 u = ur[dt]; u32x2 w;
            w.x = pk_h2((float)u[0] * (acc[dt][0] + bias), (float)u[1] * (acc[dt][1] + bias)); w.y = pk_h2((float)u[2] * (acc[dt][2] + bias), (float)u[3] * (acc[dt][3] + bias));
            *(u32x2*)(Z + ro + 16 * dt) = w; }
        __syncthreads();
    }
#undef SGU_LOAD
}

__device__ __forceinline__ int swzb(int row) { return (row >> 1) & 7; }
__device__ __forceinline__ void mout_phase(LAS unsigned char* lds, const Ptrs& p, unsigned char* ws, int G, int bx, h16* Zdst) {
    const int wid = __builtin_amdgcn_readfirstlane(threadIdx.x >> 6);
    constexpr int QB = 0, KB = 16384, CB = 32768, VB = 69632, SM = 135168;
    const h16* QK = (const h16*)p.out; const h16* Vg = (const h16*)(ws + WS_V); const h16* OG = (const h16*)(ws + WS_OG); h16* Z = (h16*)(ws + WS_XH);
    const float* ALg = (const float*)(ws + OFF_AL); const float* BEg = (const float*)(ws + OFF_BE); const float* NMg = (const float*)(ws + OFF_NM); const float* MST = (const float*)(ws + OFF_MST);
    LAS float* ALs = (LAS float*)(lds + SM); LAS float* BEs = ALs + 128;
#define OPAQUE_TID() int tid = threadIdx.x; asm volatile("" : "+v"(tid)); const int lane = tid & 63, fr = lane & 15, fq = lane >> 4, cg = tid & 7, rp = tid >> 3, tq = (lane & 15) >> 2, tp = lane & 3, trow = 16 * wid + fr; (void)cg; (void)rp; (void)tq; (void)tp; (void)trow; (void)fq
    for (int L = bx; L < 512; L += G) {
        const int bh = L >> 6, c = L & 63, b = bh >> 2, hd = bh & 3, t0 = b * SEQ + c * CHUNK;
        const h16* Ct = (const h16*)(ws + WS_CST) + ((size_t)(bh * 64 + c)) * 65536; const float* nst = (const float*)(ws + WS_NST) + (size_t)(bh * 64 + c) * 256;
        __syncthreads();
        { OPAQUE_TID();
        if (tid < 128) ALs[tid] = ALg[(t0 + tid) * 4 + hd]; else if (tid < 256) BEs[tid - 128] = BEg[(t0 + tid - 128) * 4 + hd];
#pragma unroll
        for (int q = 0; q < 8; ++q) { const int I = wid * 8 + q, row = I * 2 + (lane >> 5), ch = (lane & 31) ^ ((row & 7) << 1);
            GLDS16((const char*)(Vg + (size_t)(t0 + row) * 1024 + hd * 256) + ch * 16, lds + VB + I * 1024); }
        }
        f32x4 S[8], acc[17];
#pragma unroll
        for (int i = 0; i < 8; ++i) S[i] = (f32x4){0.f, 0.f, 0.f, 0.f};
#pragma unroll
        for (int i = 0; i < 17; ++i) acc[i] = (f32x4){0.f, 0.f, 0.f, 0.f};
#pragma unroll 1
        for (int dch = 0; dch < 4; ++dch) {
            OPAQUE_TID();
#pragma unroll
            for (int q = 0; q < 4; ++q) { const int I = wid * 4 + q, row = I * 8 + (lane >> 3), ch = (lane & 7) ^ swzb(row);
                GLDS16((const char*)(Ct + (size_t)row * 256 + dch * 64) + ch * 16, lds + CB + I * 1024); }
            if (tid < 8) { const f32x4 a = *(const f32x4*)(nst + dch * 64 + 8 * tid), c2 = *(const f32x4*)(nst + dch * 64 + 8 * tid + 4); *(LAS u32x4*)(lds + CB + 32768 + tid * 16) = pk_h8(a, c2); }
#pragma unroll 1
            for (int which = 0; which < 2; ++which) {
                const int col = which * 1024 + hd * 256 + dch * 64 + 8 * cg;
                u32x4 raw[5];
#pragma unroll
                for (int k = 0; k < 5; ++k) { const int tl = c * CHUNK + 2 * rp - 3 + k; raw[k] = (u32x4){0u, 0u, 0u, 0u}; if (tl >= 0) raw[k] = *(const u32x4*)(QK + (size_t)(b * SEQ + tl) * 2048 + col); }
                f32x4 cw[4][2];
#pragma unroll
                for (int j = 0; j < 4; ++j) { cw[j][0] = *(const f32x4*)(p.conv_w + j * 2048 + col); cw[j][1] = *(const f32x4*)(p.conv_w + j * 2048 + col + 4); }
                const f32x4 cb0 = *(const f32x4*)(p.conv_b + col), cb1 = *(const f32x4*)(p.conv_b + col + 4);
                const float sc = which ? 0.0625f : 1.f;
#pragma unroll
                for (int rr = 0; rr < 2; ++rr) { f32x4 y0 = cb0, y1 = cb1;
#pragma unroll
                    for (int j = 0; j < 4; ++j) { const h16x8 xr = __builtin_bit_cast(h16x8, raw[rr + j]);
#pragma unroll
                        for (int q = 0; q < 4; ++q) { y0[q] += cw[j][0][q] * (float)xr[q]; y1[q] += cw[j][1][q] * (float)xr[4 + q]; } }
#pragma unroll
                    for (int q = 0; q < 4; ++q) { y0[q] = fsilu(y0[q]) * sc; y1[q] = fsilu(y1[q]) * sc; }
                    const int row = 2 * rp + rr; *(LAS u32x4*)(lds + (which ? KB : QB) + row * 128 + ((cg ^ swzb(row)) * 16)) = pk_h8(y0, y1); }
            }
            asm volatile("s_waitcnt vmcnt(0) lgkmcnt(0)" ::: "memory"); __builtin_amdgcn_s_barrier(); asm volatile("" ::: "memory");
            h16x8 Y[2];
#pragma unroll
            for (int ks = 0; ks < 2; ++ks) Y[ks] = *(const LAS h16x8*)(lds + QB + trow * 128 + (((4 * ks + fq) ^ swzb(trow)) * 16));
#pragma unroll
            for (int st = 0; st < 8; ++st) if (st <= wid) {
#pragma unroll
                for (int ks = 0; ks < 2; ++ks) { const int krow = 16 * st + fr; const h16x8 X = *(const LAS h16x8*)(lds + KB + krow * 128 + (((4 * ks + fq) ^ swzb(krow)) * 16));
                    S[st] = __builtin_amdgcn_mfma_f32_16x16x32_f16(X, Y[ks], S[st], 0, 0, 0); } }
#pragma unroll
            for (int et = 0; et < 17; ++et) {
#pragma unroll
                for (int ks = 0; ks < 2; ++ks) { const int crow = 16 * et + fr; const h16x8 X = *(const LAS h16x8*)(lds + CB + crow * 128 + (((4 * ks + fq) ^ swzb(crow)) * 16));
                    acc[et] = __builtin_amdgcn_mfma_f32_16x16x32_f16(X, Y[ks], acc[et], 0, 0, 0); }
                if ((et & 3) == 3) __builtin_amdgcn_sched_barrier(0); }
            asm volatile("s_waitcnt lgkmcnt(0)" ::: "memory"); __builtin_amdgcn_s_barrier(); asm volatile("" ::: "memory");
        }
        OPAQUE_TID();
        const float al = ALs[trow], mc = MST[bh * 64 + c], iw = __expf(al + mc);
#pragma unroll
        for (int et = 0; et < 16; ++et) acc[et] *= iw;
        const float qn = __shfl(acc[16][0], fr);
        float den = 0.f;
#pragma unroll
        for (int st = 0; st < 8; ++st) { const f32x4 be = *(const LAS f32x4*)(BEs + 16 * st + 4 * fq);
#pragma unroll
            for (int r = 0; r < 4; ++r) { float v = S[st][r] * __expf(al + be[r]); if (st == wid) v = (4 * fq + r <= fr) ? v : 0.f; if (st > wid) v = 0.f; S[st][r] = v; den += v; } }
        den += __shfl_xor(den, 16); den += __shfl_xor(den, 32);
        den += iw * qn;
        h16x8 pf[4];
#pragma unroll
        for (int i = 0; i < 4; ++i) pf[i] = cat8(cvt4(S[2 * i]), cvt4(S[2 * i + 1]));
#pragma unroll
        for (int ks = 0; ks < 4; ++ks) if (ks <= (wid >> 1)) { const int r0 = 32 * ks + 4 * fq + tq, r1 = r0 + 16;
#pragma unroll
            for (int et = 0; et < 16; ++et) {
                const h16x4 lo = tr_read4(lds + VB + r0 * 512 + (((2 * et + (tp >> 1)) ^ ((r0 & 7) << 1)) * 16) + (tp & 1) * 8);
                const h16x4 hi = tr_read4(lds + VB + r1 * 512 + (((2 * et + (tp >> 1)) ^ ((r1 & 7) << 1)) * 16) + (tp & 1) * 8);
                acc[et] = __builtin_amdgcn_mfma_f32_16x16x32_f16(cat8(lo, hi), pf[ks], acc[et], 0, 0, 0);
                if ((et & 3) == 3) __builtin_amdgcn_sched_barrier(0); } }
        const int tg = t0 + trow; const float inv = 1.f / fmaxf(fabsf(den), __expf(NMg[tg * 4 + hd]));
        float ss = 0.f;
#pragma unroll
        for (int et = 0; et < 16; ++et) { acc[et] *= inv; ss += (acc[et][0] * acc[et][0] + acc[et][1] * acc[et][1]) + (acc[et][2] * acc[et][2] + acc[et][3] * acc[et][3]); }
        ss += __shfl_xor(ss, 16); ss += __shfl_xor(ss, 32);
        const float rstd = rsqrtf(ss * (1.f / DH) + EPS);
#pragma unroll
        for (int half = 0; half < 2; ++half) { f32x4 gg[8]; h16x4 ogv[8], zv[8];
#pragma unroll
            for (int e8 = 0; e8 < 8; ++e8) { const int col = hd * 256 + 16 * (8 * half + e8) + 4 * fq; const size_t o = (size_t)tg * 1024 + col;
                gg[e8] = *(const f32x4*)(p.mh_norm_g + col); ogv[e8] = *(const h16x4*)(OG + o); zv[e8] = *(const h16x4*)(Z + o); }
            REGBAR8(gg); REGBAR8(ogv); REGBAR8(zv);
#pragma unroll
            for (int e8 = 0; e8 < 8; ++e8) { const int et = 8 * half + e8; const size_t o = (size_t)tg * 1024 + hd * 256 + 16 * et + 4 * fq; u32x2 w;
                w.x = pk_h2((float)zv[e8][0] + acc[et][0] * rstd * gg[e8][0] * (float)ogv[e8][0], (float)zv[e8][1] + acc[et][1] * rstd * gg[e8][1] * (float)ogv[e8][1]);
                w.y = pk_h2((float)zv[e8][2] + acc[et][2] * rstd * gg[e8][2] * (float)ogv[e8][2], (float)zv[e8][3] + acc[et][3] * rstd * gg[e8][3] * (float)ogv[e8][3]);
                *(u32x2*)(Zdst + o) = w; }
            asm volatile("" ::: "memory"); }
    }
    asm volatile("s_waitcnt vmcnt(0) lgkmcnt(0)" ::: "memory"); __builtin_amdgcn_s_barrier();
#undef OPAQUE_TID
}

struct TpItem { const float* W; const float* gk; h16* WT; int ldw, srccol0, K, destrow0, k0; };
__device__ __forceinline__ void tp_load(const TpItem& t, f32x4 (&v)[8], float (&g)[8], int lane) {
    const int col4 = lane & 7, krow = lane >> 3;
#pragma unroll
    for (int i = 0; i < 8; ++i) { v[i] = *(const f32x4*)(t.W + (size_t)(t.k0 + 8 * i + krow) * t.ldw + t.srccol0 + 4 * col4); g[i] = t.gk ? t.gk[t.k0 + 8 * i + krow] : 1.f; }
}
__device__ __forceinline__ void tp_store(const TpItem& t, const f32x4 (&v)[8], const float (&g)[8], LAS unsigned char* scr, int lane) {
    const int col4 = lane & 7, krow = lane >> 3;
#pragma unroll
    for (int i = 0; i < 8; ++i) { const int k = 8 * i + krow; const f32x4 x = v[i] * g[i]; u32x2 w; w.x = pk_h2(x[0], x[1]); w.y = pk_h2(x[2], x[3]);
        *(LAS u32x2*)(scr + k * 64 + (((col4 >> 1) ^ (2 * (i & 1))) * 16) + (col4 & 1) * 8) = w; }
    LDS_WAIT(); asm volatile("" ::: "memory");
    const int gq = lane >> 4, li = lane & 15, q = li >> 2, pp = li & 3;
#pragma unroll
    for (int h = 0; h < 2; ++h)
#pragma unroll
        for (int it = 0; it < 2; ++it) { const int m = gq + 4 * it, r0 = 8 * m + q, r1 = r0 + 4, ch = (2 * h + (pp >> 1)) ^ (2 * (m & 1));
            const h16x4 lo = tr_read4(scr + r0 * 64 + ch * 16 + (pp & 1) * 8), hi = tr_read4(scr + r1 * 64 + ch * 16 + (pp & 1) * 8);
            *(GAS h16x8*)(t.WT + (size_t)(t.destrow0 + 16 * h + li) * t.K + t.k0 + 8 * m) = cat8(lo, hi); }
    LDS_WAIT(); asm volatile("" ::: "memory");
}
template <class Dec>
__device__ __forceinline__ void tp_loop(const Dec& dec, int first, int count, int stride, LAS unsigned char* scr, int lane) {
    if (first >= count) return;
    TpItem cur = dec(first); f32x4 v[8]; float g[8]; tp_load(cur, v, g, lane);
    for (int it = first; it < count; it += stride) {
        const int nx = it + stride; TpItem nxt = cur; f32x4 v2[8]; float g2[8];
#pragma unroll
        for (int i = 0; i < 8; ++i) { v2[i] = v[i]; g2[i] = g[i]; }
        if (nx < count) { nxt = dec(nx); tp_load(nxt, v2, g2, lane); }
        asm volatile("" ::: "memory");
        tp_store(cur, v, g, scr, lane);
        cur = nxt;
#pragma unroll
        for (int i = 0; i < 8; ++i) { v[i] = v2[i]; g[i] = g2[i]; }
    }
}
__device__ __forceinline__ int win_destrow(int l) {
    if (l < 3072) return l;
    if (l < 4096) { const int c = l - 3072; return 3072 + (c >> 7) * 256 + (c & 127); }
    if (l < 5120) { const int c = l - 4096; return 5120 + (c >> 7) * 256 + (c & 127); }
    if (l < 6144) return 7168 + (l - 5120);
    if (l < 7168) { const int c = l - 6144; return 3072 + (c >> 7) * 256 + 128 + (c & 127); }
    { const int c = l - 7168; return 5120 + (c >> 7) * 256 + 128 + (c & 127); }
}

struct TpDecP0 { const Ptrs* p; unsigned char* ws;
    __device__ __forceinline__ TpItem operator()(int it) const {
        constexpr int I_WIN = 16 * 256, I_SQ = 16 * 32, I_KV = 16 * 64; h16* wsm = (h16*)(ws + WS_WSM); int r = it; TpItem t;
        if (r < I_WIN) { const int kb = r >> 8, nb = r & 255, l0 = 32 * nb; t = TpItem{p->w_in, p->norm_mix_g, (h16*)(ws + WS_WIN), IN_DIM, l0 < 4096 ? l0 : l0 + 8, DM, win_destrow(l0), 64 * kb}; return t; } r -= I_WIN;
        if (r < I_SQ) { t = TpItem{p->w_out, nullptr, wsm, DM, 32 * (r & 31), DM, 32 * (r & 31), 64 * (r >> 5)}; return t; } r -= I_SQ;
        if (r < I_SQ) { t = TpItem{p->w_xq, p->norm_x_g, wsm + 1024 * 1024, DM, 32 * (r & 31), DM, 32 * (r & 31), 64 * (r >> 5)}; return t; } r -= I_SQ;
        if (r < I_KV) { t = TpItem{p->w_xkv, p->norm_mem_g, wsm + 2 * 1024 * 1024, 2048, 32 * (r & 63), DM, 32 * (r & 63), 64 * (r >> 6)}; return t; } r -= I_KV;
        t = TpItem{p->w_xo, nullptr, wsm + 4 * 1024 * 1024, DM, 32 * (r & 31), DM, 32 * (r & 31), 64 * (r >> 5)}; return t; } };
struct TpDecP4 { const Ptrs* p; unsigned char* ws;
    __device__ __forceinline__ TpItem operator()(int it) const {
        h16* W13 = (h16*)(ws + WS_UG); h16* W2T = (h16*)(ws + WS_UG + 64 * MiB); const int e = it / 768, r = it % 768; TpItem t;
        if (r < 256) { const int kb = r >> 4, nb = r & 15, f0 = 32 * nb; t = TpItem{p->w1 + (size_t)e * DM * FF, p->norm_moe_g, W13 + (size_t)e * 1024 * 1024, FF, f0, DM, (f0 >> 7) * 256 + (f0 & 127), 64 * kb}; return t; }
        if (r < 512) { const int q = r - 256, kb = q >> 4, nb = q & 15, f0 = 32 * nb; t = TpItem{p->w3 + (size_t)e * DM * FF, p->norm_moe_g, W13 + (size_t)e * 1024 * 1024, FF, f0, DM, (f0 >> 7) * 256 + 128 + (f0 & 127), 64 * kb}; return t; }
        const int q = r - 512, kb = q >> 5, nb = q & 31; t = TpItem{p->w2 + (size_t)e * FF * DM, nullptr, W2T + (size_t)e * 1024 * 512, DM, 32 * nb, FF, 32 * nb, 64 * kb}; return t; } };
template <bool GATES>
__device__ __forceinline__ float p0_row(const f32x4 (&v)[4], h16* orow, const LAS float* gt, float (&acc)[8], int lane) {
    float ss = 0.f;
#pragma unroll
    for (int j = 0; j < 4; ++j) ss += (v[j].x * v[j].x + v[j].y * v[j].y) + (v[j].z * v[j].z + v[j].w * v[j].w);
    GAS u32x2* o8 = (GAS u32x2*)orow + lane;
#pragma unroll
    for (int j = 0; j < 4; ++j) { u32x2 w; w.x = pk_h2(v[j].x, v[j].y); w.y = pk_h2(v[j].z, v[j].w); o8[64 * j] = w; }
    if constexpr (GATES) {
#pragma unroll
        for (int q = 0; q < 8; ++q) acc[q] = 0.f;
#pragma unroll
        for (int j = 0; j < 4; ++j)
#pragma unroll
            for (int c = 0; c < 4; ++c) { const int k = 4 * (64 * j + lane) + c; const f32x4 g0 = *(const LAS f32x4*)(gt + k * 8), g1 = *(const LAS f32x4*)(gt + k * 8 + 4); const float xv = v[j][c];
                acc[0] += xv * g0.x; acc[1] += xv * g0.y; acc[2] += xv * g0.z; acc[3] += xv * g0.w; acc[4] += xv * g1.x; acc[5] += xv * g1.y; acc[6] += xv * g1.z; acc[7] += xv * g1.w; }
        const bool b5 = (lane & 32) != 0, b4 = (lane & 16) != 0, b3 = (lane & 8) != 0; float k4[4], k2[2], k1;
#pragma unroll
        for (int q = 0; q < 4; ++q) { const float snd = b5 ? acc[q] : acc[4 + q]; k4[q] = (b5 ? acc[4 + q] : acc[q]) + __shfl_xor(snd, 32); }
#pragma unroll
        for (int q = 0; q < 2; ++q) { const float snd = b4 ? k4[q] : k4[2 + q]; k2[q] = (b4 ? k4[2 + q] : k4[q]) + __shfl_xor(snd, 16); }
        { const float snd = b3 ? k2[0] : k2[1]; k1 = (b3 ? k2[1] : k2[0]) + __shfl_xor(snd, 8); }
        k1 += __shfl_xor(k1, 4); k1 += __shfl_xor(k1, 2); k1 += __shfl_xor(k1, 1);
#pragma unroll
        for (int q = 0; q < 8; ++q) acc[q] = __builtin_bit_cast(float, __builtin_amdgcn_readlane(__builtin_bit_cast(int, k1), 8 * q));
    }
    return wave_sum(ss);
}
__device__ __forceinline__ void mstate_wave(const float* ig, const float* lf, float* mst, int bh, int lane) {
    const int b = bh >> 2, h = bh & 3; float B = 0.f, mx = -INFINITY;
    for (int s = 0; s < CHUNK; ++s) { const int t = b * SEQ + lane * CHUNK + s; B += lf[t * 4 + h]; mx = fmaxf(mx, ig[t * 4 + h] - B); }
    const float blast = B, maxw = B + mx; float m = 0.f;
    for (int c = 0; c < NCHUNK; ++c) { const float bl = __shfl(blast, c), mw = __shfl(maxw, c); if (lane == c) mst[bh * 64 + c] = m; m = fmaxf(bl + m, mw); }
}

struct Args { Ptrs p; int ph_lo, ph_hi, li, pad; };
__global__ void __launch_bounds__(NTHREADS, 2) mega(Args a) {
    extern __shared__ __attribute__((aligned(16))) unsigned char lds_[];
    LAS unsigned char* lds = (LAS unsigned char*)lds_;
    volatile LAS unsigned* MISC = (volatile LAS unsigned*)(lds + MISC_OFF);
    const Ptrs& p = a.p;
#define PH_IDS() int tid = threadIdx.x; asm volatile("" : "+v"(tid)); const int lane = tid & 63, wave = __builtin_amdgcn_readfirstlane(tid >> 6); const int gw = vcu * NWAVES + wave, NGW = G * NWAVES; (void)lane; (void)gw; (void)NGW
    const int G = gridDim.x, bx = blockIdx.x, vcu = (G % 8 == 0) ? (bx % 8) * (G / 8) + bx / 8 : bx;
    unsigned char* ws = p.ws;
    unsigned* ctl = (unsigned*)(ws + WS_CTL);
    for (int u = threadIdx.x; u < (LDS_BYTES - LDSCTL_OFF) / 4; u += NTHREADS) ((LAS unsigned*)(lds + LDSCTL_OFF))[u] = 0u;
    __syncthreads();
    XcdBarrier bar = xcd_barrier_post(ctl + CW_BAR + a.li * XCD_BAR_WORDS, MISC + 8);
    const int lo = a.ph_lo, hi = a.ph_hi;
#ifndef PH_MASK
#define PH_MASK 0xFFFF
#endif
#define IN(k) (((PH_MASK >> (k)) & 1) && lo <= (k) && (k) < hi)
#ifndef REPEAT_MASK
#define REPEAT_MASK 0
#endif
#define REP(k) for (int rep_ = 0; rep_ < 1 + ((REPEAT_MASK >> (k)) & 1); ++rep_)
#define BOTH(k) (IN(k) && IN((k) + 1))
#define GRID_BAR() xcd_barrier(bar)

    if (IN(0)) REP(0) {
        PH_IDS();
        __syncthreads();
        LAS float* gt = (LAS float*)lds;
        for (int i = tid; i < 8192; i += NTHREADS) { const int k = i >> 3, j = i & 7; gt[i] = p.norm_mix_g[k] * p.w_in[(size_t)k * IN_DIM + C_I + j]; }
        { float* wrt = (float*)(ws + OFF_WRT); for (int i = bx * NTHREADS + tid; i < 36 * 1024; i += G * NTHREADS) { const int j = i >> 10, k = i & 1023; wrt[i] = p.norm_moe_g[k] * (j < 4 ? p.w_rg[k * 4 + j] : p.w_re[k * 32 + (j - 4)]); } }
        { float* z = (float*)(ws + OFF_SSSV); for (int i = bx * NTHREADS + tid; i < 3 * NTOK; i += G * NTHREADS) z[i] = 0.f; }
        __syncthreads();
        float acc[8]; float bif[8];
#pragma unroll
        for (int h = 0; h < 8; ++h) bif[h] = p.b_if[h];
        {   f32x4 v[4], nv[4];
            if (gw < NTOK) {
#pragma unroll
                for (int j = 0; j < 4; ++j) v[j] = ((const GAS f32x4*)(p.x + (size_t)gw * DM) + lane)[64 * j]; }
            for (int m = gw; m < NTOK; m += NGW) {
                const int mn = (m + NGW < NTOK) ? m + NGW : m;
#pragma unroll
                for (int j = 0; j < 4; ++j) nv[j] = ((const GAS f32x4*)(p.x + (size_t)mn * DM) + lane)[64 * j];
                asm volatile("" ::: "memory");
                const float ss = p0_row<true>(v, (h16*)(ws + WS_XH) + (size_t)m * DM, gt, acc, lane);
                const float rstd = rsqrtf(ss * (1.f / DM) + EPS);
                if (lane == 0) { ((float*)(ws + OFF_RSTD0))[m] = rstd; f32x4 igv, lfv;
#pragma unroll
                    for (int h = 0; h < 4; ++h) { igv[h] = acc[h] * rstd + bif[h]; lfv[h] = logsigmoidf_(acc[4 + h] * rstd + bif[4 + h]); }
                    *(f32x4*)((float*)(ws + OFF_IG) + m * 4) = igv; *(f32x4*)((float*)(ws + OFF_LF) + m * 4) = lfv; }
#pragma unroll
                for (int j = 0; j < 4; ++j) v[j] = nv[j];
            }
        }
        for (int m = gw; m < NB * NMEM; m += NGW) { f32x4 v[4];
#pragma unroll
            for (int j = 0; j < 4; ++j) v[j] = ((const GAS f32x4*)(p.mem + (size_t)m * DM) + lane)[64 * j];
            const float ss = p0_row<false>(v, (h16*)(ws + WS_MEMH) + (size_t)m * DM, gt, acc, lane);
            if (lane == 0) ((float*)(ws + OFF_RSTDM))[m] = rsqrtf(ss * (1.f / DM) + EPS);
        }
        LAS unsigned char* scr = lds + 32768 + wave * 4096;
        { TpDecP0 dec{&p, ws}; tp_loop(dec, gw, 16 * 256 + 3 * 16 * 32 + 16 * 64, NGW, scr, lane); }
        if (BOTH(0)) GRID_BAR();
    }
    if (IN(1)) REP(1) {
        PH_IDS();
        if (bx < 8) mstate_ext(ws, bx, wave, lane);
        { pg8::StaticOrder S; S.init(ws + WS_XH, ws + WS_WIN, NTOK, 8192, DM, G, bx);
          EpiProj E{(const float*)(ws + OFF_RSTD0), p.b_gate, (h16*)p.out, (h16*)(ws + WS_V), (h16*)(ws + WS_OG), (h16*)(ws + WS_UG), (h16*)(ws + WS_SV), (float*)(ws + OFF_SSSV), rep_ == 0};
          pg8::gemm_phase<EpiProj, pg8::StaticOrder, false, true>(lds, DM, S, E); }
        { pg8::StaticOrder S; S.init(ws + WS_MEMH, ws + WS_WSM + 2 * 2097152, NB * NMEM, 2048, DM, G, (bx + G - 64) % G);
          EpiKV E{(const float*)(ws + OFF_RSTDM), (h16*)(ws + WS_KM), (h16*)(ws + WS_VTM)};
          pg8::gemm_phase<EpiKV, pg8::StaticOrder, false, true>(lds, DM, S, E); }
        if (BOTH(1)) GRID_BAR();
    }

    if (IN(2)) REP(2) {
        if (G >= 256) { if (bx < 128) scan_task(lds, p, ws, bx); else if (bx < 256) sgu_task(lds, p, ws, bx - 128); }
        else { for (int t = bx; t < 256; t += G) { if (t < 128) scan_task(lds, p, ws, t); else sgu_task(lds, p, ws, t - 128); __syncthreads(); } }
        if (BOTH(2)) GRID_BAR();
    }
    if (IN(3)) REP(3) {
        mout_phase(lds, p, ws, G, bx, (((REPEAT_MASK >> 3) & 1) && rep_ == 0) ? (h16*)(ws + WS_UG) : (h16*)(ws + WS_XH));
        if (BOTH(3)) GRID_BAR();
    }
    if (IN(4)) REP(4) {
        PH_IDS();
        { LAS unsigned char* scr = lds + 32768 + wave * 4096;
          TpDecP4 dec{&p, ws}; tp_loop(dec, gw, 32 * 768, NGW, scr, lane);
          __syncthreads(); }
        { pg8::StaticOrder S; S.init(ws + WS_XH, ws + WS_WSM, NTOK, DM, DM, G, bx);
          EpiResid E{p.x, p.out, (h16*)(ws + WS_V), (float*)(ws + OFF_SS1), rep_ == 0};
          pg8::gemm_phase<EpiResid, pg8::StaticOrder, false, false>(lds, DM, S, E); }
        if (BOTH(4)) GRID_BAR();
    }
    if (IN(5)) REP(5) {
        { pg8::StaticOrder S; S.init(ws + WS_V, ws + WS_WSM + 2097152, NTOK, DM, DM, G, bx);
          EpiQ E{(const float*)(ws + OFF_SS1), (h16*)(ws + WS_XH)};
          pg8::gemm_phase<EpiQ, pg8::StaticOrder, false, false>(lds, DM, S, E); }
        if (BOTH(5)) GRID_BAR();
    }
    if (IN(6)) REP(6) {
        attn_phase(lds, (const h16*)(ws + WS_XH), (const h16*)(ws + WS_KM), (const h16*)(ws + WS_VTM), (h16*)(ws + WS_OG), G, bx);
        if (BOTH(6)) GRID_BAR();
    }
    if (IN(7)) {
        { pg8::StaticOrder S; S.init(ws + WS_OG, ws + WS_WSM + 4 * 2097152, NTOK, DM, DM, G, bx);
          EpiResid E{p.out, p.out, (h16*)(ws + WS_V), (float*)(ws + OFF_SS2), true};
          pg8::gemm_phase<EpiResid, pg8::StaticOrder, false, false>(lds, DM, S, E); }
        if (BOTH(7)) GRID_BAR();
    }
    if (IN(8)) REP(8) {
        PH_IDS();
        if (rep_ == 1) { GRID_BAR(); if (bx == 0 && tid < 32) (ctl + CW_CNT)[tid * 64] = 0u; GRID_BAR(); }
        unsigned* cnt = ctl + CW_CNT; int* list = (int*)(ws + OFF_LIST); float* gate = (float*)(ws + OFF_GATE);
        LAS unsigned* lc = (LAS unsigned*)lds; __syncthreads(); if (tid < 64) lc[tid] = 0u; __syncthreads();
        const float* ss2 = (const float*)(ws + OFF_SS2); const float* WRT = (const float*)(ws + OFF_WRT);
        const bool b5 = (lane & 32) != 0, b4 = (lane & 16) != 0, b3 = (lane & 8) != 0;
        int myE = 0, mySlot = 0; float myG = 0.f; int nmine = 0;
        f32x4 xn[4]; float ssc = 1.f;
        if (gw < NTOK) { ssc = ss2[gw];
#pragma unroll
            for (int j = 0; j < 4; ++j) xn[j] = ((const GAS f32x4*)(p.out + (size_t)gw * DM) + lane)[64 * j]; }
        for (int t = gw; t < NTOK; t += NGW) {
            const int tn = (t + NGW < NTOK) ? t + NGW : t; const GAS f32x4* xr = (const GAS f32x4*)(p.out + (size_t)tn * DM) + lane; const float rs = rsqrtf(ssc * (1.f / DM) + EPS);
            f32x4 v[4];
#pragma unroll
            for (int j = 0; j < 4; ++j) { v[j] = xn[j] * rs; xn[j] = xr[64 * j]; }
            ssc = ss2[tn];
            float a0 = 0.f, a1 = 0.f, a2 = 0.f, a3 = 0.f;
            { f32x4 wv[16];
#pragma unroll
              for (int j = 0; j < 4; ++j) { const GAS f32x4* wp = (const GAS f32x4*)WRT + 64 * j + lane; wv[4 * j] = wp[0]; wv[4 * j + 1] = wp[256]; wv[4 * j + 2] = wp[512]; wv[4 * j + 3] = wp[768]; }
              REGBAR16(wv);
#pragma unroll
              for (int j = 0; j < 4; ++j) { const f32x4 w0 = wv[4 * j], w1 = wv[4 * j + 1], w2 = wv[4 * j + 2], w3 = wv[4 * j + 3];
                a0 += (v[j].x * w0.x + v[j].y * w0.y) + (v[j].z * w0.z + v[j].w * w0.w); a1 += (v[j].x * w1.x + v[j].y * w1.y) + (v[j].z * w1.z + v[j].w * w1.w);
                a2 += (v[j].x * w2.x + v[j].y * w2.y) + (v[j].z * w2.z + v[j].w * w2.w); a3 += (v[j].x * w3.x + v[j].y * w3.y) + (v[j].z * w3.z + v[j].w * w3.w); } }
            { const float s0 = b5 ? a0 : a2, s1 = b5 ? a1 : a3; float k0 = (b5 ? a2 : a0) + __shfl_xor(s0, 32), k1 = (b5 ? a3 : a1) + __shfl_xor(s1, 32);
              const float s2 = b4 ? k0 : k1; a0 = (b4 ? k1 : k0) + __shfl_xor(s2, 16); }
            a0 += __shfl_xor(a0, 8); a0 += __shfl_xor(a0, 4); a0 += __shfl_xor(a0, 2); a0 += __shfl_xor(a0, 1);
            float gl[4];
#pragma unroll
            for (int j = 0; j < 4; ++j) gl[j] = __builtin_bit_cast(float, __builtin_amdgcn_readlane(__builtin_bit_cast(int, a0), 16 * j)) + p.b_rg[j];
            int gi = 0; float gm = gl[0];
#pragma unroll
            for (int j = 1; j < 4; ++j) if (gl[j] > gm) { gm = gl[j]; gi = j; }
            float gs = 0.f;
#pragma unroll
            for (int j = 0; j < 4; ++j) gs += __expf(gl[j] - gm);
            const float pg = 1.f / gs;
            float e[8];
#pragma unroll
            for (int q = 0; q < 8; ++q) e[q] = 0.f;
            const GAS f32x4* we = (const GAS f32x4*)WRT + (size_t)(4 + gi * 8) * 256 + lane;
#pragma unroll
            for (int hq = 0; hq < 2; ++hq) { f32x4 wv[16];
#pragma unroll
                for (int q = 0; q < 4; ++q)
#pragma unroll
                    for (int j = 0; j < 4; ++j) wv[4 * q + j] = we[(4 * hq + q) * 256 + 64 * j];
                REGBAR16(wv);
#pragma unroll
                for (int q = 0; q < 4; ++q)
#pragma unroll
                    for (int j = 0; j < 4; ++j) { const f32x4 w = wv[4 * q + j]; e[4 * hq + q] += (v[j].x * w.x + v[j].y * w.y) + (v[j].z * w.z + v[j].w * w.w); } }
            float k4[4];
#pragma unroll
            for (int q = 0; q < 4; ++q) { const float snd = b5 ? e[q] : e[4 + q]; k4[q] = (b5 ? e[4 + q] : e[q]) + __shfl_xor(snd, 32); }
            float k2[2];
#pragma unroll
            for (int q = 0; q < 2; ++q) { const float snd = b4 ? k4[q] : k4[2 + q]; k2[q] = (b4 ? k4[2 + q] : k4[q]) + __shfl_xor(snd, 16); }
            float k1; { const float snd = b3 ? k2[0] : k2[1]; k1 = (b3 ? k2[1] : k2[0]) + __shfl_xor(snd, 8); }
            k1 += __shfl_xor(k1, 4); k1 += __shfl_xor(k1, 2); k1 += __shfl_xor(k1, 1);
            float ev[8];
#pragma unroll
            for (int q = 0; q < 8; ++q) ev[q] = __builtin_bit_cast(float, __builtin_amdgcn_readlane(__builtin_bit_cast(int, k1), 8 * q)) + p.b_re[gi * 8 + q];
            int i1 = 0; float v1 = ev[0];
#pragma unroll
            for (int q = 1; q < 8; ++q) if (ev[q] > v1) { v1 = ev[q]; i1 = q; }
            int i2 = -1; float v2 = -INFINITY;
#pragma unroll
            for (int q = 0; q < 8; ++q) if (q != i1 && ev[q] > v2) { v2 = ev[q]; i2 = q; }
            const float e2 = __expf(v2 - v1), g1 = pg / (1.f + e2), g2 = pg * e2 / (1.f + e2);
            if (lane == 2 * nmine) { myE = gi * 8 + i1; mySlot = 2 * t; myG = g1; }
            if (lane == 2 * nmine + 1) { myE = gi * 8 + i2; mySlot = 2 * t + 1; myG = g2; }
            ++nmine;
            if (nmine == 32) { { const unsigned pos = atomicAdd(cnt + myE * 64, 1u); list[myE * NTOK + pos] = mySlot; gate[mySlot] = myG; } nmine = 0; }
        }
        {
            unsigned lpos = 0u; if (lane < 2 * nmine) lpos = __hip_atomic_fetch_add(&lc[myE], 1u, __ATOMIC_RELAXED, __HIP_MEMORY_SCOPE_WORKGROUP);
            __syncthreads();
            if (tid < 32) { const unsigned c = lc[tid]; lc[32 + tid] = c ? atomicAdd(cnt + tid * 64, c) : 0u; }
            __syncthreads();
            if (lane < 2 * nmine) { const unsigned pos = lc[32 + myE] + lpos; list[myE * NTOK + pos] = mySlot; gate[mySlot] = myG; }
        }
        if (BOTH(8)) GRID_BAR();
    }
    if (IN(9) || IN(10)) {
        PH_IDS();
        LAS int* tab = (LAS int*)(lds + LDSCTL_OFF + 1024);
        if (tid == 0) { const unsigned* cnt = ctl + CW_CNT; int s = 0; for (int e = 0; e < 32; ++e) { tab[e] = s; s += (int)((__hip_atomic_load(cnt + e * 64, RLX_AGENT) + 255u) >> 8); } tab[32] = s; }
        __syncthreads();
        if (IN(9)) REP(9) {
            MoeOrder S{(const char*)(ws + WS_V), (const char*)(ws + WS_UG), DM, (size_t)1024 * 1024 * 2, (const int*)(ws + OFF_LIST), ctl + CW_CNT, tab, G, bx};
            EpiFfn1 E{(const int*)(ws + OFF_LIST), (const float*)(ws + OFF_SS2), (h16*)(ws + WS_H)};
            pg8::gemm_phase<EpiFfn1, MoeOrder, true, true>(lds, DM, S, E);
            if (BOTH(9)) GRID_BAR();
        }
        if (IN(10)) REP(10) {
            MoeOrder S{(const char*)(ws + WS_H), (const char*)(ws + WS_UG + 64 * MiB), FF, (size_t)1024 * 512 * 2, (const int*)(ws + OFF_LIST), ctl + CW_CNT, tab, G, bx};
            EpiFfn2 E{(const int*)(ws + OFF_LIST), (const float*)(ws + OFF_GATE), (h16*)(ws + WS_Y)};
            pg8::gemm_phase<EpiFfn2, MoeOrder, false, true>(lds, FF, S, E);
            if (BOTH(10)) GRID_BAR();
        }
    }
    if (IN(11)) REP(11) {
        PH_IDS();
        float* fdst = (((REPEAT_MASK >> 11) & 1) && rep_ == 0) ? (float*)(ws + WS_UG) : p.out;
        for (int t = gw; t < NTOK; t += NGW) {
            GAS f32x4* xr = (GAS f32x4*)(p.out + (size_t)t * DM) + lane; const GAS u32x2* y0 = (const GAS u32x2*)(ws + WS_Y + (size_t)(2 * t) * DM * 2) + lane; const GAS u32x2* y1 = y0 + DM / 4;
            f32x4 v[4]; float ss = 0.f;
#pragma unroll
            for (int j = 0; j < 4; ++j) { const u32x2 a = y0[64 * j], b = y1[64 * j]; const h16x4 ha = __builtin_bit_cast(h16x4, a), hb = __builtin_bit_cast(h16x4, b);
                v[j] = xr[64 * j];
#pragma unroll
                for (int c = 0; c < 4; ++c) { v[j][c] += (float)ha[c] + (float)hb[c]; ss += v[j][c] * v[j][c]; } }
            ss = wave_sum(ss); const float rs = rsqrtf(ss * (1.f / DM) + EPS);
#pragma unroll
            for (int j = 0; j < 4; ++j) { const f32x4 g = *(const f32x4*)(p.norm_f_g + 4 * (64 * j + lane)); ((GAS f32x4*)(fdst + (size_t)t * DM) + lane)[64 * j] = v[j] * rs * g; }
        }
    }
#ifdef EXTRA_BARS
    for (int i = 0; i < EXTRA_BARS; ++i) GRID_BAR();
#endif
#undef IN
#undef BOTH
#undef GRID_BAR
}

static int mega_grid() {
    static int grid = 0;
    if (grid == 0) {
        int dev = 0, cus = 0;
        if (hipGetDevice(&dev) != hipSuccess || hipDeviceGetAttribute(&cus, hipDeviceAttributeMultiprocessorCount, dev) != hipSuccess) { grid = -1; return grid; }
        if (hipFuncSetAttribute((const void*)mega, hipFuncAttributeMaxDynamicSharedMemorySize, LDS_BYTES) != hipSuccess) { fprintf(stderr, "hipFuncSetAttribute failed\n"); grid = -1; return grid; }
        (void)hipGetLastError();
        grid = cus;
    }
    return grid;
}
static void launch_mega(const Ptrs& p, int lo, int hi, int li, hipStream_t stream) {
    const int grid = mega_grid(); if (grid <= 0) return;
    Args a{}; a.p = p; a.ph_lo = lo; a.ph_hi = hi; a.li = li; a.pad = 0;
    hipLaunchKernelGGL(mega, dim3(grid), dim3(NTHREADS), LDS_BYTES, stream, a);
}

extern "C" void kernel_launch(void* const* d_in, const int* in_sizes, int n_in, void* d_out, int out_size, void* d_ws, size_t ws_size, hipStream_t stream) {
    if (n_in != 27 || ws_size < WS_END) { fprintf(stderr, "kernel_launch: unexpected n_in %d or ws_size %zu (< %zu)\n", n_in, ws_size, (size_t)WS_END); return; }
    Ptrs p{};
    const float** f = (const float**)&p;
    for (int i = 0; i < 27; ++i) f[i] = (const float*)d_in[i];
    p.out = (float*)d_out; p.ws = (unsigned char*)d_ws;
    (void)hipMemsetAsync((char*)d_ws + WS_CTL, 0, CTL_BYTES, stream);
    launch_mega(p, 0, 12, 0, stream);
}
```

```cpp
#include <hip/hip_runtime.h>
#include <cstdio>
#include <cstdint>
#include <cmath>

typedef _Float16 h16;
typedef unsigned short u16;

constexpr int DM = 1024, NB = 2, SEQ = 8192, NTOK = NB * SEQ;
constexpr int NMEM = 256, NHEAD = 4, DH = 256, CHUNK = 128, NCHUNK = SEQ / CHUNK;
constexpr int IN_DIM = 8200;
constexpr int C_QK = 0, C_V = 2048, C_O = 3072, C_I = 4096, C_F = 4100, C_U = 4104, C_SV = 5128, C_G = 6152;
constexpr int NEXP = 32, NGRP = 4, EPG = 8, FF = 512, NSLOT = NTOK * 2;
constexpr float EPS = 1e-6f;

constexpr size_t MiB = 1u << 20;
constexpr size_t WS_CTL = 0;
constexpr size_t CTL_BYTES = 1 * MiB;
constexpr size_t WS_SMALL = 1 * MiB;
constexpr size_t OFF_RSTD0 = WS_SMALL;
constexpr size_t OFF_SSSV  = OFF_RSTD0 + 65536;
constexpr size_t OFF_SS1   = OFF_SSSV + 65536;
constexpr size_t OFF_SS2   = OFF_SS1 + 65536;
constexpr size_t OFF_IG    = OFF_SS2 + 65536;
constexpr size_t OFF_LF    = OFF_IG + 262144;
constexpr size_t OFF_MST   = OFF_LF + 262144;
constexpr size_t OFF_RSTDM = OFF_MST + 4096;
constexpr size_t OFF_AL    = 4 * MiB + 1048576;
constexpr size_t OFF_BE    = OFF_AL + 262144;
constexpr size_t OFF_NM    = OFF_BE + 262144;
constexpr size_t OFF_WU    = OFF_NM + 262144;
constexpr size_t OFF_DEC   = OFF_WU + 262144;
constexpr size_t OFF_WRT   = 7 * MiB;
constexpr size_t OFF_GATE  = 2 * MiB;
constexpr size_t OFF_SLOTE = OFF_GATE + 131072;
constexpr size_t OFF_SLOTP = OFF_SLOTE + 131072;
constexpr size_t OFF_LIST  = 3 * MiB;
constexpr size_t OFF_NAIVE_C = 262 * MiB;
constexpr size_t OFF_NAIVE_N = 6 * MiB + 8192;
constexpr size_t OFF_NAIVE_S = 6 * MiB + 65536;
constexpr size_t WS_WSM  = 8 * MiB;
constexpr size_t WS_KM   = 18 * MiB;
constexpr size_t WS_VTM  = 19 * MiB;
constexpr size_t WS_WIN  = 20 * MiB;
constexpr size_t WS_XH   = 36 * MiB;
constexpr size_t WS_V    = 68 * MiB;
constexpr size_t WS_OG   = 100 * MiB;
constexpr size_t WS_UG   = 132 * MiB;
constexpr size_t WS_SV   = 164 * MiB;
constexpr size_t WS_CST  = 196 * MiB;
constexpr size_t WS_H    = 228 * MiB;
constexpr size_t WS_NST  = 260 * MiB;
constexpr size_t WS_MEMH = 261 * MiB;
constexpr size_t WS_W2T  = 268 * MiB;
constexpr size_t WS_END  = 300 * MiB;
constexpr size_t WS_Y    = WS_XH;
constexpr size_t WS_QC   = WS_UG;
constexpr size_t WS_KC   = WS_SV;
static_assert(OFF_RSTDM + 4096 <= 2 * MiB && OFF_SLOTP + 131072 <= OFF_LIST && OFF_LIST + 2 * MiB <= OFF_AL && OFF_DEC + 4096 <= OFF_NAIVE_N && OFF_NAIVE_N + 8192 <= OFF_NAIVE_S && OFF_NAIVE_S + 524288 <= WS_WSM && OFF_NAIVE_C + 2 * MiB <= WS_END, "small map");
constexpr size_t CSTRIDE = 272 * 256;
constexpr int CW_CNT = 64;

struct Ptrs {
    const float *x, *mem, *norm_mix_g, *w_in, *b_gate, *b_if, *conv_w, *conv_b, *mh_norm_g, *sgu_norm_g, *w_s, *b_s, *w_out,
                *norm_x_g, *norm_mem_g, *w_xq, *w_xkv, *w_xo, *norm_moe_g, *w_rg, *b_rg, *w_re, *b_re, *w1, *w3, *w2, *norm_f_g;
    float* out; unsigned char* ws;
};

__device__ __forceinline__ float sigmoidf_(float v) { return 1.f / (1.f + __expf(-v)); }
__device__ __forceinline__ float siluf_(float v) { return v / (1.f + __expf(-v)); }
__device__ __forceinline__ float gelu_tanh(float v) { const float u = 0.7978845608028654f * (v + 0.044715f * v * v * v); return v / (1.f + __expf(-2.f * u)); }
__device__ __forceinline__ float logsigmoidf_(float v) { return fminf(v, 0.f) - log1pf(__expf(-fabsf(v))); }
__device__ __forceinline__ float wave_sum(float v) {
#pragma unroll
    for (int o = 1; o < 64; o <<= 1) v += __shfl_xor(v, o);
    return v;
}
__device__ __forceinline__ float wave_max(float v) {
#pragma unroll
    for (int o = 1; o < 64; o <<= 1) v = fmaxf(v, __shfl_xor(v, o));
    return v;
}
__host__ __device__ __forceinline__ int vt_slot(int key) { const int g = key & ~15, r = key & 15;   const int hh = (r >> 2) & 1, j = ((r >> 3) << 2) | (r & 3); return g + 8 * hh + j; }

#define LAS __attribute__((address_space(3)))
#define GAS __attribute__((address_space(1)))
typedef _Float16 h16x8 __attribute__((ext_vector_type(8)));
typedef _Float16 h16x4 __attribute__((ext_vector_type(4)));
typedef _Float16 h16x2 __attribute__((ext_vector_type(2)));
typedef float f32x4 __attribute__((ext_vector_type(4)));
typedef float f32x2 __attribute__((ext_vector_type(2)));
typedef unsigned u32x4 __attribute__((ext_vector_type(4)));
typedef unsigned u32x2 __attribute__((ext_vector_type(2)));
typedef GAS unsigned gu32;
#define RLX_AGENT __ATOMIC_RELAXED, __HIP_MEMORY_SCOPE_AGENT
#define LDS_WAIT() asm volatile("s_waitcnt lgkmcnt(0)" ::: "memory")
#define VM_WAIT() asm volatile("s_waitcnt vmcnt(0)" ::: "memory")
__device__ __forceinline__ unsigned pk_h2(float lo, float hi) { f32x2 v = {lo, hi}; return __builtin_bit_cast(unsigned, __builtin_convertvector(v, h16x2)); }
__device__ __forceinline__ u32x4 pk_h8(f32x4 a, f32x4 b) { u32x4 w; w.x = pk_h2(a[0], a[1]); w.y = pk_h2(a[2], a[3]); w.z = pk_h2(b[0], b[1]); w.w = pk_h2(b[2], b[3]); return w; }
__device__ __forceinline__ float fsigmoid(float v) { return __builtin_amdgcn_rcpf(1.f + __expf(-v)); }
__device__ __forceinline__ float fgelu(float v) { const float u = 1.5957691216057308f * (v + 0.044715f * v * v * v); return v * __builtin_amdgcn_rcpf(1.f + __expf(-u)); }
__device__ __forceinline__ float fsilu(float v) { return v * __builtin_amdgcn_rcpf(1.f + __expf(-v)); }

constexpr int NWAVES = 8, NTHREADS = 512;
constexpr int RING_BYTES = 143360, LDSCTL_OFF = RING_BYTES, MISC_OFF = LDSCTL_OFF + 320, LDS_BYTES = 147456;
constexpr int CW_TMO = 0, CW_BAR = 4096;

#define XB_TMO      128
#define XB_XCNT(j)  (256  + 64 * (j))
#define XB_XSUB(j)  (1280 + 64 * (j))
#define XB_XGEN(j)  (2304 + 64 * (j))
#define XB_TOP      3328
#define XB_TOPGEN   3392
#define XCD_BAR_WORDS 3456
#define XB_SPIN_CAP (1u << 20)
__device__ __forceinline__ unsigned xb_ld(unsigned* p)              { return __hip_atomic_load(p, __ATOMIC_RELAXED, __HIP_MEMORY_SCOPE_AGENT); }
__device__ __forceinline__ unsigned xb_add(unsigned* p, unsigned v) { return __hip_atomic_fetch_add(p, v, __ATOMIC_RELAXED, __HIP_MEMORY_SCOPE_AGENT); }
__device__ __forceinline__ unsigned xb_xcc_id() { return (unsigned)__builtin_amdgcn_s_getreg((3 << 11) | 20) & 0xFu; }
#define XB_SPIN(cond, bar) do { unsigned _sp = 0; while (cond) { __builtin_amdgcn_s_sleep(1); \
    if ((++_sp & 255u) == 0u) { if (xb_ld(&(bar)[XB_TMO])) break; if (_sp > XB_SPIN_CAP) { atomicAdd(&(bar)[XB_TMO], 1u); break; } } } } while (0)
struct XcdBarrier { unsigned* bar; unsigned x; volatile LAS unsigned* st; };
__device__ __forceinline__ XcdBarrier xcd_barrier_post(unsigned* bar, volatile LAS unsigned* st) {
    XcdBarrier b; b.bar = bar; b.x = xb_xcc_id(); b.st = st;
    if (threadIdx.x == 0) (void)xb_add(&bar[XB_XCNT(b.x)], 1u);
    return b;
}
__device__ __forceinline__ void xcd_barrier_complete(unsigned* bar, unsigned x, unsigned& nloc, unsigned& nx) {
    const unsigned G = gridDim.x * gridDim.y * gridDim.z;
    unsigned sum, cnt, mine, sp = 0u;
    for (;;) {
        sum = 0u; cnt = 0u; mine = 0u;
#pragma unroll
        for (unsigned j = 0; j < 16; ++j) { const unsigned c = xb_ld(&bar[XB_XCNT(j)]); sum += c; cnt += (c > 0u) ? 1u : 0u; mine = (j == x) ? c : mine; }
        if (sum == G) break;
        __builtin_amdgcn_s_sleep(1);
        if ((++sp & 255u) == 0u) { if (xb_ld(&bar[XB_TMO])) break; if (sp > XB_SPIN_CAP) { atomicAdd(&bar[XB_TMO], 1u); break; } }
    }
    nloc = mine > 0u ? mine : 1u; nx = cnt > 0u ? cnt : 1u;
}
__device__ __forceinline__ void xcd_barrier(const XcdBarrier& b) {
    asm volatile("s_waitcnt vmcnt(0)" ::: "memory");
    __syncthreads();
    if (threadIdx.x == 0) {
        unsigned* bar = b.bar;
        __builtin_amdgcn_s_waitcnt(0);
        unsigned nloc = b.st[0], nx = b.st[1];
        if (nloc == 0u) { xcd_barrier_complete(bar, b.x, nloc, nx); b.st[0] = nloc; b.st[1] = nx; }
        const unsigned old = xb_add(&bar[XB_XSUB(b.x)], 1u);
        const unsigned gen = old / nloc;
        if (old + 1u == (gen + 1u) * nloc) {
            __builtin_amdgcn_fence(__ATOMIC_RELEASE, "agent");
            asm volatile("s_waitcnt vmcnt(0)" ::: "memory");
            const unsigned og = xb_add(&bar[XB_TOP], 1u);
            const unsigned tg = og / nx;
            if (og + 1u == (tg + 1u) * nx) xb_add(&bar[XB_TOPGEN], 1u);
            else XB_SPIN(xb_ld(&bar[XB_TOPGEN]) == tg, bar);
            __builtin_amdgcn_fence(__ATOMIC_ACQUIRE, "agent");
            xb_add(&bar[XB_XGEN(b.x)], 1u);
            asm volatile("s_waitcnt vmcnt(0)" ::: "memory");
        } else {
            XB_SPIN(xb_ld(&bar[XB_XGEN(b.x)]) == gen, bar);
            __builtin_amdgcn_fence(__ATOMIC_ACQUIRE, "agent");
            asm volatile("s_waitcnt vmcnt(0)" ::: "memory");
        }
    }
    __syncthreads();
}

namespace pg8 {
constexpr int BM = 256, BK = 64, HALF = 128, HTB = HALF * BK * 2, STAGE_BYTES = 8 * HTB, NXCD = 8, WGM = 8;
__host__ __device__ __forceinline__ int lds_byte(int r, int c) { const int st = (r >> 4) * 2 + (c >> 5), rr = r & 15, cc = c & 31, ob = rr * 64 + cc * 2; return st * 1024 + (ob ^ (((ob >> 9) & 1) << 5)); }
__host__ __device__ __forceinline__ void stage_rc(int b, int& R, int& C) { const int st = b / 1024, sb = b % 1024, swz = sb ^ (((sb >> 9) & 1) << 5); R = (st >> 1) * 16 + swz / 64; C = (st & 1) * 32 + (swz % 64) / 2; }
__host__ __device__ __forceinline__ int perm32(int rho) { const int n = rho >> 4, i = rho & 15; return 8 * (i >> 2) + 4 * n + (i & 3); }
struct Unit { int pm, pn, e, nv, rb, roff, nr; };
struct StaticOrder {
    static constexpr bool PARTIAL = false;
    const char* A; const char* Bt; int K; int nM, nN, nwg, G, c;
    __device__ __forceinline__ void init(const void* A_, const void* Bt_, int M, int N, int K_, int G_, int c_) { A = (const char*)A_; Bt = (const char*)Bt_; K = K_; nM = M / BM; nN = N / BM; nwg = nM * nN; G = G_; c = c_; }
    __device__ __forceinline__ bool next(int i, Unit& u) const {
        const long L = (long)i * G + c; if (L >= nwg) return false;
        int wgid = (int)L; { const int q = nwg / NXCD, r = nwg % NXCD, xcd = wgid % NXCD, off = wgid / NXCD; wgid = (xcd < r ? xcd * (q + 1) : r * (q + 1) + (xcd - r) * q) + off; }
        const int nig = WGM * nN, gid = wgid / nig, fm = gid * WGM, gsz = (nM - fm) < WGM ? (nM - fm) : WGM;
        u.pm = fm + ((wgid % nig) % gsz); u.pn = (wgid % nig) / gsz; u.e = 0; u.nv = 256; u.rb = 0; u.roff = 0; u.nr = 256; return true;
    }
    __device__ __forceinline__ const char* a_base(const Unit& u) const { return A + (size_t)u.pm * (size_t)(BM * 2) * K; }
    __device__ __forceinline__ const char* b_base(const Unit& u) const { return Bt + (size_t)u.pn * (size_t)(BM * 2) * K; }
    __device__ __forceinline__ const char* g_base() const { return A; }
    __device__ __forceinline__ unsigned a_off(const Unit& u, int h, int R) const { return 0u; }
};

template <class Epi, class Sched, bool GATHER, bool ALIGN_EPI>
__device__ __forceinline__ void gemm_phase(LAS unsigned char* lds, const int K, const Sched& S, const Epi& E) {
    int tid = threadIdx.x; asm volatile("" : "+v"(tid));
    const int wid = __builtin_amdgcn_readfirstlane(tid >> 6), lane = tid & 63, wr = wid >> 2, wc = wid & 3, fr = lane & 15, fq = lane >> 4;
    const int nt = K / BK;
    unsigned voffA[2], voffB[2];
#pragma unroll
    for (int i = 0; i < 2; ++i) { int R, C; stage_rc(tid * 16 + i * 8192, R, C); const int Rb = Epi::PERM ? ((R & ~31) + perm32(R & 31)) : R;
        voffA[i] = (unsigned)(R * K + C) * 2u; voffB[i] = (unsigned)(Rb * K + C) * 2u; }
    const size_t kstep = (size_t)(BK * 2);
    const size_t hstep = (size_t)HALF * K * 2;
    const unsigned ldsw = (unsigned)wid * 1024u;
    const int aoff = lds_byte(wr * 64 + fr, fq * 8), boff = lds_byte(wc * 32 + fr, fq * 8);
    const char* const gA = S.g_base();
#define PG8_SA(b, h) (((b) * 2 + (h)) * HTB)
#define PG8_SB(b, h) ((4 + (b) * 2 + (h)) * HTB)
#define PG8_GLDS(src, bufoff, i_) __builtin_amdgcn_global_load_lds((const unsigned*)(src), (LAS unsigned*)(lds + (bufoff) + ldsw + (i_) * 8192), 16, 0, 0)
#define PG8_STAGE_B(bufoff, gbase) do { _Pragma("unroll") for (int _i = 0; _i < 2; ++_i) PG8_GLDS((const char*)(gbase) + voffB[_i], bufoff, _i); } while (0)
#define PG8_STAGE_A(bufoff, pa, offs, h_, kb) do { _Pragma("unroll") for (int _i = 0; _i < 2; ++_i) { \
        if constexpr (GATHER) PG8_GLDS(gA + (size_t)((offs)[h_][_i] + (unsigned)(kb)), bufoff, _i); else PG8_GLDS((const char*)(pa) + (h_) * hstep + voffA[_i], bufoff, _i); } } while (0)
#define PG8_STAGE_A2(bufoff, pa, h_, kb) do { _Pragma("unroll") for (int _i = 0; _i < 2; ++_i) { \
        if constexpr (GATHER) PG8_GLDS(gA + (size_t)((last ? aon[h_][_i] : aoc[h_][_i] + t2off) + (unsigned)(kb)), bufoff, _i); else PG8_GLDS((const char*)(pa) + (h_) * hstep + voffA[_i], bufoff, _i); } } while (0)
#define PG8_LDA(dst, b, h) do { _Pragma("unroll") for (int m = 0; m < 4; ++m) _Pragma("unroll") for (int k = 0; k < 2; ++k) dst[m][k] = *(const LAS h16x8*)(lds + PG8_SA(b, h) + aoff + m * 2048 + k * 1024); } while (0)
#define PG8_LDB(dst, b, h) do { _Pragma("unroll") for (int n = 0; n < 2; ++n) _Pragma("unroll") for (int k = 0; k < 2; ++k) dst[n][k] = *(const LAS h16x8*)(lds + PG8_SB(b, h) + boff + n * 2048 + k * 1024); } while (0)
#define PG8_MMA(ai, bj, At, Bt) do { __builtin_amdgcn_s_setprio(1); _Pragma("unroll") for (int m = 0; m < 4; ++m) _Pragma("unroll") for (int n = 0; n < 2; ++n) _Pragma("unroll") for (int k = 0; k < 2; ++k) \
        acc[ai][bj][m][n] = __builtin_amdgcn_mfma_f32_16x16x32_f16(Bt[n][k], At[m][k], acc[ai][bj][m][n], 0, 0, 0); __builtin_amdgcn_s_setprio(0); } while (0)
#define PG8_WAIT_V(n) asm volatile("s_waitcnt vmcnt(" #n ")" ::: "memory")
#define PG8_WAIT_L(n) asm volatile("s_waitcnt lgkmcnt(" #n ")" ::: "memory")
#define PG8_BAR __builtin_amdgcn_s_barrier()
#define PG8_SCHED __builtin_amdgcn_sched_barrier(0)
    Unit cur, nxt; int ui = 0;
    if (!S.next(0, cur)) return;
    f32x4 acc[2][2][4][2];
#pragma unroll
    for (int a = 0; a < 2; ++a)
#pragma unroll
        for (int b = 0; b < 2; ++b)
#pragma unroll
            for (int m = 0; m < 4; ++m)
#pragma unroll
                for (int n = 0; n < 2; ++n) acc[a][b][m][n] = (f32x4){0.f, 0.f, 0.f, 0.f};
    h16x8 At[4][2], B0[2][2], B1[2][2];
    const char* cA = S.a_base(cur); const char* cB = S.b_base(cur);
    unsigned aoc[2][2], aon[2][2];
    if constexpr (GATHER) {
#pragma unroll
        for (int h = 0; h < 2; ++h)
#pragma unroll
            for (int i = 0; i < 2; ++i) { int R, C; stage_rc(tid * 16 + i * 8192, R, C); aoc[h][i] = S.a_off(cur, h, R) + (unsigned)(C * 2); aon[h][i] = aoc[h][i]; }
    }
    PG8_STAGE_B(PG8_SB(0, 0), cB); PG8_STAGE_B(PG8_SB(0, 1), cB + hstep); PG8_STAGE_A(PG8_SA(0, 0), cA, aoc, 0, 0); PG8_STAGE_A(PG8_SA(0, 1), cA, aoc, 1, 0);
    if (wr == 1) PG8_BAR;
    PG8_WAIT_V(2); PG8_BAR;
    PG8_STAGE_B(PG8_SB(1, 0), cB + kstep); PG8_STAGE_A(PG8_SA(1, 0), cA + kstep, aoc, 0, kstep); PG8_STAGE_B(PG8_SB(1, 1), cB + hstep + kstep);
    PG8_WAIT_V(6); PG8_BAR;
    for (;;) {
        const bool has_next = S.next(ui + 1, nxt);
        const bool half1 = Sched::PARTIAL ? (cur.nv > HALF) : true;
        const char* nA = has_next ? S.a_base(nxt) : cA; const char* nB = has_next ? S.b_base(nxt) : cB;
        if constexpr (GATHER) {
#pragma unroll
            for (int h = 0; h < 2; ++h)
#pragma unroll
                for (int i = 0; i < 2; ++i) { int R, C; stage_rc(tid * 16 + i * 8192, R, C); aon[h][i] = has_next ? S.a_off(nxt, h, R) + (unsigned)(C * 2) : aoc[h][i]; }
        }
        for (int t = 0; t < nt; t += 2) {
            const bool last = (t == nt - 2);
            const char* a1 = cA + (size_t)(t + 1) * kstep;
            const char* a2 = last ? nA : cA + (size_t)(t + 2) * kstep; const char* b2 = last ? nB : cB + (size_t)(t + 2) * kstep;
            const char* a3 = a2 + kstep; const char* b3 = b2 + kstep;
            const unsigned t2off = (unsigned)((t + 2) * (int)kstep);
            PG8_LDB(B0, 0, 0); PG8_LDB(B1, 0, 1); PG8_SCHED; PG8_LDA(At, 0, 0); PG8_STAGE_A(PG8_SA(1, 1), a1, aoc, 1, (t + 1) * (int)kstep);
            PG8_WAIT_V(8); PG8_WAIT_L(0); PG8_BAR; PG8_MMA(0, 0, At, B0); PG8_MMA(0, 1, At, B1); PG8_BAR; PG8_SCHED;
            if (half1) PG8_LDA(At, 0, 1); PG8_STAGE_B(PG8_SB(0, 0), b2); PG8_STAGE_B(PG8_SB(0, 1), b2 + hstep); PG8_STAGE_A2(PG8_SA(0, 0), a2, 0, 0);
            PG8_WAIT_V(8); PG8_WAIT_L(0); PG8_BAR; if (half1) { PG8_MMA(1, 0, At, B0); PG8_MMA(1, 1, At, B1); } PG8_BAR; PG8_SCHED;
            PG8_LDB(B0, 1, 0); PG8_LDB(B1, 1, 1); PG8_SCHED; PG8_LDA(At, 1, 0); PG8_STAGE_A2(PG8_SA(0, 1), a2, 1, 0);
            PG8_WAIT_V(8); PG8_WAIT_L(0); PG8_BAR; PG8_MMA(0, 0, At, B0); PG8_MMA(0, 1, At, B1); PG8_BAR; PG8_SCHED;
            if (half1) PG8_LDA(At, 1, 1); PG8_STAGE_B(PG8_SB(1, 0), b3); PG8_STAGE_B(PG8_SB(1, 1), b3 + hstep); PG8_STAGE_A2(PG8_SA(1, 0), a3, 0, kstep);
            PG8_WAIT_V(8); PG8_WAIT_L(0); PG8_BAR; if (half1) { PG8_MMA(1, 0, At, B0); PG8_MMA(1, 1, At, B1); } PG8_BAR; PG8_SCHED;
        }
        if constexpr (ALIGN_EPI) { if (wr == 0) PG8_BAR; }
        E(acc, cur, wr, wc, fr, fq);
        if (!has_next) break;
#pragma unroll
        for (int a = 0; a < 2; ++a)
#pragma unroll
            for (int b = 0; b < 2; ++b)
#pragma unroll
                for (int m = 0; m < 4; ++m)
#pragma unroll
                    for (int n = 0; n < 2; ++n) acc[a][b][m][n] = (f32x4){0.f, 0.f, 0.f, 0.f};
        cur = nxt; cA = nA; cB = nB; ++ui;
        if constexpr (GATHER) {
#pragma unroll
            for (int h = 0; h < 2; ++h)
#pragma unroll
                for (int i = 0; i < 2; ++i) aoc[h][i] = aon[h][i];
        }
        if constexpr (ALIGN_EPI) { if (wr == 1) PG8_BAR; }
    }
    PG8_WAIT_V(0);
    if constexpr (!ALIGN_EPI) { if (wr == 0) PG8_BAR; }
    PG8_BAR;
#undef PG8_SA
#undef PG8_SB
#undef PG8_GLDS
#undef PG8_STAGE_A
#undef PG8_STAGE_A2
#undef PG8_STAGE_B
#undef PG8_LDA
#undef PG8_LDB
#undef PG8_MMA
#undef PG8_WAIT_V
#undef PG8_WAIT_L
#undef PG8_BAR
#undef PG8_SCHED
}
}
#define REGBAR16(a) asm volatile("" : "+v"(a[0]), "+v"(a[1]), "+v"(a[2]), "+v"(a[3]), "+v"(a[4]), "+v"(a[5]), "+v"(a[6]), "+v"(a[7]), "+v"(a[8]), "+v"(a[9]), "+v"(a[10]), "+v"(a[11]), "+v"(a[12]), "+v"(a[13]), "+v"(a[14]), "+v"(a[15]))
#define REGBAR8(a) asm volatile("" : "+v"(a[0]), "+v"(a[1]), "+v"(a[2]), "+v"(a[3]), "+v"(a[4]), "+v"(a[5]), "+v"(a[6]), "+v"(a[7]))
#define REGBAR4(a) asm volatile("" : "+v"(a[0]), "+v"(a[1]), "+v"(a[2]), "+v"(a[3]))
using pg8::Unit;
struct EpiProj {
    static constexpr bool PERM = true;
    const float* rstd0; const float* b_gate; h16* QK; h16* V; h16* OG; h16* UG; h16* SV; float* sssv; bool doat;
    __device__ __forceinline__ void operator()(const f32x4 (&acc)[2][2][4][2], const Unit& u, int wr, int wc, int fr, int fq) const {
        const int row0 = u.pm * 256 + wr * 64 + fr, cw = wc * 32 + 8 * fq, pn = u.pn;
        float rsv[8];
#pragma unroll
        for (int i = 0; i < 8; ++i) rsv[i] = rstd0[row0 + (i >> 2) * 128 + (i & 3) * 16];
        REGBAR8(rsv);
        if (pn < 12) {
            h16* base; int ld, col;
            if (pn < 8) { base = QK; ld = 2048; col = pn * 256; } else { base = V; ld = 1024; col = (pn - 8) * 256; }
#pragma unroll
            for (int ai = 0; ai < 2; ++ai)
#pragma unroll
                for (int m = 0; m < 4; ++m) { const int row = row0 + ai * 128 + m * 16; const float rs = rsv[ai * 4 + m]; h16* rp = base + (size_t)row * ld + col + cw;
#pragma unroll
                    for (int bj = 0; bj < 2; ++bj) *(u32x4*)(rp + bj * 128) = pk_h8(acc[ai][bj][m][0] * rs, acc[ai][bj][m][1] * rs); }
        } else if (pn < 28) {
            const bool isO = pn < 20; h16* base = isO ? OG : UG; const int c0 = (isO ? pn - 12 : pn - 20) * 128 + cw; const float* bg = b_gate + (isO ? 0 : 1024) + c0;
            const f32x4 b0 = *(const f32x4*)bg, b1 = *(const f32x4*)(bg + 4);
#pragma unroll
            for (int ai = 0; ai < 2; ++ai)
#pragma unroll
                for (int m = 0; m < 4; ++m) { const int row = row0 + ai * 128 + m * 16; const float rs = rsv[ai * 4 + m];
                    f32x4 a0 = acc[ai][0][m][0] * rs, a1 = acc[ai][0][m][1] * rs; const f32x4 g0 = acc[ai][1][m][0] * rs + b0, g1 = acc[ai][1][m][1] * rs + b1;
                    if (isO) {
#pragma unroll
                        for (int j = 0; j < 4; ++j) { a0[j] = __builtin_amdgcn_rcpf((1.f + __expf(-a0[j])) * (1.f + __expf(-g0[j]))); a1[j] = __builtin_amdgcn_rcpf((1.f + __expf(-a1[j])) * (1.f + __expf(-g1[j]))); }
                    } else {
#pragma unroll
                        for (int j = 0; j < 4; ++j) { const float u0 = 1.5957691216057308f * (a0[j] + 0.044715f * a0[j] * a0[j] * a0[j]), u1 = 1.5957691216057308f * (a1[j] + 0.044715f * a1[j] * a1[j] * a1[j]);
                            a0[j] = a0[j] * __builtin_amdgcn_rcpf((1.f + __expf(-u0)) * (1.f + __expf(-g0[j]))); a1[j] = a1[j] * __builtin_amdgcn_rcpf((1.f + __expf(-u1)) * (1.f + __expf(-g1[j]))); }
                    }
                    *(u32x4*)(base + (size_t)row * 1024 + c0) = pk_h8(a0, a1); }
        } else {
            const int col = (pn - 28) * 256 + cw;
#pragma unroll
            for (int ai = 0; ai < 2; ++ai)
#pragma unroll
                for (int m = 0; m < 4; ++m) { const int row = row0 + ai * 128 + m * 16; const float rs = rsv[ai * 4 + m]; float sum = 0.f;
#pragma unroll
                    for (int bj = 0; bj < 2; ++bj) { f32x4 a0 = acc[ai][bj][m][0] * rs, a1 = acc[ai][bj][m][1] * rs;
#pragma unroll
                        for (int j = 0; j < 4; ++j) { a0[j] = fgelu(a0[j]); a1[j] = fgelu(a1[j]); sum += a0[j] * a0[j] + a1[j] * a1[j]; }
                        *(u32x4*)(SV + (size_t)row * 1024 + col + bj * 128) = pk_h8(a0, a1); }
                    sum += __shfl_xor(sum, 16); sum += __shfl_xor(sum, 32);
                    if (fq == 0 && doat) atomicAdd(sssv + row, sum); }
        }
    }
};
struct EpiKV {
    static constexpr bool PERM = true;
    const float* rstdm; h16* KM; h16* VM;
    __device__ __forceinline__ void operator()(const f32x4 (&acc)[2][2][4][2], const Unit& u, int wr, int wc, int fr, int fq) const {
        const int row0 = u.pm * 256 + wr * 64 + fr, cw = wc * 32 + 8 * fq, pn = u.pn; h16* base = (pn < 4) ? KM + pn * 256 : VM + (pn - 4) * 256;
        float rsv[8];
#pragma unroll
        for (int i = 0; i < 8; ++i) rsv[i] = rstdm[row0 + (i >> 2) * 128 + (i & 3) * 16];
        REGBAR8(rsv);
#pragma unroll
        for (int ai = 0; ai < 2; ++ai)
#pragma unroll
            for (int m = 0; m < 4; ++m) { const int row = row0 + ai * 128 + m * 16; const float rs = rsv[ai * 4 + m];
#pragma unroll
                for (int bj = 0; bj < 2; ++bj) *(u32x4*)(base + (size_t)row * 1024 + bj * 128 + cw) = pk_h8(acc[ai][bj][m][0] * rs, acc[ai][bj][m][1] * rs); }
    }
};
template <bool RES16>
struct EpiResid {
    static constexpr bool PERM = false;
    const void* resid; h16* outh; float* ss; bool doat;
    __device__ __forceinline__ void operator()(const f32x4 (&acc)[2][2][4][2], const Unit& u, int wr, int wc, int fr, int fq) const {
        const int row0 = u.pm * 256 + wr * 64 + fr, col0 = u.pn * 256 + wc * 32 + 4 * fq;
#pragma unroll
        for (int ai = 0; ai < 2; ++ai) {
            f32x4 rv[16];
            if constexpr (RES16) { h16x4 hv[16];
#pragma unroll
                for (int m = 0; m < 4; ++m)
#pragma unroll
                    for (int bj = 0; bj < 2; ++bj)
#pragma unroll
                        for (int n = 0; n < 2; ++n) hv[m * 4 + bj * 2 + n] = *(const h16x4*)((const h16*)resid + (size_t)(row0 + ai * 128 + m * 16) * DM + col0 + bj * 128 + n * 16);
                REGBAR16(hv);
#pragma unroll
                for (int i = 0; i < 16; ++i) rv[i] = __builtin_convertvector(hv[i], f32x4);
            } else {
#pragma unroll
                for (int m = 0; m < 4; ++m)
#pragma unroll
                    for (int bj = 0; bj < 2; ++bj)
#pragma unroll
                        for (int n = 0; n < 2; ++n) rv[m * 4 + bj * 2 + n] = *(const f32x4*)((const float*)resid + (size_t)(row0 + ai * 128 + m * 16) * DM + col0 + bj * 128 + n * 16);
                REGBAR16(rv);
            }
#pragma unroll
            for (int m = 0; m < 4; ++m) { const int row = row0 + ai * 128 + m * 16; const size_t off = (size_t)row * DM + col0; float sum = 0.f;
#pragma unroll
                for (int bj = 0; bj < 2; ++bj)
#pragma unroll
                    for (int n = 0; n < 2; ++n) { const size_t o = off + bj * 128 + n * 16; const f32x4 v = rv[m * 4 + bj * 2 + n] + acc[ai][bj][m][n];
                        const h16x4 hv = __builtin_convertvector(v, h16x4); *(h16x4*)(outh + o) = hv; const f32x4 vr = __builtin_convertvector(hv, f32x4);
                        sum += (vr[0] * vr[0] + vr[1] * vr[1]) + (vr[2] * vr[2] + vr[3] * vr[3]); }
                sum += __shfl_xor(sum, 16); sum += __shfl_xor(sum, 32);
                if (fq == 0 && doat) atomicAdd(ss + row, sum); }
        }
    }
};
struct EpiQ {
    static constexpr bool PERM = true;
    const float* ss1; h16* Q;
    __device__ __forceinline__ void operator()(const f32x4 (&acc)[2][2][4][2], const Unit& u, int wr, int wc, int fr, int fq) const {
        const int row0 = u.pm * 256 + wr * 64 + fr, col0 = u.pn * 256 + wc * 32 + 8 * fq;
        float rsv[8];
#pragma unroll
        for (int i = 0; i < 8; ++i) rsv[i] = ss1[row0 + (i >> 2) * 128 + (i & 3) * 16];
        REGBAR8(rsv);
#pragma unroll
        for (int ai = 0; ai < 2; ++ai)
#pragma unroll
            for (int m = 0; m < 4; ++m) { const int row = row0 + ai * 128 + m * 16; const float rs = rsqrtf(rsv[ai * 4 + m] * (1.f / DM) + EPS) * 0.0625f;
#pragma unroll
                for (int bj = 0; bj < 2; ++bj) *(u32x4*)(Q + (size_t)row * DM + col0 + bj * 128) = pk_h8(acc[ai][bj][m][0] * rs, acc[ai][bj][m][1] * rs); }
    }
};
struct MoeOrder {
    static constexpr bool PARTIAL = true;
    const char* A; const char* Bt; int K; size_t bexp; const int* list; const unsigned* cnt; const LAS int* tab; int G, c;
    __device__ __forceinline__ bool next(int i, Unit& u) const {
        const int xcd = c & 7, slot = c >> 3, ns = G >> 3;
        int n0 = tab[xcd + 1] - tab[xcd], n1 = tab[xcd + 9] - tab[xcd + 8], n2 = tab[xcd + 17] - tab[xcd + 16], n3 = tab[xcd + 25] - tab[xcd + 24];
        const int total = 4 * (n0 + n1 + n2 + n3), F = (total / ns) * ns, R = total - F; const bool split = (R > 0) && (2 * R <= ns);
        const int L = i * ns + slot; int Lu, half = -1;
        if (L < F || !split) { if (L >= total) return false; Lu = L; }
        else { const int idx = L - F; if (idx >= 2 * R) return false; Lu = F + (idx >> 1); half = idx & 1; }
        int j = Lu >> 2, e = xcd;
        if (j >= n0) { j -= n0; e += 8; if (j >= n1) { j -= n1; e += 8; if (j >= n2) { j -= n2; e += 8; } } }
        const int rb = j; u.pm = tab[e] + rb; u.pn = Lu & 3; u.e = e; u.rb = rb; const int left = (int)__hip_atomic_load(cnt + e * 64, __ATOMIC_RELAXED, __HIP_MEMORY_SCOPE_AGENT) - rb * 256;
        const int nvf = left < 256 ? left : 256;
        if (half < 0) { u.roff = 0; u.nr = 256; u.nv = nvf; } else { u.roff = 128 * half; u.nr = 128; const int v = nvf - u.roff; u.nv = v < 0 ? 0 : (v > 128 ? 128 : v); }
        return true;
    }
    __device__ __forceinline__ const char* a_base(const Unit& u) const { return A + (size_t)(u.pm * 256 + u.roff) * (size_t)(2 * K); }
    __device__ __forceinline__ const char* b_base(const Unit& u) const { return Bt + (size_t)u.e * bexp + (size_t)u.pn * (size_t)(256 * 2) * K; }
    __device__ __forceinline__ const char* g_base() const { return A; }
    __device__ __forceinline__ unsigned a_off(const Unit& u, int h, int R) const { const int r = h * 128 + R; const int tok = (r < u.nv) ? (list[u.e * NTOK + u.rb * 256 + u.roff + r] >> 1) : 0; return (unsigned)tok * (unsigned)(K * 2); }
};
struct EpiFfn1 {
    static constexpr bool PERM = true;
    const int* list; const float* ss2; h16* H;
    __device__ __forceinline__ void operator()(const f32x4 (&acc)[2][2][4][2], const Unit& u, int wr, int wc, int fr, int fq) const {
        const int r0 = wr * 64 + fr, cw = wc * 32 + 8 * fq;
        int tokv[8]; float rsv[8];
#pragma unroll
        for (int i = 0; i < 8; ++i) { const int r = r0 + (i >> 2) * 128 + (i & 3) * 16; tokv[i] = list[u.e * NTOK + u.rb * 256 + u.roff + (r < u.nv ? r : 0)]; }
        REGBAR8(tokv);
#pragma unroll
        for (int i = 0; i < 8; ++i) { const int r = r0 + (i >> 2) * 128 + (i & 3) * 16; rsv[i] = ss2[(r < u.nv) ? (tokv[i] >> 1) : 0]; }
        REGBAR8(rsv);
#pragma unroll
        for (int ai = 0; ai < 2; ++ai)
#pragma unroll
            for (int m = 0; m < 4; ++m) { const int r = r0 + ai * 128 + m * 16;
                const float rs = rsqrtf(rsv[ai * 4 + m] * (1.f / DM) + EPS);
                f32x4 a0 = acc[ai][0][m][0] * rs, a1 = acc[ai][0][m][1] * rs; const f32x4 b0 = acc[ai][1][m][0] * rs, b1 = acc[ai][1][m][1] * rs;
#pragma unroll
                for (int j = 0; j < 4; ++j) { a0[j] = fsilu(a0[j]) * b0[j]; a1[j] = fsilu(a1[j]) * b1[j]; }
                if (r < u.nr) *(u32x4*)(H + ((size_t)u.pm * 256 + u.roff + r) * FF + u.pn * 128 + cw) = pk_h8(a0, a1); }
    }
};
struct EpiFfn2 {
    static constexpr bool PERM = true;
    const int* list; const float* gate; h16* Y;
    __device__ __forceinline__ void operator()(const f32x4 (&acc)[2][2][4][2], const Unit& u, int wr, int wc, int fr, int fq) const {
        const int r0 = wr * 64 + fr, cw = u.pn * 256 + wc * 32 + 8 * fq;
        int slv[8]; float gv[8];
#pragma unroll
        for (int i = 0; i < 8; ++i) { const int r = r0 + (i >> 2) * 128 + (i & 3) * 16; slv[i] = list[u.e * NTOK + u.rb * 256 + u.roff + (r < u.nv ? r : 0)]; }
        REGBAR8(slv);
#pragma unroll
        for (int i = 0; i < 8; ++i) { const int r = r0 + (i >> 2) * 128 + (i & 3) * 16; gv[i] = gate[(r < u.nv) ? slv[i] : 0]; }
        REGBAR8(gv);
#pragma unroll
        for (int ai = 0; ai < 2; ++ai)
#pragma unroll
            for (int m = 0; m < 4; ++m) { const int r = r0 + ai * 128 + m * 16;
                if (r < u.nv) { const int slot = slv[ai * 4 + m]; const float g = gv[ai * 4 + m];
#pragma unroll
                    for (int bj = 0; bj < 2; ++bj) *(u32x4*)(Y + (size_t)slot * DM + cw + bj * 128) = pk_h8(acc[ai][bj][m][0] * g, acc[ai][bj][m][1] * g); } }
    }
};


typedef short s16x4 __attribute__((ext_vector_type(4)));
__device__ __forceinline__ h16x4 tr_read4(const LAS unsigned char* p) { return __builtin_bit_cast(h16x4, __builtin_amdgcn_ds_read_tr16_b64_v4i16((LAS s16x4*)p)); }
__device__ __forceinline__ h16x8 cat8(h16x4 a, h16x4 b) { return __builtin_shufflevector(a, b, 0, 1, 2, 3, 4, 5, 6, 7); }
__device__ __forceinline__ h16x4 cvt4(f32x4 v) { return __builtin_convertvector(v, h16x4); }
__device__ __forceinline__ void glds16_asm(const void* gsrc, unsigned lds_dst) { unsigned keep;
    asm volatile("s_mov_b32 %0, m0\n\ts_mov_b32 m0, %2\n\ts_nop 0\n\tglobal_load_lds_dwordx4 %1, off\n\ts_mov_b32 m0, %0" : "=&s"(keep) : "v"(gsrc), "s"(lds_dst) : "memory"); }
#define GLDS16(src, dst) glds16_asm((const void*)(src), __builtin_amdgcn_readfirstlane((unsigned)(size_t)(dst)))
constexpr int ATT_UNITS = 512, ATT_CH = 32768;
__device__ __forceinline__ void attn_issue(LAS unsigned char* lds, const h16* KM, const h16* VM, int c, int G, int bx, int wid, int lane, int fh, int ft0) {
    const int i = c >> 3, n = c & 7, L = i * G + bx, hd = (fh >= 0) ? fh : (L & 3), tile = (fh >= 0) ? ft0 + i : (L >> 2), b = tile >> 6;
    LAS unsigned char* buf = lds + (unsigned)(c & 3) * ATT_CH;
    if (n < 4) { const char* Kb = (const char*)(KM + (size_t)(b * 256) * 1024 + hd * 256) + n * 128;
#pragma unroll
        for (int q = 0; q < 4; ++q) { const int I = wid * 4 + q, row = I * 8 + (lane >> 3), slot = (lane & 7) ^ ((row >> 1) & 7); GLDS16(Kb + (size_t)row * 2048 + slot * 16, buf + I * 1024); }
    } else { const char* Vb = (const char*)(VM + (size_t)(b * 256 + 64 * (n - 4)) * 1024 + hd * 256);
#pragma unroll
        for (int q = 0; q < 4; ++q) { const int I = wid * 4 + q, row = I * 2 + (lane >> 5), ch = (lane & 31) ^ ((row & 7) << 1); GLDS16(Vb + (size_t)row * 2048 + ch * 16, buf + I * 1024); }
    }
}
__device__ __forceinline__ void attn_phase(LAS unsigned char* lds, const h16* Q, const h16* KM, const h16* VM, h16* ATT, int G, int bx, int fh, int ft0) {
    int tid = threadIdx.x; asm volatile("" : "+v"(tid));
    const int wid = __builtin_amdgcn_readfirstlane(tid >> 6), lane = tid & 63, fr = lane & 15, fq = lane >> 4;
    if (fh < 0 && bx >= ATT_UNITS) return;
    const int nun = (fh >= 0) ? 2 : (ATT_UNITS - bx + G - 1) / G, total = nun * 8;
    attn_issue(lds, KM, VM, 0, G, bx, wid, lane, fh, ft0); attn_issue(lds, KM, VM, 1, G, bx, wid, lane, fh, ft0); attn_issue(lds, KM, VM, 2, G, bx, wid, lane, fh, ft0);
    const int tq = (lane & 15) >> 2, tp = lane & 3;
    for (int i = 0; i < nun; ++i) {
        const int L = i * G + bx, hd = (fh >= 0) ? fh : (L & 3), tile = (fh >= 0) ? ft0 + i : (L >> 2); const int trow = tile * 128 + wid * 16 + fr;
        f32x4 S[16]; h16x8 qf[8], pf[8]; f32x4 O[16]; float linv = 0.f;
#pragma unroll
        for (int kt = 0; kt < 16; ++kt) S[kt] = (f32x4){0.f, 0.f, 0.f, 0.f};
#pragma unroll
        for (int n = 0; n < 8; ++n) {
            const int c = i * 8 + n;
            if (c + 2 < total) asm volatile("s_waitcnt vmcnt(8)" ::: "memory"); else asm volatile("s_waitcnt vmcnt(0)" ::: "memory");
            __builtin_amdgcn_s_barrier(); asm volatile("" ::: "memory");
            if (n == 0) {
#pragma unroll
                for (int st = 0; st < 8; ++st) qf[st] = *(const h16x8*)(Q + (size_t)trow * 1024 + hd * 256 + 32 * st + 8 * fq);
            }
            if (c + 3 < total) attn_issue(lds, KM, VM, c + 3, G, bx, wid, lane, fh, ft0);
            const LAS unsigned char* buf = lds + (unsigned)(c & 3) * ATT_CH;
            if (n < 4) {
#pragma unroll
                for (int k4 = 0; k4 < 4; ++k4) { h16x8 bf[8];
#pragma unroll
                    for (int i = 0; i < 8; ++i) { const int kt = 4 * k4 + (i >> 1), ks = i & 1, key = kt * 16 + fr, slot = 4 * ks + fq; bf[i] = *(const LAS h16x8*)(buf + key * 128 + ((slot ^ ((key >> 1) & 7)) * 16)); }
                    REGBAR8(bf);
#pragma unroll
                    for (int i = 0; i < 8; ++i) { const int kt = 4 * k4 + (i >> 1), ks = i & 1; S[kt] = __builtin_amdgcn_mfma_f32_16x16x32_f16(bf[i], qf[2 * n + ks], S[kt], 0, 0, 0); } }
                if (n == 3) {
                    float mx = -INFINITY;
#pragma unroll
                    for (int kt = 0; kt < 16; ++kt)
#pragma unroll
                        for (int j = 0; j < 4; ++j) mx = fmaxf(mx, S[kt][j]);
                    mx = fmaxf(mx, __shfl_xor(mx, 16)); mx = fmaxf(mx, __shfl_xor(mx, 32));
                    float l = 0.f;
#pragma unroll
                    for (int kt = 0; kt < 16; ++kt)
#pragma unroll
                        for (int j = 0; j < 4; ++j) { const float e = __expf(S[kt][j] - mx); S[kt][j] = e; l += e; }
                    l += __shfl_xor(l, 16); l += __shfl_xor(l, 32); linv = 1.f / l;
#pragma unroll
                    for (int st = 0; st < 8; ++st) pf[st] = cat8(cvt4(S[2 * st]), cvt4(S[2 * st + 1]));
                }
            } else {
                if (n == 4) {
#pragma unroll
                    for (int dt = 0; dt < 16; ++dt) O[dt] = (f32x4){0.f, 0.f, 0.f, 0.f};
                }
#pragma unroll
                for (int ks = 0; ks < 2; ++ks) { const int r0 = 32 * ks + 4 * fq + tq, r1 = r0 + 16;
#pragma unroll
                    for (int d8 = 0; d8 < 2; ++d8) { h16x8 vf[8];
#pragma unroll
                        for (int i = 0; i < 8; ++i) { const int dt = 8 * d8 + i;
                            vf[i] = cat8(tr_read4(buf + r0 * 512 + (((2 * dt + (tp >> 1)) ^ ((r0 & 7) << 1)) * 16) + (tp & 1) * 8), tr_read4(buf + r1 * 512 + (((2 * dt + (tp >> 1)) ^ ((r1 & 7) << 1)) * 16) + (tp & 1) * 8)); }
                        REGBAR8(vf);
#pragma unroll
                        for (int i = 0; i < 8; ++i) O[8 * d8 + i] = __builtin_amdgcn_mfma_f32_16x16x32_f16(vf[i], pf[2 * (n - 4) + ks], O[8 * d8 + i], 0, 0, 0); } }
                if (n == 7) {
#pragma unroll
                    for (int dt = 0; dt < 16; ++dt) { const f32x4 o = O[dt] * linv; u32x2 w; w.x = pk_h2(o[0], o[1]); w.y = pk_h2(o[2], o[3]);
                        *(u32x2*)(ATT + (size_t)trow * 1024 + hd * 256 + 16 * dt + 4 * fq) = w; }
                }
            }
        }
    }
    asm volatile("s_waitcnt vmcnt(0)" ::: "memory"); __builtin_amdgcn_s_barrier();
}


__device__ __forceinline__ void mstate_ext(unsigned char* ws, int bh, int wave, int lane, LAS float* scr) {
    const float* ig = (const float*)(ws + OFF_IG); const float* lf = (const float*)(ws + OFF_LF);
    const int b = bh >> 2, h = bh & 3, tb = b * SEQ + lane * CHUNK + 16 * wave;
    float lv[16], iv[16];
#pragma unroll
    for (int s = 0; s < 16; ++s) { lv[s] = lf[(tb + s) * 4 + h]; iv[s] = ig[(tb + s) * 4 + h]; }
    float B = 0.f, mx = -INFINITY;
#pragma unroll
    for (int s = 0; s < 16; ++s) { B += lv[s]; mx = fmaxf(mx, iv[s] - B); }
    scr[wave * 64 + lane] = B; scr[512 + wave * 64 + lane] = mx;
    __syncthreads();
    float bpre = 0.f, rmpre = -INFINITY, btot = 0.f, mtot = -INFINITY;
#pragma unroll
    for (int w = 0; w < 8; ++w) { const float bw = scr[w * 64 + lane], mw = scr[512 + w * 64 + lane];
        if (w == wave) { bpre = btot; rmpre = mtot; }
        mtot = fmaxf(mtot, mw - btot); btot += bw; }
    const float blast = btot, maxw = btot + mtot;
    float fb = blast, fm = maxw;
#pragma unroll
    for (int d = 1; d < 64; d <<= 1) { const float pb = __shfl_up(fb, d), pm = __shfl_up(fm, d); if (lane >= d) { fm = fmaxf(fb + pm, fm); fb = fb + pb; } }
    const float mn = fmaxf(fb, fm);
    float mc = __shfl_up(mn, 1); if (lane == 0) mc = 0.f;
    if (wave == 0) { ((float*)(ws + OFF_MST))[bh * 64 + lane] = mc; ((float*)(ws + OFF_DEC))[bh * 64 + lane] = __expf(blast + mc - mn); }
    float* AL = (float*)(ws + OFF_AL); float* BE = (float*)(ws + OFF_BE); float* NM = (float*)(ws + OFF_NM); float* WU = (float*)(ws + OFF_WU);
    B = bpre; float rm = rmpre;
#pragma unroll
    for (int s = 0; s < 16; ++s) { const int t = tb + s; B += lv[s]; rm = fmaxf(rm, iv[s] - B); const float mt = B + fmaxf(mc, rm);
        AL[t * 4 + h] = B - mt; BE[t * 4 + h] = iv[s] - B; NM[t * 4 + h] = -mt; WU[t * 4 + h] = __expf(iv[s] - B + blast - mn); }
    __syncthreads();
}

__device__ __forceinline__ int swz128(int row) { return (((row >> 1) & 1) | (((row >> 3) & 1) << 1)) << 1; }
__device__ __forceinline__ void scan_task(LAS unsigned char* lds, const Ptrs& p, unsigned char* ws, int task) {
    int tid = threadIdx.x; asm volatile("" : "+v"(tid));
    const int wid = __builtin_amdgcn_readfirstlane(tid >> 6), lane = tid & 63, fr = lane & 15, fq = lane >> 4;
    const int bh = task >> 4, et = (task >> 2) & 3, dtb = task & 3, b = bh >> 2, hd = bh & 3, e0 = et * 64, d0 = dtb * 64;
    const int cg = tid & 7, rp = tid >> 3, kcol = 1024 + hd * 256 + d0 + 8 * cg;
    h16x8 cwh[4], cbh;
#pragma unroll
    for (int j = 0; j < 4; ++j) cwh[j] = cat8(cvt4(*(const f32x4*)(p.conv_w + j * 2048 + kcol)), cvt4(*(const f32x4*)(p.conv_w + j * 2048 + kcol + 4)));
    cbh = cat8(cvt4(*(const f32x4*)(p.conv_b + kcol)), cvt4(*(const f32x4*)(p.conv_b + kcol + 4)));
    const h16* QK = (const h16*)p.out; const float* WU = (const float*)(ws + OFF_WU); const float* DEC = (const float*)(ws + OFF_DEC) + bh * 64;
    const h16* Vg = (const h16*)(ws + WS_V);
    h16* CST = (h16*)(ws + WS_CST) + (size_t)bh * 64 * CSTRIDE;
    const int dti = wid & 3, ep = wid >> 2; const bool doN = (et == 0) && (ep == 0);
    const int tq = (lane & 15) >> 2, tp = lane & 3;
    u32x4 raw[3][5]; float wu[3][2]; float dcv[3];
    f32x4 acc[2] = {(f32x4){0.f, 0.f, 0.f, 0.f}, (f32x4){0.f, 0.f, 0.f, 0.f}}; f32x4 nacc = (f32x4){0.f, 0.f, 0.f, 0.f};
    const h16x8 ones = {(h16)1.f, (h16)1.f, (h16)1.f, (h16)1.f, (h16)1.f, (h16)1.f, (h16)1.f, (h16)1.f};
#define SCAN_LOAD(c_, set_) do { const int t0_ = b * SEQ + (c_) * CHUNK; \
        _Pragma("unroll") for (int q = 0; q < 2; ++q) { const int I = wid * 2 + q, row = I * 8 + (lane >> 3), ch = (lane & 7) ^ swz128(row); \
            GLDS16((const char*)(Vg + (size_t)(t0_ + row) * 1024 + hd * 256 + e0) + ch * 16, lds + 32768 + ((c_) & 3) * 16384 + I * 1024); } \
        _Pragma("unroll") for (int k = 0; k < 5; ++k) { int tl = (c_) * CHUNK + 2 * rp - 3 + k; tl = tl < 0 ? 0 : tl; raw[set_][k] = *(const u32x4*)(QK + (size_t)(b * SEQ + tl) * 2048 + kcol); } \
        wu[set_][0] = WU[(t0_ + 2 * rp) * 4 + hd]; wu[set_][1] = WU[(t0_ + 2 * rp + 1) * 4 + hd]; dcv[set_] = DEC[c_]; } while (0)
#define SCAN_STORE(c_) do { \
        _Pragma("unroll") for (int j = 0; j < 2; ++j) { u32x2 w; w.x = pk_h2(acc[j][0], acc[j][1]); w.y = pk_h2(acc[j][2], acc[j][3]); \
            *(u32x2*)(CST + (size_t)(c_) * CSTRIDE + (size_t)(e0 + 16 * (2 * ep + j) + fr) * 256 + d0 + 16 * dti + 4 * fq) = w; } \
        if (doN && fr == 0) { u32x2 w; w.x = pk_h2(nacc[0], nacc[1]); w.y = pk_h2(nacc[2], nacc[3]); *(u32x2*)(CST + (size_t)(c_) * CSTRIDE + 65536 + d0 + 16 * dti + 4 * fq) = w; } } while (0)
#define SCAN_STEP(c_, set_) do { const int c = (c_); \
        SCAN_STORE(c); \
        LAS unsigned char* kb = lds + (c & 1) * 16384; LAS unsigned char* vb = lds + 32768 + (c & 3) * 16384; \
        if (c == 0) { _Pragma("unroll") for (int k = 0; k < 3; ++k) if (2 * rp - 3 + k < 0) raw[set_][k] = (u32x4){0u, 0u, 0u, 0u}; } \
        _Pragma("unroll") for (int rr = 0; rr < 2; ++rr) { h16x8 yh = cbh; \
            _Pragma("unroll") for (int j = 0; j < 4; ++j) yh += cwh[j] * __builtin_bit_cast(h16x8, raw[set_][rr + j]); \
            f32x4 y0 = {(float)yh[0], (float)yh[1], (float)yh[2], (float)yh[3]}, y1 = {(float)yh[4], (float)yh[5], (float)yh[6], (float)yh[7]}; \
            const float sc = 0.0625f * wu[set_][rr]; \
            _Pragma("unroll") for (int q = 0; q < 4; ++q) { y0[q] = fsilu(y0[q]) * sc; y1[q] = fsilu(y1[q]) * sc; } \
            const int row = 2 * rp + rr; *(LAS u32x4*)(kb + row * 128 + ((cg ^ swz128(row)) * 16)) = pk_h8(y0, y1); } \
        asm volatile("s_waitcnt lgkmcnt(0)" ::: "memory"); __builtin_amdgcn_s_barrier(); asm volatile("" ::: "memory"); \
        const float dec = dcv[set_]; \
        if (c + 3 < NCHUNK - 1) SCAN_LOAD(c + 3, set_); \
        acc[0] *= dec; acc[1] *= dec; nacc *= dec; \
        { h16x8 X[4], Y0[4], Y1[4]; \
        _Pragma("unroll") for (int ks = 0; ks < 4; ++ks) { const int r0 = 32 * ks + 8 * fq + tq, r1 = r0 + 4; \
            const int o0 = r0 * 128 + (tp & 1) * 8, o1 = r1 * 128 + (tp & 1) * 8, s0 = swz128(r0), s1 = swz128(r1), cx = 2 * dti + (tp >> 1), cy0 = 2 * (2 * ep) + (tp >> 1), cy1 = cy0 + 2; \
            X[ks] = cat8(tr_read4(kb + o0 + ((cx ^ s0) * 16)), tr_read4(kb + o1 + ((cx ^ s1) * 16))); \
            Y0[ks] = cat8(tr_read4(vb + o0 + ((cy0 ^ s0) * 16)), tr_read4(vb + o1 + ((cy0 ^ s1) * 16))); \
            Y1[ks] = cat8(tr_read4(vb + o0 + ((cy1 ^ s0) * 16)), tr_read4(vb + o1 + ((cy1 ^ s1) * 16))); } \
        REGBAR4(X); REGBAR4(Y0); REGBAR4(Y1); \
        _Pragma("unroll") for (int ks = 0; ks < 4; ++ks) { \
            acc[0] = __builtin_amdgcn_mfma_f32_16x16x32_f16(X[ks], Y0[ks], acc[0], 0, 0, 0); acc[1] = __builtin_amdgcn_mfma_f32_16x16x32_f16(X[ks], Y1[ks], acc[1], 0, 0, 0); \
            if (doN) nacc = __builtin_amdgcn_mfma_f32_16x16x32_f16(X[ks], ones, nacc, 0, 0, 0); } } } while (0)
    SCAN_LOAD(0, 0); SCAN_LOAD(1, 1); SCAN_LOAD(2, 2);
#pragma unroll 1
    for (int c3 = 0; c3 < NCHUNK - 1; c3 += 3) { SCAN_STEP(c3, 0); SCAN_STEP(c3 + 1, 1); SCAN_STEP(c3 + 2, 2); }
    SCAN_STORE(NCHUNK - 1);
#undef SCAN_STEP
#undef SCAN_STORE
#undef SCAN_LOAD
    asm volatile("s_waitcnt vmcnt(0) lgkmcnt(0)" ::: "memory"); __builtin_amdgcn_s_barrier();
}

__device__ __forceinline__ int swz256(int row) { return ((row & 3) + 4 * ((row >> 3) & 1)) << 1; }
#ifdef TIME_SGSUB
#define SGCK(k_) do { if ((k_) == TIME_SGSUB && task == 0 && g == 1 && threadIdx.x == 0) { const unsigned long long dt = (__builtin_amdgcn_s_memrealtime() - tsg_) * 10ull, t0_ = __builtin_amdgcn_s_memrealtime(); while (__builtin_amdgcn_s_memrealtime() - t0_ < dt) __builtin_amdgcn_s_sleep(8); } } while (0)
#define SGT0() if (g == 1) tsg_ = __builtin_amdgcn_s_memrealtime()
#else
#define SGCK(k_) do { } while (0)
#define SGT0() do { } while (0)
#endif
__device__ __forceinline__ void sgu_task(LAS unsigned char* lds, const Ptrs& p, unsigned char* ws, int task) {
    unsigned long long tsg_ = 0ull; (void)tsg_;
    int tid = threadIdx.x; asm volatile("" : "+v"(tid));
    const int wid = __builtin_amdgcn_readfirstlane(tid >> 6), lane = tid & 63, fr = lane & 15, fq = lane >> 4;
    const int t0 = task * CHUNK;
    LAS unsigned char* wb = lds; LAS unsigned char* vb = lds + 32768; LAS float* rs = (LAS float*)(lds + 65536);
    const float* ss = (const float*)(ws + OFF_SSSV); const h16* SV = (const h16*)(ws + WS_SV); const h16* UG = (const h16*)(ws + WS_UG); h16* Z = (h16*)(ws + WS_XH);
    LAS float* gsl = rs + 128; LAS float* bsl = gsl + 1024;
    if (tid < CHUNK) rs[tid] = rsqrtf(ss[t0 + tid] * (1.f / DM) + EPS);
    { const f32x4 gv_ = *(const f32x4*)(p.sgu_norm_g + 4 * (tid & 255)), bv_ = *(const f32x4*)(p.b_s + 4 * (tid & 255)); if (tid < 256) { *(LAS f32x4*)(gsl + 4 * tid) = gv_; *(LAS f32x4*)(bsl + 4 * tid) = bv_; } }
    __syncthreads();
    const int lrow = tid >> 2, lq = tid & 3, tq = (lane & 15) >> 2, tp = lane & 3, trow = 16 * wid + fr;
    f32x4 wraw[8]; h16x8 vraw[4]; h16x4 urn[8];
#define SGU_LOAD(g_) do { const float* wsrc = p.w_s + (size_t)((g_) * 128 + lrow) * 128 + 32 * lq; const h16* vsrc = SV + (size_t)(t0 + lrow) * 1024 + (g_) * 128 + 32 * lq; \
        _Pragma("unroll") for (int i = 0; i < 8; ++i) wraw[i] = *(const f32x4*)(wsrc + 4 * i); \
        _Pragma("unroll") for (int i = 0; i < 4; ++i) vraw[i] = *(const h16x8*)(vsrc + 8 * i); \
        _Pragma("unroll") for (int hb = 0; hb < 2; ++hb) { const int tr_ = 16 * (hb ? 7 - wid : wid) + fr; const size_t ro_ = (size_t)(t0 + tr_) * 1024 + (g_) * 128 + 4 * fq; \
            _Pragma("unroll") for (int d4 = 0; d4 < 4; ++d4) urn[4 * hb + d4] = *(const h16x4*)(UG + ro_ + 16 * (4 * hb + d4)); } } while (0)
    SGU_LOAD(0);
#pragma unroll 1
    for (int g = 0; g < 8; ++g) {
        SGT0();
        {
            const float r = rs[lrow];
#pragma unroll
            for (int i = 0; i < 4; ++i) { f32x4 a = wraw[2 * i], c = wraw[2 * i + 1];
#pragma unroll
                for (int q = 0; q < 4; ++q) { if (32 * lq + 8 * i + q > lrow) a[q] = 0.f; if (32 * lq + 8 * i + 4 + q > lrow) c[q] = 0.f; }
                *(LAS u32x4*)(wb + lrow * 256 + (((4 * lq + i) ^ (lrow & 15)) * 16)) = pk_h8(a, c); }
#pragma unroll
            for (int i = 0; i < 4; ++i) { const h16x8 v = vraw[i]; f32x4 a, c;
#pragma unroll
                for (int q = 0; q < 4; ++q) { a[q] = (float)v[q] * r; c[q] = (float)v[4 + q] * r; }
                *(LAS u32x4*)(vb + lrow * 256 + (((4 * lq + i) ^ swz256(lrow)) * 16)) = pk_h8(a, c); }
        }
        SGCK(1);
        __syncthreads();
        SGCK(2);
        h16x4 ur[8];
#pragma unroll
        for (int i = 0; i < 8; ++i) ur[i] = urn[i];
        if (g + 1 < 8) SGU_LOAD(g + 1);
        f32x4 acc[8]; f32x4 gq[8]; float bias[2];
#pragma unroll
        for (int hb = 0; hb < 2; ++hb) { const int rt = hb ? 7 - wid : wid, tr = 16 * rt + fr; bias[hb] = bsl[g * 128 + tr];
#pragma unroll
            for (int d4 = 0; d4 < 4; ++d4) { const int dt = 4 * hb + d4; gq[dt] = *(const LAS f32x4*)(gsl + g * 128 + 16 * dt + 4 * fq); acc[dt] = (f32x4){0.f, 0.f, 0.f, 0.f}; } }
#pragma unroll
        for (int hb = 0; hb < 2; ++hb) { const int rt = hb ? 7 - wid : wid, tr = 16 * rt + fr, nks = (rt >> 1) + 1;
            for (int ks = 0; ks < nks; ++ks) {
                const h16x8 Y = *(const LAS h16x8*)(wb + tr * 256 + (((4 * ks + fq) ^ (tr & 15)) * 16));
                const int r0 = 32 * ks + 8 * fq + tq, r1 = r0 + 4, o0 = r0 * 256 + (tp & 1) * 8, o1 = r1 * 256 + (tp & 1) * 8, s0 = swz256(r0), s1 = swz256(r1);
                h16x8 X[4];
#pragma unroll
                for (int d4 = 0; d4 < 4; ++d4) { const int cx = 2 * (4 * hb + d4) + (tp >> 1); X[d4] = cat8(tr_read4(vb + o0 + ((cx ^ s0) * 16)), tr_read4(vb + o1 + ((cx ^ s1) * 16))); }
                REGBAR4(X);
#pragma unroll
                for (int d4 = 0; d4 < 4; ++d4) acc[4 * hb + d4] = __builtin_amdgcn_mfma_f32_16x16x32_f16(X[d4], Y, acc[4 * hb + d4], 0, 0, 0);
            } }
        SGCK(3);
#pragma unroll
        for (int hb = 0; hb < 2; ++hb) { const int rt = hb ? 7 - wid : wid, tr = 16 * rt + fr; const size_t ro = (size_t)(t0 + tr) * 1024 + g * 128 + 4 * fq; const float bs = bias[hb];
#pragma unroll
            for (int d4 = 0; d4 < 4; ++d4) { const int dt = 4 * hb + d4; const h16x4 u = ur[dt]; u32x2 w;
                w.x = pk_h2((float)u[0] * (acc[dt][0] * gq[dt][0] + bs), (float)u[1] * (acc[dt][1] * gq[dt][1] + bs)); w.y = pk_h2((float)u[2] * (acc[dt][2] * gq[dt][2] + bs), (float)u[3] * (acc[dt][3] * gq[dt][3] + bs));
                *(u32x2*)(Z + ro + 16 * dt) = w; } }
        SGCK(4);
        __syncthreads();
        SGCK(5);
    }
#undef SGU_LOAD
}


__device__ __forceinline__ void kv_task(LAS unsigned char* lds, const Ptrs& p, unsigned char* ws, int task) {
    int tid = threadIdx.x; asm volatile("" : "+v"(tid));
    const int wid = __builtin_amdgcn_readfirstlane(tid >> 6), lane = tid & 63, fr = lane & 15, fq = lane >> 4, tq = (lane & 15) >> 2, tp = lane & 3;
    const int r0 = 64 * (task >> 5), c0 = 64 * (task & 31);
    const int arow = tid >> 3, akq = tid & 7, bk = tid >> 4, bn4 = tid & 15;
    LAS unsigned char* ab = lds; LAS unsigned char* bb = lds + 16384; LAS float* rsd = (LAS float*)(lds + 32768);
    const float* Ag = p.mem + (size_t)(r0 + arow) * DM + 4 * akq; const float* Bg = p.w_xkv + (size_t)bk * 2048 + c0 + 4 * bn4; const float* Gg = p.norm_mem_g + 4 * akq;
    f32x4 av[4], bv[4], gv[4]; float ssq = 0.f;
#define KV_LOAD(kc_) do { _Pragma("unroll") for (int i = 0; i < 4; ++i) { av[i] = *(const f32x4*)(Ag + (kc_) * 128 + 32 * i); gv[i] = *(const f32x4*)(Gg + (kc_) * 128 + 32 * i); bv[i] = *(const f32x4*)(Bg + (size_t)((kc_) * 128 + 32 * i) * 2048); } } while (0)
    KV_LOAD(0);
    const int ntile = wid & 3, rt2 = wid >> 2;
    f32x4 acc[2] = {(f32x4){0.f, 0.f, 0.f, 0.f}, (f32x4){0.f, 0.f, 0.f, 0.f}};
    __syncthreads();
#pragma unroll 1
    for (int kc = 0; kc < 8; ++kc) {
#pragma unroll
        for (int i = 0; i < 4; ++i) { const f32x4 a = av[i]; ssq += (a[0] * a[0] + a[1] * a[1]) + (a[2] * a[2] + a[3] * a[3]); const f32x4 ag = a * gv[i];
            u32x2 w; w.x = pk_h2(ag[0], ag[1]); w.y = pk_h2(ag[2], ag[3]); const int kk = 4 * akq + 32 * i;
            *(LAS u32x2*)(ab + arow * 256 + (((kk >> 3) ^ (arow & 15)) * 16) + ((kk >> 2) & 1) * 8) = w;
            const f32x4 b = bv[i]; u32x2 wb; wb.x = pk_h2(b[0], b[1]); wb.y = pk_h2(b[2], b[3]); const int brow = bk + 32 * i;
            *(LAS u32x2*)(bb + brow * 128 + (((bn4 >> 1) ^ swz128(brow)) * 16) + (bn4 & 1) * 8) = wb; }
        __syncthreads();
        if (kc + 1 < 8) KV_LOAD(kc + 1);
#pragma unroll
        for (int ks = 0; ks < 4; ++ks) { const int q0 = 32 * ks + 8 * fq + tq, q1 = q0 + 4, cx = 2 * ntile + (tp >> 1);
            const h16x8 X = cat8(tr_read4(bb + q0 * 128 + ((cx ^ swz128(q0)) * 16) + (tp & 1) * 8), tr_read4(bb + q1 * 128 + ((cx ^ swz128(q1)) * 16) + (tp & 1) * 8));
#pragma unroll
            for (int j = 0; j < 2; ++j) { const int row = 16 * (2 * rt2 + j) + fr; const h16x8 Y = *(const LAS h16x8*)(ab + row * 256 + (((4 * ks + fq) ^ (row & 15)) * 16));
                acc[j] = __builtin_amdgcn_mfma_f32_16x16x32_f16(X, Y, acc[j], 0, 0, 0); } }
        __syncthreads();
    }
#undef KV_LOAD
    ssq += __shfl_xor(ssq, 1); ssq += __shfl_xor(ssq, 2); ssq += __shfl_xor(ssq, 4);
    if (akq == 0) rsd[arow] = rsqrtf(ssq * (1.f / DM) + EPS);
    __syncthreads();
    h16* dst = (c0 < 1024) ? (h16*)(ws + WS_KM) + c0 : (h16*)(ws + WS_VTM) + (c0 - 1024);
#pragma unroll
    for (int j = 0; j < 2; ++j) { const int row = 16 * (2 * rt2 + j) + fr; const float rs = rsd[row]; u32x2 w; w.x = pk_h2(acc[j][0] * rs, acc[j][1] * rs); w.y = pk_h2(acc[j][2] * rs, acc[j][3] * rs);
        *(u32x2*)(dst + (size_t)(r0 + row) * 1024 + 16 * ntile + 4 * fq) = w; }
    __syncthreads();
}

__device__ __forceinline__ int swzb(int row) { return (row >> 1) & 7; }
#ifdef TIME_P3SUB
#define P3CK(k_) do { if ((k_) == TIME_P3SUB && bx == 0 && L == bx && threadIdx.x == 0) { const unsigned long long dt = (__builtin_amdgcn_s_memrealtime() - t3s_) * 10ull, t0_ = __builtin_amdgcn_s_memrealtime(); while (__builtin_amdgcn_s_memrealtime() - t0_ < dt) __builtin_amdgcn_s_sleep(8); } } while (0)
#else
#define P3CK(k_) do { } while (0)
#endif
__device__ __forceinline__ void mout_phase(LAS unsigned char* lds, const Ptrs& p, unsigned char* ws, int G, int bx, h16* Zdst) {
#ifdef TIME_P3SUB
    const unsigned long long t3s_ = __builtin_amdgcn_s_memrealtime();
#endif
    const int wid = __builtin_amdgcn_readfirstlane(threadIdx.x >> 6);
    constexpr int QB = 0, KB = 16384, CB0 = 32768, CBS = 34816, WB = 102400, VHI = 67584 - 64 * 512, SM = LDSCTL_OFF + 2048;
    const h16* QK = (const h16*)p.out; const h16* Vg = (const h16*)(ws + WS_V); const h16* OG = (const h16*)(ws + WS_OG); h16* Z = (h16*)(ws + WS_XH);
    const float* ALg = (const float*)(ws + OFF_AL); const float* BEg = (const float*)(ws + OFF_BE); const float* NMg = (const float*)(ws + OFF_NM); const float* MST = (const float*)(ws + OFF_MST);
    LAS float* ALs = (LAS float*)(lds + SM); LAS float* BEs = ALs + 128; LAS float* Wl = (LAS float*)(lds + WB);
#define OPAQUE_TID() int tid = threadIdx.x; asm volatile("" : "+v"(tid)); const int lane = tid & 63, fr = lane & 15, fq = lane >> 4, cg = tid & 7, rp = tid >> 3, tq = (lane & 15) >> 2, tp = lane & 3, trow = 16 * wid + fr; (void)cg; (void)rp; (void)tq; (void)tp; (void)trow; (void)fq
    if (bx >= 512) return;
    u32x4 rawq[5], rawk[5];
#define MO_ISSUE_CT(L_, dch_, par_) do { const int bh_ = (L_) >> 6, c_ = (L_) & 63; \
        const h16* Ct_ = (const h16*)(ws + WS_CST) + ((size_t)(bh_ * 64 + c_)) * CSTRIDE; \
        _Pragma("unroll") for (int q = 0; q < 4; ++q) { const int I = wid * 4 + q, row = I * 8 + (lane >> 3), ch = (lane & 7) ^ swzb(row); \
            GLDS16((const char*)(Ct_ + (size_t)row * 256 + (dch_) * 64) + ch * 16, lds + CB0 + (par_) * CBS + I * 1024); } \
        if (wid == 0) { const int row = 256 + (lane >> 3), ch = (lane & 7) ^ swzb(row); GLDS16((const char*)(Ct_ + (size_t)row * 256 + (dch_) * 64) + ch * 16, lds + CB0 + (par_) * CBS + 32768); } } while (0)
#define MO_ISSUE_RAW(L_, dch_, WH_, R_) do { const int bh_ = (L_) >> 6, c_ = (L_) & 63, b_ = bh_ >> 2, hd_ = bh_ & 3; const int col_ = (WH_) * 1024 + hd_ * 256 + (dch_) * 64 + 8 * cg; \
        _Pragma("unroll") for (int k = 0; k < 5; ++k) { int tl = c_ * CHUNK + 2 * rp - 3 + k; tl = tl < 0 ? 0 : tl; R_[k] = *(const u32x4*)(QK + (size_t)(b_ * SEQ + tl) * 2048 + col_); } } while (0)
#define MO_CONV(WH_, R_) do { const LAS h16* wl = (const LAS h16*)Wl + (WH_) * 1280 + dch * 64 + 8 * cg; h16x8 cwh[5]; \
        _Pragma("unroll") for (int j = 0; j < 5; ++j) cwh[j] = *(const LAS h16x8*)(wl + j * 256); \
        const float sc = (WH_) ? 0.0625f : 1.f; \
        _Pragma("unroll") for (int rr = 0; rr < 2; ++rr) { h16x8 yh = cwh[4]; \
            _Pragma("unroll") for (int j = 0; j < 4; ++j) { u32x4 rw = R_[rr + j]; if (c == 0 && 2 * rp - 3 + rr + j < 0) rw = (u32x4){0u, 0u, 0u, 0u}; yh += cwh[j] * __builtin_bit_cast(h16x8, rw); } \
            f32x4 y0 = {(float)yh[0], (float)yh[1], (float)yh[2], (float)yh[3]}, y1 = {(float)yh[4], (float)yh[5], (float)yh[6], (float)yh[7]}; \
            _Pragma("unroll") for (int q = 0; q < 4; ++q) { y0[q] = fsilu(y0[q]) * sc; y1[q] = fsilu(y1[q]) * sc; } \
            const int row = 2 * rp + rr; *(LAS u32x4*)(lds + ((WH_) ? KB : QB) + row * 128 + ((cg ^ swzb(row)) * 16)) = pk_h8(y0, y1); } } while (0)
#define MO_CHUNK(dch_) do { const int dch = (dch_); OPAQUE_TID(); const bool nxu = (dch == 3) && (L + G < 512); \
        if (dch < 3) MO_ISSUE_CT(L, dch + 1, (dch + 1) & 1); else if (nxu) MO_ISSUE_CT(L + G, 0, 0); \
        if (dch == 0) P3CK(5); MO_CONV(0, rawq); if (dch == 0) P3CK(6); \
        if (dch < 3) MO_ISSUE_RAW(L, dch + 1, 0, rawq); else if (nxu) MO_ISSUE_RAW(L + G, 0, 0, rawq); \
        MO_CONV(1, rawk); if (dch == 0) P3CK(7); \
        if (dch < 3) MO_ISSUE_RAW(L, dch + 1, 1, rawk); else if (nxu) MO_ISSUE_RAW(L + G, 0, 1, rawk); \
        asm volatile("s_waitcnt lgkmcnt(0)" ::: "memory"); __builtin_amdgcn_s_barrier(); asm volatile("" ::: "memory"); \
        if (dch == 0) P3CK(8); const int cbo = CB0 + (dch & 1) * CBS; h16x8 Y[2]; \
        _Pragma("unroll") for (int ks = 0; ks < 2; ++ks) Y[ks] = *(const LAS h16x8*)(lds + QB + trow * 128 + (((4 * ks + fq) ^ swzb(trow)) * 16)); \
        _Pragma("unroll") for (int s2 = 0; s2 < 4; ++s2) if (2 * s2 <= wid) { h16x8 X[4]; \
            _Pragma("unroll") for (int i = 0; i < 4; ++i) { const int krow = 16 * (2 * s2 + (i >> 1)) + fr; X[i] = *(const LAS h16x8*)(lds + KB + krow * 128 + (((4 * (i & 1) + fq) ^ swzb(krow)) * 16)); } \
            REGBAR4(X); \
            _Pragma("unroll") for (int i = 0; i < 4; ++i) S[2 * s2 + (i >> 1)] = __builtin_amdgcn_mfma_f32_16x16x32_f16(X[i], Y[i & 1], S[2 * s2 + (i >> 1)], 0, 0, 0); } \
        _Pragma("unroll") for (int e4 = 0; e4 < 4; ++e4) { h16x8 X[8]; \
            _Pragma("unroll") for (int i = 0; i < 8; ++i) { const int et = 4 * e4 + (i >> 1), ks = i & 1, crow = 16 * et + fr; X[i] = *(const LAS h16x8*)(lds + cbo + crow * 128 + (((4 * ks + fq) ^ swzb(crow)) * 16)); } \
            REGBAR8(X); \
            _Pragma("unroll") for (int i = 0; i < 8; ++i) acc[4 * e4 + (i >> 1)] = __builtin_amdgcn_mfma_f32_16x16x32_f16(X[i], Y[i & 1], acc[4 * e4 + (i >> 1)], 0, 0, 0); } \
        { const int crow = 256 + fr; const h16x8 X0 = *(const LAS h16x8*)(lds + cbo + crow * 128 + (((fq) ^ swzb(crow)) * 16)), X1 = *(const LAS h16x8*)(lds + cbo + crow * 128 + (((4 + fq) ^ swzb(crow)) * 16)); \
          acc[16] = __builtin_amdgcn_mfma_f32_16x16x32_f16(X0, Y[0], acc[16], 0, 0, 0); acc[16] = __builtin_amdgcn_mfma_f32_16x16x32_f16(X1, Y[1], acc[16], 0, 0, 0); } \
        asm volatile("s_waitcnt lgkmcnt(0)" ::: "memory"); __builtin_amdgcn_s_barrier(); asm volatile("" ::: "memory"); if (dch == 0) P3CK(9); } while (0)
    int hd_staged = -1;
    { OPAQUE_TID(); MO_ISSUE_CT(bx, 0, 0); MO_ISSUE_RAW(bx, 0, 0, rawq); MO_ISSUE_RAW(bx, 0, 1, rawk); }
    for (int L = bx; L < 512; L += G) {
        const int bh = L >> 6, c = L & 63, b = bh >> 2, hd = bh & 3, t0 = b * SEQ + c * CHUNK;
        float nmv;
        { OPAQUE_TID();
          if (hd != hd_staged) {
              float wv[5];
#pragma unroll
              for (int q = 0; q < 5; ++q) { const int i = tid + NTHREADS * q, w_ = i / 1280, r_ = i % 1280, j = r_ >> 8, cc = r_ & 255, col = w_ * 1024 + hd * 256 + cc; wv[q] = (j < 4) ? p.conv_w[j * 2048 + col] : p.conv_b[col]; }
#pragma unroll
              for (int q = 0; q < 5; ++q) ((LAS h16*)Wl)[tid + NTHREADS * q] = (h16)wv[q];
              hd_staged = hd; }
          if (tid < 128) ALs[tid] = ALg[(t0 + tid) * 4 + hd]; else if (tid < 256) BEs[tid - 128] = BEg[(t0 + tid - 128) * 4 + hd];
          nmv = NMg[(t0 + trow) * 4 + hd];
        }
        f32x4 S[8], acc[17];
#pragma unroll
        for (int i = 0; i < 8; ++i) S[i] = (f32x4){0.f, 0.f, 0.f, 0.f};
#pragma unroll
        for (int i = 0; i < 17; ++i) acc[i] = (f32x4){0.f, 0.f, 0.f, 0.f};
        __syncthreads();
        P3CK(1);
#pragma unroll 1
        for (int dq = 0; dq < 4; ++dq) MO_CHUNK(dq);
        P3CK(2);
        OPAQUE_TID();
#pragma unroll
        for (int q = 0; q < 8; ++q) { const int I = wid * 8 + q, row = I * 2 + (lane >> 5), ch = (lane & 31) ^ ((row & 7) << 1);
            GLDS16((const char*)(Vg + (size_t)(t0 + row) * 1024 + hd * 256) + ch * 16, lds + (row < 64 ? 0 : VHI) + I * 1024); }
        const float al = ALs[trow], mc = MST[bh * 64 + c], iw = __expf(al + mc);
#pragma unroll
        for (int et = 0; et < 16; ++et) acc[et] *= iw;
        const float qn = __shfl(acc[16][0], fr);
        float den = 0.f;
#pragma unroll
        for (int st = 0; st < 8; ++st) { const f32x4 be = *(const LAS f32x4*)(BEs + 16 * st + 4 * fq);
#pragma unroll
            for (int r = 0; r < 4; ++r) { float v = S[st][r] * __expf(al + be[r]); if (st == wid) v = (4 * fq + r <= fr) ? v : 0.f; if (st > wid) v = 0.f; S[st][r] = v; den += v; } }
        den += __shfl_xor(den, 16); den += __shfl_xor(den, 32);
        den += iw * qn;
        h16x8 pf[4];
#pragma unroll
        for (int i = 0; i < 4; ++i) pf[i] = cat8(cvt4(S[2 * i]), cvt4(S[2 * i + 1]));
        asm volatile("s_waitcnt vmcnt(0)" ::: "memory"); __builtin_amdgcn_s_barrier(); asm volatile("" ::: "memory");
#pragma unroll
        for (int ks = 0; ks < 4; ++ks) if (ks <= (wid >> 1)) { const int r0 = 32 * ks + 4 * fq + tq, r1 = r0 + 16; const int vbase = (ks < 2) ? 0 : VHI;
#pragma unroll
            for (int e8 = 0; e8 < 2; ++e8) { h16x8 vf[8];
#pragma unroll
                for (int i = 0; i < 8; ++i) { const int et = 8 * e8 + i;
                    vf[i] = cat8(tr_read4(lds + vbase + r0 * 512 + (((2 * et + (tp >> 1)) ^ ((r0 & 7) << 1)) * 16) + (tp & 1) * 8), tr_read4(lds + vbase + r1 * 512 + (((2 * et + (tp >> 1)) ^ ((r1 & 7) << 1)) * 16) + (tp & 1) * 8)); }
                REGBAR8(vf);
#pragma unroll
                for (int i = 0; i < 8; ++i) acc[8 * e8 + i] = __builtin_amdgcn_mfma_f32_16x16x32_f16(vf[i], pf[ks], acc[8 * e8 + i], 0, 0, 0); } }
        P3CK(3);
        const int tg = t0 + trow; const float inv = 1.f / fmaxf(fabsf(den), __expf(nmv));
        float ss = 0.f;
#pragma unroll
        for (int et = 0; et < 16; ++et) { acc[et] *= inv; ss += (acc[et][0] * acc[et][0] + acc[et][1] * acc[et][1]) + (acc[et][2] * acc[et][2] + acc[et][3] * acc[et][3]); }
        ss += __shfl_xor(ss, 16); ss += __shfl_xor(ss, 32);
        const float rstd = rsqrtf(ss * (1.f / DH) + EPS);
#pragma unroll
        for (int half = 0; half < 2; ++half) { f32x4 gg[8]; h16x4 ogv[8], zv[8];
#pragma unroll
            for (int e8 = 0; e8 < 8; ++e8) { const int col = hd * 256 + 16 * (8 * half + e8) + 4 * fq; const size_t o = (size_t)tg * 1024 + col;
                gg[e8] = *(const f32x4*)(p.mh_norm_g + col); ogv[e8] = *(const h16x4*)(OG + o); zv[e8] = *(const h16x4*)(Z + o); }
            REGBAR8(gg); REGBAR8(ogv); REGBAR8(zv);
#pragma unroll
            for (int e8 = 0; e8 < 8; ++e8) { const int et = 8 * half + e8; const size_t o = (size_t)tg * 1024 + hd * 256 + 16 * et + 4 * fq; u32x2 w;
                w.x = pk_h2((float)zv[e8][0] + acc[et][0] * rstd * gg[e8][0] * (float)ogv[e8][0], (float)zv[e8][1] + acc[et][1] * rstd * gg[e8][1] * (float)ogv[e8][1]);
                w.y = pk_h2((float)zv[e8][2] + acc[et][2] * rstd * gg[e8][2] * (float)ogv[e8][2], (float)zv[e8][3] + acc[et][3] * rstd * gg[e8][3] * (float)ogv[e8][3]);
                *(u32x2*)(Zdst + o) = w; }
            asm volatile("" ::: "memory"); }
        P3CK(4);
    }
    asm volatile("s_waitcnt vmcnt(0) lgkmcnt(0)" ::: "memory"); __builtin_amdgcn_s_barrier();
#undef OPAQUE_TID
#undef MO_ISSUE_CT
#undef MO_ISSUE_RAW
#undef MO_CONV
#undef MO_CHUNK
}

struct TpItem { const float* W; const float* gk; h16* WT; int ldw, srccol0, K, destrow0, k0; };
__device__ __forceinline__ void tp_load(const TpItem& t, f32x4 (&v)[8], float (&g)[8], int lane) {
    const int col4 = lane & 7, krow = lane >> 3;
#pragma unroll
    for (int i = 0; i < 8; ++i) { v[i] = *(const f32x4*)(t.W + (size_t)(t.k0 + 8 * i + krow) * t.ldw + t.srccol0 + 4 * col4); g[i] = t.gk ? t.gk[t.k0 + 8 * i + krow] : 1.f; }
}
__device__ __forceinline__ void tp_store(const TpItem& t, const f32x4 (&v)[8], const float (&g)[8], LAS unsigned char* scr, int lane) {
    const int col4 = lane & 7, krow = lane >> 3;
#pragma unroll
    for (int i = 0; i < 8; ++i) { const int k = 8 * i + krow; const f32x4 x = v[i] * g[i]; u32x2 w; w.x = pk_h2(x[0], x[1]); w.y = pk_h2(x[2], x[3]);
        *(LAS u32x2*)(scr + k * 64 + (((col4 >> 1) ^ (2 * (i & 1))) * 16) + (col4 & 1) * 8) = w; }
    LDS_WAIT(); asm volatile("" ::: "memory");
    const int gq = lane >> 4, li = lane & 15, q = li >> 2, pp = li & 3;
#pragma unroll
    for (int h = 0; h < 2; ++h)
#pragma unroll
        for (int it = 0; it < 2; ++it) { const int m = gq + 4 * it, r0 = 8 * m + q, r1 = r0 + 4, ch = (2 * h + (pp >> 1)) ^ (2 * (m & 1));
            const h16x4 lo = tr_read4(scr + r0 * 64 + ch * 16 + (pp & 1) * 8), hi = tr_read4(scr + r1 * 64 + ch * 16 + (pp & 1) * 8);
            *(GAS h16x8*)(t.WT + (size_t)(t.destrow0 + 16 * h + li) * t.K + t.k0 + 8 * m) = cat8(lo, hi); }
    LDS_WAIT(); asm volatile("" ::: "memory");
}
template <class Dec>
__device__ __forceinline__ void tp_loop(const Dec& dec, int first, int count, int stride, LAS unsigned char* scr, int lane) {
    if (first >= count) return;
    TpItem cur = dec(first); f32x4 v[8]; float g[8]; tp_load(cur, v, g, lane);
    for (int it = first; it < count; it += stride) {
        const int nx = it + stride; TpItem nxt = cur; f32x4 v2[8]; float g2[8];
#pragma unroll
        for (int i = 0; i < 8; ++i) { v2[i] = v[i]; g2[i] = g[i]; }
        if (nx < count) { nxt = dec(nx); tp_load(nxt, v2, g2, lane); }
        asm volatile("" ::: "memory");
        tp_store(cur, v, g, scr, lane);
        cur = nxt;
#pragma unroll
        for (int i = 0; i < 8; ++i) { v[i] = v2[i]; g[i] = g2[i]; }
    }
}
__device__ __forceinline__ int win_destrow(int l) {
    if (l < 3072) return l;
    if (l < 4096) { const int c = l - 3072; return 3072 + (c >> 7) * 256 + (c & 127); }
    if (l < 5120) { const int c = l - 4096; return 5120 + (c >> 7) * 256 + (c & 127); }
    if (l < 6144) return 7168 + (l - 5120);
    if (l < 7168) { const int c = l - 6144; return 3072 + (c >> 7) * 256 + 128 + (c & 127); }
    { const int c = l - 7168; return 5120 + (c >> 7) * 256 + 128 + (c & 127); }
}

struct TpDecP0 { const Ptrs* p; unsigned char* ws;
    __device__ __forceinline__ TpItem operator()(int it) const {
        constexpr int I_WIN = 16 * 256, I_SQ = 16 * 32; h16* wsm = (h16*)(ws + WS_WSM); int r = it; TpItem t;
        if (r < I_WIN) { const int kb = r >> 8, nb = r & 255, l0 = 32 * nb; t = TpItem{p->w_in, p->norm_mix_g, (h16*)(ws + WS_WIN), IN_DIM, l0 < 4096 ? l0 : l0 + 8, DM, win_destrow(l0), 64 * kb}; return t; } r -= I_WIN;
        if (r < I_SQ) { t = TpItem{p->w_out, nullptr, wsm, DM, 32 * (r & 31), DM, 32 * (r & 31), 64 * (r >> 5)}; return t; } r -= I_SQ;
        if (r < I_SQ) { t = TpItem{p->w_xq, p->norm_x_g, wsm + 1024 * 1024, DM, 32 * (r & 31), DM, 32 * (r & 31), 64 * (r >> 5)}; return t; } r -= I_SQ;
        t = TpItem{p->w_xo, nullptr, wsm + 4 * 1024 * 1024, DM, 32 * (r & 31), DM, 32 * (r & 31), 64 * (r >> 5)}; return t; } };
struct TpDecW13 { const Ptrs* p; unsigned char* ws;
    __device__ __forceinline__ TpItem operator()(int it) const {
        h16* W13 = (h16*)(ws + WS_UG); const int e = it >> 9, r = it & 511; TpItem t;
        if (r < 256) { const int kb = r >> 4, nb = r & 15, f0 = 32 * nb; t = TpItem{p->w1 + (size_t)e * DM * FF, p->norm_moe_g, W13 + (size_t)e * 1024 * 1024, FF, f0, DM, (f0 >> 7) * 256 + (f0 & 127), 64 * kb}; return t; }
        const int q = r - 256, kb = q >> 4, nb = q & 15, f0 = 32 * nb; t = TpItem{p->w3 + (size_t)e * DM * FF, p->norm_moe_g, W13 + (size_t)e * 1024 * 1024, FF, f0, DM, (f0 >> 7) * 256 + 128 + (f0 & 127), 64 * kb}; return t; } };
struct TpDecW2 { const Ptrs* p; unsigned char* ws;
    __device__ __forceinline__ TpItem operator()(int it) const {
        h16* W2T = (h16*)(ws + WS_W2T); const int e = it >> 8, q = it & 255, kb = q >> 5, nb = q & 31;
        TpItem t = TpItem{p->w2 + (size_t)e * FF * DM, nullptr, W2T + (size_t)e * 1024 * 512, DM, 32 * nb, FF, 32 * nb, 64 * kb}; return t; } };
template <bool GATES>
__device__ __forceinline__ float p0_row(const f32x4 (&v)[4], h16* orow, const LAS float* gt, float (&acc)[8], int lane) {
    float ss = 0.f;
#pragma unroll
    for (int j = 0; j < 4; ++j) ss += (v[j].x * v[j].x + v[j].y * v[j].y) + (v[j].z * v[j].z + v[j].w * v[j].w);
    GAS u32x2* o8 = (GAS u32x2*)orow + lane;
#pragma unroll
    for (int j = 0; j < 4; ++j) { u32x2 w; w.x = pk_h2(v[j].x, v[j].y); w.y = pk_h2(v[j].z, v[j].w); o8[64 * j] = w; }
    if constexpr (GATES) {
#pragma unroll
        for (int q = 0; q < 8; ++q) acc[q] = 0.f;
#pragma unroll
        for (int j = 0; j < 4; ++j)
#pragma unroll
            for (int q = 0; q < 8; ++q) { const f32x4 w = *(const LAS f32x4*)(gt + q * 1024 + 4 * (64 * j + lane)); acc[q] += (v[j].x * w.x + v[j].y * w.y) + (v[j].z * w.z + v[j].w * w.w); }
        const bool b5 = (lane & 32) != 0, b4 = (lane & 16) != 0, b3 = (lane & 8) != 0; float k4[4], k2[2], k1;
#pragma unroll
        for (int q = 0; q < 4; ++q) { const float snd = b5 ? acc[q] : acc[4 + q]; k4[q] = (b5 ? acc[4 + q] : acc[q]) + __shfl_xor(snd, 32); }
#pragma unroll
        for (int q = 0; q < 2; ++q) { const float snd = b4 ? k4[q] : k4[2 + q]; k2[q] = (b4 ? k4[2 + q] : k4[q]) + __shfl_xor(snd, 16); }
        { const float snd = b3 ? k2[0] : k2[1]; k1 = (b3 ? k2[1] : k2[0]) + __shfl_xor(snd, 8); }
        k1 += __shfl_xor(k1, 4); k1 += __shfl_xor(k1, 2); k1 += __shfl_xor(k1, 1);
#pragma unroll
        for (int q = 0; q < 8; ++q) acc[q] = __builtin_bit_cast(float, __builtin_amdgcn_readlane(__builtin_bit_cast(int, k1), 8 * q));
    }
    return wave_sum(ss);
}
__device__ __forceinline__ void mstate_wave(const float* ig, const float* lf, float* mst, int bh, int lane) {
    const int b = bh >> 2, h = bh & 3; float B = 0.f, mx = -INFINITY;
    for (int s = 0; s < CHUNK; ++s) { const int t = b * SEQ + lane * CHUNK + s; B += lf[t * 4 + h]; mx = fmaxf(mx, ig[t * 4 + h] - B); }
    const float blast = B, maxw = B + mx; float m = 0.f;
    for (int c = 0; c < NCHUNK; ++c) { const float bl = __shfl(blast, c), mw = __shfl(maxw, c); if (lane == c) mst[bh * 64 + c] = m; m = fmaxf(bl + m, mw); }
}

struct Args { Ptrs p; int ph_lo, ph_hi, li, pad; };
__global__ void __launch_bounds__(NTHREADS, 2) mega(Args a) {
    extern __shared__ __attribute__((aligned(16))) unsigned char lds_[];
    LAS unsigned char* lds = (LAS unsigned char*)lds_;
    volatile LAS unsigned* MISC = (volatile LAS unsigned*)(lds + MISC_OFF);
    const Ptrs& p = a.p;
#define PH_IDS() int tid = threadIdx.x; asm volatile("" : "+v"(tid)); const int lane = tid & 63, wave = __builtin_amdgcn_readfirstlane(tid >> 6); const int gw = vcu * NWAVES + wave, NGW = G * NWAVES; (void)lane; (void)gw; (void)NGW
    const int G = gridDim.x, bx = blockIdx.x, vcu = (G % 8 == 0) ? (bx % 8) * (G / 8) + bx / 8 : bx;
    unsigned char* ws = p.ws;
    unsigned* ctl = (unsigned*)(ws + WS_CTL);
    for (int u = threadIdx.x; u < (LDS_BYTES - LDSCTL_OFF) / 4; u += NTHREADS) ((LAS unsigned*)(lds + LDSCTL_OFF))[u] = 0u;
    __syncthreads();
    XcdBarrier bar = xcd_barrier_post(ctl + CW_BAR + a.li * XCD_BAR_WORDS, MISC + 8);
    const int lo = a.ph_lo, hi = a.ph_hi;
#ifndef PH_MASK
#define PH_MASK 0xFFFF
#endif
#define IN(k) (((PH_MASK >> (k)) & 1) && lo <= (k) && (k) < hi)
#ifndef REPEAT_MASK
#define REPEAT_MASK 0
#endif
#ifdef TIME_PHASE
    unsigned long long tp0_ = 0ull, tp1_ = 0ull;
#define TSTAMP(k) do { if ((k) == TIME_PHASE) tp0_ = __builtin_amdgcn_s_memrealtime(); if ((k) == TIME_PHASE + 1) tp1_ = __builtin_amdgcn_s_memrealtime(); } while (0)
#else
#define TSTAMP(k) do { } while (0)
#endif
#define REP(k) for (int rep_ = 0; rep_ < 1 + ((REPEAT_MASK >> (k)) & 1); ++rep_)
#define BOTH(k) (IN(k) && IN((k) + 1))
#define GRID_BAR() xcd_barrier(bar)

    TSTAMP(0);
    if (IN(0)) REP(0) {
        PH_IDS();
#ifdef TIME_P0CK
        const unsigned long long tp0ck_ = __builtin_amdgcn_s_memrealtime();
#endif
        __syncthreads();
        LAS float* gt = (LAS float*)lds;
        { float gw_[16], gg_[16];
#pragma unroll
          for (int q = 0; q < 16; ++q) { const int i = tid + NTHREADS * q, k = i >> 3, j = i & 7; gw_[q] = p.w_in[(size_t)k * IN_DIM + C_I + j]; gg_[q] = p.norm_mix_g[k]; }
#pragma unroll
          for (int q = 0; q < 16; ++q) { const int i = tid + NTHREADS * q, k = i >> 3, j = i & 7; gt[j * 1024 + k] = gg_[q] * gw_[q]; } }
        { h16* wh = (h16*)(ws + OFF_WRT); h16* wl = wh + 48 * 1024;
          for (int i = bx * NTHREADS + tid; i < 48 * 1024; i += G * NTHREADS) { const int j = i >> 10, k = i & 1023; float w = 0.f; if (j < 36) w = p.norm_moe_g[k] * (j < 4 ? p.w_rg[k * 4 + j] : p.w_re[k * 32 + (j - 4)]);
              const h16 hi = (h16)w; wh[i] = hi; wl[i] = (h16)((w - (float)hi) * 4096.f); } }
        { float* z = (float*)(ws + OFF_SSSV); for (int i = bx * NTHREADS + tid; i < 3 * NTOK; i += G * NTHREADS) z[i] = 0.f; }
        __syncthreads();
        float acc[8]; float bif[8];
#pragma unroll
        for (int h = 0; h < 8; ++h) bif[h] = p.b_if[h];
        {   f32x4 v[4], nv[4];
            if (gw < NTOK) {
#pragma unroll
                for (int j = 0; j < 4; ++j) v[j] = ((const GAS f32x4*)(p.x + (size_t)gw * DM) + lane)[64 * j]; }
            for (int m = gw; m < NTOK; m += NGW) {
                const int mn = (m + NGW < NTOK) ? m + NGW : m;
#pragma unroll
                for (int j = 0; j < 4; ++j) nv[j] = ((const GAS f32x4*)(p.x + (size_t)mn * DM) + lane)[64 * j];
                asm volatile("" ::: "memory");
                const float ss = p0_row<true>(v, (h16*)(ws + WS_XH) + (size_t)m * DM, gt, acc, lane);
                const float rstd = rsqrtf(ss * (1.f / DM) + EPS);
                if (lane == 0) { ((float*)(ws + OFF_RSTD0))[m] = rstd; f32x4 igv, lfv;
#pragma unroll
                    for (int h = 0; h < 4; ++h) { igv[h] = acc[h] * rstd + bif[h]; { const float fx = acc[4 + h] * rstd + bif[4 + h]; lfv[h] = fminf(fx, 0.f) - __logf(1.f + __expf(-fabsf(fx))); } }
                    *(f32x4*)((float*)(ws + OFF_IG) + m * 4) = igv; *(f32x4*)((float*)(ws + OFF_LF) + m * 4) = lfv; }
#pragma unroll
                for (int j = 0; j < 4; ++j) v[j] = nv[j];
            }
        }
#ifdef TIME_P0CK
        if (bx == 0 && threadIdx.x == 0) { const unsigned long long dt = (__builtin_amdgcn_s_memrealtime() - tp0ck_) * 10ull, t0_ = __builtin_amdgcn_s_memrealtime(); while (__builtin_amdgcn_s_memrealtime() - t0_ < dt) __builtin_amdgcn_s_sleep(8); }
#endif
        LAS unsigned char* scr = lds + 32768 + wave * 4096;
        { TpDecP0 dec{&p, ws}; tp_loop(dec, gw, 16 * 256 + 3 * 16 * 32, NGW, scr, lane); }
        if (BOTH(0)) GRID_BAR();
    }
    TSTAMP(1);
    if (IN(1)) REP(1) {
        PH_IDS();
        if (bx < 8) mstate_ext(ws, bx, wave, lane, (LAS float*)(lds + 131072));
        { pg8::StaticOrder S; S.init(ws + WS_XH, ws + WS_WIN, NTOK, 8192, DM, G, bx);
          EpiProj E{(const float*)(ws + OFF_RSTD0), p.b_gate, (h16*)p.out, (h16*)(ws + WS_V), (h16*)(ws + WS_OG), (h16*)(ws + WS_UG), (h16*)(ws + WS_SV), (float*)(ws + OFF_SSSV), rep_ == 0};
          pg8::gemm_phase<EpiProj, pg8::StaticOrder, false, true>(lds, DM, S, E); }
        if (BOTH(1)) GRID_BAR();
    }

    TSTAMP(2);
    if (IN(2)) REP(2) {
#ifdef TIME_CUSTOM
        unsigned long long tc0_ = __builtin_amdgcn_s_memrealtime();
#endif
        if (G >= 256) { if (bx < 128) scan_task(lds, p, ws, bx); else if (bx < 256) { sgu_task(lds, p, ws, bx - 128); kv_task(lds, p, ws, 2 * (bx - 128)); kv_task(lds, p, ws, 2 * (bx - 128) + 1);
            { int tid2 = threadIdx.x; asm volatile("" : "+v"(tid2)); const int wv = __builtin_amdgcn_readfirstlane(tid2 >> 6); TpDecW2 dec{&p, ws}; tp_loop(dec, (bx - 128) * NWAVES + wv, 32 * 256, 128 * NWAVES, lds + wv * 4096, tid2 & 63); __syncthreads(); } } }
        else { for (int t = bx; t < 256; t += G) { if (t < 128) scan_task(lds, p, ws, t); else { sgu_task(lds, p, ws, t - 128); kv_task(lds, p, ws, 2 * (t - 128)); kv_task(lds, p, ws, 2 * (t - 128) + 1);
            { int tid2 = threadIdx.x; asm volatile("" : "+v"(tid2)); const int wv = __builtin_amdgcn_readfirstlane(tid2 >> 6); TpDecW2 dec{&p, ws}; tp_loop(dec, (t - 128) * NWAVES + wv, 32 * 256, 128 * NWAVES, lds + wv * 4096, tid2 & 63); } } __syncthreads(); } }
#ifdef TIME_CUSTOM
        if (bx == TIME_CUSTOM && threadIdx.x == 0) { const unsigned long long dt = (__builtin_amdgcn_s_memrealtime() - tc0_) * 10ull, t0_ = __builtin_amdgcn_s_memrealtime(); while (__builtin_amdgcn_s_memrealtime() - t0_ < dt) __builtin_amdgcn_s_sleep(8); }
#endif
        if (BOTH(2)) GRID_BAR();
    }
    TSTAMP(3);
    if (IN(3)) REP(3) {
        mout_phase(lds, p, ws, G, bx, (((REPEAT_MASK >> 3) & 1) && rep_ == 0) ? (h16*)(ws + WS_UG) : (h16*)(ws + WS_XH));
        if (BOTH(3)) GRID_BAR();
    }
    TSTAMP(4);
    if (IN(4)) REP(4) {
        PH_IDS();
        const bool convFirst = ((bx >> 3) & 1) != 0;
        if (convFirst) { LAS unsigned char* scr = lds + 32768 + wave * 4096; TpDecW13 dec{&p, ws}; tp_loop(dec, gw, 32 * 512, NGW, scr, lane); __syncthreads(); }
        { pg8::StaticOrder S; S.init(ws + WS_XH, ws + WS_WSM, NTOK, DM, DM, G, bx);
          EpiResid<false> E{p.x, (h16*)(ws + WS_V), (float*)(ws + OFF_SS1), rep_ == 0};
          pg8::gemm_phase<EpiResid<false>, pg8::StaticOrder, false, false>(lds, DM, S, E); }
        if (!convFirst) { PH_IDS(); __syncthreads(); LAS unsigned char* scr = lds + 32768 + wave * 4096; TpDecW13 dec{&p, ws}; tp_loop(dec, gw, 32 * 512, NGW, scr, lane); __syncthreads(); }
        if (BOTH(4)) GRID_BAR();
    }
    TSTAMP(5);
    if (IN(5)) REP(5) {
        { pg8::StaticOrder S; S.init(ws + WS_V, ws + WS_WSM + 2097152, NTOK, DM, DM, G, bx);
          EpiQ E{(const float*)(ws + OFF_SS1), (h16*)(ws + WS_XH)};
          pg8::gemm_phase<EpiQ, pg8::StaticOrder, false, false>(lds, DM, S, E);
          if (G * 1 == (NTOK / 256) * 4 && IN(6)) { pg8::Unit u; if (S.next(0, u)) { __syncthreads(); attn_phase(lds, (const h16*)(ws + WS_XH), (const h16*)(ws + WS_KM), (const h16*)(ws + WS_VTM), (h16*)(ws + WS_OG), G, bx, u.pn, 2 * u.pm); } } }
        if (BOTH(5) && !(G * 1 == (NTOK / 256) * 4 && IN(6))) GRID_BAR();
    }
    TSTAMP(6);
    if (IN(6) && !(G * 1 == (NTOK / 256) * 4 && IN(5))) REP(6) {
        attn_phase(lds, (const h16*)(ws + WS_XH), (const h16*)(ws + WS_KM), (const h16*)(ws + WS_VTM), (h16*)(ws + WS_OG), G, bx, -1, 0);
        if (BOTH(6)) GRID_BAR();
    }
    if (IN(6) && (G * 1 == (NTOK / 256) * 4 && IN(5))) { if (BOTH(6)) GRID_BAR(); }
    TSTAMP(7);
    if (IN(7)) {
        { pg8::StaticOrder S; S.init(ws + WS_OG, ws + WS_WSM + 4 * 2097152, NTOK, DM, DM, G, bx);
          EpiResid<true> E{(const void*)(ws + WS_V), (h16*)(ws + WS_V), (float*)(ws + OFF_SS2), true};
          pg8::gemm_phase<EpiResid<true>, pg8::StaticOrder, false, false>(lds, DM, S, E); }
        if (BOTH(7)) GRID_BAR();
    }
    TSTAMP(8);
    if (IN(8)) REP(8) {
        PH_IDS();
        if (rep_ == 1) { GRID_BAR(); if (bx == 0 && tid < 32) (ctl + CW_CNT)[tid * 64] = 0u; GRID_BAR(); }
        unsigned* cnt = ctl + CW_CNT; int* list = (int*)(ws + OFF_LIST); float* gate = (float*)(ws + OFF_GATE);
        const float* ss2 = (const float*)(ws + OFF_SS2); const h16* WH = (const h16*)(ws + OFF_WRT); const h16* X2 = (const h16*)(ws + WS_V);
        LAS unsigned char* wbuf = lds;
        LAS float* lg = (LAS float*)(lds + 49152);
        LAS unsigned* lc = (LAS unsigned*)(lds + 49152 + 12288);
        LAS int* ent = (LAS int*)(lds + 49152 + 12288 + 256);
        const int fr = lane & 15, fq = lane >> 4;
        for (int rg = bx; rg < NTOK / 64; rg += G) {
            __syncthreads();
            if (tid < 64) lc[tid] = 0u;
            const int trow = 64 * rg + 16 * wave + fr;
            f32x4 ah[3], al[3];
#pragma unroll
            for (int j = 0; j < 3; ++j) { ah[j] = (f32x4){0.f, 0.f, 0.f, 0.f}; al[j] = (f32x4){0.f, 0.f, 0.f, 0.f}; }
            u32x4 wst[3];
#define RT_LOADW(kc_) do { _Pragma("unroll") for (int q = 0; q < 3; ++q) { const int pc = tid + 512 * q, hl = pc / 768, rem = pc % 768, row = rem >> 4, ch = rem & 15; \
                wst[q] = *(const u32x4*)(WH + (size_t)hl * 48 * 1024 + (size_t)row * 1024 + (kc_) * 128 + ch * 8); } } while (0)
#define RT_STOREW(buf_) do { _Pragma("unroll") for (int q = 0; q < 3; ++q) { const int pc = tid + 512 * q, hl = pc / 768, rem = pc % 768, row = rem >> 4, ch = rem & 15; \
                *(LAS u32x4*)(wbuf + (buf_) * 24576 + hl * 12288 + row * 256 + ((ch ^ (row & 15)) * 16)) = wst[q]; } } while (0)
            RT_LOADW(0);
            h16x8 xf[4];
#pragma unroll 1
            for (int kc = 0; kc < 8; ++kc) {
                RT_STOREW(kc & 1);
                if (wave < 4) {
#pragma unroll
                    for (int ks = 0; ks < 4; ++ks) xf[ks] = *(const h16x8*)(X2 + (size_t)trow * DM + kc * 128 + 32 * ks + 8 * fq); }
                __syncthreads();
                if (kc + 1 < 8) RT_LOADW(kc + 1);
                if (wave < 4) { const LAS unsigned char* wb = wbuf + (kc & 1) * 24576;
#pragma unroll
                    for (int ks = 0; ks < 4; ++ks)
#pragma unroll
                        for (int j = 0; j < 3; ++j) { const int row = 16 * j + fr; const int off = row * 256 + (((4 * ks + fq) ^ (row & 15)) * 16);
                            const h16x8 xh = *(const LAS h16x8*)(wb + off), xl = *(const LAS h16x8*)(wb + 12288 + off);
                            ah[j] = __builtin_amdgcn_mfma_f32_16x16x32_f16(xh, xf[ks], ah[j], 0, 0, 0); al[j] = __builtin_amdgcn_mfma_f32_16x16x32_f16(xl, xf[ks], al[j], 0, 0, 0); } }
            }
#undef RT_LOADW
#undef RT_STOREW
            if (wave < 4) { const float rs = rsqrtf(ss2[trow] * (1.f / DM) + EPS);
#pragma unroll
                for (int j = 0; j < 3; ++j) { const f32x4 v = (ah[j] + al[j] * (1.f / 4096.f)) * rs; *(LAS f32x4*)(lg + (16 * wave + fr) * 48 + 16 * j + 4 * fq) = v; } }
            __syncthreads();
            if (tid < 64) { const LAS float* lr = lg + tid * 48; const int t = 64 * rg + tid;
                float gl[4];
#pragma unroll
                for (int j = 0; j < 4; ++j) gl[j] = lr[j] + p.b_rg[j];
                int gi = 0; float gm = gl[0];
#pragma unroll
                for (int j = 1; j < 4; ++j) if (gl[j] > gm) { gm = gl[j]; gi = j; }
                float gs = 0.f;
#pragma unroll
                for (int j = 0; j < 4; ++j) gs += __expf(gl[j] - gm);
                const float pg = 1.f / gs;
                int i1 = 0, i2 = -1; float v1 = -INFINITY, v2 = -INFINITY;
#pragma unroll
                for (int q = 0; q < 8; ++q) { const float ev = lr[4 + gi * 8 + q] + p.b_re[gi * 8 + q]; if (ev > v1) { v2 = v1; i2 = i1; v1 = ev; i1 = q; } else if (ev > v2) { v2 = ev; i2 = q; } }
                const float e2 = __expf(v2 - v1), g1 = pg / (1.f + e2), g2 = pg * e2 / (1.f + e2);
                ent[2 * tid] = gi * 8 + i1; ent[2 * tid + 1] = gi * 8 + i2; ent[128 + 2 * tid] = __float_as_int(g1); ent[128 + 2 * tid + 1] = __float_as_int(g2); (void)t; }
            __syncthreads();
            unsigned lpos = 0u; int myE = 0;
            if (tid < 128) { myE = ent[tid]; lpos = __hip_atomic_fetch_add(&lc[myE], 1u, __ATOMIC_RELAXED, __HIP_MEMORY_SCOPE_WORKGROUP); }
            __syncthreads();
            if (tid < 32) { const unsigned c2 = lc[tid]; lc[32 + tid] = c2 ? atomicAdd(cnt + tid * 64, c2) : 0u; }
            __syncthreads();
            if (tid < 128) { const unsigned pos = lc[32 + myE] + lpos; const int slot = 2 * (64 * rg + (tid >> 1)) + (tid & 1); list[myE * NTOK + pos] = slot; gate[slot] = __int_as_float(ent[128 + tid]); }
        }
        if (BOTH(8)) GRID_BAR();
    }
    TSTAMP(9);
    if (IN(9) || IN(10)) {
        PH_IDS();
        LAS int* tab = (LAS int*)(lds + LDSCTL_OFF + 1024);
        if (tid < 64) {
            const unsigned* cnt = ctl + CW_CNT; const int nb = (lane < 32) ? (int)((__hip_atomic_load(cnt + (lane & 31) * 64, RLX_AGENT) + 255u) >> 8) : 0; int inc = nb;
#pragma unroll
            for (int d = 1; d < 32; d <<= 1) { const int o = __shfl_up(inc, d); if (lane >= d) inc += o; }
            if (lane < 32) tab[lane] = inc - nb; if (lane == 31) tab[32] = inc; }
        __syncthreads();
        if (IN(9)) REP(9) {
            MoeOrder S{(const char*)(ws + WS_V), (const char*)(ws + WS_UG), DM, (size_t)1024 * 1024 * 2, (const int*)(ws + OFF_LIST), ctl + CW_CNT, tab, G, bx};
            EpiFfn1 E{(const int*)(ws + OFF_LIST), (const float*)(ws + OFF_SS2), (h16*)(ws + WS_H)};
            pg8::gemm_phase<EpiFfn1, MoeOrder, true, true>(lds, DM, S, E);
            if (BOTH(9)) GRID_BAR();
        }
        TSTAMP(10);
        if (IN(10)) REP(10) {
            MoeOrder S{(const char*)(ws + WS_H), (const char*)(ws + WS_W2T), FF, (size_t)1024 * 512 * 2, (const int*)(ws + OFF_LIST), ctl + CW_CNT, tab, G, bx};
            EpiFfn2 E{(const int*)(ws + OFF_LIST), (const float*)(ws + OFF_GATE), (h16*)p.out};
            pg8::gemm_phase<EpiFfn2, MoeOrder, false, true>(lds, FF, S, E);
            if (BOTH(10)) GRID_BAR();
        }
    }
    TSTAMP(11);
    if (IN(11)) REP(11) {
        PH_IDS();
        float* fdst = (((REPEAT_MASK >> 11) & 1) && rep_ == 0) ? (float*)(ws + WS_UG) : p.out;
        h16x4 xa[4], nxa[4]; u32x2 ya[4], yb[4], nya[4], nyb[4];
#define F_LOAD(t_, X_, A_, B_) do { const GAS h16x4* xr_ = (const GAS h16x4*)((const h16*)(ws + WS_V) + (size_t)(t_) * DM) + lane; const GAS u32x2* y0_ = (const GAS u32x2*)((const unsigned char*)p.out + (size_t)(2 * (t_)) * DM * 2) + lane; \
            _Pragma("unroll") for (int j = 0; j < 4; ++j) { X_[j] = xr_[64 * j]; A_[j] = y0_[64 * j]; B_[j] = y0_[64 * j + DM / 4]; } } while (0)
        if (gw < NTOK) F_LOAD(gw, xa, ya, yb);
        for (int t = gw; t < NTOK; t += NGW) {
            const int tn = (t + NGW < NTOK) ? t + NGW : t;
            F_LOAD(tn, nxa, nya, nyb);
            asm volatile("" ::: "memory");
            f32x4 v[4]; float ss = 0.f;
#pragma unroll
            for (int j = 0; j < 4; ++j) { const h16x4 ha = __builtin_bit_cast(h16x4, ya[j]), hb = __builtin_bit_cast(h16x4, yb[j]); v[j] = __builtin_convertvector(xa[j], f32x4);
#pragma unroll
                for (int c = 0; c < 4; ++c) { v[j][c] += (float)ha[c] + (float)hb[c]; ss += v[j][c] * v[j][c]; } }
            ss = wave_sum(ss); const float rs = rsqrtf(ss * (1.f / DM) + EPS);
            if (tn != t) {
#pragma unroll
                for (int j = 0; j < 4; ++j) { const f32x4 g = *(const f32x4*)(p.norm_f_g + 4 * (64 * j + lane)); ((GAS f32x4*)(fdst + (size_t)t * DM) + lane)[64 * j] = v[j] * rs * g; }
            } else {
#pragma unroll
                for (int j = 0; j < 4; ++j) { const f32x4 g = *(const f32x4*)(p.norm_f_g + 4 * (64 * j + lane)); ((GAS f32x4*)(fdst + (size_t)t * DM) + lane)[64 * j] = v[j] * rs * g; }
            }
#pragma unroll
            for (int j = 0; j < 4; ++j) { xa[j] = nxa[j]; ya[j] = nya[j]; yb[j] = nyb[j]; }
        }
#undef F_LOAD
    }
    TSTAMP(12);
#ifdef TIME_PHASE
    if (bx == 0 && threadIdx.x == 0) { const unsigned long long dt = (tp1_ - tp0_) * 10ull, t0_ = __builtin_amdgcn_s_memrealtime(); while (__builtin_amdgcn_s_memrealtime() - t0_ < dt) __builtin_amdgcn_s_sleep(8); }
#endif
#ifdef EXTRA_BARS
    for (int i = 0; i < EXTRA_BARS; ++i) GRID_BAR();
#endif
#undef IN
#undef BOTH
#undef GRID_BAR
}

static int mega_grid() {
    static int grid = 0;
    if (grid == 0) {
        int dev = 0, cus = 0;
        if (hipGetDevice(&dev) != hipSuccess || hipDeviceGetAttribute(&cus, hipDeviceAttributeMultiprocessorCount, dev) != hipSuccess) { grid = -1; return grid; }
        if (hipFuncSetAttribute((const void*)mega, hipFuncAttributeMaxDynamicSharedMemorySize, LDS_BYTES) != hipSuccess) { fprintf(stderr, "hipFuncSetAttribute failed\n"); grid = -1; return grid; }
        (void)hipGetLastError();
        grid = cus;
    }
    return grid;
}
static void launch_mega(const Ptrs& p, int lo, int hi, int li, hipStream_t stream) {
    const int grid = mega_grid(); if (grid <= 0) return;
    Args a{}; a.p = p; a.ph_lo = lo; a.ph_hi = hi; a.li = li; a.pad = 0;
    hipLaunchKernelGGL(mega, dim3(grid), dim3(NTHREADS), LDS_BYTES, stream, a);
}

extern "C" void kernel_launch(void* const* d_in, const int* in_sizes, int n_in, void* d_out, int out_size, void* d_ws, size_t ws_size, hipStream_t stream) {
    if (n_in != 27 || ws_size < WS_END) { fprintf(stderr, "kernel_launch: unexpected n_in %d or ws_size %zu (< %zu)\n", n_in, ws_size, (size_t)WS_END); return; }
    Ptrs p{};
    const float** f = (const float**)&p;
    for (int i = 0; i < 27; ++i) f[i] = (const float*)d_in[i];
    p.out = (float*)d_out; p.ws = (unsigned char*)d_ws;
    (void)hipMemsetAsync((char*)d_ws + WS_CTL, 0, CTL_BYTES, stream);
    launch_mega(p, 0, 12, 0, stream);
}
```

```cpp
#include <hip/hip_runtime.h>
#include <cstdio>
#include <cstdint>
#include <cmath>

typedef _Float16 h16;
typedef unsigned short u16;

constexpr int DM = 1024, NB = 2, SEQ = 8192, NTOK = NB * SEQ;
constexpr int NMEM = 256, NHEAD = 4, DH = 256, CHUNK = 128, NCHUNK = SEQ / CHUNK;
constexpr int IN_DIM = 8200;
constexpr int C_QK = 0, C_V = 2048, C_O = 3072, C_I = 4096, C_F = 4100, C_U = 4104, C_SV = 5128, C_G = 6152;
constexpr int NEXP = 32, NGRP = 4, EPG = 8, FF = 512, NSLOT = NTOK * 2;
constexpr float EPS = 1e-6f;

constexpr size_t MiB = 1u << 20;
constexpr size_t WS_CTL = 0;
constexpr size_t CTL_BYTES = 1 * MiB;
constexpr size_t WS_SMALL = 1 * MiB;
constexpr size_t OFF_RSTD0 = WS_SMALL;
constexpr size_t OFF_SSSV  = OFF_RSTD0 + 65536;
constexpr size_t OFF_SS1   = OFF_SSSV + 65536;
constexpr size_t OFF_SS2   = OFF_SS1 + 65536;
constexpr size_t OFF_IG    = OFF_SS2 + 65536;
constexpr size_t OFF_LF    = OFF_IG + 262144;
constexpr size_t OFF_MST   = OFF_LF + 262144;
constexpr size_t OFF_RSTDM = OFF_MST + 4096;
constexpr size_t OFF_AL    = 4 * MiB + 1048576;
constexpr size_t OFF_BE    = OFF_AL + 262144;
constexpr size_t OFF_NM    = OFF_BE + 262144;
constexpr size_t OFF_WU    = OFF_NM + 262144;
constexpr size_t OFF_DEC   = OFF_WU + 262144;
constexpr size_t OFF_WRT   = 7 * MiB;
constexpr size_t OFF_GATE  = 2 * MiB;
constexpr size_t OFF_SLOTE = OFF_GATE + 131072;
constexpr size_t OFF_SLOTP = OFF_SLOTE + 131072;
constexpr size_t OFF_LIST  = 3 * MiB;
constexpr size_t OFF_NAIVE_C = 262 * MiB;
constexpr size_t OFF_NAIVE_N = 6 * MiB + 8192;
constexpr size_t OFF_NAIVE_S = 6 * MiB + 65536;
constexpr size_t WS_WSM  = 8 * MiB;
constexpr size_t WS_KM   = 18 * MiB;
constexpr size_t WS_VTM  = 19 * MiB;
constexpr size_t WS_WIN  = 20 * MiB;
constexpr size_t WS_XH   = 36 * MiB;
constexpr size_t WS_V    = 68 * MiB;
constexpr size_t WS_OG   = 100 * MiB;
constexpr size_t WS_UG   = 132 * MiB;
constexpr size_t WS_SV   = 164 * MiB;
constexpr size_t WS_CST  = 196 * MiB;
constexpr size_t WS_H    = 228 * MiB;
constexpr size_t WS_NST  = 260 * MiB;
constexpr size_t WS_MEMH = 261 * MiB;
constexpr size_t OFF_PSV  = 264 * MiB;
constexpr size_t OFF_PS1  = 265 * MiB;
constexpr size_t OFF_PS2  = 266 * MiB;
constexpr size_t WS_W2T  = 268 * MiB;
constexpr size_t WS_END  = 300 * MiB;
constexpr size_t WS_Y    = WS_XH;
constexpr size_t WS_QC   = WS_UG;
constexpr size_t WS_KC   = WS_SV;
static_assert(OFF_RSTDM + 4096 <= 2 * MiB && OFF_SLOTP + 131072 <= OFF_LIST && OFF_LIST + 2 * MiB <= OFF_AL && OFF_DEC + 4096 <= OFF_NAIVE_N && OFF_NAIVE_N + 8192 <= OFF_NAIVE_S && OFF_NAIVE_S + 524288 <= WS_WSM && OFF_NAIVE_C + 2 * MiB <= WS_END, "small map");
constexpr size_t CSTRIDE = 272 * 256;
constexpr int CW_CNT = 64;

struct Ptrs {
    const float *x, *mem, *norm_mix_g, *w_in, *b_gate, *b_if, *conv_w, *conv_b, *mh_norm_g, *sgu_norm_g, *w_s, *b_s, *w_out,
                *norm_x_g, *norm_mem_g, *w_xq, *w_xkv, *w_xo, *norm_moe_g, *w_rg, *b_rg, *w_re, *b_re, *w1, *w3, *w2, *norm_f_g;
    float* out; unsigned char* ws;
};

__device__ __forceinline__ float sigmoidf_(float v) { return 1.f / (1.f + __expf(-v)); }
__device__ __forceinline__ float siluf_(float v) { return v / (1.f + __expf(-v)); }
__device__ __forceinline__ float gelu_tanh(float v) { const float u = 0.7978845608028654f * (v + 0.044715f * v * v * v); return v / (1.f + __expf(-2.f * u)); }
__device__ __forceinline__ float logsigmoidf_(float v) { return fminf(v, 0.f) - log1pf(__expf(-fabsf(v))); }
__device__ __forceinline__ float wave_sum(float v) {
#pragma unroll
    for (int o = 1; o < 64; o <<= 1) v += __shfl_xor(v, o);
    return v;
}
__device__ __forceinline__ float wave_max(float v) {
#pragma unroll
    for (int o = 1; o < 64; o <<= 1) v = fmaxf(v, __shfl_xor(v, o));
    return v;
}
__host__ __device__ __forceinline__ int vt_slot(int key) { const int g = key & ~15, r = key & 15;   const int hh = (r >> 2) & 1, j = ((r >> 3) << 2) | (r & 3); return g + 8 * hh + j; }

#define LAS __attribute__((address_space(3)))
#define GAS __attribute__((address_space(1)))
typedef _Float16 h16x8 __attribute__((ext_vector_type(8)));
typedef _Float16 h16x4 __attribute__((ext_vector_type(4)));
typedef _Float16 h16x2 __attribute__((ext_vector_type(2)));
typedef float f32x4 __attribute__((ext_vector_type(4)));
typedef float f32x2 __attribute__((ext_vector_type(2)));
typedef unsigned u32x4 __attribute__((ext_vector_type(4)));
typedef unsigned u32x2 __attribute__((ext_vector_type(2)));
typedef GAS unsigned gu32;
#define RLX_AGENT __ATOMIC_RELAXED, __HIP_MEMORY_SCOPE_AGENT
#define LDS_WAIT() asm volatile("s_waitcnt lgkmcnt(0)" ::: "memory")
#define VM_WAIT() asm volatile("s_waitcnt vmcnt(0)" ::: "memory")
__device__ __forceinline__ unsigned pk_h2(float lo, float hi) { f32x2 v = {lo, hi}; return __builtin_bit_cast(unsigned, __builtin_convertvector(v, h16x2)); }
__device__ __forceinline__ u32x4 pk_h8(f32x4 a, f32x4 b) { u32x4 w; w.x = pk_h2(a[0], a[1]); w.y = pk_h2(a[2], a[3]); w.z = pk_h2(b[0], b[1]); w.w = pk_h2(b[2], b[3]); return w; }
__device__ __forceinline__ float fsigmoid(float v) { return __builtin_amdgcn_rcpf(1.f + __expf(-v)); }
__device__ __forceinline__ float fgelu(float v) { const float u = 1.5957691216057308f * (v + 0.044715f * v * v * v); return v * __builtin_amdgcn_rcpf(1.f + __expf(-u)); }
__device__ __forceinline__ float fsilu(float v) { return v * __builtin_amdgcn_rcpf(1.f + __expf(-v)); }

constexpr int NWAVES = 8, NTHREADS = 512;
constexpr int RING_BYTES = 143360, LDSCTL_OFF = RING_BYTES, MISC_OFF = LDSCTL_OFF + 320, LDS_BYTES = 147456;
constexpr int CW_TMO = 0, CW_BAR = 4096;

#define XB_TMO      128
#define XB_XCNT(j)  (256  + 64 * (j))
#define XB_XSUB(j)  (1280 + 64 * (j))
#define XB_XGEN(j)  (2304 + 64 * (j))
#define XB_TOP      3328
#define XB_TOPGEN   3392
#define XCD_BAR_WORDS 3456
#define XB_SPIN_CAP (1u << 20)
__device__ __forceinline__ unsigned xb_ld(unsigned* p)              { return __hip_atomic_load(p, __ATOMIC_RELAXED, __HIP_MEMORY_SCOPE_AGENT); }
__device__ __forceinline__ unsigned xb_add(unsigned* p, unsigned v) { return __hip_atomic_fetch_add(p, v, __ATOMIC_RELAXED, __HIP_MEMORY_SCOPE_AGENT); }
__device__ __forceinline__ unsigned xb_xcc_id() { return (unsigned)__builtin_amdgcn_s_getreg((3 << 11) | 20) & 0xFu; }
#define XB_SPIN(cond, bar) do { unsigned _sp = 0; while (cond) { __builtin_amdgcn_s_sleep(1); \
    if ((++_sp & 255u) == 0u) { if (xb_ld(&(bar)[XB_TMO])) break; if (_sp > XB_SPIN_CAP) { atomicAdd(&(bar)[XB_TMO], 1u); break; } } } } while (0)
struct XcdBarrier { unsigned* bar; unsigned x; volatile LAS unsigned* st; };
__device__ __forceinline__ XcdBarrier xcd_barrier_post(unsigned* bar, volatile LAS unsigned* st) {
    XcdBarrier b; b.bar = bar; b.x = xb_xcc_id(); b.st = st;
    if (threadIdx.x == 0) (void)xb_add(&bar[XB_XCNT(b.x)], 1u);
    return b;
}
__device__ __forceinline__ void xcd_barrier_complete(unsigned* bar, unsigned x, unsigned& nloc, unsigned& nx) {
    const unsigned G = gridDim.x * gridDim.y * gridDim.z;
    unsigned sum, cnt, mine, sp = 0u;
    for (;;) {
        sum = 0u; cnt = 0u; mine = 0u;
#pragma unroll
        for (unsigned j = 0; j < 16; ++j) { const unsigned c = xb_ld(&bar[XB_XCNT(j)]); sum += c; cnt += (c > 0u) ? 1u : 0u; mine = (j == x) ? c : mine; }
        if (sum == G) break;
        __builtin_amdgcn_s_sleep(1);
        if ((++sp & 255u) == 0u) { if (xb_ld(&bar[XB_TMO])) break; if (sp > XB_SPIN_CAP) { atomicAdd(&bar[XB_TMO], 1u); break; } }
    }
    nloc = mine > 0u ? mine : 1u; nx = cnt > 0u ? cnt : 1u;
}
__device__ __forceinline__ void xcd_barrier(const XcdBarrier& b) {
    asm volatile("s_waitcnt vmcnt(0)" ::: "memory");
    __syncthreads();
    if (threadIdx.x == 0) {
        unsigned* bar = b.bar;
        __builtin_amdgcn_s_waitcnt(0);
        unsigned nloc = b.st[0], nx = b.st[1];
        if (nloc == 0u) { xcd_barrier_complete(bar, b.x, nloc, nx); b.st[0] = nloc; b.st[1] = nx; }
        const unsigned old = xb_add(&bar[XB_XSUB(b.x)], 1u);
        const unsigned gen = old / nloc;
        if (old + 1u == (gen + 1u) * nloc) {
            __builtin_amdgcn_fence(__ATOMIC_RELEASE, "agent");
            asm volatile("s_waitcnt vmcnt(0)" ::: "memory");
            const unsigned og = xb_add(&bar[XB_TOP], 1u);
            const unsigned tg = og / nx;
            if (og + 1u == (tg + 1u) * nx) xb_add(&bar[XB_TOPGEN], 1u);
            else XB_SPIN(xb_ld(&bar[XB_TOPGEN]) == tg, bar);
            __builtin_amdgcn_fence(__ATOMIC_ACQUIRE, "agent");
            xb_add(&bar[XB_XGEN(b.x)], 1u);
            asm volatile("s_waitcnt vmcnt(0)" ::: "memory");
        } else {
            XB_SPIN(xb_ld(&bar[XB_XGEN(b.x)]) == gen, bar);
            __builtin_amdgcn_fence(__ATOMIC_ACQUIRE, "agent");
            asm volatile("s_waitcnt vmcnt(0)" ::: "memory");
        }
    }
    __syncthreads();
}

namespace pg8 {
constexpr int BM = 256, BK = 64, HALF = 128, HTB = HALF * BK * 2, STAGE_BYTES = 8 * HTB, NXCD = 8, WGM = 8;
__host__ __device__ __forceinline__ int lds_byte(int r, int c) { const int st = (r >> 4) * 2 + (c >> 5), rr = r & 15, cc = c & 31, ob = rr * 64 + cc * 2; return st * 1024 + (ob ^ (((ob >> 9) & 1) << 5)); }
__host__ __device__ __forceinline__ void stage_rc(int b, int& R, int& C) { const int st = b / 1024, sb = b % 1024, swz = sb ^ (((sb >> 9) & 1) << 5); R = (st >> 1) * 16 + swz / 64; C = (st & 1) * 32 + (swz % 64) / 2; }
__host__ __device__ __forceinline__ int perm32(int rho) { const int n = rho >> 4, i = rho & 15; return 8 * (i >> 2) + 4 * n + (i & 3); }
struct Unit { int pm, pn, e, nv, rb, roff, nr; };
struct StaticOrder {
    static constexpr bool PARTIAL = false;
    const char* A; const char* Bt; int K; int nM, nN, nwg, G, c;
    __device__ __forceinline__ void init(const void* A_, const void* Bt_, int M, int N, int K_, int G_, int c_) { A = (const char*)A_; Bt = (const char*)Bt_; K = K_; nM = M / BM; nN = N / BM; nwg = nM * nN; G = G_; c = c_; }
    __device__ __forceinline__ bool next(int i, Unit& u) const {
        const long L = (long)i * G + c; if (L >= nwg) return false;
        int wgid = (int)L; { const int q = nwg / NXCD, r = nwg % NXCD, xcd = wgid % NXCD, off = wgid / NXCD; wgid = (xcd < r ? xcd * (q + 1) : r * (q + 1) + (xcd - r) * q) + off; }
        const int nig = WGM * nN, gid = wgid / nig, fm = gid * WGM, gsz = (nM - fm) < WGM ? (nM - fm) : WGM;
        u.pm = fm + ((wgid % nig) % gsz); u.pn = (wgid % nig) / gsz; u.e = 0; u.nv = 256; u.rb = 0; u.roff = 0; u.nr = 256; return true;
    }
    __device__ __forceinline__ const char* a_base(const Unit& u) const { return A + (size_t)u.pm * (size_t)(BM * 2) * K; }
    __device__ __forceinline__ const char* b_base(const Unit& u) const { return Bt + (size_t)u.pn * (size_t)(BM * 2) * K; }
    __device__ __forceinline__ const char* g_base() const { return A; }
    __device__ __forceinline__ unsigned a_off(const Unit& u, int h, int R) const { return 0u; }
};

struct StaggerOrder : StaticOrder {
    static constexpr bool PARTIAL = true;
    __device__ __forceinline__ bool next(int i, Unit& u) const {
        const bool gb = (c >> 3) & 1; const int n = (nwg - c + G - 1) / G;
        if (gb && i > n) return false;
        const bool hf = gb && (i == 0 || i == n);
        if (!StaticOrder::next(hf ? 0 : i, u)) return false;
        if (hf) { u.roff = (i == 0) ? 0 : 128; u.nr = 128; u.nv = 128; }
        return true;
    }
    __device__ __forceinline__ const char* a_base(const Unit& u) const { return A + ((size_t)u.pm * BM + u.roff) * (size_t)(2 * K); }
};
#ifdef TIME_KLOOP
struct StaticOrderDbl : StaticOrder { __device__ __forceinline__ bool next(int i, Unit& u) const { const bool r = StaticOrder::next(i >> 1, u); u.e = i & 1; return r; } };
#endif
template <class Epi, class Sched, bool GATHER, bool ALIGN_EPI>
__device__ __forceinline__ void gemm_phase(LAS unsigned char* lds, const int K, const Sched& S, const Epi& E) {
    int tid = threadIdx.x; asm volatile("" : "+v"(tid));
    const int wid = __builtin_amdgcn_readfirstlane(tid >> 6), lane = tid & 63, wr = wid >> 2, wc = wid & 3, fr = lane & 15, fq = lane >> 4;
    const int nt = K / BK;
    unsigned voffA[2], voffB[2];
#pragma unroll
    for (int i = 0; i < 2; ++i) { int R, C; stage_rc(tid * 16 + i * 8192, R, C); const int Rb = Epi::PERM ? ((R & ~31) + perm32(R & 31)) : R;
        voffA[i] = (unsigned)(R * K + C) * 2u; voffB[i] = (unsigned)(Rb * K + C) * 2u; }
    const size_t kstep = (size_t)(BK * 2);
    const size_t hstep = (size_t)HALF * K * 2;
    const unsigned ldsw = (unsigned)wid * 1024u;
    const int aoff = lds_byte(wr * 64 + fr, fq * 8), boff = lds_byte(wc * 32 + fr, fq * 8);
    const char* const gA = S.g_base();
#define PG8_SA(b, h) (((b) * 2 + (h)) * HTB)
#define PG8_SB(b, h) ((4 + (b) * 2 + (h)) * HTB)
#define PG8_GLDS(src, bufoff, i_) __builtin_amdgcn_global_load_lds((const unsigned*)(src), (LAS unsigned*)(lds + (bufoff) + ldsw + (i_) * 8192), 16, 0, 0)
#define PG8_STAGE_B(bufoff, gbase) do { _Pragma("unroll") for (int _i = 0; _i < 2; ++_i) PG8_GLDS((const char*)(gbase) + voffB[_i], bufoff, _i); } while (0)
#define PG8_STAGE_A(bufoff, pa, offs, h_, kb) do { _Pragma("unroll") for (int _i = 0; _i < 2; ++_i) { \
        if constexpr (GATHER) PG8_GLDS(gA + (size_t)((offs)[h_][_i] + (unsigned)(kb)), bufoff, _i); else PG8_GLDS((const char*)(pa) + (h_) * hstep + voffA[_i], bufoff, _i); } } while (0)
#define PG8_STAGE_A2(bufoff, pa, h_, kb) do { _Pragma("unroll") for (int _i = 0; _i < 2; ++_i) { \
        if constexpr (GATHER) PG8_GLDS(gA + (size_t)((last ? aon[h_][_i] : aoc[h_][_i] + t2off) + (unsigned)(kb)), bufoff, _i); else PG8_GLDS((const char*)(pa) + (h_) * hstep + voffA[_i], bufoff, _i); } } while (0)
#define PG8_LDA(dst, b, h) do { _Pragma("unroll") for (int m = 0; m < 4; ++m) _Pragma("unroll") for (int k = 0; k < 2; ++k) dst[m][k] = *(const LAS h16x8*)(lds + PG8_SA(b, h) + aoff + m * 2048 + k * 1024); } while (0)
#define PG8_LDB(dst, b, h) do { _Pragma("unroll") for (int n = 0; n < 2; ++n) _Pragma("unroll") for (int k = 0; k < 2; ++k) dst[n][k] = *(const LAS h16x8*)(lds + PG8_SB(b, h) + boff + n * 2048 + k * 1024); } while (0)
#define PG8_MMA(ai, bj, At, Bt) do { __builtin_amdgcn_s_setprio(1); _Pragma("unroll") for (int m = 0; m < 4; ++m) _Pragma("unroll") for (int n = 0; n < 2; ++n) _Pragma("unroll") for (int k = 0; k < 2; ++k) \
        acc[ai][bj][m][n] = __builtin_amdgcn_mfma_f32_16x16x32_f16(Bt[n][k], At[m][k], acc[ai][bj][m][n], 0, 0, 0); __builtin_amdgcn_s_setprio(0); } while (0)
#define PG8_WAIT_V(n) asm volatile("s_waitcnt vmcnt(" #n ")" ::: "memory")
#define PG8_WAIT_L(n) asm volatile("s_waitcnt lgkmcnt(" #n ")" ::: "memory")
#define PG8_BAR __builtin_amdgcn_s_barrier()
#define PG8_SCHED __builtin_amdgcn_sched_barrier(0)
    Unit cur, nxt; int ui = 0;
    unsigned pre[8] = {0u, 0u, 0u, 0u, 0u, 0u, 0u, 0u};
    if (!S.next(0, cur)) return;
    f32x4 acc[2][2][4][2];
#pragma unroll
    for (int a = 0; a < 2; ++a)
#pragma unroll
        for (int b = 0; b < 2; ++b)
#pragma unroll
            for (int m = 0; m < 4; ++m)
#pragma unroll
                for (int n = 0; n < 2; ++n) acc[a][b][m][n] = (f32x4){0.f, 0.f, 0.f, 0.f};
    h16x8 At[4][2], B0[2][2], B1[2][2];
    const char* cA = S.a_base(cur); const char* cB = S.b_base(cur);
    unsigned aoc[2][2], aon[2][2];
    if constexpr (GATHER) {
#pragma unroll
        for (int h = 0; h < 2; ++h)
#pragma unroll
            for (int i = 0; i < 2; ++i) { int R, C; stage_rc(tid * 16 + i * 8192, R, C); aoc[h][i] = S.a_off(cur, h, R) + (unsigned)(C * 2); aon[h][i] = aoc[h][i]; }
    }
    PG8_STAGE_B(PG8_SB(0, 0), cB); PG8_STAGE_B(PG8_SB(0, 1), cB + hstep); PG8_STAGE_A(PG8_SA(0, 0), cA, aoc, 0, 0); PG8_STAGE_A(PG8_SA(0, 1), cA, aoc, 1, 0);
    if (wr == 1) PG8_BAR;
    PG8_WAIT_V(2); PG8_BAR;
    PG8_STAGE_B(PG8_SB(1, 0), cB + kstep); PG8_STAGE_A(PG8_SA(1, 0), cA + kstep, aoc, 0, kstep); PG8_STAGE_B(PG8_SB(1, 1), cB + hstep + kstep);
    PG8_WAIT_V(6); PG8_BAR;
    for (;;) {
        const bool has_next = S.next(ui + 1, nxt);
        const bool half1 = Sched::PARTIAL ? (cur.nv > HALF) : true;
        const char* nA = has_next ? S.a_base(nxt) : cA; const char* nB = has_next ? S.b_base(nxt) : cB;
        if constexpr (GATHER) {
#pragma unroll
            for (int h = 0; h < 2; ++h)
#pragma unroll
                for (int i = 0; i < 2; ++i) { int R, C; stage_rc(tid * 16 + i * 8192, R, C); aon[h][i] = has_next ? S.a_off(nxt, h, R) + (unsigned)(C * 2) : aoc[h][i]; }
        }
        for (int t = 0; t < nt; t += 2) {
            const bool last = (t == nt - 2);
            if (last) E.pre(cur, wr, fr, pre);
            const char* a1 = cA + (size_t)(t + 1) * kstep;
            const char* a2 = last ? nA : cA + (size_t)(t + 2) * kstep; const char* b2 = last ? nB : cB + (size_t)(t + 2) * kstep;
            const char* a3 = a2 + kstep; const char* b3 = b2 + kstep;
            const unsigned t2off = (unsigned)((t + 2) * (int)kstep);
            PG8_LDB(B0, 0, 0); PG8_LDB(B1, 0, 1); PG8_SCHED; PG8_LDA(At, 0, 0); PG8_STAGE_A(PG8_SA(1, 1), a1, aoc, 1, (t + 1) * (int)kstep);
            PG8_WAIT_V(8); PG8_WAIT_L(0); PG8_BAR; PG8_MMA(0, 0, At, B0); PG8_MMA(0, 1, At, B1); PG8_BAR; PG8_SCHED;
            if (half1) PG8_LDA(At, 0, 1); PG8_STAGE_B(PG8_SB(0, 0), b2); PG8_STAGE_B(PG8_SB(0, 1), b2 + hstep); PG8_STAGE_A2(PG8_SA(0, 0), a2, 0, 0);
            PG8_WAIT_V(8); PG8_WAIT_L(0); PG8_BAR; if (half1) { PG8_MMA(1, 0, At, B0); PG8_MMA(1, 1, At, B1); } PG8_BAR; PG8_SCHED;
            PG8_LDB(B0, 1, 0); PG8_LDB(B1, 1, 1); PG8_SCHED; PG8_LDA(At, 1, 0); PG8_STAGE_A2(PG8_SA(0, 1), a2, 1, 0);
            PG8_WAIT_V(8); PG8_WAIT_L(0); PG8_BAR; PG8_MMA(0, 0, At, B0); PG8_MMA(0, 1, At, B1); PG8_BAR; PG8_SCHED;
            if (half1) PG8_LDA(At, 1, 1); PG8_STAGE_B(PG8_SB(1, 0), b3); PG8_STAGE_B(PG8_SB(1, 1), b3 + hstep); PG8_STAGE_A2(PG8_SA(1, 0), a3, 0, kstep);
            PG8_WAIT_V(8); PG8_WAIT_L(0); PG8_BAR; if (half1) { PG8_MMA(1, 0, At, B0); PG8_MMA(1, 1, At, B1); } PG8_BAR; PG8_SCHED;
        }
        if constexpr (ALIGN_EPI) { if (wr == 0) PG8_BAR; }
        E(acc, cur, wr, wc, fr, fq, pre);
        if (!has_next) break;
#pragma unroll
        for (int a = 0; a < 2; ++a)
#pragma unroll
            for (int b = 0; b < 2; ++b)
#pragma unroll
                for (int m = 0; m < 4; ++m)
#pragma unroll
                    for (int n = 0; n < 2; ++n) acc[a][b][m][n] = (f32x4){0.f, 0.f, 0.f, 0.f};
        cur = nxt; cA = nA; cB = nB; ++ui;
        if constexpr (GATHER) {
#pragma unroll
            for (int h = 0; h < 2; ++h)
#pragma unroll
                for (int i = 0; i < 2; ++i) aoc[h][i] = aon[h][i];
        }
        if constexpr (ALIGN_EPI) { if (wr == 1) PG8_BAR; }
    }
    PG8_WAIT_V(0);
    if constexpr (!ALIGN_EPI) { if (wr == 0) PG8_BAR; }
    PG8_BAR;
#undef PG8_SA
#undef PG8_SB
#undef PG8_GLDS
#undef PG8_STAGE_A
#undef PG8_STAGE_A2
#undef PG8_STAGE_B
#undef PG8_LDA
#undef PG8_LDB
#undef PG8_MMA
#undef PG8_WAIT_V
#undef PG8_WAIT_L
#undef PG8_BAR
#undef PG8_SCHED
}
}
#define REGBAR16(a) asm volatile("" : "+v"(a[0]), "+v"(a[1]), "+v"(a[2]), "+v"(a[3]), "+v"(a[4]), "+v"(a[5]), "+v"(a[6]), "+v"(a[7]), "+v"(a[8]), "+v"(a[9]), "+v"(a[10]), "+v"(a[11]), "+v"(a[12]), "+v"(a[13]), "+v"(a[14]), "+v"(a[15]))
#define REGBAR8(a) asm volatile("" : "+v"(a[0]), "+v"(a[1]), "+v"(a[2]), "+v"(a[3]), "+v"(a[4]), "+v"(a[5]), "+v"(a[6]), "+v"(a[7]))
#define REGBAR4(a) asm volatile("" : "+v"(a[0]), "+v"(a[1]), "+v"(a[2]), "+v"(a[3]))
__device__ __forceinline__ float sum16(const float* p16) { const f32x4 a = *(const f32x4*)p16, b = *(const f32x4*)(p16 + 4), c = *(const f32x4*)(p16 + 8), d = *(const f32x4*)(p16 + 12);
    return (((a.x + a.y) + (a.z + a.w)) + ((b.x + b.y) + (b.z + b.w))) + (((c.x + c.y) + (c.z + c.w)) + ((d.x + d.y) + (d.z + d.w))); }
using pg8::Unit;
constexpr int W13_SCAN_ITEMS = 1024;
constexpr int W13_EARLY_E = 8;
constexpr int P0_ITEMS_WIN = 16 * 256, P0_ITEMS_ALL = 16 * 256 + 3 * 16 * 32;
struct EpiProj {
    static constexpr bool PERM = true;
    __device__ __forceinline__ void pre(const Unit& u, int wr, int fr, unsigned (&o)[8]) const { const int row0 = u.pm * 256 + u.roff + wr * 64 + fr;
        _Pragma("unroll") for (int i = 0; i < 8; ++i) o[i] = __builtin_bit_cast(unsigned, rstd0[row0 + (i >> 2) * 128 + (i & 3) * 16]); }
    const float* rstd0; const float* b_gate; h16* QK; h16* V; h16* OG; h16* UG; h16* SV; float* sssv; bool doat;
    __device__ __forceinline__ void operator()(const f32x4 (&acc)[2][2][4][2], const Unit& u, int wr, int wc, int fr, int fq, const unsigned (&pre)[8]) const {
#ifdef TIME_KLOOP
        if (u.e == 0) return;
#endif
        const int row0 = u.pm * 256 + u.roff + wr * 64 + fr, cw = wc * 32 + 8 * fq, pn = u.pn, nai = (u.nv > 128) ? 2 : 1;
        float rsv[8];
#pragma unroll
        for (int i = 0; i < 8; ++i) rsv[i] = __builtin_bit_cast(float, pre[i]);
        if (pn < 12) {
            h16* base; int ld, col;
            if (pn < 8) { base = QK; ld = 2048; col = pn * 256; } else { base = V; ld = 1024; col = (pn - 8) * 256; }
#pragma unroll
            for (int ai = 0; ai < 2; ++ai) if (ai < nai)
#pragma unroll
                for (int m = 0; m < 4; ++m) { const int row = row0 + ai * 128 + m * 16; const float rs = rsv[ai * 4 + m]; h16* rp = base + (size_t)row * ld + col + cw;
#pragma unroll
                    for (int bj = 0; bj < 2; ++bj) *(u32x4*)(rp + bj * 128) = pk_h8(acc[ai][bj][m][0] * rs, acc[ai][bj][m][1] * rs); }
        } else if (pn < 28) {
            const bool isO = pn < 20; h16* base = isO ? OG : UG; const int c0 = (isO ? pn - 12 : pn - 20) * 128 + cw; const float* bg = b_gate + (isO ? 0 : 1024) + c0;
            const f32x4 b0 = *(const f32x4*)bg, b1 = *(const f32x4*)(bg + 4);
#pragma unroll
            for (int ai = 0; ai < 2; ++ai) if (ai < nai)
#pragma unroll
                for (int m = 0; m < 4; ++m) { const int row = row0 + ai * 128 + m * 16; const float rs = rsv[ai * 4 + m];
                    f32x4 a0 = acc[ai][0][m][0] * rs, a1 = acc[ai][0][m][1] * rs; const f32x4 g0 = acc[ai][1][m][0] * rs + b0, g1 = acc[ai][1][m][1] * rs + b1;
                    if (isO) {
#pragma unroll
                        for (int j = 0; j < 4; ++j) { a0[j] = __builtin_amdgcn_rcpf((1.f + __expf(-a0[j])) * (1.f + __expf(-g0[j]))); a1[j] = __builtin_amdgcn_rcpf((1.f + __expf(-a1[j])) * (1.f + __expf(-g1[j]))); }
                    } else {
#pragma unroll
                        for (int j = 0; j < 4; ++j) { const float u0 = 1.5957691216057308f * (a0[j] + 0.044715f * a0[j] * a0[j] * a0[j]), u1 = 1.5957691216057308f * (a1[j] + 0.044715f * a1[j] * a1[j] * a1[j]);
                            a0[j] = a0[j] * __builtin_amdgcn_rcpf((1.f + __expf(-u0)) * (1.f + __expf(-g0[j]))); a1[j] = a1[j] * __builtin_amdgcn_rcpf((1.f + __expf(-u1)) * (1.f + __expf(-g1[j]))); }
                    }
                    *(u32x4*)(base + (size_t)row * 1024 + c0) = pk_h8(a0, a1); }
        } else {
            const int col = (pn - 28) * 256 + cw;
#pragma unroll
            for (int ai = 0; ai < 2; ++ai) if (ai < nai)
#pragma unroll
                for (int m = 0; m < 4; ++m) { const int row = row0 + ai * 128 + m * 16; const float rs = rsv[ai * 4 + m]; float sum = 0.f;
#pragma unroll
                    for (int bj = 0; bj < 2; ++bj) { f32x4 a0 = acc[ai][bj][m][0] * rs, a1 = acc[ai][bj][m][1] * rs;
#pragma unroll
                        for (int j = 0; j < 4; ++j) { a0[j] = fgelu(a0[j]); a1[j] = fgelu(a1[j]); sum += a0[j] * a0[j] + a1[j] * a1[j]; }
                        *(u32x4*)(SV + (size_t)row * 1024 + col + bj * 128) = pk_h8(a0, a1); }
                    sum += __shfl_xor(sum, 16); sum += __shfl_xor(sum, 32);
                    if (fq == 0) sssv[row * 16 + (pn - 28) * 4 + wc] = sum; }
        }
    }
};
struct EpiKV {
    static constexpr bool PERM = true;
    __device__ __forceinline__ void pre(const Unit&, int, int, unsigned (&)[8]) const {}
    const float* rstdm; h16* KM; h16* VM;
    __device__ __forceinline__ void operator()(const f32x4 (&acc)[2][2][4][2], const Unit& u, int wr, int wc, int fr, int fq, const unsigned (&pre)[8]) const {
        const int row0 = u.pm * 256 + wr * 64 + fr, cw = wc * 32 + 8 * fq, pn = u.pn; h16* base = (pn < 4) ? KM + pn * 256 : VM + (pn - 4) * 256;
        float rsv[8];
#pragma unroll
        for (int i = 0; i < 8; ++i) rsv[i] = rstdm[row0 + (i >> 2) * 128 + (i & 3) * 16];
        REGBAR8(rsv);
#pragma unroll
        for (int ai = 0; ai < 2; ++ai)
#pragma unroll
            for (int m = 0; m < 4; ++m) { const int row = row0 + ai * 128 + m * 16; const float rs = rsv[ai * 4 + m];
#pragma unroll
                for (int bj = 0; bj < 2; ++bj) *(u32x4*)(base + (size_t)row * 1024 + bj * 128 + cw) = pk_h8(acc[ai][bj][m][0] * rs, acc[ai][bj][m][1] * rs); }
    }
};
template <bool RES16>
struct EpiResid {
    static constexpr bool PERM = true;
    __device__ __forceinline__ void pre(const Unit&, int, int, unsigned (&)[8]) const {}
    const void* resid; h16* outh; float* ss; bool doat;
    __device__ __forceinline__ void operator()(const f32x4 (&acc)[2][2][4][2], const Unit& u, int wr, int wc, int fr, int fq, const unsigned (&pre)[8]) const {
        const int row0 = u.pm * 256 + wr * 64 + fr, cw = u.pn * 256 + wc * 32 + 8 * fq;
        if constexpr (RES16) {
#pragma unroll
            for (int ai = 0; ai < 2; ++ai) {
                h16x8 hv[8];
#pragma unroll
                for (int m = 0; m < 4; ++m)
#pragma unroll
                    for (int bj = 0; bj < 2; ++bj) hv[m * 2 + bj] = *(const h16x8*)((const h16*)resid + (size_t)(row0 + ai * 128 + m * 16) * DM + cw + bj * 128);
                REGBAR8(hv);
#pragma unroll
                for (int m = 0; m < 4; ++m) { const int row = row0 + ai * 128 + m * 16; float sum = 0.f;
#pragma unroll
                    for (int bj = 0; bj < 2; ++bj) { const h16x8 r = hv[m * 2 + bj];
                        const f32x4 v0 = (f32x4){(float)r[0], (float)r[1], (float)r[2], (float)r[3]} + acc[ai][bj][m][0], v1 = (f32x4){(float)r[4], (float)r[5], (float)r[6], (float)r[7]} + acc[ai][bj][m][1];
                        const h16x4 h0 = __builtin_convertvector(v0, h16x4), h1 = __builtin_convertvector(v1, h16x4);
                        *(h16x8*)(outh + (size_t)row * DM + cw + bj * 128) = __builtin_shufflevector(h0, h1, 0, 1, 2, 3, 4, 5, 6, 7);
                        const f32x4 q0 = __builtin_convertvector(h0, f32x4), q1 = __builtin_convertvector(h1, f32x4);
                        sum += ((q0[0] * q0[0] + q0[1] * q0[1]) + (q0[2] * q0[2] + q0[3] * q0[3])) + ((q1[0] * q1[0] + q1[1] * q1[1]) + (q1[2] * q1[2] + q1[3] * q1[3])); }
                    sum += __shfl_xor(sum, 16); sum += __shfl_xor(sum, 32);
                    if (fq == 0) ss[row * 16 + u.pn * 4 + wc] = sum; }
            }
        } else {
#pragma unroll
            for (int ai = 0; ai < 2; ++ai) {
                f32x4 rv[16];
#pragma unroll
                for (int m = 0; m < 4; ++m)
#pragma unroll
                    for (int bj = 0; bj < 2; ++bj)
#pragma unroll
                        for (int n = 0; n < 2; ++n) rv[m * 4 + bj * 2 + n] = *(const f32x4*)((const float*)resid + (size_t)(row0 + ai * 128 + m * 16) * DM + cw + bj * 128 + 4 * n);
                REGBAR16(rv);
#pragma unroll
                for (int m = 0; m < 4; ++m) { const int row = row0 + ai * 128 + m * 16; float sum = 0.f;
#pragma unroll
                    for (int bj = 0; bj < 2; ++bj) { const f32x4 v0 = rv[m * 4 + bj * 2] + acc[ai][bj][m][0], v1 = rv[m * 4 + bj * 2 + 1] + acc[ai][bj][m][1];
                        const h16x4 h0 = __builtin_convertvector(v0, h16x4), h1 = __builtin_convertvector(v1, h16x4);
                        *(h16x8*)(outh + (size_t)row * DM + cw + bj * 128) = __builtin_shufflevector(h0, h1, 0, 1, 2, 3, 4, 5, 6, 7);
                        const f32x4 q0 = __builtin_convertvector(h0, f32x4), q1 = __builtin_convertvector(h1, f32x4);
                        sum += ((q0[0] * q0[0] + q0[1] * q0[1]) + (q0[2] * q0[2] + q0[3] * q0[3])) + ((q1[0] * q1[0] + q1[1] * q1[1]) + (q1[2] * q1[2] + q1[3] * q1[3])); }
                    sum += __shfl_xor(sum, 16); sum += __shfl_xor(sum, 32);
                    if (fq == 0) ss[row * 16 + u.pn * 4 + wc] = sum; }
            }
        }
    }
};
struct EpiQ {
    static constexpr bool PERM = true;
    __device__ __forceinline__ void pre(const Unit&, int, int, unsigned (&)[8]) const {}
    const float* ss1; h16* Q; const LAS float* rsl;
    __device__ __forceinline__ void operator()(const f32x4 (&acc)[2][2][4][2], const Unit& u, int wr, int wc, int fr, int fq, const unsigned (&pre)[8]) const {
        const int row0 = u.pm * 256 + wr * 64 + fr, col0 = u.pn * 256 + wc * 32 + 8 * fq;
        if (rsl) {
#pragma unroll
            for (int ai = 0; ai < 2; ++ai)
#pragma unroll
                for (int m = 0; m < 4; ++m) { const int row = row0 + ai * 128 + m * 16; const float rs = rsl[wr * 64 + fr + ai * 128 + m * 16];
#pragma unroll
                    for (int bj = 0; bj < 2; ++bj) *(u32x4*)(Q + (size_t)row * DM + col0 + bj * 128) = pk_h8(acc[ai][bj][m][0] * rs, acc[ai][bj][m][1] * rs); }
            return;
        }
        float rsv[8];
#pragma unroll
        for (int hb = 0; hb < 2; ++hb) { f32x4 pv[16];
#pragma unroll
            for (int i = 0; i < 4; ++i)
#pragma unroll
                for (int q = 0; q < 4; ++q) pv[i * 4 + q] = *(const f32x4*)(ss1 + (size_t)(row0 + hb * 128 + i * 16) * 16 + 4 * q);
            REGBAR16(pv);
#pragma unroll
            for (int i = 0; i < 4; ++i) { const f32x4 a = pv[i * 4], b = pv[i * 4 + 1], c = pv[i * 4 + 2], d = pv[i * 4 + 3];
                rsv[hb * 4 + i] = (((a.x + a.y) + (a.z + a.w)) + ((b.x + b.y) + (b.z + b.w))) + (((c.x + c.y) + (c.z + c.w)) + ((d.x + d.y) + (d.z + d.w))); } }
#pragma unroll
        for (int ai = 0; ai < 2; ++ai)
#pragma unroll
            for (int m = 0; m < 4; ++m) { const int row = row0 + ai * 128 + m * 16; const float rs = rsqrtf(rsv[ai * 4 + m] * (1.f / DM) + EPS) * 0.0625f;
#pragma unroll
                for (int bj = 0; bj < 2; ++bj) *(u32x4*)(Q + (size_t)row * DM + col0 + bj * 128) = pk_h8(acc[ai][bj][m][0] * rs, acc[ai][bj][m][1] * rs); }
    }
};
struct MoeOrder {
    static constexpr bool PARTIAL = true;
    const char* A; const char* Bt; int K; size_t bexp; const int* list; const unsigned* cnt; const LAS int* tab; int G, c; const char* Bt0; int ne0;
    __device__ __forceinline__ bool next(int i, Unit& u) const {
        const int xcd = c & 7, slot = c >> 3, ns = G >> 3;
        int n0 = tab[xcd + 1] - tab[xcd], n1 = tab[xcd + 9] - tab[xcd + 8], n2 = tab[xcd + 17] - tab[xcd + 16], n3 = tab[xcd + 25] - tab[xcd + 24];
        const int total = 4 * (n0 + n1 + n2 + n3), F = (total / ns) * ns, R = total - F; const bool split = (R > 0) && (2 * R <= ns);
        const int L = i * ns + slot; int Lu, half = -1;
        if (L < F || !split) { if (L >= total) return false; Lu = L; }
        else { const int idx = L - F; if (idx >= 2 * R) return false; Lu = F + (idx >> 1); half = idx & 1; }
        int j = Lu >> 2, e = xcd;
        if (j >= n0) { j -= n0; e += 8; if (j >= n1) { j -= n1; e += 8; if (j >= n2) { j -= n2; e += 8; } } }
        const int rb = j; u.pm = tab[e] + rb; u.pn = Lu & 3; u.e = e; u.rb = rb; const int left = (int)__hip_atomic_load(cnt + e * 64, __ATOMIC_RELAXED, __HIP_MEMORY_SCOPE_AGENT) - rb * 256;
        const int nvf = left < 256 ? left : 256;
        if (half < 0) { u.roff = 0; u.nr = 256; u.nv = nvf; } else { u.roff = 128 * half; u.nr = 128; const int v = nvf - u.roff; u.nv = v < 0 ? 0 : (v > 128 ? 128 : v); }
        return true;
    }
    __device__ __forceinline__ const char* a_base(const Unit& u) const { return A + (size_t)(u.pm * 256 + u.roff) * (size_t)(2 * K); }
    __device__ __forceinline__ const char* b_base(const Unit& u) const { return (u.e < ne0 ? Bt0 : Bt) + (size_t)u.e * bexp + (size_t)u.pn * (size_t)(256 * 2) * K; }
    __device__ __forceinline__ const char* g_base() const { return A; }
    __device__ __forceinline__ unsigned a_off(const Unit& u, int h, int R) const { const int r = h * 128 + R; const int tok = (r < u.nv) ? (list[u.e * NTOK + u.rb * 256 + u.roff + r] >> 1) : 0; return (unsigned)tok * (unsigned)(K * 2); }
};
struct EpiFfn1 {
    static constexpr bool PERM = true;
    __device__ __forceinline__ void pre(const Unit&, int, int, unsigned (&)[8]) const {}
    const int* list; const float* ss2; h16* H;
    __device__ __forceinline__ void operator()(const f32x4 (&acc)[2][2][4][2], const Unit& u, int wr, int wc, int fr, int fq, const unsigned (&pre)[8]) const {
        const int r0 = wr * 64 + fr, cw = wc * 32 + 8 * fq;
        float rsv[8];
#pragma unroll
        for (int i = 0; i < 8; ++i) { const int r = r0 + (i >> 2) * 128 + (i & 3) * 16; rsv[i] = ss2[u.e * NTOK + u.rb * 256 + u.roff + (r < u.nv ? r : 0)]; }
        REGBAR8(rsv);
#pragma unroll
        for (int ai = 0; ai < 2; ++ai)
#pragma unroll
            for (int m = 0; m < 4; ++m) { const int r = r0 + ai * 128 + m * 16;
                const float rs = rsv[ai * 4 + m];
                f32x4 a0 = acc[ai][0][m][0] * rs, a1 = acc[ai][0][m][1] * rs; const f32x4 b0 = acc[ai][1][m][0] * rs, b1 = acc[ai][1][m][1] * rs;
#pragma unroll
                for (int j = 0; j < 4; ++j) { a0[j] = fsilu(a0[j]) * b0[j]; a1[j] = fsilu(a1[j]) * b1[j]; }
                if (r < u.nr) *(u32x4*)(H + ((size_t)u.pm * 256 + u.roff + r) * FF + u.pn * 128 + cw) = pk_h8(a0, a1); }
    }
};
struct EpiFfn2 {
    static constexpr bool PERM = true;
    __device__ __forceinline__ void pre(const Unit&, int, int, unsigned (&)[8]) const {}
    const int* list; const float* gate; h16* Y;
    __device__ __forceinline__ void operator()(const f32x4 (&acc)[2][2][4][2], const Unit& u, int wr, int wc, int fr, int fq, const unsigned (&pre)[8]) const {
        const int r0 = wr * 64 + fr, cw = u.pn * 256 + wc * 32 + 8 * fq;
        int slv[8]; float gv[8];
#pragma unroll
        for (int i = 0; i < 8; ++i) { const int r = r0 + (i >> 2) * 128 + (i & 3) * 16, li = u.e * NTOK + u.rb * 256 + u.roff + (r < u.nv ? r : 0); slv[i] = list[li]; gv[i] = gate[li]; }
        REGBAR8(slv); REGBAR8(gv);
#pragma unroll
        for (int ai = 0; ai < 2; ++ai)
#pragma unroll
            for (int m = 0; m < 4; ++m) { const int r = r0 + ai * 128 + m * 16;
                if (r < u.nv) { const int slot = slv[ai * 4 + m]; const float g = gv[ai * 4 + m];
#pragma unroll
                    for (int bj = 0; bj < 2; ++bj) *(u32x4*)(Y + (size_t)slot * DM + cw + bj * 128) = pk_h8(acc[ai][bj][m][0] * g, acc[ai][bj][m][1] * g); } }
    }
};


typedef short s16x4 __attribute__((ext_vector_type(4)));
__device__ __forceinline__ h16x4 tr_read4(const LAS unsigned char* p) { return __builtin_bit_cast(h16x4, __builtin_amdgcn_ds_read_tr16_b64_v4i16((LAS s16x4*)p)); }
__device__ __forceinline__ h16x8 cat8(h16x4 a, h16x4 b) { return __builtin_shufflevector(a, b, 0, 1, 2, 3, 4, 5, 6, 7); }
__device__ __forceinline__ h16x4 cvt4(f32x4 v) { return __builtin_convertvector(v, h16x4); }
__device__ __forceinline__ void glds16_asm(const void* gsrc, unsigned lds_dst) { unsigned keep;
    asm volatile("s_mov_b32 %0, m0\n\ts_mov_b32 m0, %2\n\ts_nop 0\n\tglobal_load_lds_dwordx4 %1, off\n\ts_mov_b32 m0, %0" : "=&s"(keep) : "v"(gsrc), "s"(lds_dst) : "memory"); }
#define GLDS16(src, dst) glds16_asm((const void*)(src), __builtin_amdgcn_readfirstlane((unsigned)(size_t)(dst)))
constexpr int ATT_UNITS = 512, ATT_CH = 32768;
__device__ __forceinline__ void attn_issue(LAS unsigned char* lds, const h16* KM, const h16* VM, int c, int G, int bx, int wid, int lane, int fh, int ft0) {
    const int i = c >> 3, n = c & 7, L = i * G + bx, hd = (fh >= 0) ? fh : (L & 3), tile = (fh >= 0) ? ft0 + i : (L >> 2), b = tile >> 6;
    LAS unsigned char* buf = lds + (unsigned)(c & 3) * ATT_CH;
    if (n < 4) { const char* Kb = (const char*)(KM + (size_t)(b * 256) * 1024 + hd * 256) + n * 128;
#pragma unroll
        for (int q = 0; q < 4; ++q) { const int I = wid * 4 + q, row = I * 8 + (lane >> 3), slot = (lane & 7) ^ ((row >> 1) & 7); GLDS16(Kb + (size_t)row * 2048 + slot * 16, buf + I * 1024); }
    } else { const char* Vb = (const char*)(VM + (size_t)(b * 256 + 64 * (n - 4)) * 1024 + hd * 256);
#pragma unroll
        for (int q = 0; q < 4; ++q) { const int I = wid * 4 + q, row = I * 2 + (lane >> 5), ch = (lane & 31) ^ ((row & 7) << 1); GLDS16(Vb + (size_t)row * 2048 + ch * 16, buf + I * 1024); }
    }
}
__device__ __forceinline__ void glds16_s(const void* sbase, unsigned voff, unsigned lds_dst) {
    unsigned keep;
    asm volatile("s_mov_b32 %0, m0\n\ts_mov_b32 m0, %3\n\ts_nop 0\n\tglobal_load_lds_dwordx4 %1, %2\n\ts_mov_b32 m0, %0" : "=&s"(keep) : "v"(voff), "s"(sbase), "s"(lds_dst) : "memory"); }
__device__ __forceinline__ void attn_issue8(LAS unsigned char* lds, const h16* KM, const h16* VM, int n, int w4, int lane, int hd, int tile) {
    const int b = tile >> 6;
    const unsigned bufo = __builtin_amdgcn_readfirstlane((unsigned)(size_t)(lds + (unsigned)(n & 3) * ATT_CH)) + (unsigned)w4 * 8192u;
    if (n < 4) { const char* Kb = (const char*)(KM + (size_t)(b * 256 + w4 * 64) * 1024 + hd * 256) + n * 128;
        const unsigned ro = (unsigned)(lane >> 3) * 2048u;
#pragma unroll
        for (int q = 0; q < 8; ++q) { const unsigned slot = (unsigned)((lane & 7) ^ ((4 * (q & 1) + (lane >> 4)) & 7)); glds16_s(Kb + q * 16384, ro + slot * 16u, bufo + q * 1024); }
    } else { const char* Vb = (const char*)(VM + (size_t)(b * 256 + 64 * (n - 4) + w4 * 16) * 1024 + hd * 256);
        const unsigned ro = (unsigned)(lane >> 5) * 2048u;
#pragma unroll
        for (int q = 0; q < 8; ++q) { const unsigned ch = (unsigned)((lane & 31) ^ (((2 * (q & 3) + (lane >> 5)) & 7) << 1)); glds16_s(Vb + q * 4096, ro + ch * 16u, bufo + q * 1024); }
    }
}
__device__ __forceinline__ void attn_phase(LAS unsigned char* lds, const h16* Q, const h16* KM, const h16* VM, h16* ATT, int G, int bx, int fh, int ft0) {
    int tid = threadIdx.x; asm volatile("" : "+v"(tid));
    const int wid = __builtin_amdgcn_readfirstlane(tid >> 6), lane = tid & 63, fr = lane & 15, fq = lane >> 4;
    if (fh < 0 && bx >= ATT_UNITS) return;
    const int nun = (fh >= 0) ? 2 : (ATT_UNITS - bx + G - 1) / G, total = nun * 8;
    attn_issue(lds, KM, VM, 0, G, bx, wid, lane, fh, ft0); attn_issue(lds, KM, VM, 1, G, bx, wid, lane, fh, ft0); attn_issue(lds, KM, VM, 2, G, bx, wid, lane, fh, ft0);
    const int tq = (lane & 15) >> 2, tp = lane & 3;
    for (int i = 0; i < nun; ++i) {
        const int L = i * G + bx, hd = (fh >= 0) ? fh : (L & 3), tile = (fh >= 0) ? ft0 + i : (L >> 2); const int trow = tile * 128 + wid * 16 + fr;
        f32x4 S[16]; h16x8 qf[8], pf[8]; f32x4 O[16]; float linv = 0.f;
#pragma unroll
        for (int kt = 0; kt < 16; ++kt) S[kt] = (f32x4){0.f, 0.f, 0.f, 0.f};
#pragma unroll
        for (int n = 0; n < 8; ++n) {
            const int c = i * 8 + n;
            if (c + 2 < total) asm volatile("s_waitcnt vmcnt(8)" ::: "memory"); else asm volatile("s_waitcnt vmcnt(0)" ::: "memory");
            __builtin_amdgcn_s_barrier(); asm volatile("" ::: "memory");
            if (n == 0) {
#pragma unroll
                for (int st = 0; st < 8; ++st) qf[st] = *(const h16x8*)(Q + (size_t)trow * 1024 + hd * 256 + 32 * st + 8 * fq);
            }
            if (c + 3 < total) attn_issue(lds, KM, VM, c + 3, G, bx, wid, lane, fh, ft0);
            const LAS unsigned char* buf = lds + (unsigned)(c & 3) * ATT_CH;
            if (n < 4) {
#pragma unroll
                for (int k4 = 0; k4 < 4; ++k4) { h16x8 bf[8];
#pragma unroll
                    for (int i = 0; i < 8; ++i) { const int kt = 4 * k4 + (i >> 1), ks = i & 1, key = kt * 16 + fr, slot = 4 * ks + fq; bf[i] = *(const LAS h16x8*)(buf + key * 128 + ((slot ^ ((key >> 1) & 7)) * 16)); }
                    REGBAR8(bf);
#pragma unroll
                    for (int i = 0; i < 8; ++i) { const int kt = 4 * k4 + (i >> 1), ks = i & 1; S[kt] = __builtin_amdgcn_mfma_f32_16x16x32_f16(bf[i], qf[2 * n + ks], S[kt], 0, 0, 0); } }
                if (n == 3) {
                    float mx = -INFINITY;
#pragma unroll
                    for (int kt = 0; kt < 16; ++kt)
#pragma unroll
                        for (int j = 0; j < 4; ++j) mx = fmaxf(mx, S[kt][j]);
                    mx = fmaxf(mx, __shfl_xor(mx, 16)); mx = fmaxf(mx, __shfl_xor(mx, 32));
                    float l = 0.f;
#pragma unroll
                    for (int kt = 0; kt < 16; ++kt)
#pragma unroll
                        for (int j = 0; j < 4; ++j) { const float e = __expf(S[kt][j] - mx); S[kt][j] = e; l += e; }
                    l += __shfl_xor(l, 16); l += __shfl_xor(l, 32); linv = 1.f / l;
#pragma unroll
                    for (int st = 0; st < 8; ++st) pf[st] = cat8(cvt4(S[2 * st]), cvt4(S[2 * st + 1]));
                }
            } else {
                if (n == 4) {
#pragma unroll
                    for (int dt = 0; dt < 16; ++dt) O[dt] = (f32x4){0.f, 0.f, 0.f, 0.f};
                }
#pragma unroll
                for (int ks = 0; ks < 2; ++ks) { const int r0 = 32 * ks + 4 * fq + tq, r1 = r0 + 16;
#pragma unroll
                    for (int d8 = 0; d8 < 2; ++d8) { h16x8 vf[8];
#pragma unroll
                        for (int i = 0; i < 8; ++i) { const int dt = 8 * d8 + i;
                            vf[i] = cat8(tr_read4(buf + r0 * 512 + (((2 * dt + (tp >> 1)) ^ ((r0 & 7) << 1)) * 16) + (tp & 1) * 8), tr_read4(buf + r1 * 512 + (((2 * dt + (tp >> 1)) ^ ((r1 & 7) << 1)) * 16) + (tp & 1) * 8)); }
                        REGBAR8(vf);
#pragma unroll
                        for (int i = 0; i < 8; ++i) O[8 * d8 + i] = __builtin_amdgcn_mfma_f32_16x16x32_f16(vf[i], pf[2 * (n - 4) + ks], O[8 * d8 + i], 0, 0, 0); } }
                if (n == 7) {
#pragma unroll
                    for (int dt = 0; dt < 16; ++dt) { const f32x4 o = O[dt] * linv; u32x2 w; w.x = pk_h2(o[0], o[1]); w.y = pk_h2(o[2], o[3]);
                        *(u32x2*)(ATT + (size_t)trow * 1024 + hd * 256 + 16 * dt + 4 * fq) = w; }
                }
            }
        }
    }
    asm volatile("s_waitcnt vmcnt(0)" ::: "memory"); __builtin_amdgcn_s_barrier();
}


__device__ __forceinline__ unsigned xchg16(unsigned v, bool oddrow) { const auto r = __builtin_amdgcn_permlane16_swap(v, v, false, false); return oddrow ? r[0] : r[1]; }
#define PAIR_GET(seg_, odd_, lo_, hi_) do { const unsigned s0_ = (odd_) ? (seg_).x : (seg_).z, s1_ = (odd_) ? (seg_).y : (seg_).w, k0_ = (odd_) ? (seg_).z : (seg_).x, k1_ = (odd_) ? (seg_).w : (seg_).y; \
        const unsigned r0_ = xchg16(s0_, (odd_)), r1_ = xchg16(s1_, (odd_)); \
        (lo_).x = (odd_) ? r0_ : k0_; (lo_).y = (odd_) ? r1_ : k1_; (hi_).x = (odd_) ? k0_ : r0_; (hi_).y = (odd_) ? k1_ : r1_; } while (0)
#define PAIR_PUT(lo_, hi_, odd_, seg_) do { const unsigned s0_ = (odd_) ? (lo_).x : (hi_).x, s1_ = (odd_) ? (lo_).y : (hi_).y, k0_ = (odd_) ? (hi_).x : (lo_).x, k1_ = (odd_) ? (hi_).y : (lo_).y; \
        const unsigned r0_ = xchg16(s0_, (odd_)), r1_ = xchg16(s1_, (odd_)); \
        (seg_).x = (odd_) ? r0_ : k0_; (seg_).y = (odd_) ? r1_ : k1_; (seg_).z = (odd_) ? k0_ : r0_; (seg_).w = (odd_) ? k1_ : r1_; } while (0)
template <int MODE>
__device__ __forceinline__ void attn_pair(LAS unsigned char* lds, const h16* Q, const h16* KM, const h16* VM, h16* ATT, int G, int bx, int hd, int ft0) {
    int tid = threadIdx.x; asm volatile("" : "+v"(tid));
#ifdef TIME_ATSUB
    if (threadIdx.x == 0) *(LAS unsigned long long*)(lds + LDSCTL_OFF + 1024) = __builtin_amdgcn_s_memrealtime();
#define ATCK(k) do { if ((k) == TIME_ATSUB && bx == 37 && threadIdx.x == 0) { const unsigned long long dt = (__builtin_amdgcn_s_memrealtime() - *(LAS unsigned long long*)(lds + LDSCTL_OFF + 1024)) * 10ull, t0_ = __builtin_amdgcn_s_memrealtime(); while (__builtin_amdgcn_s_memrealtime() - t0_ < dt) __builtin_amdgcn_s_sleep(8); } } while (0)
#else
#define ATCK(k) do { } while (0)
#endif
    const int wid = __builtin_amdgcn_readfirstlane(tid >> 6), lane = tid & 63, fr = lane & 15, fq = lane >> 4;
    const int tq = (lane & 15) >> 2, tp = lane & 3;
    const int trow = ft0 * 128 + wid * 16 + fr;
    const int half = wid >> 2;
#define AP_ISSUE(c_) do { if (half == ((c_) & 1)) { int lo_ = tid & 63; asm volatile("" : "+v"(lo_)); attn_issue8(lds, KM, VM, (c_), wid & 3, lo_, hd, ft0); } } while (0)
    AP_ISSUE(0); AP_ISSUE(1); AP_ISSUE(2);
    h16x8 q0[8], q1[8];
#pragma unroll
    for (int st = 0; st < 8; ++st) { q0[st] = *(const h16x8*)(Q + (size_t)trow * 1024 + hd * 256 + 32 * st + 8 * fq); q1[st] = *(const h16x8*)(Q + (size_t)(trow + 128) * 1024 + hd * 256 + 32 * st + 8 * fq); }
    REGBAR8(q0); REGBAR8(q1);
    f32x4 S0[16], S1[16]; h16x8 p0[8], p1[8]; f32x4 O0[16], O1[16]; float linv0 = 0.f, linv1 = 0.f;
#pragma unroll
    for (int kt = 0; kt < 16; ++kt) { S0[kt] = (f32x4){0.f, 0.f, 0.f, 0.f}; S1[kt] = (f32x4){0.f, 0.f, 0.f, 0.f}; }
#pragma unroll
    for (int n = 0; n < 8; ++n) {
        if (half == (n & 1)) { if (n + 2 < 8) asm volatile("s_waitcnt vmcnt(8)" ::: "memory"); else asm volatile("s_waitcnt vmcnt(0)" ::: "memory"); }
        __builtin_amdgcn_s_barrier(); asm volatile("" ::: "memory");
        if (n + 3 < 8) AP_ISSUE(n + 3);
        const LAS unsigned char* buf = lds + (unsigned)(n & 3) * ATT_CH;
        if constexpr (MODE == 2) continue;
        if (MODE != 0 && n >= 4) { if (n == 7 && linv0 + linv1 == 123456.789f) { _Pragma("unroll") for (int st = 0; st < 8; ++st) { *(h16x8*)(ATT + (size_t)trow * 1024 + 8 * st) = p0[st]; *(h16x8*)(ATT + (size_t)trow * 1024 + 64 + 8 * st) = p1[st]; } } continue; }
        if (n < 4) {
            { h16x8 bf3[2][4];
#define AP_LDK(dst, k8_) do { _Pragma("unroll") for (int i = 0; i < 4; ++i) { const int kt = 2 * (k8_) + (i >> 1), ks = i & 1, key = kt * 16 + fr, slot = 4 * ks + fq; dst[i] = *(const LAS h16x8*)(buf + key * 128 + ((slot ^ ((key >> 1) & 7)) * 16)); } } while (0)
#define AP_MMK(src, k8_) do { _Pragma("unroll") for (int i = 0; i < 4; ++i) { const int kt = 2 * (k8_) + (i >> 1), ks = i & 1; \
                    S0[kt] = __builtin_amdgcn_mfma_f32_16x16x32_f16(src[i], q0[2 * n + ks], S0[kt], 0, 0, 0); \
                    S1[kt] = __builtin_amdgcn_mfma_f32_16x16x32_f16(src[i], q1[2 * n + ks], S1[kt], 0, 0, 0); } } while (0)
              AP_LDK(bf3[0], 0);
#pragma unroll
              for (int k8 = 0; k8 < 8; ++k8) {
                  if (k8 + 1 < 8) { AP_LDK(bf3[(k8 + 1) & 1], k8 + 1); } __builtin_amdgcn_sched_barrier(0);
                  REGBAR4(bf3[k8 & 1]); AP_MMK(bf3[k8 & 1], k8); __builtin_amdgcn_sched_barrier(0);
              }
#undef AP_LDK
#undef AP_MMK
            }
            if (n == 3) {
#define ATT_SOFTMAX(S_, p_, linv_) do { float mx = -INFINITY; \
                _Pragma("unroll") for (int kt = 0; kt < 16; ++kt) _Pragma("unroll") for (int j = 0; j < 4; ++j) mx = fmaxf(mx, S_[kt][j]); \
                mx = fmaxf(mx, __shfl_xor(mx, 16)); mx = fmaxf(mx, __shfl_xor(mx, 32)); float l = 0.f; \
                _Pragma("unroll") for (int kt = 0; kt < 16; ++kt) _Pragma("unroll") for (int j = 0; j < 4; ++j) { const float e = __expf(S_[kt][j] - mx); S_[kt][j] = e; l += e; } \
                l += __shfl_xor(l, 16); l += __shfl_xor(l, 32); linv_ = 1.f / l; \
                _Pragma("unroll") for (int st = 0; st < 8; ++st) p_[st] = cat8(cvt4(S_[2 * st]), cvt4(S_[2 * st + 1])); REGBAR8(p_); } while (0)
                ATT_SOFTMAX(S0, p0, linv0); ATT_SOFTMAX(S1, p1, linv1);
#undef ATT_SOFTMAX
            }
        } else {
            if (n == 4) {
#pragma unroll
                for (int dt = 0; dt < 16; ++dt) { O0[dt] = (f32x4){0.f, 0.f, 0.f, 0.f}; O1[dt] = (f32x4){0.f, 0.f, 0.f, 0.f}; }
            }
            { h16x8 vf3[2][4];
#define AP_LDV(dst, b_) do { int mo = 4 * (fq & 1) + tq; asm volatile("" : "+v"(mo)); const LAS unsigned char* rb = buf + (32 * ((b_) >> 2) + 4 * fq + tq) * 512 + (tp >> 1) * 16 + (tp & 1) * 8; \
                  _Pragma("unroll") for (int i = 0; i < 4; ++i) { const int dt = 4 * ((b_) & 3) + i; const int off = (((dt & 7) ^ mo) + (dt & 8)) * 32; dst[i] = cat8(tr_read4(rb + off), tr_read4(rb + off + 16 * 512)); } } while (0)
#define AP_MMV(src, b_) do { _Pragma("unroll") for (int i = 0; i < 4; ++i) { const int dt = 4 * ((b_) & 3) + i; \
                  O0[dt] = __builtin_amdgcn_mfma_f32_16x16x32_f16(src[i], p0[2 * (n - 4) + ((b_) >> 2)], O0[dt], 0, 0, 0); \
                  O1[dt] = __builtin_amdgcn_mfma_f32_16x16x32_f16(src[i], p1[2 * (n - 4) + ((b_) >> 2)], O1[dt], 0, 0, 0); } } while (0)
              AP_LDV(vf3[0], 0);
#pragma unroll
              for (int bq = 0; bq < 8; ++bq) {
                  if (bq + 1 < 8) { AP_LDV(vf3[(bq + 1) & 1], bq + 1); } __builtin_amdgcn_sched_barrier(0);
                  REGBAR4(vf3[bq & 1]); AP_MMV(vf3[bq & 1], bq); __builtin_amdgcn_sched_barrier(0);
              }
#undef AP_LDV
#undef AP_MMV
            }
            if (n == 7) {
                int t2 = threadIdx.x; asm volatile("" : "+v"(t2));
                const int fq2 = (t2 & 63) >> 4; const bool oddq = (fq2 & 1) != 0;
                h16* orow = ATT + (size_t)(ft0 * 128 + (t2 >> 6) * 16 + (t2 & 15)) * 1024 + hd * 256 + 16 * (fq2 & 1) + 4 * (fq2 & 2);
#pragma unroll
                for (int i = 0; i < 8; ++i) { const f32x4 a = O0[2 * i] * linv0, c2 = O0[2 * i + 1] * linv0; u32x2 lo, hi; lo.x = pk_h2(a[0], a[1]); lo.y = pk_h2(a[2], a[3]); hi.x = pk_h2(c2[0], c2[1]); hi.y = pk_h2(c2[2], c2[3]);
                    u32x4 seg; PAIR_PUT(lo, hi, oddq, seg); *(u32x4*)(orow + 32 * i) = seg; }
#pragma unroll
                for (int i = 0; i < 8; ++i) { const f32x4 a = O1[2 * i] * linv1, c2 = O1[2 * i + 1] * linv1; u32x2 lo, hi; lo.x = pk_h2(a[0], a[1]); lo.y = pk_h2(a[2], a[3]); hi.x = pk_h2(c2[0], c2[1]); hi.y = pk_h2(c2[2], c2[3]);
                    u32x4 seg; PAIR_PUT(lo, hi, oddq, seg); *(u32x4*)(orow + 128 * 1024 + 32 * i) = seg; }
            }
        }
    }
#undef AP_ISSUE
#undef ATCK
    asm volatile("s_waitcnt vmcnt(0)" ::: "memory"); __builtin_amdgcn_s_barrier();
}

__device__ __forceinline__ void mstate_ext(unsigned char* ws, int bh, int wave, int lane, LAS float* scr) {
    const float* ig = (const float*)(ws + OFF_IG); const float* lf = (const float*)(ws + OFF_LF);
    const int b = bh >> 2, h = bh & 3, tb = b * SEQ + lane * CHUNK + 16 * wave;
    float lv[16], iv[16];
#pragma unroll
    for (int q = 0; q < 4; ++q) { const f32x4 a = *(const f32x4*)(lf + (size_t)h * NTOK + tb + 4 * q), c2 = *(const f32x4*)(ig + (size_t)h * NTOK + tb + 4 * q);
#pragma unroll
        for (int r = 0; r < 4; ++r) { lv[4 * q + r] = a[r]; iv[4 * q + r] = c2[r]; } }
    float B = 0.f, mx = -INFINITY;
#pragma unroll
    for (int s = 0; s < 16; ++s) { B += lv[s]; mx = fmaxf(mx, iv[s] - B); }
    scr[wave * 64 + lane] = B; scr[512 + wave * 64 + lane] = mx;
    __syncthreads();
    float bpre = 0.f, rmpre = -INFINITY, btot = 0.f, mtot = -INFINITY;
#pragma unroll
    for (int w = 0; w < 8; ++w) { const float bw = scr[w * 64 + lane], mw = scr[512 + w * 64 + lane];
        if (w == wave) { bpre = btot; rmpre = mtot; }
        mtot = fmaxf(mtot, mw - btot); btot += bw; }
    const float blast = btot, maxw = btot + mtot;
    float fb = blast, fm = maxw;
#pragma unroll
    for (int d = 1; d < 64; d <<= 1) { const float pb = __shfl_up(fb, d), pm = __shfl_up(fm, d); if (lane >= d) { fm = fmaxf(fb + pm, fm); fb = fb + pb; } }
    const float mn = fmaxf(fb, fm);
    float mc = __shfl_up(mn, 1); if (lane == 0) mc = 0.f;
    if (wave == 0) { ((float*)(ws + OFF_MST))[bh * 64 + lane] = mc; ((float*)(ws + OFF_DEC))[bh * 64 + lane] = __expf(blast + mc - mn); }
    float* AL = (float*)(ws + OFF_AL); float* BE = (float*)(ws + OFF_BE); float* NM = (float*)(ws + OFF_NM); float* WU = (float*)(ws + OFF_WU);
    B = bpre; float rm = rmpre;
    float oa[16], ob[16], on[16], ow[16];
#pragma unroll
    for (int s = 0; s < 16; ++s) { B += lv[s]; rm = fmaxf(rm, iv[s] - B); const float mt = B + fmaxf(mc, rm); oa[s] = B - mt; ob[s] = iv[s] - B; on[s] = -mt; ow[s] = __expf(iv[s] - B + blast - mn); }
#pragma unroll
    for (int q = 0; q < 4; ++q) { const size_t o = (size_t)h * NTOK + tb + 4 * q;
        *(f32x4*)(AL + o) = (f32x4){oa[4 * q], oa[4 * q + 1], oa[4 * q + 2], oa[4 * q + 3]}; *(f32x4*)(BE + o) = (f32x4){ob[4 * q], ob[4 * q + 1], ob[4 * q + 2], ob[4 * q + 3]};
        *(f32x4*)(NM + o) = (f32x4){on[4 * q], on[4 * q + 1], on[4 * q + 2], on[4 * q + 3]}; *(f32x4*)(WU + o) = (f32x4){ow[4 * q], ow[4 * q + 1], ow[4 * q + 2], ow[4 * q + 3]}; }
    __syncthreads();
}

__device__ __forceinline__ h16x8 silu8_h(h16x8 y) {
    const h16x8 e = __builtin_elementwise_exp2(y * (h16)(-1.4426950408889634f)); const h16x8 d = e + (h16)1.f; h16x8 r;
#pragma unroll
    for (int i = 0; i < 8; ++i) r[i] = __builtin_amdgcn_rcph(d[i]);
    return y * r;
}
__device__ __forceinline__ int swz128(int row) { return (((row >> 1) & 1) | (((row >> 3) & 1) << 1)) << 1; }
#ifdef TIME_SCSUB
#define SCCK(k_) do { if ((k_) == TIME_SCSUB && task == 0 && c == 30 && threadIdx.x == 0) { const unsigned long long dt = (__builtin_amdgcn_s_memrealtime() - tsc_) * 20ull, t0_ = __builtin_amdgcn_s_memrealtime(); while (__builtin_amdgcn_s_memrealtime() - t0_ < dt) __builtin_amdgcn_s_sleep(8); } } while (0)
#define SCT0() if (c == 30) tsc_ = __builtin_amdgcn_s_memrealtime()
#else
#define SCCK(k_) do { } while (0)
#define SCT0() do { } while (0)
#endif
__device__ __forceinline__ void scan_task(LAS unsigned char* lds, const Ptrs& p, unsigned char* ws, int task) {
    unsigned long long tsc_ = 0ull; (void)tsc_;
    int tid = threadIdx.x; asm volatile("" : "+v"(tid));
    const int wid = __builtin_amdgcn_readfirstlane(tid >> 6), lane = tid & 63, fr = lane & 15, fq = lane >> 4;
    const int bh = task >> 4, et = (task >> 2) & 3, dtb = task & 3, b = bh >> 2, hd = bh & 3, e0 = et * 64, d0 = dtb * 64;
    const int cg = tid & 7, rp = tid >> 3, kcol = 1024 + hd * 256 + d0 + 8 * cg;
    h16x8 cwh[4], cbh;
#pragma unroll
    for (int j = 0; j < 4; ++j) cwh[j] = cat8(cvt4(*(const f32x4*)(p.conv_w + j * 2048 + kcol)), cvt4(*(const f32x4*)(p.conv_w + j * 2048 + kcol + 4)));
    cbh = cat8(cvt4(*(const f32x4*)(p.conv_b + kcol)), cvt4(*(const f32x4*)(p.conv_b + kcol + 4)));
    const h16* QK = (const h16*)p.out; const float* WU = (const float*)(ws + OFF_WU); const float* DEC = (const float*)(ws + OFF_DEC) + bh * 64;
    const h16* Vg = (const h16*)(ws + WS_V);
    h16* CST = (h16*)(ws + WS_CST) + (size_t)bh * 64 * CSTRIDE;
    const int dti = wid & 3, ep = wid >> 2; const bool doN = (et == 0) && (ep == 0);
    const int tq = (lane & 15) >> 2, tp = lane & 3;
    u32x4 raw[3][5]; float wu[3][2]; float dcv[3];
    f32x4 acc[2] = {(f32x4){0.f, 0.f, 0.f, 0.f}, (f32x4){0.f, 0.f, 0.f, 0.f}}; f32x4 nacc = (f32x4){0.f, 0.f, 0.f, 0.f};
    const h16x8 ones = {(h16)1.f, (h16)1.f, (h16)1.f, (h16)1.f, (h16)1.f, (h16)1.f, (h16)1.f, (h16)1.f};
#define SCAN_LOAD(c_, set_) do { const int t0_ = b * SEQ + (c_) * CHUNK; \
        _Pragma("unroll") for (int q = 0; q < 2; ++q) { const int I = wid * 2 + q, row = I * 8 + (lane >> 3), ch = (lane & 7) ^ swz128(row); \
            GLDS16((const char*)(Vg + (size_t)(t0_ + row) * 1024 + hd * 256 + e0) + ch * 16, lds + 32768 + ((c_) & 3) * 16384 + I * 1024); } \
        _Pragma("unroll") for (int k = 0; k < 5; ++k) { int tl = (c_) * CHUNK + 2 * rp - 3 + k; tl = tl < 0 ? 0 : tl; raw[set_][k] = *(const u32x4*)(QK + (size_t)(b * SEQ + tl) * 2048 + kcol); } \
        wu[set_][0] = WU[(size_t)hd * NTOK + t0_ + 2 * rp]; wu[set_][1] = WU[(size_t)hd * NTOK + t0_ + 2 * rp + 1]; dcv[set_] = DEC[c_]; } while (0)
#define SCAN_STORE(c_) do { \
        _Pragma("unroll") for (int j = 0; j < 2; ++j) { u32x2 w; w.x = pk_h2(acc[j][0], acc[j][1]); w.y = pk_h2(acc[j][2], acc[j][3]); \
            *(u32x2*)(CST + (size_t)(c_) * CSTRIDE + (size_t)(e0 + 16 * (2 * ep + j) + fr) * 256 + d0 + 16 * dti + 4 * fq) = w; } \
        if (doN && fr == 0) { u32x2 w; w.x = pk_h2(nacc[0], nacc[1]); w.y = pk_h2(nacc[2], nacc[3]); *(u32x2*)(CST + (size_t)(c_) * CSTRIDE + 65536 + d0 + 16 * dti + 4 * fq) = w; } } while (0)
#define SCAN_CONV(c_, set_) do { LAS unsigned char* kbw = lds + ((c_) & 1) * 16384; \
        if ((c_) == 0) { _Pragma("unroll") for (int k = 0; k < 3; ++k) if (2 * rp - 3 + k < 0) raw[set_][k] = (u32x4){0u, 0u, 0u, 0u}; } \
        _Pragma("unroll") for (int rr = 0; rr < 2; ++rr) { h16x8 yh = cbh; \
            _Pragma("unroll") for (int j = 0; j < 4; ++j) yh += cwh[j] * __builtin_bit_cast(h16x8, raw[set_][rr + j]); \
            const h16x8 ys = silu8_h(yh) * (h16)(0.0625f * wu[set_][rr]); \
            const int row = 2 * rp + rr; *(LAS u32x4*)(kbw + row * 128 + ((cg ^ swz128(row)) * 16)) = __builtin_bit_cast(u32x4, ys); } } while (0)
#define SCAN_STEP(c_, set_, nset_) do { const int c = (c_); SCT0(); \
        SCAN_STORE(c); SCCK(1); \
        LAS unsigned char* kb = lds + (c & 1) * 16384; LAS unsigned char* vb = lds + 32768 + (c & 3) * 16384; \
        SCCK(2); asm volatile("s_waitcnt lgkmcnt(0)" ::: "memory"); __builtin_amdgcn_s_barrier(); asm volatile("" ::: "memory"); SCCK(3); \
        const float dec = dcv[set_]; \
        if (c + 3 < NCHUNK - 1) SCAN_LOAD(c + 3, set_); \
        SCCK(4); acc[0] *= dec; acc[1] *= dec; nacc *= dec; \
        { h16x8 X[4], Y0[4], Y1[4]; \
        _Pragma("unroll") for (int ks = 0; ks < 4; ++ks) { const int r0 = 32 * ks + 8 * fq + tq, r1 = r0 + 4; \
            const int o0 = r0 * 128 + (tp & 1) * 8, o1 = r1 * 128 + (tp & 1) * 8, s0 = swz128(r0), s1 = swz128(r1), cx = 2 * dti + (tp >> 1), cy0 = 2 * (2 * ep) + (tp >> 1), cy1 = cy0 + 2; \
            X[ks] = cat8(tr_read4(kb + o0 + ((cx ^ s0) * 16)), tr_read4(kb + o1 + ((cx ^ s1) * 16))); \
            Y0[ks] = cat8(tr_read4(vb + o0 + ((cy0 ^ s0) * 16)), tr_read4(vb + o1 + ((cy0 ^ s1) * 16))); \
            Y1[ks] = cat8(tr_read4(vb + o0 + ((cy1 ^ s0) * 16)), tr_read4(vb + o1 + ((cy1 ^ s1) * 16))); } \
        REGBAR4(X); REGBAR4(Y0); REGBAR4(Y1); \
        _Pragma("unroll") for (int ks = 0; ks < 4; ++ks) { \
            acc[0] = __builtin_amdgcn_mfma_f32_16x16x32_f16(X[ks], Y0[ks], acc[0], 0, 0, 0); acc[1] = __builtin_amdgcn_mfma_f32_16x16x32_f16(X[ks], Y1[ks], acc[1], 0, 0, 0); \
            if (doN) nacc = __builtin_amdgcn_mfma_f32_16x16x32_f16(X[ks], ones, nacc, 0, 0, 0); } } \
        __builtin_amdgcn_sched_barrier(0); \
        if (c + 1 < NCHUNK - 1) SCAN_CONV(c + 1, nset_); SCCK(5); } while (0)
    SCAN_LOAD(0, 0); SCAN_LOAD(1, 1); SCAN_LOAD(2, 2);
    SCAN_CONV(0, 0);
#pragma unroll 1
    for (int c3 = 0; c3 < NCHUNK - 1; c3 += 3) { SCAN_STEP(c3, 0, 1); SCAN_STEP(c3 + 1, 1, 2); SCAN_STEP(c3 + 2, 2, 0); }
    SCAN_STORE(NCHUNK - 1);
#undef SCAN_CONV
#undef SCAN_STEP
#undef SCAN_STORE
#undef SCAN_LOAD
    asm volatile("s_waitcnt vmcnt(0) lgkmcnt(0)" ::: "memory"); __builtin_amdgcn_s_barrier();
}

__device__ __forceinline__ void scan_task2(LAS unsigned char* lds, const Ptrs& p, unsigned char* ws, int task) {
    int tid = threadIdx.x; asm volatile("" : "+v"(tid));
    const int wid = __builtin_amdgcn_readfirstlane(tid >> 6), lane = tid & 63, fr = lane & 15, fq = lane >> 4;
    const int bh = task >> 4, et = (task >> 2) & 3, dtb = task & 3, b = bh >> 2, hd = bh & 3, e0 = et * 64, d0 = dtb * 64;
    const int cg = tid & 7, rp = tid >> 3, kcol = 1024 + hd * 256 + d0 + 8 * cg;
    h16x8 cwh[4], cbh;
#pragma unroll
    for (int j = 0; j < 4; ++j) cwh[j] = cat8(cvt4(*(const f32x4*)(p.conv_w + j * 2048 + kcol)), cvt4(*(const f32x4*)(p.conv_w + j * 2048 + kcol + 4)));
    cbh = cat8(cvt4(*(const f32x4*)(p.conv_b + kcol)), cvt4(*(const f32x4*)(p.conv_b + kcol + 4)));
    const h16* QK = (const h16*)p.out; const float* WU = (const float*)(ws + OFF_WU); const float* DEC = (const float*)(ws + OFF_DEC) + bh * 64;
    const h16* Vg = (const h16*)(ws + WS_V);
    h16* CST = (h16*)(ws + WS_CST) + (size_t)bh * 64 * CSTRIDE;
    const int dti = wid & 3, ep = wid >> 2; const bool doN = (et == 0) && (ep == 0);
    const int tq = (lane & 15) >> 2, tp = lane & 3;
    u32x4 raw[2][7]; f32x4 wu[2]; float dc0[2], dc1[2];
    f32x4 acc[2] = {(f32x4){0.f, 0.f, 0.f, 0.f}, (f32x4){0.f, 0.f, 0.f, 0.f}}; f32x4 nacc = (f32x4){0.f, 0.f, 0.f, 0.f};
    const h16x8 ones = {(h16)1.f, (h16)1.f, (h16)1.f, (h16)1.f, (h16)1.f, (h16)1.f, (h16)1.f, (h16)1.f};
#define S2_LOADR(j_, set_) do { const int t0_ = b * SEQ + (j_) * 256; \
        _Pragma("unroll") for (int k = 0; k < 7; ++k) { int tl = (j_) * 256 + 4 * rp - 3 + k; tl = tl < 0 ? 0 : tl; raw[set_][k] = *(const u32x4*)(QK + (size_t)(b * SEQ + tl) * 2048 + kcol); } \
        wu[set_] = *(const f32x4*)(WU + (size_t)hd * NTOK + t0_ + 4 * rp); dc0[set_] = DEC[2 * (j_)]; dc1[set_] = DEC[2 * (j_) + 1]; } while (0)
#define S2_LOADV(j_) do { const int t0_ = b * SEQ + (j_) * 256; \
        _Pragma("unroll") for (int q = 0; q < 4; ++q) { const int I = wid * 4 + q, row = I * 8 + (lane >> 3), ch = (lane & 7) ^ swz128(row); \
            GLDS16((const char*)(Vg + (size_t)(t0_ + row) * 1024 + hd * 256 + e0) + ch * 16, lds + 65536 + ((j_) & 1) * 32768 + I * 1024); } } while (0)
#define S2_STORE(c_) do { \
        _Pragma("unroll") for (int j = 0; j < 2; ++j) { u32x2 w; w.x = pk_h2(acc[j][0], acc[j][1]); w.y = pk_h2(acc[j][2], acc[j][3]); \
            *(u32x2*)(CST + (size_t)(c_) * CSTRIDE + (size_t)(e0 + 16 * (2 * ep + j) + fr) * 256 + d0 + 16 * dti + 4 * fq) = w; } \
        if (doN && fr == 0) { u32x2 w; w.x = pk_h2(nacc[0], nacc[1]); w.y = pk_h2(nacc[2], nacc[3]); *(u32x2*)(CST + (size_t)(c_) * CSTRIDE + 65536 + d0 + 16 * dti + 4 * fq) = w; } } while (0)
#define S2_MMA(half_) do { h16x8 X[4], Y0[4], Y1[4]; \
        _Pragma("unroll") for (int ks = 0; ks < 4; ++ks) { const int r0 = 128 * (half_) + 32 * ks + 8 * fq + tq, r1 = r0 + 4; \
            const int o0 = r0 * 128 + (tp & 1) * 8, o1 = r1 * 128 + (tp & 1) * 8, s0 = swz128(r0), s1 = swz128(r1), cx = 2 * dti + (tp >> 1), cy0 = 2 * (2 * ep) + (tp >> 1), cy1 = cy0 + 2; \
            X[ks] = cat8(tr_read4(kb + o0 + ((cx ^ s0) * 16)), tr_read4(kb + o1 + ((cx ^ s1) * 16))); \
            Y0[ks] = cat8(tr_read4(vb + o0 + ((cy0 ^ s0) * 16)), tr_read4(vb + o1 + ((cy0 ^ s1) * 16))); \
            Y1[ks] = cat8(tr_read4(vb + o0 + ((cy1 ^ s0) * 16)), tr_read4(vb + o1 + ((cy1 ^ s1) * 16))); } \
        REGBAR4(X); REGBAR4(Y0); REGBAR4(Y1); \
        _Pragma("unroll") for (int ks = 0; ks < 4; ++ks) { \
            acc[0] = __builtin_amdgcn_mfma_f32_16x16x32_f16(X[ks], Y0[ks], acc[0], 0, 0, 0); acc[1] = __builtin_amdgcn_mfma_f32_16x16x32_f16(X[ks], Y1[ks], acc[1], 0, 0, 0); \
            if (doN) nacc = __builtin_amdgcn_mfma_f32_16x16x32_f16(X[ks], ones, nacc, 0, 0, 0); } } while (0)
#define S2_STEP(j_, set_) do { const int j2 = (j_); \
        S2_STORE(2 * j2); \
        LAS unsigned char* kb = lds + (j2 & 1) * 32768; LAS unsigned char* vb = lds + 65536 + (j2 & 1) * 32768; \
        if (j2 == 0) { _Pragma("unroll") for (int k = 0; k < 3; ++k) if (4 * rp - 3 + k < 0) raw[set_][k] = (u32x4){0u, 0u, 0u, 0u}; } \
        _Pragma("unroll") for (int rr = 0; rr < 4; ++rr) { h16x8 yh = cbh; \
            _Pragma("unroll") for (int j = 0; j < 4; ++j) yh += cwh[j] * __builtin_bit_cast(h16x8, raw[set_][rr + j]); \
            f32x4 y0 = {(float)yh[0], (float)yh[1], (float)yh[2], (float)yh[3]}, y1 = {(float)yh[4], (float)yh[5], (float)yh[6], (float)yh[7]}; \
            const float sc = 0.0625f * wu[set_][rr]; \
            _Pragma("unroll") for (int q = 0; q < 4; ++q) { y0[q] = fsilu(y0[q]) * sc; y1[q] = fsilu(y1[q]) * sc; } \
            const int row = 4 * rp + rr; *(LAS u32x4*)(kb + row * 128 + ((cg ^ swz128(row)) * 16)) = pk_h8(y0, y1); } \
        const float da = dc0[set_], db = dc1[set_]; \
        asm volatile("s_waitcnt vmcnt(0) lgkmcnt(0)" ::: "memory"); __builtin_amdgcn_s_barrier(); asm volatile("" ::: "memory"); \
        if (j2 + 2 < 32) S2_LOADR(j2 + 2, set_); \
        if (j2 + 1 < 32) S2_LOADV(j2 + 1); \
        acc[0] *= da; acc[1] *= da; nacc *= da; \
        S2_MMA(0); \
        S2_STORE(2 * j2 + 1); \
        if (j2 < 31) { acc[0] *= db; acc[1] *= db; nacc *= db; S2_MMA(1); } } while (0)
    S2_LOADR(0, 0); S2_LOADR(1, 1); S2_LOADV(0);
#pragma unroll 1
    for (int jj = 0; jj < 32; jj += 2) { S2_STEP(jj, 0); S2_STEP(jj + 1, 1); }
#undef S2_STEP
#undef S2_MMA
#undef S2_STORE
#undef S2_LOADV
#undef S2_LOADR
    asm volatile("s_waitcnt vmcnt(0) lgkmcnt(0)" ::: "memory"); __builtin_amdgcn_s_barrier();
}

__device__ __forceinline__ int swz256(int row) { return ((row & 3) + 4 * ((row >> 3) & 1)) << 1; }
#ifdef TIME_SGSUB
#define SGCK(k_) do { if ((k_) == TIME_SGSUB && task == 0 && g == 1 && threadIdx.x == 0) { const unsigned long long dt = (__builtin_amdgcn_s_memrealtime() - tsg_) * 10ull, t0_ = __builtin_amdgcn_s_memrealtime(); while (__builtin_amdgcn_s_memrealtime() - t0_ < dt) __builtin_amdgcn_s_sleep(8); } } while (0)
#define SGT0() if (g == 1) tsg_ = __builtin_amdgcn_s_memrealtime()
#else
#define SGCK(k_) do { } while (0)
#define SGT0() do { } while (0)
#endif
__device__ __forceinline__ void sgu_task(LAS unsigned char* lds, const Ptrs& p, unsigned char* ws, int task) {
    unsigned long long tsg_ = 0ull; (void)tsg_;
    int tid = threadIdx.x; asm volatile("" : "+v"(tid));
    const int wid = __builtin_amdgcn_readfirstlane(tid >> 6), lane = tid & 63, fr = lane & 15, fq = lane >> 4;
    const int t0 = task * CHUNK;
    LAS unsigned char* wb = lds; LAS unsigned char* vb = lds + 32768; LAS float* rs = (LAS float*)(lds + 65536);
    const float* ss = (const float*)(ws + OFF_PSV); const h16* SV = (const h16*)(ws + WS_SV); const h16* UG = (const h16*)(ws + WS_UG); h16* Z = (h16*)(ws + WS_XH);
    LAS float* gsl = rs + 128; LAS float* bsl = gsl + 1024;
    if (tid < CHUNK) rs[tid] = rsqrtf(sum16(ss + (size_t)(t0 + tid) * 16) * (1.f / DM) + EPS);
    { const f32x4 gv_ = *(const f32x4*)(p.sgu_norm_g + 4 * (tid & 255)), bv_ = *(const f32x4*)(p.b_s + 4 * (tid & 255)); if (tid < 256) { *(LAS f32x4*)(gsl + 4 * tid) = gv_; *(LAS f32x4*)(bsl + 4 * tid) = bv_; } }
    __syncthreads();
    const int lrow = tid >> 2, lq = tid & 3, tq = (lane & 15) >> 2, tp = lane & 3, trow = 16 * wid + fr;
    f32x4 wraw[8]; h16x8 vraw[4]; h16x4 urn[8];
#define SGU_LOAD(g_) do { const float* wsrc = p.w_s + (size_t)((g_) * 128 + lrow) * 128 + 32 * lq; const h16* vsrc = SV + (size_t)(t0 + lrow) * 1024 + (g_) * 128 + 32 * lq; \
        _Pragma("unroll") for (int i = 0; i < 8; ++i) wraw[i] = *(const f32x4*)(wsrc + 4 * i); \
        _Pragma("unroll") for (int i = 0; i < 4; ++i) vraw[i] = *(const h16x8*)(vsrc + 8 * i); \
        _Pragma("unroll") for (int hb = 0; hb < 2; ++hb) { const int tr_ = 16 * (hb ? 7 - wid : wid) + fr; const size_t ro_ = (size_t)(t0 + tr_) * 1024 + (g_) * 128 + 4 * fq; \
            _Pragma("unroll") for (int d4 = 0; d4 < 4; ++d4) urn[4 * hb + d4] = *(const h16x4*)(UG + ro_ + 16 * (4 * hb + d4)); } } while (0)
    SGU_LOAD(0);
#pragma unroll 1
    for (int g = 0; g < 8; ++g) {
        SGT0();
        {
            const float r = rs[lrow];
#pragma unroll
            for (int i = 0; i < 4; ++i) { f32x4 a = wraw[2 * i], c = wraw[2 * i + 1];
#pragma unroll
                for (int q = 0; q < 4; ++q) { if (32 * lq + 8 * i + q > lrow) a[q] = 0.f; if (32 * lq + 8 * i + 4 + q > lrow) c[q] = 0.f; }
                *(LAS u32x4*)(wb + lrow * 256 + (((4 * lq + i) ^ (lrow & 15)) * 16)) = pk_h8(a, c); }
#pragma unroll
            for (int i = 0; i < 4; ++i) { const h16x8 v = vraw[i]; f32x4 a, c;
#pragma unroll
                for (int q = 0; q < 4; ++q) { a[q] = (float)v[q] * r; c[q] = (float)v[4 + q] * r; }
                *(LAS u32x4*)(vb + lrow * 256 + (((4 * lq + i) ^ swz256(lrow)) * 16)) = pk_h8(a, c); }
        }
        SGCK(1);
        __syncthreads();
        SGCK(2);
        h16x4 ur[8];
#pragma unroll
        for (int i = 0; i < 8; ++i) ur[i] = urn[i];
        if (g + 1 < 8) SGU_LOAD(g + 1);
        f32x4 acc[8]; f32x4 gq[8]; float bias[2];
#pragma unroll
        for (int hb = 0; hb < 2; ++hb) { const int rt = hb ? 7 - wid : wid, tr = 16 * rt + fr; bias[hb] = bsl[g * 128 + tr];
#pragma unroll
            for (int d4 = 0; d4 < 4; ++d4) { const int dt = 4 * hb + d4; gq[dt] = *(const LAS f32x4*)(gsl + g * 128 + 16 * dt + 4 * fq); acc[dt] = (f32x4){0.f, 0.f, 0.f, 0.f}; } }
#pragma unroll
        for (int hb = 0; hb < 2; ++hb) { const int rt = hb ? 7 - wid : wid, tr = 16 * rt + fr, nks = (rt >> 1) + 1;
            for (int ks = 0; ks < nks; ++ks) {
                const h16x8 Y = *(const LAS h16x8*)(wb + tr * 256 + (((4 * ks + fq) ^ (tr & 15)) * 16));
                const int r0 = 32 * ks + 8 * fq + tq, r1 = r0 + 4, o0 = r0 * 256 + (tp & 1) * 8, o1 = r1 * 256 + (tp & 1) * 8, s0 = swz256(r0), s1 = swz256(r1);
                h16x8 X[4];
#pragma unroll
                for (int d4 = 0; d4 < 4; ++d4) { const int cx = 2 * (4 * hb + d4) + (tp >> 1); X[d4] = cat8(tr_read4(vb + o0 + ((cx ^ s0) * 16)), tr_read4(vb + o1 + ((cx ^ s1) * 16))); }
                REGBAR4(X);
#pragma unroll
                for (int d4 = 0; d4 < 4; ++d4) acc[4 * hb + d4] = __builtin_amdgcn_mfma_f32_16x16x32_f16(X[d4], Y, acc[4 * hb + d4], 0, 0, 0);
            } }
        SGCK(3);
#pragma unroll
        for (int hb = 0; hb < 2; ++hb) { const int rt = hb ? 7 - wid : wid, tr = 16 * rt + fr; const size_t ro = (size_t)(t0 + tr) * 1024 + g * 128 + 4 * fq; const float bs = bias[hb];
#pragma unroll
            for (int d4 = 0; d4 < 4; ++d4) { const int dt = 4 * hb + d4; const h16x4 u = ur[dt]; u32x2 w;
                w.x = pk_h2((float)u[0] * (acc[dt][0] * gq[dt][0] + bs), (float)u[1] * (acc[dt][1] * gq[dt][1] + bs)); w.y = pk_h2((float)u[2] * (acc[dt][2] * gq[dt][2] + bs), (float)u[3] * (acc[dt][3] * gq[dt][3] + bs));
                *(u32x2*)(Z + ro + 16 * dt) = w; } }
        SGCK(4);
        __syncthreads();
        SGCK(5);
    }
#undef SGU_LOAD
}


__device__ __forceinline__ void kv_task(LAS unsigned char* lds, const Ptrs& p, unsigned char* ws, int task) {
    int tid = threadIdx.x; asm volatile("" : "+v"(tid));
    const int wid = __builtin_amdgcn_readfirstlane(tid >> 6), lane = tid & 63, fr = lane & 15, fq = lane >> 4, tq = (lane & 15) >> 2, tp = lane & 3;
    const int r0 = 64 * (task >> 4), c0 = 128 * (task & 15);
    const int arow = tid >> 3, akq = tid & 7, bk = tid >> 5, bn4 = tid & 31;
    LAS unsigned char* ab = lds; LAS unsigned char* bb = lds + 16384; LAS float* rsd = (LAS float*)(lds + 49152);
    const float* Ag = p.mem + (size_t)(r0 + arow) * DM + 4 * akq; const float* Bg = p.w_xkv + (size_t)bk * 2048 + c0 + 4 * bn4; const float* Gg = p.norm_mem_g + 4 * akq;
    f32x4 av[2][4], gv[2][4], bv[2][8]; float ssq = 0.f;
#define KV_LOAD(kc_, s_) do { _Pragma("unroll") for (int i = 0; i < 4; ++i) { av[s_][i] = *(const f32x4*)(Ag + (kc_) * 128 + 32 * i); gv[s_][i] = *(const f32x4*)(Gg + (kc_) * 128 + 32 * i); } \
        _Pragma("unroll") for (int i = 0; i < 8; ++i) bv[s_][i] = *(const f32x4*)(Bg + (size_t)((kc_) * 128 + 16 * i) * 2048); } while (0)
#define KV_STEP(kc_, s_) do { \
        _Pragma("unroll") for (int i = 0; i < 4; ++i) { const f32x4 a = av[s_][i]; ssq += (a[0] * a[0] + a[1] * a[1]) + (a[2] * a[2] + a[3] * a[3]); const f32x4 ag = a * gv[s_][i]; \
            u32x2 w; w.x = pk_h2(ag[0], ag[1]); w.y = pk_h2(ag[2], ag[3]); const int kk = 4 * akq + 32 * i; \
            *(LAS u32x2*)(ab + arow * 256 + (((kk >> 3) ^ (arow & 15)) * 16) + ((kk >> 2) & 1) * 8) = w; } \
        _Pragma("unroll") for (int i = 0; i < 8; ++i) { const f32x4 b = bv[s_][i]; u32x2 wb; wb.x = pk_h2(b[0], b[1]); wb.y = pk_h2(b[2], b[3]); const int brow = bk + 16 * i; \
            *(LAS u32x2*)(bb + brow * 256 + (((bn4 >> 1) ^ swz256(brow)) * 16) + (bn4 & 1) * 8) = wb; } \
        __syncthreads(); \
        if ((kc_) + 2 < 8) KV_LOAD((kc_) + 2, s_); \
        _Pragma("unroll") for (int ks = 0; ks < 4; ++ks) { const int q0 = 32 * ks + 8 * fq + tq, q1 = q0 + 4, cx = 2 * wid + (tp >> 1); \
            const h16x8 X = cat8(tr_read4(bb + q0 * 256 + ((cx ^ swz256(q0)) * 16) + (tp & 1) * 8), tr_read4(bb + q1 * 256 + ((cx ^ swz256(q1)) * 16) + (tp & 1) * 8)); \
            _Pragma("unroll") for (int j = 0; j < 4; ++j) { const int row = 16 * j + fr; const h16x8 Y = *(const LAS h16x8*)(ab + row * 256 + (((4 * ks + fq) ^ (row & 15)) * 16)); \
                acc[j] = __builtin_amdgcn_mfma_f32_16x16x32_f16(X, Y, acc[j], 0, 0, 0); } } \
        __syncthreads(); } while (0)
    KV_LOAD(0, 0); KV_LOAD(1, 1);
    f32x4 acc[4];
#pragma unroll
    for (int j = 0; j < 4; ++j) acc[j] = (f32x4){0.f, 0.f, 0.f, 0.f};
    __syncthreads();
#pragma unroll 1
    for (int kc2 = 0; kc2 < 8; kc2 += 2) { KV_STEP(kc2, 0); KV_STEP(kc2 + 1, 1); }
#undef KV_LOAD
#undef KV_STEP
    ssq += __shfl_xor(ssq, 1); ssq += __shfl_xor(ssq, 2); ssq += __shfl_xor(ssq, 4);
    if (akq == 0) rsd[arow] = rsqrtf(ssq * (1.f / DM) + EPS);
    __syncthreads();
    h16* dst = (c0 < 1024) ? (h16*)(ws + WS_KM) + c0 : (h16*)(ws + WS_VTM) + (c0 - 1024);
#pragma unroll
    for (int j = 0; j < 4; ++j) { const int row = 16 * j + fr; const float rs = rsd[row]; u32x2 w; w.x = pk_h2(acc[j][0] * rs, acc[j][1] * rs); w.y = pk_h2(acc[j][2] * rs, acc[j][3] * rs);
        *(u32x2*)(dst + (size_t)(r0 + row) * 1024 + 16 * wid + 4 * fq) = w; }
    __syncthreads();
}

__device__ __forceinline__ int swzb(int row) { return (row >> 1) & 7; }
#ifdef TIME_P3SUB
#define P3CK(k_) do { if ((k_) == TIME_P3SUB && bx == 0 && L == bx && threadIdx.x == 0) { const unsigned long long dt = (__builtin_amdgcn_s_memrealtime() - t3s_) * 10ull, t0_ = __builtin_amdgcn_s_memrealtime(); while (__builtin_amdgcn_s_memrealtime() - t0_ < dt) __builtin_amdgcn_s_sleep(8); } } while (0)
#else
#define P3CK(k_) do { } while (0)
#endif
__device__ __forceinline__ void mout_phase(LAS unsigned char* lds, const Ptrs& p, unsigned char* ws, int G, int bx, h16* Zdst) {
#ifdef TIME_P3SUB
    const unsigned long long t3s_ = __builtin_amdgcn_s_memrealtime();
#endif
    const int wid = __builtin_amdgcn_readfirstlane(threadIdx.x >> 6);
    constexpr int QB = 0, KB = 16384, CB0 = 32768, CBS = 34816, WB = 102400, VHI = 67584 - 64 * 512, SM = LDSCTL_OFF + 2048;
    const h16* QK = (const h16*)p.out; const h16* Vg = (const h16*)(ws + WS_V); const h16* OG = (const h16*)(ws + WS_OG); h16* Z = (h16*)(ws + WS_XH);
    const float* ALg = (const float*)(ws + OFF_AL); const float* BEg = (const float*)(ws + OFF_BE); const float* NMg = (const float*)(ws + OFF_NM); const float* MST = (const float*)(ws + OFF_MST);
    LAS float* ALs = (LAS float*)(lds + SM); LAS float* BEs = ALs + 128; LAS float* Wl = (LAS float*)(lds + WB);
#define OPAQUE_TID() int tid = threadIdx.x; asm volatile("" : "+v"(tid)); const int lane = tid & 63, fr = lane & 15, fq = lane >> 4, cg = tid & 7, rp = tid >> 3, tq = (lane & 15) >> 2, tp = lane & 3, trow = 16 * wid + fr; (void)cg; (void)rp; (void)tq; (void)tp; (void)trow; (void)fq
    if (bx >= 512) return;
    u32x4 rawq[5], rawk[5];
#define MO_ISSUE_CT(L_, dch_, par_) do { const int bh_ = (L_) >> 6, c_ = (L_) & 63; \
        const h16* Ct_ = (const h16*)(ws + WS_CST) + ((size_t)(bh_ * 64 + c_)) * CSTRIDE; \
        _Pragma("unroll") for (int q = 0; q < 4; ++q) { const int I = wid * 4 + q, row = I * 8 + (lane >> 3), ch = (lane & 7) ^ swzb(row); \
            GLDS16((const char*)(Ct_ + (size_t)row * 256 + (dch_) * 64) + ch * 16, lds + CB0 + (par_) * CBS + I * 1024); } \
        if (wid == 0) { const int row = 256 + (lane >> 3), ch = (lane & 7) ^ swzb(row); GLDS16((const char*)(Ct_ + (size_t)row * 256 + (dch_) * 64) + ch * 16, lds + CB0 + (par_) * CBS + 32768); } } while (0)
#define MO_ISSUE_RAW(L_, dch_, WH_, R_) do { const int bh_ = (L_) >> 6, c_ = (L_) & 63, b_ = bh_ >> 2, hd_ = bh_ & 3; const int col_ = (WH_) * 1024 + hd_ * 256 + (dch_) * 64 + 8 * cg; \
        _Pragma("unroll") for (int k = 0; k < 5; ++k) { int tl = c_ * CHUNK + 2 * rp - 3 + k; tl = tl < 0 ? 0 : tl; R_[k] = *(const u32x4*)(QK + (size_t)(b_ * SEQ + tl) * 2048 + col_); } } while (0)
#define MO_CONV(WH_, R_) do { const LAS h16* wl = (const LAS h16*)Wl + (WH_) * 1280 + dch * 64 + 8 * cg; h16x8 cwh[5]; \
        _Pragma("unroll") for (int j = 0; j < 5; ++j) cwh[j] = *(const LAS h16x8*)(wl + j * 256); \
        const float sc = (WH_) ? 0.0625f : 1.f; \
        _Pragma("unroll") for (int rr = 0; rr < 2; ++rr) { h16x8 yh = cwh[4]; \
            _Pragma("unroll") for (int j = 0; j < 4; ++j) { u32x4 rw = R_[rr + j]; if (c == 0 && 2 * rp - 3 + rr + j < 0) rw = (u32x4){0u, 0u, 0u, 0u}; yh += cwh[j] * __builtin_bit_cast(h16x8, rw); } \
            const h16x8 ys = silu8_h(yh) * (h16)sc; \
            const int row = 2 * rp + rr; *(LAS u32x4*)(lds + ((WH_) ? KB : QB) + row * 128 + ((cg ^ swzb(row)) * 16)) = __builtin_bit_cast(u32x4, ys); } } while (0)
#define MO_CHUNK(dch_) do { const int dch = (dch_); OPAQUE_TID(); const bool nxu = (dch == 3) && (L + G < 512); \
        if (dch < 3) MO_ISSUE_CT(L, dch + 1, (dch + 1) & 1); else if (nxu) MO_ISSUE_CT(L + G, 0, 0); \
        if (dch == 0) P3CK(5); MO_CONV(0, rawq); if (dch == 0) P3CK(6); \
        if (dch < 3) MO_ISSUE_RAW(L, dch + 1, 0, rawq); else if (nxu) MO_ISSUE_RAW(L + G, 0, 0, rawq); \
        MO_CONV(1, rawk); if (dch == 0) P3CK(7); \
        if (dch < 3) MO_ISSUE_RAW(L, dch + 1, 1, rawk); else if (nxu) MO_ISSUE_RAW(L + G, 0, 1, rawk); \
        asm volatile("s_waitcnt lgkmcnt(0)" ::: "memory"); __builtin_amdgcn_s_barrier(); asm volatile("" ::: "memory"); \
        if (dch == 0) P3CK(8); const int cbo = CB0 + (dch & 1) * CBS; h16x8 Y[2]; \
        _Pragma("unroll") for (int ks = 0; ks < 2; ++ks) Y[ks] = *(const LAS h16x8*)(lds + QB + trow * 128 + (((4 * ks + fq) ^ swzb(trow)) * 16)); \
        _Pragma("unroll") for (int s2 = 0; s2 < 4; ++s2) if (2 * s2 <= wid) { h16x8 X[4]; \
            _Pragma("unroll") for (int i = 0; i < 4; ++i) { const int krow = 16 * (2 * s2 + (i >> 1)) + fr; X[i] = *(const LAS h16x8*)(lds + KB + krow * 128 + (((4 * (i & 1) + fq) ^ swzb(krow)) * 16)); } \
            REGBAR4(X); \
            _Pragma("unroll") for (int i = 0; i < 4; ++i) S[2 * s2 + (i >> 1)] = __builtin_amdgcn_mfma_f32_16x16x32_f16(X[i], Y[i & 1], S[2 * s2 + (i >> 1)], 0, 0, 0); } \
        _Pragma("unroll") for (int e4 = 0; e4 < 4; ++e4) { h16x8 X[8]; \
            _Pragma("unroll") for (int i = 0; i < 8; ++i) { const int et = 4 * e4 + (i >> 1), ks = i & 1, crow = 16 * et + fr; X[i] = *(const LAS h16x8*)(lds + cbo + crow * 128 + (((4 * ks + fq) ^ swzb(crow)) * 16)); } \
            REGBAR8(X); \
            _Pragma("unroll") for (int i = 0; i < 8; ++i) acc[4 * e4 + (i >> 1)] = __builtin_amdgcn_mfma_f32_16x16x32_f16(X[i], Y[i & 1], acc[4 * e4 + (i >> 1)], 0, 0, 0); } \
        { const int crow = 256 + fr; const h16x8 X0 = *(const LAS h16x8*)(lds + cbo + crow * 128 + (((fq) ^ swzb(crow)) * 16)), X1 = *(const LAS h16x8*)(lds + cbo + crow * 128 + (((4 + fq) ^ swzb(crow)) * 16)); \
          acc[16] = __builtin_amdgcn_mfma_f32_16x16x32_f16(X0, Y[0], acc[16], 0, 0, 0); acc[16] = __builtin_amdgcn_mfma_f32_16x16x32_f16(X1, Y[1], acc[16], 0, 0, 0); } \
        asm volatile("s_waitcnt lgkmcnt(0)" ::: "memory"); __builtin_amdgcn_s_barrier(); asm volatile("" ::: "memory"); if (dch == 0) P3CK(9); } while (0)
    int hd_staged = -1; float abn, nmn;
    { OPAQUE_TID(); MO_ISSUE_CT(bx, 0, 0); MO_ISSUE_RAW(bx, 0, 0, rawq); MO_ISSUE_RAW(bx, 0, 1, rawk);
      const int bh0 = bx >> 6, c0 = bx & 63, t00 = (bh0 >> 2) * SEQ + c0 * CHUNK, h0 = bh0 & 3;
      abn = (tid < 128) ? ALg[(size_t)h0 * NTOK + t00 + (tid & 127)] : BEg[(size_t)h0 * NTOK + t00 + (tid & 127)]; nmn = NMg[(size_t)h0 * NTOK + t00 + trow]; }
    for (int L = bx; L < 512; L += G) {
        const int bh = L >> 6, c = L & 63, b = bh >> 2, hd = bh & 3, t0 = b * SEQ + c * CHUNK;
        float nmv;
        { OPAQUE_TID();
          if (hd != hd_staged) {
              float wv[5];
#pragma unroll
              for (int q = 0; q < 5; ++q) { const int i = tid + NTHREADS * q, w_ = i / 1280, r_ = i % 1280, j = r_ >> 8, cc = r_ & 255, col = w_ * 1024 + hd * 256 + cc; wv[q] = (j < 4) ? p.conv_w[j * 2048 + col] : p.conv_b[col]; }
#pragma unroll
              for (int q = 0; q < 5; ++q) ((LAS h16*)Wl)[tid + NTHREADS * q] = (h16)wv[q];
              if (tid < 64) *(LAS f32x4*)(lds + WB + 5120 + tid * 16) = *(const f32x4*)(p.mh_norm_g + hd * 256 + 4 * tid);
              hd_staged = hd; }
          if (tid < 256) ALs[tid] = abn;
          nmv = nmn;
          { const int Ln = (L + G < 512) ? L + G : L, bhn = Ln >> 6, cn = Ln & 63, tn0 = (bhn >> 2) * SEQ + cn * CHUNK, hn = bhn & 3;
            abn = (tid < 128) ? ALg[(size_t)hn * NTOK + tn0 + (tid & 127)] : BEg[(size_t)hn * NTOK + tn0 + (tid & 127)]; nmn = NMg[(size_t)hn * NTOK + tn0 + trow]; }
        }
        f32x4 S[8], acc[17];
#pragma unroll
        for (int i = 0; i < 8; ++i) S[i] = (f32x4){0.f, 0.f, 0.f, 0.f};
#pragma unroll
        for (int i = 0; i < 17; ++i) acc[i] = (f32x4){0.f, 0.f, 0.f, 0.f};
        __syncthreads();
        P3CK(1);
#pragma unroll 1
        for (int dq = 0; dq < 4; ++dq) MO_CHUNK(dq);
        P3CK(2);
        OPAQUE_TID();
#pragma unroll
        for (int q = 0; q < 8; ++q) { const int I = wid * 8 + q, row = I * 2 + (lane >> 5), ch = (lane & 31) ^ ((row & 7) << 1);
            GLDS16((const char*)(Vg + (size_t)(t0 + row) * 1024 + hd * 256) + ch * 16, lds + (row < 64 ? 0 : VHI) + I * 1024); }
        u32x4 og8[8];
        { const size_t ob = (size_t)(t0 + trow) * 1024 + hd * 256 + 16 * (fq & 1) + 4 * (fq & 2);
#pragma unroll
          for (int i = 0; i < 8; ++i) og8[i] = *(const u32x4*)(OG + ob + 32 * i); }
        const float al = ALs[trow], mc = MST[bh * 64 + c], iw = __expf(al + mc);
#pragma unroll
        for (int et = 0; et < 16; ++et) acc[et] *= iw;
        const float qn = __shfl(acc[16][0], fr);
        float den = 0.f;
#pragma unroll
        for (int st = 0; st < 8; ++st) { const f32x4 be = *(const LAS f32x4*)(BEs + 16 * st + 4 * fq);
#pragma unroll
            for (int r = 0; r < 4; ++r) { float v = S[st][r] * __expf(al + be[r]); if (st == wid) v = (4 * fq + r <= fr) ? v : 0.f; if (st > wid) v = 0.f; S[st][r] = v; den += v; } }
        den += __shfl_xor(den, 16); den += __shfl_xor(den, 32);
        den += iw * qn;
        h16x8 pf[4];
#pragma unroll
        for (int i = 0; i < 4; ++i) pf[i] = cat8(cvt4(S[2 * i]), cvt4(S[2 * i + 1]));
        asm volatile("s_waitcnt vmcnt(0)" ::: "memory"); __builtin_amdgcn_s_barrier(); asm volatile("" ::: "memory");
#pragma unroll
        for (int ks = 0; ks < 4; ++ks) if (ks <= (wid >> 1)) { const int r0 = 32 * ks + 4 * fq + tq, r1 = r0 + 16; const int vbase = (ks < 2) ? 0 : VHI;
#pragma unroll
            for (int e8 = 0; e8 < 2; ++e8) { h16x8 vf[8];
#pragma unroll
                for (int i = 0; i < 8; ++i) { const int et = 8 * e8 + i;
                    vf[i] = cat8(tr_read4(lds + vbase + r0 * 512 + (((2 * et + (tp >> 1)) ^ ((r0 & 7) << 1)) * 16) + (tp & 1) * 8), tr_read4(lds + vbase + r1 * 512 + (((2 * et + (tp >> 1)) ^ ((r1 & 7) << 1)) * 16) + (tp & 1) * 8)); }
                REGBAR8(vf);
#pragma unroll
                for (int i = 0; i < 8; ++i) acc[8 * e8 + i] = __builtin_amdgcn_mfma_f32_16x16x32_f16(vf[i], pf[ks], acc[8 * e8 + i], 0, 0, 0); } }
        P3CK(3);
        const int tg = t0 + trow; const float inv = 1.f / fmaxf(fabsf(den), __expf(nmv));
        u32x4 z8[8]; const bool oddq = (fq & 1) != 0; const size_t ob8 = (size_t)tg * 1024 + hd * 256 + 16 * (fq & 1) + 4 * (fq & 2);
#pragma unroll
        for (int i = 0; i < 8; ++i) z8[i] = *(const u32x4*)(Z + ob8 + 32 * i);
        float ss = 0.f;
#pragma unroll
        for (int et = 0; et < 16; ++et) { acc[et] *= inv; ss += (acc[et][0] * acc[et][0] + acc[et][1] * acc[et][1]) + (acc[et][2] * acc[et][2] + acc[et][3] * acc[et][3]); }
        ss += __shfl_xor(ss, 16); ss += __shfl_xor(ss, 32);
        const float rstd = rsqrtf(ss * (1.f / DH) + EPS);
#pragma unroll
        for (int i = 0; i < 8; ++i) { u32x2 zl, zh, ol, oh, rl, rh; PAIR_GET(z8[i], oddq, zl, zh); PAIR_GET(og8[i], oddq, ol, oh);
#pragma unroll
            for (int h = 0; h < 2; ++h) { const int et = 2 * i + h; const f32x4 gg = *(const LAS f32x4*)(lds + WB + 5120 + (16 * et + 4 * fq) * 4);
                const h16x4 zq = __builtin_bit_cast(h16x4, h ? zh : zl), oq = __builtin_bit_cast(h16x4, h ? oh : ol); u32x2 w;
                w.x = pk_h2((float)zq[0] + acc[et][0] * rstd * gg[0] * (float)oq[0], (float)zq[1] + acc[et][1] * rstd * gg[1] * (float)oq[1]);
                w.y = pk_h2((float)zq[2] + acc[et][2] * rstd * gg[2] * (float)oq[2], (float)zq[3] + acc[et][3] * rstd * gg[3] * (float)oq[3]);
                if (h) rh = w; else rl = w; }
            u32x4 seg; PAIR_PUT(rl, rh, oddq, seg); *(u32x4*)(Zdst + ob8 + 32 * i) = seg; }
        P3CK(4);
    }
    asm volatile("s_waitcnt vmcnt(0) lgkmcnt(0)" ::: "memory"); __builtin_amdgcn_s_barrier();
#undef OPAQUE_TID
#undef MO_ISSUE_CT
#undef MO_ISSUE_RAW
#undef MO_CONV
#undef MO_CHUNK
}

struct TpItem { const float* W; const float* gk; h16* WT; int ldw, srccol0, K, destrow0, k0; };
__device__ __forceinline__ void tp_load(const TpItem& t, f32x4 (&v)[8], float (&g)[8], int lane) {
    const int col4 = lane & 7, krow = lane >> 3;
    const float* gp = t.gk ? t.gk : t.W;
#pragma unroll
    for (int i = 0; i < 8; ++i) { v[i] = __builtin_nontemporal_load((const f32x4*)(t.W + (size_t)(t.k0 + 8 * i + krow) * t.ldw + t.srccol0 + 4 * col4)); g[i] = gp[t.k0 + 8 * i + krow]; }
}
__device__ __forceinline__ void tp_store(const TpItem& t, const f32x4 (&v)[8], const float (&g)[8], LAS unsigned char* scr, int lane) {
    const int col4 = lane & 7, krow = lane >> 3;
#pragma unroll
    for (int i = 0; i < 8; ++i) { const int k = 8 * i + krow; const f32x4 x = v[i] * (t.gk ? g[i] : 1.f); u32x2 w; w.x = pk_h2(x[0], x[1]); w.y = pk_h2(x[2], x[3]);
        *(LAS u32x2*)(scr + k * 64 + (((col4 >> 1) ^ (2 * (i & 1))) * 16) + (col4 & 1) * 8) = w; }
    LDS_WAIT(); asm volatile("" ::: "memory");
    const int gq = lane >> 4, li = lane & 15, q = li >> 2, pp = li & 3;
#pragma unroll
    for (int h = 0; h < 2; ++h)
#pragma unroll
        for (int it = 0; it < 2; ++it) { const int m = gq + 4 * it, r0 = 8 * m + q, r1 = r0 + 4, ch = (2 * h + (pp >> 1)) ^ (2 * (m & 1));
            const h16x4 lo = tr_read4(scr + r0 * 64 + ch * 16 + (pp & 1) * 8), hi = tr_read4(scr + r1 * 64 + ch * 16 + (pp & 1) * 8);
            *(GAS h16x8*)(t.WT + (size_t)(t.destrow0 + 16 * h + li) * t.K + t.k0 + 8 * m) = cat8(lo, hi); }
    LDS_WAIT(); asm volatile("" ::: "memory");
}
template <class Dec>
__device__ __forceinline__ void tp_loop(const Dec& dec, int first, int count, int stride, LAS unsigned char* scr, int lane) {
    if (first >= count) return;
    TpItem ia = dec(first), ib = ia, ic = ia, id = ia; f32x4 va[8], vb[8], vc[8], vd[8]; float ga[8], gb[8], gc[8], gd[8];
    tp_load(ia, va, ga, lane);
    if (first + stride < count) { ib = dec(first + stride); tp_load(ib, vb, gb, lane); }
    if (first + 2 * stride < count) { ic = dec(first + 2 * stride); tp_load(ic, vc, gc, lane); }
    for (int it = first; it < count; it += 4 * stride) {
        const int n3 = it + 3 * stride, n4 = it + 4 * stride, n5 = it + 5 * stride, n6 = it + 6 * stride;
        if (n3 < count) { id = dec(n3); tp_load(id, vd, gd, lane); }
        asm volatile("" ::: "memory");
        tp_store(ia, va, ga, scr, lane);
        if (it + stride >= count) break;
        if (n4 < count) { ia = dec(n4); tp_load(ia, va, ga, lane); }
        asm volatile("" ::: "memory");
        tp_store(ib, vb, gb, scr, lane);
        if (it + 2 * stride >= count) break;
        if (n5 < count) { ib = dec(n5); tp_load(ib, vb, gb, lane); }
        asm volatile("" ::: "memory");
        tp_store(ic, vc, gc, scr, lane);
        if (n3 >= count) break;
        if (n6 < count) { ic = dec(n6); tp_load(ic, vc, gc, lane); }
        asm volatile("" ::: "memory");
        tp_store(id, vd, gd, scr, lane);
    }
}
__device__ __forceinline__ int win_destrow(int l) {
    if (l < 3072) return l;
    if (l < 4096) { const int c = l - 3072; return 3072 + (c >> 7) * 256 + (c & 127); }
    if (l < 5120) { const int c = l - 4096; return 5120 + (c >> 7) * 256 + (c & 127); }
    if (l < 6144) return 7168 + (l - 5120);
    if (l < 7168) { const int c = l - 6144; return 3072 + (c >> 7) * 256 + 128 + (c & 127); }
    { const int c = l - 7168; return 5120 + (c >> 7) * 256 + 128 + (c & 127); }
}

struct TpDecP0 { const Ptrs* p; unsigned char* ws;
    __device__ __forceinline__ TpItem operator()(int it) const {
        constexpr int I_WIN = 16 * 256, I_SQ = 16 * 32; h16* wsm = (h16*)(ws + WS_WSM); int r = it; TpItem t;
        if (r < I_WIN) { const int kb = r >> 8, nb = r & 255, l0 = 32 * nb; t = TpItem{p->w_in, p->norm_mix_g, (h16*)(ws + WS_WIN), IN_DIM, l0 < 4096 ? l0 : l0 + 8, DM, win_destrow(l0), 64 * kb}; return t; } r -= I_WIN;
        if (r < I_SQ) { t = TpItem{p->w_out, nullptr, wsm, DM, 32 * (r & 31), DM, 32 * (r & 31), 64 * (r >> 5)}; return t; } r -= I_SQ;
        if (r < I_SQ) { t = TpItem{p->w_xq, p->norm_x_g, wsm + 1024 * 1024, DM, 32 * (r & 31), DM, 32 * (r & 31), 64 * (r >> 5)}; return t; } r -= I_SQ;
        t = TpItem{p->w_xo, nullptr, wsm + 4 * 1024 * 1024, DM, 32 * (r & 31), DM, 32 * (r & 31), 64 * (r >> 5)}; return t; } };
struct TpDecW13 { const Ptrs* p; unsigned char* ws;
    __device__ __forceinline__ TpItem operator()(int it) const {
        const int e = it >> 9, r = it & 511; h16* W13 = (h16*)(ws + (e < W13_EARLY_E ? WS_WIN : WS_UG)); TpItem t;
        if (r < 256) { const int kb = r >> 4, nb = r & 15, f0 = 32 * nb; t = TpItem{p->w1 + (size_t)e * DM * FF, p->norm_moe_g, W13 + (size_t)e * 1024 * 1024, FF, f0, DM, (f0 >> 7) * 256 + (f0 & 127), 64 * kb}; return t; }
        const int q = r - 256, kb = q >> 4, nb = q & 15, f0 = 32 * nb; t = TpItem{p->w3 + (size_t)e * DM * FF, p->norm_moe_g, W13 + (size_t)e * 1024 * 1024, FF, f0, DM, (f0 >> 7) * 256 + 128 + (f0 & 127), 64 * kb}; return t; } };
constexpr int W2_EARLY = 3072;
struct TpDecW2 { const Ptrs* p; unsigned char* ws;
    __device__ __forceinline__ TpItem operator()(int it) const {
        h16* W2T = (h16*)(ws + WS_W2T); const int e = it >> 8, q = it & 255, kb = q >> 5, nb = q & 31;
        TpItem t = TpItem{p->w2 + (size_t)e * FF * DM, nullptr, W2T + (size_t)e * 1024 * 512, DM, 32 * nb, FF, 32 * nb, 64 * kb}; return t; } };
template <bool GATES>
__device__ __forceinline__ float p0_row(const f32x4 (&v)[4], h16* orow, const LAS float* gt, float (&acc)[8], int lane) {
    float ss = 0.f;
#pragma unroll
    for (int j = 0; j < 4; ++j) ss += (v[j].x * v[j].x + v[j].y * v[j].y) + (v[j].z * v[j].z + v[j].w * v[j].w);
    GAS u32x2* o8 = (GAS u32x2*)orow + lane;
#pragma unroll
    for (int j = 0; j < 4; ++j) { u32x2 w; w.x = pk_h2(v[j].x, v[j].y); w.y = pk_h2(v[j].z, v[j].w); o8[64 * j] = w; }
    if constexpr (GATES) {
#pragma unroll
        for (int q = 0; q < 8; ++q) acc[q] = 0.f;
#pragma unroll
        for (int j = 0; j < 4; ++j)
#pragma unroll
            for (int q = 0; q < 8; ++q) { const f32x4 w = *(const LAS f32x4*)(gt + q * 1024 + 4 * (64 * j + lane)); acc[q] += (v[j].x * w.x + v[j].y * w.y) + (v[j].z * w.z + v[j].w * w.w); }
        const bool b5 = (lane & 32) != 0, b4 = (lane & 16) != 0, b3 = (lane & 8) != 0; float k4[4], k2[2], k1;
#pragma unroll
        for (int q = 0; q < 4; ++q) { const float snd = b5 ? acc[q] : acc[4 + q]; k4[q] = (b5 ? acc[4 + q] : acc[q]) + __shfl_xor(snd, 32); }
#pragma unroll
        for (int q = 0; q < 2; ++q) { const float snd = b4 ? k4[q] : k4[2 + q]; k2[q] = (b4 ? k4[2 + q] : k4[q]) + __shfl_xor(snd, 16); }
        { const float snd = b3 ? k2[0] : k2[1]; k1 = (b3 ? k2[1] : k2[0]) + __shfl_xor(snd, 8); }
        k1 += __shfl_xor(k1, 4); k1 += __shfl_xor(k1, 2); k1 += __shfl_xor(k1, 1);
#pragma unroll
        for (int q = 0; q < 8; ++q) acc[q] = __builtin_bit_cast(float, __builtin_amdgcn_readlane(__builtin_bit_cast(int, k1), 8 * q));
    }
    return wave_sum(ss);
}
__device__ __forceinline__ void mstate_wave(const float* ig, const float* lf, float* mst, int bh, int lane) {
    const int b = bh >> 2, h = bh & 3; float B = 0.f, mx = -INFINITY;
    for (int s = 0; s < CHUNK; ++s) { const int t = b * SEQ + lane * CHUNK + s; B += lf[(size_t)h * NTOK + t]; mx = fmaxf(mx, ig[(size_t)h * NTOK + t] - B); }
    const float blast = B, maxw = B + mx; float m = 0.f;
    for (int c = 0; c < NCHUNK; ++c) { const float bl = __shfl(blast, c), mw = __shfl(maxw, c); if (lane == c) mst[bh * 64 + c] = m; m = fmaxf(bl + m, mw); }
}

struct Args { Ptrs p; int ph_lo, ph_hi, li, pad; };
__global__ void __launch_bounds__(NTHREADS, 2) mega(Args a) {
    extern __shared__ __attribute__((aligned(16))) unsigned char lds_[];
    LAS unsigned char* lds = (LAS unsigned char*)lds_;
    volatile LAS unsigned* MISC = (volatile LAS unsigned*)(lds + MISC_OFF);
    const Ptrs& p = a.p;
#define PH_IDS() int tid = threadIdx.x; asm volatile("" : "+v"(tid)); const int lane = tid & 63, wave = __builtin_amdgcn_readfirstlane(tid >> 6); const int gw = vcu * NWAVES + wave, NGW = G * NWAVES; (void)lane; (void)gw; (void)NGW
    const int G = gridDim.x, bx = blockIdx.x, vcu = (G % 8 == 0) ? (bx % 8) * (G / 8) + bx / 8 : bx;
    unsigned char* ws = p.ws;
    unsigned* ctl = (unsigned*)(ws + WS_CTL);
    for (int u = threadIdx.x; u < (LDS_BYTES - LDSCTL_OFF) / 4; u += NTHREADS) ((LAS unsigned*)(lds + LDSCTL_OFF))[u] = 0u;
    __syncthreads();
    XcdBarrier bar = xcd_barrier_post(ctl + CW_BAR + a.li * XCD_BAR_WORDS, MISC + 8);
    const int lo = a.ph_lo, hi = a.ph_hi;
#ifndef PH_MASK
#define PH_MASK 0xFFFF
#endif
#define IN(k) (((PH_MASK >> (k)) & 1) && lo <= (k) && (k) < hi)
#ifndef REPEAT_MASK
#define REPEAT_MASK 0
#endif
#ifdef TIME_PHASE
    unsigned long long tp0_ = 0ull, tp1_ = 0ull;
#define TSTAMP(k) do { if ((k) == TIME_PHASE) tp0_ = __builtin_amdgcn_s_memrealtime(); if ((k) == TIME_PHASE + 1) tp1_ = __builtin_amdgcn_s_memrealtime(); } while (0)
#else
#define TSTAMP(k) do { } while (0)
#endif
#define REP(k) for (int rep_ = 0; rep_ < 1 + ((REPEAT_MASK >> (k)) & 1); ++rep_)
#define BOTH(k) (IN(k) && IN((k) + 1))
#define GRID_BAR() xcd_barrier(bar)

    TSTAMP(0);
    if (IN(0)) REP(0) {
        PH_IDS();
#ifdef TIME_P0CK
        const unsigned long long tp0ck_ = __builtin_amdgcn_s_memrealtime();
#endif
        __syncthreads();
        LAS float* gt = (LAS float*)lds;
        { float gw_[16], gg_[16];
#pragma unroll
          for (int q = 0; q < 16; ++q) { const int i = tid + NTHREADS * q, k = i >> 3, j = i & 7; gw_[q] = p.w_in[(size_t)k * IN_DIM + C_I + j]; gg_[q] = p.norm_mix_g[k]; }
#pragma unroll
          for (int q = 0; q < 16; ++q) { const int i = tid + NTHREADS * q, k = i >> 3, j = i & 7; gt[j * 1024 + k] = gg_[q] * gw_[q]; } }
        { h16* wh = (h16*)(ws + OFF_WRT); h16* wl = wh + 48 * 1024;
          for (int i = bx * NTHREADS + tid; i < 48 * 1024; i += G * NTHREADS) { const int j = i >> 10, k = i & 1023; float w = 0.f; if (j < 36) w = p.norm_moe_g[k] * (j < 4 ? p.w_rg[k * 4 + j] : p.w_re[k * 32 + (j - 4)]);
              const h16 hi = (h16)w; wh[i] = hi; wl[i] = (h16)((w - (float)hi) * 4096.f); } }
        __syncthreads();
        float acc[8]; float bif[8];
#pragma unroll
        for (int h = 0; h < 8; ++h) bif[h] = p.b_if[h];
        {   f32x4 v[4], nv[4];
            if (gw < NTOK) {
#pragma unroll
                for (int j = 0; j < 4; ++j) v[j] = __builtin_nontemporal_load(((const GAS f32x4*)(p.x + (size_t)gw * DM) + lane) + 64 * j); }
            for (int m = gw; m < NTOK; m += NGW) {
                const int mn = (m + NGW < NTOK) ? m + NGW : m;
#pragma unroll
                for (int j = 0; j < 4; ++j) nv[j] = __builtin_nontemporal_load(((const GAS f32x4*)(p.x + (size_t)mn * DM) + lane) + 64 * j);
                asm volatile("" ::: "memory");
                const float ss = p0_row<true>(v, (h16*)(ws + WS_XH) + (size_t)m * DM, gt, acc, lane);
                const float rstd = rsqrtf(ss * (1.f / DM) + EPS);
                if (lane == 0) { ((float*)(ws + OFF_RSTD0))[m] = rstd; f32x4 igv, lfv;
#pragma unroll
                    for (int h = 0; h < 4; ++h) { igv[h] = acc[h] * rstd + bif[h]; { const float fx = acc[4 + h] * rstd + bif[4 + h]; lfv[h] = fminf(fx, 0.f) - __logf(1.f + __expf(-fabsf(fx))); } }
#pragma unroll
                    for (int h = 0; h < 4; ++h) { ((float*)(ws + OFF_IG))[h * NTOK + m] = igv[h]; ((float*)(ws + OFF_LF))[h * NTOK + m] = lfv[h]; } }
#pragma unroll
                for (int j = 0; j < 4; ++j) v[j] = nv[j];
            }
        }
#ifdef TIME_P0CK
        if (bx == 0 && threadIdx.x == 0) { const unsigned long long dt = (__builtin_amdgcn_s_memrealtime() - tp0ck_) * 10ull, t0_ = __builtin_amdgcn_s_memrealtime(); while (__builtin_amdgcn_s_memrealtime() - t0_ < dt) __builtin_amdgcn_s_sleep(8); }
#endif
        LAS unsigned char* scr = lds + 32768 + wave * 4096;
        { TpDecP0 dec{&p, ws}; tp_loop(dec, gw, (G >= 256) ? P0_ITEMS_WIN : P0_ITEMS_ALL, NGW, scr, lane); }
        if (BOTH(0)) GRID_BAR();
    }
    TSTAMP(1);
    if (IN(1)) REP(1) {
        PH_IDS();
        if (bx < 8) mstate_ext(ws, bx, wave, lane, (LAS float*)(lds + 131072));
        const bool stag = (G >= 256), grpB = ((bx >> 3) & 1) != 0; const int gidx = ((bx >> 4) << 3) + (bx & 7);
        if (stag && grpB) { int tid2 = threadIdx.x; asm volatile("" : "+v"(tid2)); const int wv = __builtin_amdgcn_readfirstlane(tid2 >> 6); TpDecW2 dec{&p, ws}; tp_loop(dec, gidx * NWAVES + wv, W2_EARLY, 128 * NWAVES, lds + wv * 4096, tid2 & 63); __syncthreads(); }
#ifdef TIME_KLOOP
        { pg8::StaticOrderDbl S; S.init(ws + WS_XH, ws + WS_WIN, NTOK, 8192, DM, G, bx);
          EpiProj E{(const float*)(ws + OFF_RSTD0), p.b_gate, (h16*)p.out, (h16*)(ws + WS_V), (h16*)(ws + WS_OG), (h16*)(ws + WS_UG), (h16*)(ws + WS_SV), (float*)(ws + OFF_PSV), rep_ == 0};
          pg8::gemm_phase<EpiProj, pg8::StaticOrderDbl, false, true>(lds, DM, S, E); }
#else
        { pg8::StaticOrder S; S.init(ws + WS_XH, ws + WS_WIN, NTOK, 8192, DM, G, bx);
          EpiProj E{(const float*)(ws + OFF_RSTD0), p.b_gate, (h16*)p.out, (h16*)(ws + WS_V), (h16*)(ws + WS_OG), (h16*)(ws + WS_UG), (h16*)(ws + WS_SV), (float*)(ws + OFF_PSV), rep_ == 0};
          pg8::gemm_phase<EpiProj, pg8::StaticOrder, false, true>(lds, DM, S, E); }
#endif
        if (stag && !grpB && bx >= 8) { int tid2 = threadIdx.x; asm volatile("" : "+v"(tid2)); const int wv = __builtin_amdgcn_readfirstlane(tid2 >> 6); TpDecP0 dec{&p, ws}; tp_loop(dec, P0_ITEMS_WIN + (gidx - 8) * NWAVES + wv, P0_ITEMS_ALL, 120 * NWAVES, lds + wv * 4096, tid2 & 63); __syncthreads(); }
        if (BOTH(1)) GRID_BAR();
    }

    TSTAMP(2);
    if (IN(2)) REP(2) {
#ifdef TIME_CUSTOM
        unsigned long long tc0_ = __builtin_amdgcn_s_memrealtime();
#endif
        if (G >= 256) { if (bx < 128) { scan_task(lds, p, ws, bx);
            { int tid2 = threadIdx.x; asm volatile("" : "+v"(tid2)); const int wv = __builtin_amdgcn_readfirstlane(tid2 >> 6); TpDecW13 dec13{&p, ws}; tp_loop(dec13, bx * NWAVES + wv, W13_SCAN_ITEMS, 128 * NWAVES, lds + wv * 4096, tid2 & 63); __syncthreads(); } }
          else if (bx < 256) { sgu_task(lds, p, ws, bx - 128); kv_task(lds, p, ws, bx - 128);
            { int tid2 = threadIdx.x; asm volatile("" : "+v"(tid2)); const int wv = __builtin_amdgcn_readfirstlane(tid2 >> 6); TpDecW2 dec{&p, ws}; tp_loop(dec, W2_EARLY + (bx - 128) * NWAVES + wv, 32 * 256, 128 * NWAVES, lds + wv * 4096, tid2 & 63);
              TpDecW13 dec13{&p, ws}; tp_loop(dec13, W13_SCAN_ITEMS + (bx - 128) * NWAVES + wv, W13_EARLY_E * 512, 128 * NWAVES, lds + wv * 4096, tid2 & 63); __syncthreads(); } } }
        else { for (int t = bx; t < 256; t += G) { if (t < 128) scan_task(lds, p, ws, t); else { sgu_task(lds, p, ws, t - 128); kv_task(lds, p, ws, t - 128);
            { int tid2 = threadIdx.x; asm volatile("" : "+v"(tid2)); const int wv = __builtin_amdgcn_readfirstlane(tid2 >> 6); TpDecW2 dec{&p, ws}; tp_loop(dec, (t - 128) * NWAVES + wv, 32 * 256, 128 * NWAVES, lds + wv * 4096, tid2 & 63); } } __syncthreads(); } }
#ifdef TIME_CUSTOM
        if (bx == TIME_CUSTOM && threadIdx.x == 0) { const unsigned long long dt = (__builtin_amdgcn_s_memrealtime() - tc0_) * 10ull, t0_ = __builtin_amdgcn_s_memrealtime(); while (__builtin_amdgcn_s_memrealtime() - t0_ < dt) __builtin_amdgcn_s_sleep(8); }
#endif
        if (BOTH(2)) GRID_BAR();
    }
    TSTAMP(3);
    if (IN(3)) REP(3) {
        mout_phase(lds, p, ws, G, bx, (((REPEAT_MASK >> 3) & 1) && rep_ == 0) ? (h16*)(ws + WS_UG) : (h16*)(ws + WS_XH));
        if (BOTH(3)) GRID_BAR();
    }
    TSTAMP(4);
    if (IN(4)) REP(4) {
        PH_IDS();
        const bool convFirst = ((bx >> 3) & 1) != 0;
        if (convFirst) { LAS unsigned char* scr = lds + 32768 + wave * 4096; TpDecW13 dec{&p, ws}; tp_loop(dec, ((G >= 256) ? W13_EARLY_E * 512 : 0) + gw, 32 * 512, NGW, scr, lane); __syncthreads(); }
        { pg8::StaticOrder S; S.init(ws + WS_XH, ws + WS_WSM, NTOK, DM, DM, G, bx);
          EpiResid<false> E{p.x, (h16*)(ws + WS_V), (float*)(ws + OFF_PS1), rep_ == 0};
          pg8::gemm_phase<EpiResid<false>, pg8::StaticOrder, false, false>(lds, DM, S, E); }
        if (!convFirst) { PH_IDS(); __syncthreads(); LAS unsigned char* scr = lds + 32768 + wave * 4096; TpDecW13 dec{&p, ws}; tp_loop(dec, ((G >= 256) ? W13_EARLY_E * 512 : 0) + gw, 32 * 512, NGW, scr, lane); __syncthreads(); }
        if (BOTH(4)) GRID_BAR();
    }
    TSTAMP(5);
    if (IN(5)) REP(5) {
        { pg8::StaticOrder S; S.init(ws + WS_V, ws + WS_WSM + 2097152, NTOK, DM, DM, G, bx);
          const LAS float* rsl = nullptr;
          { pg8::Unit u0; if (G * 1 == (NTOK / 256) * 4 && S.next(0, u0)) { LAS float* w = (LAS float*)(lds + LDSCTL_OFF + 2048); rsl = w;
              int t3 = threadIdx.x; asm volatile("" : "+v"(t3));
              if (t3 < 256) w[t3] = rsqrtf(sum16((const float*)(ws + OFF_PS1) + (size_t)(u0.pm * 256 + t3) * 16) * (1.f / DM) + EPS) * 0.0625f; } }
          EpiQ E{(const float*)(ws + OFF_PS1), (h16*)(ws + WS_XH), rsl};
          pg8::gemm_phase<EpiQ, pg8::StaticOrder, false, false>(lds, DM, S, E);
          if (G * 1 == (NTOK / 256) * 4 && IN(6)) { pg8::Unit u; if (S.next(0, u)) { __syncthreads();
#ifdef TIME_ATTN
              const unsigned long long ta0_ = __builtin_amdgcn_s_memrealtime();
#endif
              attn_pair<0>(lds, (const h16*)(ws + WS_XH), (const h16*)(ws + WS_KM), (const h16*)(ws + WS_VTM), (h16*)(ws + WS_OG), G, bx, u.pn, 2 * u.pm);
#ifdef ATTN_TWICE
              attn_pair<ATTN_TWICE>(lds, (const h16*)(ws + WS_XH), (const h16*)(ws + WS_KM), (const h16*)(ws + WS_VTM), (h16*)(ws + WS_OG), G, bx, u.pn, 2 * u.pm);
#endif
#ifdef TIME_ATTN
              if (bx == TIME_ATTN && threadIdx.x == 0) { const unsigned long long dt = (__builtin_amdgcn_s_memrealtime() - ta0_) * 10ull, t0_ = __builtin_amdgcn_s_memrealtime(); while (__builtin_amdgcn_s_memrealtime() - t0_ < dt) __builtin_amdgcn_s_sleep(8); }
#endif
          } } }
        if (BOTH(5) && !(G * 1 == (NTOK / 256) * 4 && IN(6))) GRID_BAR();
    }
    TSTAMP(6);
    if (IN(6) && !(G * 1 == (NTOK / 256) * 4 && IN(5))) REP(6) {
        attn_phase(lds, (const h16*)(ws + WS_XH), (const h16*)(ws + WS_KM), (const h16*)(ws + WS_VTM), (h16*)(ws + WS_OG), G, bx, -1, 0);
        if (BOTH(6)) GRID_BAR();
    }
    if (IN(6) && (G * 1 == (NTOK / 256) * 4 && IN(5))) { if (BOTH(6)) GRID_BAR(); }
    TSTAMP(7);
    if (IN(7)) {
        { pg8::StaticOrder S; S.init(ws + WS_OG, ws + WS_WSM + 4 * 2097152, NTOK, DM, DM, G, bx);
          EpiResid<true> E{(const void*)(ws + WS_V), (h16*)(ws + WS_V), (float*)(ws + OFF_PS2), true};
          pg8::gemm_phase<EpiResid<true>, pg8::StaticOrder, false, false>(lds, DM, S, E); }
        if (BOTH(7)) GRID_BAR();
    }
    TSTAMP(8);
    if (IN(8)) REP(8) {
        PH_IDS();
        if (rep_ == 1) { GRID_BAR(); if (bx == 0 && tid < 32) (ctl + CW_CNT)[tid * 64] = 0u; GRID_BAR(); }
        unsigned* cnt = ctl + CW_CNT; int* list = (int*)(ws + OFF_LIST); float* gate = (float*)(ws + OFF_GATE);
        const float* ps2 = (const float*)(ws + OFF_PS2); float* rstd2 = (float*)(ws + OFF_SS2); const h16* WH = (const h16*)(ws + OFF_WRT); const h16* X2 = (const h16*)(ws + WS_V);
        LAS unsigned char* wbuf = lds;
        LAS float* lg = (LAS float*)(lds + 49152);
        LAS unsigned* lc = (LAS unsigned*)(lds + 49152 + 12288);
        LAS int* ent = (LAS int*)(lds + 49152 + 12288 + 256);
        LAS float* rsl = (LAS float*)(lds + 49152 + 12288 + 256 + 1024);
        float* lrs = (float*)(ws + WS_KM); float* lgate = (float*)(ws + WS_WSM);
        const int fr = lane & 15, fq = lane >> 4;
        for (int rg = bx; rg < NTOK / 64; rg += G) {
            __syncthreads();
            if (tid < 64) lc[tid] = 0u;
            const int trow = 64 * rg + 16 * wave + fr;
            f32x4 ah[3], al[3];
#pragma unroll
            for (int j = 0; j < 3; ++j) { ah[j] = (f32x4){0.f, 0.f, 0.f, 0.f}; al[j] = (f32x4){0.f, 0.f, 0.f, 0.f}; }
            u32x4 wst[3];
#define RT_LOADW(kc_) do { _Pragma("unroll") for (int q = 0; q < 3; ++q) { const int pc = tid + 512 * q, hl = pc / 768, rem = pc % 768, row = rem >> 4, ch = rem & 15; \
                wst[q] = *(const u32x4*)(WH + (size_t)hl * 48 * 1024 + (size_t)row * 1024 + (kc_) * 128 + ch * 8); } } while (0)
#define RT_STOREW(buf_) do { _Pragma("unroll") for (int q = 0; q < 3; ++q) { const int pc = tid + 512 * q, hl = pc / 768, rem = pc % 768, row = rem >> 4, ch = rem & 15; \
                *(LAS u32x4*)(wbuf + (buf_) * 24576 + hl * 12288 + row * 256 + ((ch ^ (row & 15)) * 16)) = wst[q]; } } while (0)
            RT_LOADW(0);
            h16x8 xall[32];
            if (wave < 4) {
#pragma unroll
                for (int i = 0; i < 32; ++i) xall[i] = *(const h16x8*)(X2 + (size_t)trow * DM + 32 * i + 8 * fq); }
#pragma unroll
            for (int kc = 0; kc < 8; ++kc) {
                RT_STOREW(kc & 1);
                __syncthreads();
                if (kc + 1 < 8) RT_LOADW(kc + 1);
                if (wave < 4) { const LAS unsigned char* wb = wbuf + (kc & 1) * 24576;
#pragma unroll
                    for (int ks = 0; ks < 4; ++ks)
#pragma unroll
                        for (int j = 0; j < 3; ++j) { const int row = 16 * j + fr; const int off = row * 256 + (((4 * ks + fq) ^ (row & 15)) * 16);
                            const h16x8 xh = *(const LAS h16x8*)(wb + off), xl = *(const LAS h16x8*)(wb + 12288 + off);
                            ah[j] = __builtin_amdgcn_mfma_f32_16x16x32_f16(xh, xall[4 * kc + ks], ah[j], 0, 0, 0); al[j] = __builtin_amdgcn_mfma_f32_16x16x32_f16(xl, xall[4 * kc + ks], al[j], 0, 0, 0); } }
            }
#undef RT_LOADW
#undef RT_STOREW
            if (wave < 4) { const float rs = rsqrtf(sum16(ps2 + (size_t)trow * 16) * (1.f / DM) + EPS); if (fq == 0) { rstd2[trow] = rs; rsl[16 * wave + fr] = rs; }
#pragma unroll
                for (int j = 0; j < 3; ++j) { const f32x4 v = (ah[j] + al[j] * (1.f / 4096.f)) * rs; *(LAS f32x4*)(lg + (16 * wave + fr) * 48 + 16 * j + 4 * fq) = v; } }
            __syncthreads();
            if (tid < 64) { const LAS float* lr = lg + tid * 48; const int t = 64 * rg + tid;
                float gl[4];
#pragma unroll
                for (int j = 0; j < 4; ++j) gl[j] = lr[j] + p.b_rg[j];
                int gi = 0; float gm = gl[0];
#pragma unroll
                for (int j = 1; j < 4; ++j) if (gl[j] > gm) { gm = gl[j]; gi = j; }
                float gs = 0.f;
#pragma unroll
                for (int j = 0; j < 4; ++j) gs += __expf(gl[j] - gm);
                const float pg = 1.f / gs;
                int i1 = 0, i2 = -1; float v1 = -INFINITY, v2 = -INFINITY;
#pragma unroll
                for (int q = 0; q < 8; ++q) { const float ev = lr[4 + gi * 8 + q] + p.b_re[gi * 8 + q]; if (ev > v1) { v2 = v1; i2 = i1; v1 = ev; i1 = q; } else if (ev > v2) { v2 = ev; i2 = q; } }
                const float e2 = __expf(v2 - v1), g1 = pg / (1.f + e2), g2 = pg * e2 / (1.f + e2);
                ent[2 * tid] = gi * 8 + i1; ent[2 * tid + 1] = gi * 8 + i2; ent[128 + 2 * tid] = __float_as_int(g1); ent[128 + 2 * tid + 1] = __float_as_int(g2); (void)t; }
            __syncthreads();
            unsigned lpos = 0u; int myE = 0;
            if (tid < 128) { myE = ent[tid]; lpos = __hip_atomic_fetch_add(&lc[myE], 1u, __ATOMIC_RELAXED, __HIP_MEMORY_SCOPE_WORKGROUP); }
            __syncthreads();
            if (tid < 32) { const unsigned c2 = lc[tid]; lc[32 + tid] = c2 ? atomicAdd(cnt + tid * 64, c2) : 0u; }
            __syncthreads();
            if (tid < 128) { const unsigned pos = lc[32 + myE] + lpos; const int slot = 2 * (64 * rg + (tid >> 1)) + (tid & 1); list[myE * NTOK + pos] = slot; lrs[myE * NTOK + pos] = rsl[tid >> 1]; lgate[myE * NTOK + pos] = __int_as_float(ent[128 + tid]); }
        }
        if (BOTH(8)) GRID_BAR();
    }
    TSTAMP(9);
    if (IN(9) || IN(10)) {
        PH_IDS();
        LAS int* tab = (LAS int*)(lds + LDSCTL_OFF + 1024);
        if (tid < 64) {
            const unsigned* cnt = ctl + CW_CNT; const int nb = (lane < 32) ? (int)((__hip_atomic_load(cnt + (lane & 31) * 64, RLX_AGENT) + 255u) >> 8) : 0; int inc = nb;
#pragma unroll
            for (int d = 1; d < 32; d <<= 1) { const int o = __shfl_up(inc, d); if (lane >= d) inc += o; }
            if (lane < 32) tab[lane] = inc - nb; if (lane == 31) tab[32] = inc; }
        __syncthreads();
        if (IN(9)) REP(9) {
            MoeOrder S{(const char*)(ws + WS_V), (const char*)(ws + WS_UG), DM, (size_t)1024 * 1024 * 2, (const int*)(ws + OFF_LIST), ctl + CW_CNT, tab, G, bx, (const char*)(ws + WS_WIN), W13_EARLY_E};
            EpiFfn1 E{(const int*)(ws + OFF_LIST), (const float*)(ws + WS_KM), (h16*)(ws + WS_H)};
            pg8::gemm_phase<EpiFfn1, MoeOrder, true, true>(lds, DM, S, E);
            if (BOTH(9)) GRID_BAR();
        }
        TSTAMP(10);
        if (IN(10)) REP(10) {
            MoeOrder S{(const char*)(ws + WS_H), (const char*)(ws + WS_W2T), FF, (size_t)1024 * 512 * 2, (const int*)(ws + OFF_LIST), ctl + CW_CNT, tab, G, bx, (const char*)(ws + WS_W2T), 0};
            EpiFfn2 E{(const int*)(ws + OFF_LIST), (const float*)(ws + WS_WSM), (h16*)p.out};
            pg8::gemm_phase<EpiFfn2, MoeOrder, false, true>(lds, FF, S, E);
            if (BOTH(10)) GRID_BAR();
        }
    }
    TSTAMP(11);
    if (IN(11)) REP(11) {
        PH_IDS();
        float* fdst = (((REPEAT_MASK >> 11) & 1) && rep_ == 0) ? (float*)(ws + WS_UG) : p.out;
        h16x4 xa[4], nxa[4]; u32x2 ya[4], yb[4], nya[4], nyb[4];
#define F_LOAD(t_, X_, A_, B_) do { const GAS h16x4* xr_ = (const GAS h16x4*)((const h16*)(ws + WS_V) + (size_t)(t_) * DM) + lane; const GAS u32x2* y0_ = (const GAS u32x2*)((const unsigned char*)p.out + (size_t)(2 * (t_)) * DM * 2) + lane; \
            _Pragma("unroll") for (int j = 0; j < 4; ++j) { X_[j] = xr_[64 * j]; A_[j] = y0_[64 * j]; B_[j] = y0_[64 * j + DM / 4]; } } while (0)
        if (gw < NTOK) F_LOAD(gw, xa, ya, yb);
        for (int t = gw; t < NTOK; t += NGW) {
            const int tn = (t + NGW < NTOK) ? t + NGW : t;
            F_LOAD(tn, nxa, nya, nyb);
            asm volatile("" ::: "memory");
            f32x4 v[4]; float ss = 0.f;
#pragma unroll
            for (int j = 0; j < 4; ++j) { const h16x4 ha = __builtin_bit_cast(h16x4, ya[j]), hb = __builtin_bit_cast(h16x4, yb[j]); v[j] = __builtin_convertvector(xa[j], f32x4);
#pragma unroll
                for (int c = 0; c < 4; ++c) { v[j][c] += (float)ha[c] + (float)hb[c]; ss += v[j][c] * v[j][c]; } }
            ss = wave_sum(ss); const float rs = rsqrtf(ss * (1.f / DM) + EPS);
            if (tn != t) {
#pragma unroll
                for (int j = 0; j < 4; ++j) { const f32x4 g = *(const f32x4*)(p.norm_f_g + 4 * (64 * j + lane)); ((GAS f32x4*)(fdst + (size_t)t * DM) + lane)[64 * j] = v[j] * rs * g; }
            } else {
#pragma unroll
                for (int j = 0; j < 4; ++j) { const f32x4 g = *(const f32x4*)(p.norm_f_g + 4 * (64 * j + lane)); ((GAS f32x4*)(fdst + (size_t)t * DM) + lane)[64 * j] = v[j] * rs * g; }
            }
#pragma unroll
            for (int j = 0; j < 4; ++j) { xa[j] = nxa[j]; ya[j] = nya[j]; yb[j] = nyb[j]; }
        }
#undef F_LOAD
    }
    TSTAMP(12);
#ifdef TIME_PHASE
    if (bx == 0 && threadIdx.x == 0) { const unsigned long long dt = (tp1_ - tp0_) * 10ull, t0_ = __builtin_amdgcn_s_memrealtime(); while (__builtin_amdgcn_s_memrealtime() - t0_ < dt) __builtin_amdgcn_s_sleep(8); }
#endif
#ifdef EXTRA_BARS
    for (int i = 0; i < EXTRA_BARS; ++i) GRID_BAR();
#endif
#undef IN
#undef BOTH
#undef GRID_BAR
}

static int mega_grid() {
    static int grid = 0;
    if (grid == 0) {
        int dev = 0, cus = 0;
        if (hipGetDevice(&dev) != hipSuccess || hipDeviceGetAttribute(&cus, hipDeviceAttributeMultiprocessorCount, dev) != hipSuccess) { grid = -1; return grid; }
        if (hipFuncSetAttribute((const void*)mega, hipFuncAttributeMaxDynamicSharedMemorySize, LDS_BYTES) != hipSuccess) { fprintf(stderr, "hipFuncSetAttribute failed\n"); grid = -1; return grid; }
        (void)hipGetLastError();
        grid = cus;
    }
    return grid;
}
static void launch_mega(const Ptrs& p, int lo, int hi, int li, hipStream_t stream) {
    const int grid = mega_grid(); if (grid <= 0) return;
    Args a{}; a.p = p; a.ph_lo = lo; a.ph_hi = hi; a.li = li; a.pad = 0;
    hipLaunchKernelGGL(mega, dim3(grid), dim3(NTHREADS), LDS_BYTES, stream, a);
}

extern "C" void kernel_launch(void* const* d_in, const int* in_sizes, int n_in, void* d_out, int out_size, void* d_ws, size_t ws_size, hipStream_t stream) {
    if (n_in != 27 || ws_size < WS_END) { fprintf(stderr, "kernel_launch: unexpected n_in %d or ws_size %zu (< %zu)\n", n_in, ws_size, (size_t)WS_END); return; }
    Ptrs p{};
    const float** f = (const float**)&p;
    for (int i = 0; i < 27; ++i) f[i] = (const float*)d_in[i];
    p.out = (float*)d_out; p.ws = (unsigned char*)d_ws;
    (void)hipMemsetAsync((char*)d_ws + WS_CTL, 0, CTL_BYTES, stream);
    launch_mega(p, 0, 12, 0, stream);
}
```
